# Optimizing an MI355X kernel written in HIP

```python
import math
import jax, jax.numpy as jnp
from jax import lax
import numpy as np

D_MODEL = 1024
BATCH = 8
SEQ = 4096
DEPTH = 1

DIFF_QK_DIM = 64
DIFF_V_DIM = 2 * DIFF_QK_DIM
N_DIFF_HEADS = (D_MODEL // 2) // DIFF_V_DIM
FOX_HEAD_DIM = 64
N_FOX_HEADS = (D_MODEL // 2) // FOX_HEAD_DIM
DIFF_QK_W = N_DIFF_HEADS * 2 * DIFF_QK_DIM
DIFF_V_W = N_DIFF_HEADS * DIFF_V_DIM
FOX_W = N_FOX_HEADS * FOX_HEAD_DIM
MIX_W = DIFF_V_W + FOX_W
IN_W = 2 * DIFF_QK_W + DIFF_V_W + 3 * FOX_W + N_FOX_HEADS

N_MEM = 256
N_CROSS_HEADS = 4
CROSS_HEAD_DIM = D_MODEL // N_CROSS_HEADS
D_FF = 4 * D_MODEL
ROPE_THETA = 500000.0
ROT_DIM = DIFF_QK_DIM // 4
Q_BLOCK = 128
EPS = 1e-6
SUBLN_EPS = 1e-5

kernel_name = "hymba_diff_fox_hybrid_layer"


def rmsnorm(x, g, eps=EPS):
    xf = x.astype(jnp.float32)
    y = xf * lax.rsqrt(jnp.mean(xf * xf, axis=-1, keepdims=True) + eps)
    return (y * g.astype(jnp.float32)).astype(x.dtype)


def rope_tables(seq):
    pos = jnp.arange(seq, dtype=jnp.float32)
    inv_freq = ROPE_THETA ** (-jnp.arange(0, ROT_DIM, 2, dtype=jnp.float32) / ROT_DIM)
    ang = pos[:, None] * inv_freq[None, :]
    return jnp.cos(ang), jnp.sin(ang)


def apply_partial_rope(x, cos, sin):
    half = ROT_DIM // 2
    c = cos.astype(x.dtype)
    s = sin.astype(x.dtype)
    x1 = x[..., :half]
    x2 = x[..., half:ROT_DIM]
    return jnp.concatenate([x1 * c - x2 * s, x2 * c + x1 * s, x[..., ROT_DIM:]], axis=-1)


def causal_block_mask(start, end):
    qpos = start + jnp.arange(Q_BLOCK)[:, None]
    kpos = jnp.arange(end)[None, :]
    return kpos <= qpos


def diff_attention(q, k, v, lam):
    seq = q.shape[3]
    scale = DIFF_QK_DIM ** -0.5
    neg = jnp.finfo(jnp.float32).min
    outs = []
    for start in range(0, seq, Q_BLOCK):
        end = start + Q_BLOCK
        s = jnp.einsum('bhmqd,bhmkd->bhmqk', q[:, :, :, start:end], k[:, :, :, :end]).astype(jnp.float32) * scale
        s = jnp.where(causal_block_mask(start, end), s, neg)
        p = jax.nn.softmax(s, axis=-1)
        a = p[:, :, 0] - lam * p[:, :, 1]
        outs.append(jnp.einsum('bhqk,bhkd->bhqd', a.astype(v.dtype), v[:, :, :end]))
    return jnp.concatenate(outs, axis=2)


def forgetting_attention(q, k, v, log_f):
    seq = q.shape[2]
    scale = FOX_HEAD_DIM ** -0.5
    neg = jnp.finfo(jnp.float32).min
    c = jnp.cumsum(log_f, axis=-1)
    outs = []
    for start in range(0, seq, Q_BLOCK):
        end = start + Q_BLOCK
        s = jnp.einsum('bhqd,bhkd->bhqk', q[:, :, start:end], k[:, :, :end]).astype(jnp.float32) * scale
        s = s + c[:, :, start:end, None] - c[:, :, None, :end]
        s = jnp.where(causal_block_mask(start, end), s, neg)
        p = jax.nn.softmax(s, axis=-1)
        outs.append(jnp.einsum('bhqk,bhkd->bhqd', p.astype(v.dtype), v[:, :, :end]))
    return jnp.concatenate(outs, axis=2)


def setup_inputs(seed: int = 0) -> dict:
    key = jax.random.key(seed)
    ks = jax.random.split(key, 24)
    f32 = jnp.float32
    nrm = lambda k, shape, scale: jax.random.normal(k, shape, f32) * scale
    gain = lambda k, shape: 1.0 + 0.02 * jax.random.normal(k, shape, f32)
    return {
        "x": jax.random.normal(ks[0], (BATCH, SEQ, D_MODEL), f32),
        "mem": jax.random.normal(ks[1], (BATCH, N_MEM, D_MODEL), f32),
        "norm_mix_g": gain(ks[2], (DEPTH, D_MODEL)),
        "w_in": nrm(ks[3], (DEPTH, D_MODEL, IN_W), D_MODEL ** -0.5),
        "b_forget": 1.0 + 0.3 * jax.random.normal(ks[4], (DEPTH, N_FOX_HEADS), f32),
        "lam_q1": nrm(ks[5], (DEPTH, DIFF_QK_DIM), 0.1),
        "lam_k1": nrm(ks[6], (DEPTH, DIFF_QK_DIM), 0.1),
        "lam_q2": nrm(ks[7], (DEPTH, DIFF_QK_DIM), 0.1),
        "lam_k2": nrm(ks[8], (DEPTH, DIFF_QK_DIM), 0.1),
        "diff_subln_g": gain(ks[9], (DEPTH, DIFF_V_DIM)),
        "fox_out_g": gain(ks[10], (DEPTH, FOX_HEAD_DIM)),
        "w_out": nrm(ks[11], (DEPTH, MIX_W, D_MODEL), MIX_W ** -0.5),
        "norm_cross_g": gain(ks[12], (DEPTH, D_MODEL)),
        "norm_mem_g": gain(ks[13], (DEPTH, D_MODEL)),
        "w_cq": nrm(ks[14], (DEPTH, D_MODEL, D_MODEL), D_MODEL ** -0.5),
        "w_ckv": nrm(ks[15], (DEPTH, D_MODEL, 2 * D_MODEL), D_MODEL ** -0.5),
        "w_co": nrm(ks[16], (DEPTH, D_MODEL, D_MODEL), D_MODEL ** -0.5),
        "norm_mlp_g": gain(ks[17], (DEPTH, D_MODEL)),
        "w_up": nrm(ks[18], (DEPTH, D_MODEL, D_FF), D_MODEL ** -0.5),
        "w_down": nrm(ks[19], (DEPTH, D_FF, D_MODEL), D_FF ** -0.5),
        "norm_final_g": gain(ks[20], (D_MODEL,)),
    }


def reference(x, mem, norm_mix_g, w_in, b_forget, lam_q1, lam_k1, lam_q2, lam_k2,
              diff_subln_g, fox_out_g, w_out, norm_cross_g, norm_mem_g, w_cq, w_ckv, w_co,
              norm_mlp_g, w_up, w_down, norm_final_g):
    B, S, D = x.shape
    M = mem.shape[1]
    cos, sin = rope_tables(S)
    cos = cos[:, None, None, :]
    sin = sin[:, None, None, :]
    split_pts = [DIFF_QK_W, 2 * DIFF_QK_W, 2 * DIFF_QK_W + DIFF_V_W,
                 2 * DIFF_QK_W + DIFF_V_W + FOX_W, 2 * DIFF_QK_W + DIFF_V_W + 2 * FOX_W,
                 2 * DIFF_QK_W + DIFF_V_W + 3 * FOX_W]
    h = x
    for l in range(DEPTH):
        u = rmsnorm(h, norm_mix_g[l])
        proj = u @ w_in[l]
        dq, dk, dv, fq, fk, fv, fgate = jnp.split(proj, split_pts, axis=-1)

        lambda_init = 0.8 - 0.6 * math.exp(-0.3 * l)
        lam = (jnp.exp(jnp.sum(lam_q1[l].astype(jnp.float32) * lam_k1[l].astype(jnp.float32)))
               - jnp.exp(jnp.sum(lam_q2[l].astype(jnp.float32) * lam_k2[l].astype(jnp.float32)))
               + lambda_init)
        dq = apply_partial_rope(dq.reshape(B, S, N_DIFF_HEADS, 2, DIFF_QK_DIM), cos, sin)
        dk = apply_partial_rope(dk.reshape(B, S, N_DIFF_HEADS, 2, DIFF_QK_DIM), cos, sin)
        dv = dv.reshape(B, S, N_DIFF_HEADS, DIFF_V_DIM).transpose(0, 2, 1, 3)
        d_out = diff_attention(dq.transpose(0, 2, 3, 1, 4), dk.transpose(0, 2, 3, 1, 4), dv, lam)
        d_out = rmsnorm(d_out, diff_subln_g[l], SUBLN_EPS) * (1.0 - lambda_init)
        d_out = d_out.transpose(0, 2, 1, 3).reshape(B, S, DIFF_V_W)

        log_f = jax.nn.log_sigmoid((fgate + b_forget[l]).astype(jnp.float32)).transpose(0, 2, 1)
        to_heads = lambda t: t.reshape(B, S, N_FOX_HEADS, FOX_HEAD_DIM).transpose(0, 2, 1, 3)
        f_out = forgetting_attention(to_heads(fq), to_heads(fk), to_heads(fv), log_f)
        f_out = rmsnorm(f_out, fox_out_g[l])
        f_out = f_out.transpose(0, 2, 1, 3).reshape(B, S, FOX_W)

        h = h + jnp.concatenate([d_out, f_out], axis=-1) @ w_out[l]

        cq = (rmsnorm(h, norm_cross_g[l]) @ w_cq[l]).reshape(B, S, N_CROSS_HEADS, CROSS_HEAD_DIM)
        ckv = rmsnorm(mem, norm_mem_g[l]) @ w_ckv[l]
        ck, cv = jnp.split(ckv, 2, axis=-1)
        ck = ck.reshape(B, M, N_CROSS_HEADS, CROSS_HEAD_DIM)
        cv = cv.reshape(B, M, N_CROSS_HEADS, CROSS_HEAD_DIM)
        cs = jnp.einsum('bshd,bmhd->bhsm', cq, ck).astype(jnp.float32) * (CROSS_HEAD_DIM ** -0.5)
        cp = jax.nn.softmax(cs, axis=-1).astype(cv.dtype)
        co = jnp.einsum('bhsm,bmhd->bshd', cp, cv).reshape(B, S, D)
        h = h + co @ w_co[l]

        z = rmsnorm(h, norm_mlp_g[l]) @ w_up[l]
        h = h + jnp.square(jax.nn.relu(z)) @ w_down[l]
    return rmsnorm(h, norm_final_g)
```

```cpp
#include <hip/hip_runtime.h>
#include <hip/hip_cooperative_groups.h>
#include <hip/hip_bf16.h>
#include <cstdio>
#include <cstdint>
#include <cmath>
namespace cg = cooperative_groups;
__device__ __forceinline__ int mk_lane() { int l = (int)__builtin_amdgcn_mbcnt_hi(~0u, __builtin_amdgcn_mbcnt_lo(~0u, 0u)); asm volatile("" : "+v"(l)); return l; }
namespace pg8 {
#define PG8_LAS __attribute__((address_space(3)))
typedef unsigned short bf16_t;
typedef short bf16x8 __attribute__((ext_vector_type(8)));
typedef float f32x4 __attribute__((ext_vector_type(4)));
typedef unsigned u32x4 __attribute__((ext_vector_type(4)));
constexpr int BM = 256, BK = 64, HALF = 128, HTB = HALF * BK * 2  , STAGE_BYTES = 8 * HTB, NXCD = 8, WGM = 8;

__host__ __device__ __forceinline__ int lds_byte(int r, int c) { const int st = (r >> 4) * 2 + (c >> 5), rr = r & 15, cc = c & 31, ob = rr * 64 + cc * 2; return st * 1024 + (ob ^ (((ob >> 9) & 1) << 5)); }
__host__ __device__ __forceinline__ void stage_rc(int b, int& R, int& C) { const int st = b / 1024, sb = b % 1024, swz = sb ^ (((sb >> 9) & 1) << 5); R = (st >> 1) * 16 + swz / 64; C = (st & 1) * 32 + (swz % 64) / 2; }
__host__ __device__ __forceinline__ int perm32(int rho) { const int n = rho >> 4, i = rho & 15; return 8 * (i >> 2) + 4 * n + (i & 3); }

struct Unit { int pm, pn; };
struct Gemm { const bf16_t* A; const bf16_t* Bt; int M, N, K; };

struct StaticOrder {
    int nM, nN, nwg, G, c; bool rev = false;
    __host__ __device__ __forceinline__ void init(int M, int N, int G_, int c_) { nM = M / BM; nN = N / BM; nwg = nM * nN; G = G_; c = c_; }
    __host__ __device__ __forceinline__ bool next(int i, Unit& u) const {
        const long L = (long)i * G + c; if (L >= nwg) return false;
        int wgid = (int)L; { const int q = nwg / NXCD, r = nwg % NXCD, xcd = wgid % NXCD, off = wgid / NXCD; wgid = (xcd < r ? xcd * (q + 1) : r * (q + 1) + (xcd - r) * q) + off; }
        const int nig = WGM * nN, gid = wgid / nig, fm = gid * WGM, gsz = (nM - fm) < WGM ? (nM - fm) : WGM;
        u.pm = fm + ((wgid % nig) % gsz); u.pn = (wgid % nig) / gsz; if (rev) u.pm = nM - 1 - u.pm; return true;
    }
    __device__ __forceinline__ void a_ready(const Unit&) const {}
    __device__ __forceinline__ void done(const Unit&) const {}
};

__device__ __forceinline__ unsigned cvt_pk_bf16(float lo, float hi) { unsigned r; asm volatile("v_cvt_pk_bf16_f32 %0, %1, %2" : "=v"(r) : "v"(lo), "v"(hi)); return r; }
typedef float f32x2 __attribute__((ext_vector_type(2)));
__device__ __forceinline__ f32x2 gelu_pk(f32x2 v) {
    const f32x2 av = __builtin_elementwise_abs(v), d = av * 0.2316418882f + 1.0f;
    f32x2 t; t.x = __builtin_amdgcn_rcpf(d.x); t.y = __builtin_amdgcn_rcpf(d.y);
    f32x2 q = t * 0.5307027145f + (-0.7265760135f); q = q * t + 0.7107068705f; q = q * t + (-0.142248368f); q = q * t + 0.127414796f; q = q * t;
    const f32x2 s = (v * v) * (-0.72134752044f);
    f32x2 e; e.x = __builtin_amdgcn_exp2f(s.x); e.y = __builtin_amdgcn_exp2f(s.y);
    const f32x2 m = v * (q * e), r = v - m;
    f32x2 o; o.x = v.x < 0.f ? m.x : r.x; o.y = v.y < 0.f ? m.y : r.y; return o;
}

template <int ACT  > struct EpiBf16 {
    static constexpr bool PERM = true, AFTER_DRAIN = false; static_assert(ACT == 0 || ACT == 1, "EpiBf16: ACT is 0 (none) or 1 (gelu_pk)");
    bf16_t* O; int ldc; const float* bias; int split_cols; size_t split_stride; float scale0;
    __device__ __forceinline__ void operator()(const f32x4 (&acc)[2][2][4][2], const Unit& u, int wr, int wc, int fr, int fq) const {
        const int row0 = u.pm * BM + wr * 64 + fr; int colt = u.pn * BM; bf16_t* base = O;
        float sc = 1.f; if (split_cols) { const int t = colt / split_cols; base += (size_t)t * split_stride; colt -= t * split_cols; if (t == 0) sc = scale0; }
        const int col0 = colt + wc * 32 + 8 * fq, bcol0 = u.pn * BM + wc * 32 + 8 * fq;
        f32x4 bv[2][2];
#pragma unroll
        for (int bj = 0; bj < 2; ++bj)
#pragma unroll
            for (int n = 0; n < 2; ++n) bv[bj][n] = bias ? *(const f32x4*)(bias + bcol0 + bj * HALF + 4 * n) : (f32x4){0.f, 0.f, 0.f, 0.f};
#pragma unroll
        for (int ai = 0; ai < 2; ++ai)
#pragma unroll
            for (int m = 0; m < 4; ++m) { bf16_t* rowp = base + (size_t)(row0 + ai * HALF + m * 16) * ldc + col0;
#pragma unroll
                for (int bj = 0; bj < 2; ++bj) { f32x4 v0 = acc[ai][bj][m][0] + bv[bj][0], v1 = acc[ai][bj][m][1] + bv[bj][1];
                    if (ACT == 1) { f32x2 a = gelu_pk((f32x2){v0[0], v0[1]}), b = gelu_pk((f32x2){v0[2], v0[3]}), c = gelu_pk((f32x2){v1[0], v1[1]}), d = gelu_pk((f32x2){v1[2], v1[3]});
                        v0 = (f32x4){a.x, a.y, b.x, b.y}; v1 = (f32x4){c.x, c.y, d.x, d.y}; }
                    v0 = v0 * sc; v1 = v1 * sc; u32x4 w; w.x = cvt_pk_bf16(v0[0], v0[1]); w.y = cvt_pk_bf16(v0[2], v0[3]); w.z = cvt_pk_bf16(v1[0], v1[1]); w.w = cvt_pk_bf16(v1[2], v1[3]);
                    *(u32x4*)(rowp + bj * HALF) = w; } }
    }
};

constexpr float QK_C2 = 0.125f * 1.4426950408889634f;
constexpr float CROSS_C2 = 0.0625f * 1.4426950408889634f;
__device__ __forceinline__ float row_rstd(const float* part, int row, float eps) {
    const f32x4* p = (const f32x4*)(part + (size_t)row * 16);
    const f32x4 a = p[0], b = p[1], c = p[2], d = p[3];
    const float s = ((a[0] + a[1]) + (a[2] + a[3])) + ((b[0] + b[1]) + (b[2] + b[3])) + ((c[0] + c[1]) + (c[2] + c[3])) + ((d[0] + d[1]) + (d[2] + d[3]));
    return 1.0f / sqrtf(s * (1.0f / 1024.0f) + eps);
}
struct EpiProj {
    static constexpr bool PERM = true, AFTER_DRAIN = false;
    bf16_t* O; const float* rope; float* nrm;
    __device__ __forceinline__ void operator()(const f32x4 (&acc)[2][2][4][2], const Unit& u, int wr, int wc, int fr, int fq) const {
        const int row0 = u.pm * BM + wr * 64 + fr, col0 = u.pn * BM + wc * 32 + 8 * fq;
        const int typ = u.pn >> 1;
        const float sc = (typ == 0 || typ == 3) ? QK_C2 : 1.f;
        const bool ropew = (typ < 2) && ((wc & 1) == 0);
        const bool nrmw = (typ == 3 || typ == 4); float mxn[2] = {0.f, 0.f};
#pragma unroll
        for (int ai = 0; ai < 2; ++ai) {
            f32x4 rc[4][4];
            if (ropew) {
#pragma unroll
                for (int m = 0; m < 4; ++m) { const f32x4* rp = (const f32x4*)(rope + (size_t)((row0 + ai * HALF + m * 16) & 4095) * 16); rc[m][0] = rp[0]; rc[m][1] = rp[1]; rc[m][2] = rp[2]; rc[m][3] = rp[3]; }
            }
#pragma unroll
            for (int m = 0; m < 4; ++m) {
                const int row = row0 + ai * HALF + m * 16;
                bf16_t* rowp = O + (size_t)row * 3072 + col0;
                f32x4 c0 = {1.f, 1.f, 1.f, 1.f}, c1 = c0, s0 = {0.f, 0.f, 0.f, 0.f}, s1 = s0;
                if (ropew) { c0 = rc[m][0]; c1 = rc[m][1]; s0 = rc[m][2]; s1 = rc[m][3]; if (fq == 0) { s0 = -s0; s1 = -s1; } if (fq >= 2) { c0 = (f32x4){1.f, 1.f, 1.f, 1.f}; c1 = c0; s0 = (f32x4){0.f, 0.f, 0.f, 0.f}; s1 = s0; } }
#pragma unroll
                for (int bj = 0; bj < 2; ++bj) {
                    f32x4 v0 = acc[ai][bj][m][0], v1 = acc[ai][bj][m][1];
                    if (ropew) {
                        f32x4 p0, p1;
#pragma unroll
                        for (int e = 0; e < 4; ++e) { p0[e] = __shfl_xor(v0[e], 16); p1[e] = __shfl_xor(v1[e], 16); }
                        v0 = v0 * c0 + p0 * s0; v1 = v1 * c1 + p1 * s1;
                    }
                    v0 = v0 * sc; v1 = v1 * sc;
                    if (nrmw) { float q = (v0[0] * v0[0] + v0[1] * v0[1]) + (v0[2] * v0[2] + v0[3] * v0[3]) + (v1[0] * v1[0] + v1[1] * v1[1]) + (v1[2] * v1[2] + v1[3] * v1[3]);
                        q += __shfl_xor(q, 16); q += __shfl_xor(q, 32); mxn[bj] = fmaxf(mxn[bj], q); }
                    u32x4 w; w.x = cvt_pk_bf16(v0[0], v0[1]); w.y = cvt_pk_bf16(v0[2], v0[3]); w.z = cvt_pk_bf16(v1[0], v1[1]); w.w = cvt_pk_bf16(v1[2], v1[3]);
                    *(u32x4*)(rowp + bj * HALF) = w;
                }
            }
        }
        if (nrmw) {
#pragma unroll
            for (int bj = 0; bj < 2; ++bj) { float q = mxn[bj];
                q = fmaxf(q, __shfl_xor(q, 1)); q = fmaxf(q, __shfl_xor(q, 2)); q = fmaxf(q, __shfl_xor(q, 4)); q = fmaxf(q, __shfl_xor(q, 8));
                const int rel = 256 * (u.pn & 1) + 128 * bj + 32 * wc, b = (u.pm * BM) >> 12;
                if (fr == 0 && fq == 0) atomicMax((unsigned*)nrm + ((b * 2 + (typ - 3)) * 8 + (rel >> 6)) * 2 + ((rel >> 5) & 1), __float_as_uint(q * 1.02f)); }
        }
    }
};
template <bool BASE_BF16, bool OUT_BF16> struct EpiRes2 {
    static constexpr bool PERM = true, AFTER_DRAIN = false;
    const void* base; void* out; float* sspart;
    __device__ __forceinline__ void operator()(const f32x4 (&acc)[2][2][4][2], const Unit& u, int wr, int wc, int fr, int fq) const {
        const int row0 = u.pm * BM + wr * 64 + fr, col0 = u.pn * BM + wc * 32 + 8 * fq;
#pragma unroll
        for (int ai = 0; ai < 2; ++ai) {
            u32x4 bw[4][2]; f32x4 bf[4][2][2];
#pragma unroll
            for (int m = 0; m < 4; ++m)
#pragma unroll
                for (int bj = 0; bj < 2; ++bj) { const size_t off = (size_t)(row0 + ai * HALF + m * 16) * 1024 + col0 + bj * HALF;
                    if (BASE_BF16) bw[m][bj] = *(const u32x4*)((const bf16_t*)base + off);
                    else { bf[m][bj][0] = *(const f32x4*)((const float*)base + off); bf[m][bj][1] = *(const f32x4*)((const float*)base + off + 4); } }
#pragma unroll
            for (int m = 0; m < 4; ++m) {
                const int row = row0 + ai * HALF + m * 16; const size_t off = (size_t)row * 1024 + col0;
                float ss = 0.f;
#pragma unroll
                for (int bj = 0; bj < 2; ++bj) {
                    f32x4 b0, b1;
                    if (BASE_BF16) { const u32x4 w = bw[m][bj];
                        b0 = (f32x4){__builtin_bit_cast(float, w.x << 16), __builtin_bit_cast(float, w.x & 0xffff0000u), __builtin_bit_cast(float, w.y << 16), __builtin_bit_cast(float, w.y & 0xffff0000u)};
                        b1 = (f32x4){__builtin_bit_cast(float, w.z << 16), __builtin_bit_cast(float, w.z & 0xffff0000u), __builtin_bit_cast(float, w.w << 16), __builtin_bit_cast(float, w.w & 0xffff0000u)}; }
                    else { b0 = bf[m][bj][0]; b1 = bf[m][bj][1]; }
                    const f32x4 v0 = acc[ai][bj][m][0] + b0, v1 = acc[ai][bj][m][1] + b1;
                    ss += (v0[0] * v0[0] + v0[1] * v0[1]) + (v0[2] * v0[2] + v0[3] * v0[3]) + (v1[0] * v1[0] + v1[1] * v1[1]) + (v1[2] * v1[2] + v1[3] * v1[3]);
                    if (OUT_BF16) { u32x4 w; w.x = cvt_pk_bf16(v0[0], v0[1]); w.y = cvt_pk_bf16(v0[2], v0[3]); w.z = cvt_pk_bf16(v1[0], v1[1]); w.w = cvt_pk_bf16(v1[2], v1[3]);
                        *(u32x4*)((bf16_t*)out + off + bj * HALF) = w; }
                    else { *(f32x4*)((float*)out + off + bj * HALF) = v0; *(f32x4*)((float*)out + off + bj * HALF + 4) = v1; }
                }
                ss += __shfl_xor(ss, 16); ss += __shfl_xor(ss, 32);
                if (fq == 0) sspart[(size_t)row * 16 + u.pn * 4 + wc] = ss;
            }
        }
    }
};
template <int ACT> struct EpiRowScale {
    static constexpr bool PERM = true, AFTER_DRAIN = false;
    bf16_t* O; int ldc; const float* sspart; float eps; float sc;
    const PG8_LAS int* pml; const PG8_LAS float* tab;
    __device__ __forceinline__ void operator()(const f32x4 (&acc)[2][2][4][2], const Unit& u, int wr, int wc, int fr, int fq) const {
        const int row0 = u.pm * BM + wr * 64 + fr, col0 = u.pn * BM + wc * 32 + 8 * fq;
        int slot = -1;
        if (tab) { const int n = pml[8]; for (int j = 0; j < n; ++j) if (pml[j] == u.pm) slot = j; }
#pragma unroll
        for (int ai = 0; ai < 2; ++ai)
#pragma unroll
            for (int m = 0; m < 4; ++m) {
                const int row = row0 + ai * HALF + m * 16; bf16_t* rowp = O + (size_t)row * ldc + col0;
                const float r = (slot >= 0 ? tab[slot * 256 + (row - u.pm * BM)] : row_rstd(sspart, row, eps)) * sc;
#pragma unroll
                for (int bj = 0; bj < 2; ++bj) {
                    f32x4 v0 = acc[ai][bj][m][0] * r, v1 = acc[ai][bj][m][1] * r;
                    if (ACT == 1) {
#pragma unroll
                        for (int e = 0; e < 4; ++e) { const float a = fmaxf(v0[e], 0.f), b = fmaxf(v1[e], 0.f); v0[e] = a * a; v1[e] = b * b; }
                    }
                    u32x4 w; w.x = cvt_pk_bf16(v0[0], v0[1]); w.y = cvt_pk_bf16(v0[2], v0[3]); w.z = cvt_pk_bf16(v1[0], v1[1]); w.w = cvt_pk_bf16(v1[2], v1[3]);
                    *(u32x4*)(rowp + bj * HALF) = w;
                }
            }
    }
};
template <class Epi, class Sched, bool ALIGN_EPI = false, bool SP2 = false>
__device__ __forceinline__ void gemm_phase(PG8_LAS unsigned char* lds, const Gemm g, const Sched& S, const Epi& E, const int wv  ) {
    int tid_ = wv * 64 + mk_lane();
    const int tid = tid_, wid = __builtin_amdgcn_readfirstlane(tid >> 6), lane = tid & 63, wr = wid >> 2, wc = wid & 3, fr = lane & 15, fq = lane >> 4;
    const int K = g.K, nt = K / BK;
    unsigned voffA[2], voffB[2];
#pragma unroll
    for (int i = 0; i < 2; ++i) { int R, C; stage_rc(tid * 16 + i * 8192, R, C); const int Rb = Epi::PERM ? ((R & ~31) + perm32(R & 31)) : R;
        voffA[i] = (unsigned)(R * K + C) * 2u; voffB[i] = (unsigned)(Rb * K + C) * 2u; }
    const size_t kstep = (size_t)(BK * 2);
    const size_t hstep = (size_t)HALF * K * 2;
    const size_t tstep = 2 * hstep;
    const unsigned ldsw = (unsigned)wid * 1024u;
    const int aoff = lds_byte(wr * 64 + fr, fq * 8), boff = lds_byte(wc * 32 + fr, fq * 8);
#define PG8_SA(b, h) (((b) * 2 + (h)) * HTB)
#define PG8_SB(b, h) ((4 + (b) * 2 + (h)) * HTB)
#define PG8_STAGE(bufoff, gbase, voff) do { _Pragma("unroll") for (int _i = 0; _i < 2; ++_i) \
        __builtin_amdgcn_global_load_lds((const unsigned*)((const char*)(gbase) + (voff)[_i]), (PG8_LAS unsigned*)(lds + (bufoff) + ldsw + _i * 8192), 16, 0, 0); } while (0)
#define PG8_LDA(dst, b, h) do { _Pragma("unroll") for (int m = 0; m < 4; ++m) _Pragma("unroll") for (int k = 0; k < 2; ++k) dst[m][k] = *(const PG8_LAS bf16x8*)(lds + PG8_SA(b, h) + aoff + m * 2048 + k * 1024); } while (0)
#define PG8_LDB(dst, b, h) do { _Pragma("unroll") for (int n = 0; n < 2; ++n) _Pragma("unroll") for (int k = 0; k < 2; ++k) dst[n][k] = *(const PG8_LAS bf16x8*)(lds + PG8_SB(b, h) + boff + n * 2048 + k * 1024); } while (0)
#define PG8_MMA(ai, bj, At, Bt) do { __builtin_amdgcn_s_setprio(1); _Pragma("unroll") for (int m = 0; m < 4; ++m) _Pragma("unroll") for (int n = 0; n < 2; ++n) _Pragma("unroll") for (int k = 0; k < 2; ++k) \
        acc[ai][bj][m][n] = __builtin_amdgcn_mfma_f32_16x16x32_bf16(Bt[n][k], At[m][k], acc[ai][bj][m][n], 0, 0, 0); __builtin_amdgcn_s_setprio(0); } while (0)
#define PG8_WAIT_V(n) asm volatile("s_waitcnt vmcnt(" #n ")" ::: "memory")
#define PG8_WAIT_L(n) asm volatile("s_waitcnt lgkmcnt(" #n ")" ::: "memory")
#define PG8_BAR __builtin_amdgcn_s_barrier()
#define PG8_SCHED __builtin_amdgcn_sched_barrier(0)
    Unit cur, nxt; int ui = 0;
    if (!S.next(0, cur)) return;
    f32x4 acc[2][2][4][2];
#pragma unroll
    for (int a = 0; a < 2; ++a)
#pragma unroll
        for (int b = 0; b < 2; ++b)
#pragma unroll
            for (int m = 0; m < 4; ++m)
#pragma unroll
                for (int n = 0; n < 2; ++n) acc[a][b][m][n] = (f32x4){0.f, 0.f, 0.f, 0.f};
    bf16x8 At[4][2], B0[2][2], B1[2][2];
    const char* cA = (const char*)g.A + (size_t)cur.pm * tstep; const char* cB = (const char*)g.Bt + (size_t)cur.pn * tstep;
    S.a_ready(cur);
    if constexpr (SP2) {
        PG8_STAGE(PG8_SB(0, 0), cB, voffB); PG8_STAGE(PG8_SB(0, 1), cB + hstep, voffB); PG8_STAGE(PG8_SA(0, 0), cA, voffA); PG8_STAGE(PG8_SA(0, 1), cA + hstep, voffA);
        if (wr == 1) PG8_BAR;
        PG8_WAIT_V(2); PG8_BAR;
        PG8_STAGE(PG8_SB(1, 0), cB + kstep, voffB); PG8_STAGE(PG8_SA(1, 0), cA + kstep, voffA); PG8_STAGE(PG8_SB(1, 1), cB + hstep + kstep, voffB);
        PG8_WAIT_V(6); PG8_BAR;
    } else {
        PG8_STAGE(PG8_SB(0, 0), cB, voffB); PG8_STAGE(PG8_SA(0, 0), cA, voffA); PG8_STAGE(PG8_SB(0, 1), cB + hstep, voffB); PG8_STAGE(PG8_SA(0, 1), cA + hstep, voffA);
        if (wr == 1) PG8_BAR;
        PG8_WAIT_V(4); PG8_BAR;
        PG8_STAGE(PG8_SB(1, 0), cB + kstep, voffB); PG8_STAGE(PG8_SA(1, 0), cA + kstep, voffA); PG8_STAGE(PG8_SB(1, 1), cB + hstep + kstep, voffB);
        PG8_WAIT_V(6); PG8_BAR;
    }
    for (;;) {
        const bool has_next = S.next(ui + 1, nxt);
        const char* nA = has_next ? (const char*)g.A + (size_t)nxt.pm * tstep : cA; const char* nB = has_next ? (const char*)g.Bt + (size_t)nxt.pn * tstep : cB;
        for (int t = 0; t < nt; t += 2) {
            const bool last = (t == nt - 2);
            const char* a1 = cA + (size_t)(t + 1) * kstep;
            const char* a2 = last ? nA : cA + (size_t)(t + 2) * kstep; const char* b2 = last ? nB : cB + (size_t)(t + 2) * kstep;
            const char* a3 = a2 + kstep; const char* b3 = b2 + kstep;
            if (last && has_next) S.a_ready(nxt);
            if constexpr (SP2) {
            PG8_LDB(B0, 0, 0); PG8_LDB(B1, 0, 1); PG8_SCHED; PG8_LDA(At, 0, 0); PG8_STAGE(PG8_SA(1, 1), a1 + hstep, voffA);
            PG8_WAIT_V(8); PG8_WAIT_L(0); PG8_BAR; PG8_MMA(0, 0, At, B0); PG8_MMA(0, 1, At, B1); PG8_BAR; PG8_SCHED;
            PG8_LDA(At, 0, 1); PG8_STAGE(PG8_SB(0, 0), b2, voffB); PG8_STAGE(PG8_SB(0, 1), b2 + hstep, voffB); PG8_STAGE(PG8_SA(0, 0), a2, voffA);
            PG8_WAIT_V(8); PG8_WAIT_L(0); PG8_BAR; PG8_MMA(1, 0, At, B0); PG8_MMA(1, 1, At, B1); PG8_BAR; PG8_SCHED;
            PG8_LDB(B0, 1, 0); PG8_LDB(B1, 1, 1); PG8_SCHED; PG8_LDA(At, 1, 0); PG8_STAGE(PG8_SA(0, 1), a2 + hstep, voffA);
            PG8_WAIT_V(8); PG8_WAIT_L(0); PG8_BAR; PG8_MMA(0, 0, At, B0); PG8_MMA(0, 1, At, B1); PG8_BAR; PG8_SCHED;
            PG8_LDA(At, 1, 1); PG8_STAGE(PG8_SB(1, 0), b3, voffB); PG8_STAGE(PG8_SB(1, 1), b3 + hstep, voffB); PG8_STAGE(PG8_SA(1, 0), a3, voffA);
            PG8_WAIT_V(8); PG8_WAIT_L(0); PG8_BAR; PG8_MMA(1, 0, At, B0); PG8_MMA(1, 1, At, B1); PG8_BAR; PG8_SCHED;
            } else {
            PG8_LDB(B0, 0, 0); PG8_SCHED; PG8_LDA(At, 0, 0); PG8_STAGE(PG8_SA(1, 1), a1 + hstep, voffA);
            PG8_WAIT_L(8); PG8_BAR; PG8_WAIT_L(0); PG8_MMA(0, 0, At, B0); PG8_BAR; PG8_SCHED;
            PG8_LDB(B1, 0, 1); PG8_STAGE(PG8_SB(0, 0), b2, voffB);
            PG8_BAR; PG8_WAIT_L(0); PG8_MMA(0, 1, At, B1); PG8_BAR;
            PG8_LDA(At, 0, 1); PG8_STAGE(PG8_SA(0, 0), a2, voffA);
            PG8_BAR; PG8_WAIT_L(0); PG8_MMA(1, 0, At, B0); PG8_BAR; PG8_SCHED;
            PG8_STAGE(PG8_SB(0, 1), b2 + hstep, voffB);
            PG8_WAIT_V(6); PG8_BAR; PG8_MMA(1, 1, At, B1); PG8_BAR;
            PG8_LDB(B0, 1, 0); PG8_SCHED; PG8_LDA(At, 1, 0); PG8_STAGE(PG8_SA(0, 1), a2 + hstep, voffA);
            PG8_WAIT_L(8); PG8_BAR; PG8_WAIT_L(0); PG8_MMA(0, 0, At, B0); PG8_BAR; PG8_SCHED;
            PG8_LDB(B1, 1, 1); PG8_STAGE(PG8_SB(1, 0), b3, voffB);
            PG8_BAR; PG8_WAIT_L(0); PG8_MMA(0, 1, At, B1); PG8_BAR;
            PG8_LDA(At, 1, 1); PG8_STAGE(PG8_SA(1, 0), a3, voffA);
            PG8_BAR; PG8_WAIT_L(0); PG8_MMA(1, 0, At, B0); PG8_BAR; PG8_SCHED;
            PG8_STAGE(PG8_SB(1, 1), b3 + hstep, voffB);
            PG8_WAIT_V(6); PG8_BAR; PG8_MMA(1, 1, At, B1); PG8_BAR;
            }
        }
        if constexpr (ALIGN_EPI) { if (wr == 0) PG8_BAR; }
        if constexpr (!Epi::AFTER_DRAIN) { E(acc, cur, wr, wc, fr, fq); S.done(cur); }
        if (!has_next) break;
#pragma unroll
        for (int a = 0; a < 2; ++a)
#pragma unroll
            for (int b = 0; b < 2; ++b)
#pragma unroll
                for (int m = 0; m < 4; ++m)
#pragma unroll
                    for (int n = 0; n < 2; ++n) acc[a][b][m][n] = (f32x4){0.f, 0.f, 0.f, 0.f};
        cur = nxt; cA = nA; cB = nB; ++ui;
        if constexpr (ALIGN_EPI) { if (wr == 1) PG8_BAR; }
    }
    PG8_WAIT_V(0);
    if constexpr (!ALIGN_EPI) { if (wr == 0) PG8_BAR; }
    PG8_BAR;
    if constexpr (Epi::AFTER_DRAIN) { E.fused(acc, cur, wr, wc, fr, fq, lds, wid, lane); S.done(cur); }
#undef PG8_SA
#undef PG8_SB
#undef PG8_STAGE
#undef PG8_LDA
#undef PG8_LDB
#undef PG8_MMA
#undef PG8_WAIT_V
#undef PG8_WAIT_L
#undef PG8_BAR
#undef PG8_SCHED
}
}

#ifndef PG8_SP2
#define PG8_SP2 true
#endif
#ifndef PG8_ALIGN
#define PG8_ALIGN true
#endif
namespace attn_body {
using bf16=__hip_bfloat16;
using bf16x8=__attribute__((ext_vector_type(8)))short;
using s16x4=__attribute__((ext_vector_type(4)))short;
using f32x16=__attribute__((ext_vector_type(16)))float;
using u32x4=__attribute__((ext_vector_type(4)))unsigned; using f32x4=__attribute__((ext_vector_type(4)))float;
constexpr int SEQ=4096,D=64,PQ=3072,PO=1536;
constexpr int NW=8,QBLK=32,QB=QBLK*NW,KVBLK=64,NQB=SEQ/QB;
constexpr int ATTN_UNIT_ROWS=QB;
__device__ __forceinline__ int crow(int r,int hi){return (r&3)+8*(r>>2)+4*hi;}
#define SBAR() __builtin_amdgcn_sched_barrier(0)
__device__ __forceinline__ void cmask(f32x16&p0,f32x16&p1,int jb,int qrel,int hi){
  const float NEG=-INFINITY; int kb=64*jb+4*hi;
  #pragma unroll
  for(int r=0;r<16;++r){int kv=kb+(r&3)+8*(r>>2); if(kv>qrel)p0[r]=NEG; if(kv+32>qrel)p1[r]=NEG;}
}

template<bool B> __device__ __forceinline__ const f32x16& csel(const f32x16&a,const f32x16&b){ if constexpr(B) return a; else return b; }
constexpr int NSLOT=3, SLOTB=8192;
constexpr int LDS_K=0, LDS_V=NSLOT*SLOTB, LDS_WS=2*NSLOT*SLOTB, LDS_OST=LDS_WS+NW*64*4, LDS_KBIAS=LDS_OST+NW*4096, LDS_BYTES=LDS_KBIAS+SEQ*4;
constexpr float C2=0.125f*1.4426950408889634f;
__device__ __forceinline__ void glds16(const void*gsrc,unsigned lds_dst){unsigned keep;
  asm volatile("s_mov_b32 %0, m0\n\ts_mov_b32 m0, %2\n\ts_nop 0\n\tglobal_load_lds_dwordx4 %1, off\n\ts_mov_b32 m0, %0":"=&s"(keep):"v"(gsrc),"s"(lds_dst):"memory");}
__device__ __forceinline__ float max3f(float a,float b,float c){float r;asm("v_max3_f32 %0, %1, %2, %3":"=v"(r):"v"(a),"v"(b),"v"(c));return r;}
__device__ __forceinline__ float max2f(float a,float b){float r;asm("v_max_f32_e32 %0, %1, %2":"=v"(r):"v"(a),"v"(b));return r;}
__device__ __forceinline__ float fadd_s(float a,float b){float r;asm("v_add_f32_e32 %0, %1, %2":"=v"(r):"v"(a),"v"(b));return r;}
__device__ __forceinline__ float fsub_s(float a,float b){float r;asm("v_sub_f32_e32 %0, %1, %2":"=v"(r):"v"(a),"v"(b));return r;}
typedef float f32x2_t __attribute__((ext_vector_type(2))); typedef __bf16 bf16x2_t __attribute__((ext_vector_type(2)));
__device__ __forceinline__ unsigned cvtpk_s(float lo,float hi){f32x2_t v={lo,hi};bf16x2_t b=__builtin_convertvector(v,bf16x2_t);return __builtin_bit_cast(unsigned,b);}
#define WAIT_BAR(N) asm volatile("s_waitcnt vmcnt(" #N ") lgkmcnt(0)\n\ts_barrier":::"memory")

__device__ __forceinline__ void qkt(f32x16&p0,f32x16&p1,const char*Kslot,const bf16x8*qr,const f32x16&ci0,const f32x16&ci1,int r32,int hi){
  const char*kb=Kslot+hi*1024+r32*16;
  #pragma unroll
  for(int d0=0;d0<4;++d0){
    const bf16x8 b0=*reinterpret_cast<const bf16x8*>(kb+d0*2048);
    const bf16x8 b1=*reinterpret_cast<const bf16x8*>(kb+d0*2048+512);
    if(d0==0){p0=__builtin_amdgcn_mfma_f32_32x32x16_bf16(b0,qr[0],ci0,0,0,0);p1=__builtin_amdgcn_mfma_f32_32x32x16_bf16(b1,qr[0],ci1,0,0,0);}
    else{p0=__builtin_amdgcn_mfma_f32_32x32x16_bf16(b0,qr[d0],p0,0,0,0);p1=__builtin_amdgcn_mfma_f32_32x32x16_bf16(b1,qr[d0],p1,0,0,0);}}
}
typedef __attribute__((address_space(3))) const char* lds_cptr;
typedef short v4i16_t __attribute__((ext_vector_type(4)));
__device__ __forceinline__ void kload8(bf16x8*kf,lds_cptr kp){
  kf[0]=*(const __attribute__((address_space(3))) bf16x8*)(kp);      kf[1]=*(const __attribute__((address_space(3))) bf16x8*)(kp+512);
  kf[2]=*(const __attribute__((address_space(3))) bf16x8*)(kp+2048); kf[3]=*(const __attribute__((address_space(3))) bf16x8*)(kp+2560);
  kf[4]=*(const __attribute__((address_space(3))) bf16x8*)(kp+4096); kf[5]=*(const __attribute__((address_space(3))) bf16x8*)(kp+4608);
  kf[6]=*(const __attribute__((address_space(3))) bf16x8*)(kp+6144); kf[7]=*(const __attribute__((address_space(3))) bf16x8*)(kp+6656);
}
__device__ __forceinline__ void kload2(bf16x8*kf,lds_cptr kp,int j){ kf[2*j]=*(const __attribute__((address_space(3))) bf16x8*)(kp+j*2048); kf[2*j+1]=*(const __attribute__((address_space(3))) bf16x8*)(kp+j*2048+512); }
__device__ __forceinline__ s16x4 vtr(lds_cptr p){ return __builtin_bit_cast(s16x4,__builtin_amdgcn_ds_read_tr16_b64_v4i16((__attribute__((address_space(3))) v4i16_t*)p)); }
__device__ __forceinline__ float rowmax(const f32x16&p0,const f32x16&p1){
  float a=max3f(p0[0],p0[1],p1[0]),b=max3f(p0[2],p0[3],p1[1]);a=max3f(a,p1[2],p1[3]);
  #pragma unroll
  for(int r=4;r<16;r+=4){a=max3f(a,p0[r],p0[r+1]);b=max3f(b,p0[r+2],p0[r+3]);a=max3f(a,p1[r],p1[r+1]);b=max3f(b,p1[r+2],p1[r+3]);}
  const float m=max2f(a,b);
  auto rr=__builtin_amdgcn_permlane32_swap(__float_as_uint(m),__float_as_uint(m),false,false);
  return max2f(__uint_as_float(rr[0]),__uint_as_float(rr[1]));
}
__device__ __forceinline__ void pv(f32x16*o,int vb,bf16x8 pa0,bf16x8 pa1,bf16x8 pa2,bf16x8 pa3){
  #pragma unroll
  for(int d0=0;d0<2;++d0){s16x4 lo[4],hi[4];
    #pragma unroll
    for(int ks=0;ks<4;++ks){
      asm volatile("ds_read_b64_tr_b16 %0,%1 offset:%c2":"=&v"(lo[ks]):"v"(vb),"i"(d0*4096+ks*1024):"memory");
      asm volatile("ds_read_b64_tr_b16 %0,%1 offset:%c2":"=&v"(hi[ks]):"v"(vb),"i"(d0*4096+ks*1024+512):"memory");}
    asm volatile("s_waitcnt lgkmcnt(0)":::"memory");SBAR();
    #define PK(k) (bf16x8){lo[k][0],lo[k][1],lo[k][2],lo[k][3],hi[k][0],hi[k][1],hi[k][2],hi[k][3]}
    o[d0]=__builtin_amdgcn_mfma_f32_32x32x16_bf16(pa0,PK(0),o[d0],0,0,0);
    o[d0]=__builtin_amdgcn_mfma_f32_32x32x16_bf16(pa1,PK(1),o[d0],0,0,0);
    o[d0]=__builtin_amdgcn_mfma_f32_32x32x16_bf16(pa2,PK(2),o[d0],0,0,0);
    o[d0]=__builtin_amdgcn_mfma_f32_32x32x16_bf16(pa3,PK(3),o[d0],0,0,0);
    #undef PK
  }
}

#ifndef ATTN_STORE16
#define ATTN_STORE16(p,v) (*(u32x4*)(p)=(v))
#endif
template<int THRL,bool HASB> __device__ __forceinline__ void attn_unit(int b,int qb,const bf16*Qc,const bf16*__restrict__ Kc,const bf16*__restrict__ Vc,bf16*Oc,const float*__restrict__ kbg,int t0,char*shm,const int wv){
  int tid_=wv*64+mk_lane();
  const int tid=tid_,lane=tid&63,r32=lane&31,hi=lane>>5; const int wid=__builtin_amdgcn_readfirstlane(tid>>6);
  const long rowbase=(long)b*SEQ; const int q0=qb*QB;
  const bf16*Qw=Qc+(rowbase+q0+wid*QBLK)*PQ;
  const bf16*Kh=Kc+(rowbase+(long)t0*KVBLK)*PQ,*Vh=Vc+(rowbase+(long)t0*KVBLK)*PQ;
  const unsigned lds0=(unsigned)(uintptr_t)shm;
  float*wsf=(float*)(shm+LDS_WS)+wid*64;
  const bf16*ksrc=Kh+(long)lane*PQ+wid*8;
  const bf16*vsrc=Vh+(long)(16*(wid&3)+(lane>>2))*PQ+(wid>>2)*32+(lane&3)*8;
  const unsigned kdst=lds0+LDS_K+wid*1024, vdst=lds0+LDS_V+wid*1024;
  #define DMA_K(t,slot) glds16(ksrc+(long)(t)*KVBLK*PQ,(unsigned)__builtin_amdgcn_readfirstlane(kdst+(slot)))
  #define DMA_V(t,slot) glds16(vsrc+(long)(t)*KVBLK*PQ,(unsigned)__builtin_amdgcn_readfirstlane(vdst+(slot)))
  const int vb0=(int)(lds0+LDS_V)+((lane>>4)&1)*32+(lane&3)*8+(4*hi+((lane&15)>>2))*64;
  const char*Kbase=shm+LDS_K; bf16x8 kf[8];
  const lds_cptr shm3=(lds_cptr)shm; const lds_cptr kp0=shm3+LDS_K+hi*1024+r32*16; const lds_cptr vp0=shm3+LDS_V+((lane>>4)&1)*32+(lane&3)*8+(4*hi+((lane&15)>>2))*64;
  const int NT=(q0+QB)/KVBLK-t0;
  typedef __attribute__((address_space(3))) const f32x4 lds_cf4; typedef __attribute__((address_space(3))) f32x4 lds_f4;
  const __attribute__((address_space(3))) char* kbl=(const __attribute__((address_space(3))) char*)shm+LDS_KBIAS+hi*16;
  DMA_K(0,0);DMA_V(0,0);DMA_K(1,SLOTB);
  bf16x8 qr[4];
  #pragma unroll
  for(int d0=0;d0<4;++d0)qr[d0]=*reinterpret_cast<const bf16x8*>(&Qw[(long)r32*PQ+d0*16+hi*8]);
  float mhat=0.f,l_reg=0.f;f32x16 o[2];o[0]=f32x16{};o[1]=f32x16{};f32x16 negm=f32x16{};asm volatile("":"+v"(negm));
  const int qrel=wid*QBLK+r32;
  float mref=0.f;
  #define CINIT(C0,C1,t) do{ if(HASB){ const __attribute__((address_space(3))) char* kp_=kbl+(t)*256; \
      _Pragma("unroll") for(int g_=0;g_<4;++g_){ const f32x4 a_=*(lds_cf4*)(kp_+g_*32), b_=*(lds_cf4*)(kp_+128+g_*32); \
        _Pragma("unroll") for(int e_=0;e_<4;++e_){ C0[4*g_+e_]=a_[e_]-mhat; C1[4*g_+e_]=b_[e_]-mhat; } } } \
    }while(0)
  #define CMASK(P0,P1,t) do{int jb_=(t)-(NT-4); if(jb_>=0)cmask(P0,P1,jb_,qrel,hi);}while(0)
  bool resc=false;
  #define START(P0,P1) do{ const float rm=rowmax(P0,P1); resc=false; \
    { const float dl=HASB?__builtin_fmaxf(rm,0.f):rm; mhat=fadd_s(mhat,dl); \
      _Pragma("unroll") for(int r=0;r<16;++r){P0[r]=fsub_s(P0[r],dl);P1[r]=fsub_s(P1[r],dl);} \
      if(!HASB){ _Pragma("unroll") for(int r=0;r<16;++r)negm[r]=-mhat; asm volatile("":"+v"(negm)); } } \
    _Pragma("unroll") for(int r=0;r<16;++r)P0[r]=__builtin_amdgcn_exp2f(P0[r]); }while(0)
  #define RESC() do{ if(resc){ asm volatile("s_waitcnt lgkmcnt(0)":::"memory"); \
      _Pragma("unroll") for(int d_=0;d_<2;++d_) _Pragma("unroll") for(int r=0;r<16;++r)o[d_][r]*=wsf[crow(r,hi)]; } }while(0)
  f32x16 pA0,pA1,pB0,pB1;
  int sl_prev=0,sl_cur=0,sl_next=SLOTB;
  #define ROT() do{sl_prev=sl_cur;sl_cur=sl_next;sl_next=(sl_next==(NSLOT-1)*SLOTB)?0:sl_next+SLOTB;}while(0)
  DMA_K(2,2*SLOTB);
  if(HASB){ const int n4=(q0+QB-t0*KVBLK)/4; for(int i=tid;i<n4;i+=NW*64){ const f32x4 v=*(const f32x4*)(kbg+t0*KVBLK+4*i); *((lds_f4*)((__attribute__((address_space(3))) char*)shm+LDS_KBIAS)+i)=v; } }
  WAIT_BAR(3);
  if(HASB){ mref=*(const __attribute__((address_space(3))) float*)((const __attribute__((address_space(3))) char*)shm+LDS_KBIAS+(q0-t0*KVBLK+qrel)*4); mhat=mref; }
  { f32x16 ci0=f32x16{},ci1=f32x16{}; CINIT(ci0,ci1,0); qkt(pA0,pA1,Kbase,qr,csel<HASB>(ci0,negm),csel<HASB>(ci1,negm),r32,hi); } asm volatile("s_nop 15\n\ts_nop 7":"+v"(pA0),"+v"(pA1));CMASK(pA0,pA1,0);
  START(pA0,pA1);
  _Pragma("unroll") for(int r=0;r<16;++r)pA1[r]=__builtin_amdgcn_exp2f(pA1[r]);
  WAIT_BAR(0);
  DMA_K(3,0);DMA_V(1,SLOTB);
  ROT();
  kload8(kf,kp0+sl_cur);
  WAIT_BAR(2);
  s16x4 vlo[8],vhi[8]; u32x4 pw0,pw1,pw2,pw3;
  #define PKW(P,B) cvtpk_s(P[B],P[B+1])
  #define PAF(k) __builtin_bit_cast(bf16x8,pw##k)
  #define VFR(i) (bf16x8){vlo[i][0],vlo[i][1],vlo[i][2],vlo[i][3],vhi[i][0],vhi[i][1],vhi[i][2],vhi[i][3]}
  #define PIN(x) asm volatile("":"+v"(x))
  #define MX3(a,b,c) __builtin_fmaxf(__builtin_fmaxf((a),(b)),(c))
  #define GAPA(MF,A0,A1,A2,A3,W0,W1,PW) do{ MF; sacc+=A0; sacc+=A1; sacc+=A2; sacc+=A3; PIN(sacc); W0; W1; PIN(PW); SBAR(); }while(0)
  #define EX(v) __builtin_amdgcn_exp2f(v)
  #define GAPB(MF,X,B,Y) do{ MF; X[B]=EX(X[B]); X[B+1]=EX(X[B+1]); X[B+2]=EX(X[B+2]); X[B+3]=EX(X[B+3]); PIN(X); if(HASB){ Y[B]-=mhat; Y[B+1]-=mhat; Y[B+2]-=mhat; Y[B+3]-=mhat; PIN(Y); } SBAR(); }while(0)
  #define LOADB(Y0,Y1,t) do{ if(HASB){ const __attribute__((address_space(3))) char* kp_=kbl+(t)*256; \
      _Pragma("unroll") for(int g_=0;g_<4;++g_){ const f32x4 a_=*(lds_cf4*)(kp_+g_*32), b_=*(lds_cf4*)(kp_+128+g_*32); \
        _Pragma("unroll") for(int e_=0;e_<4;++e_){ Y0[4*g_+e_]=a_[e_]; Y1[4*g_+e_]=b_[e_]; } } } }while(0)
  #define VRD(i) do{ vlo[i]=vtr(vp_+(((i)>>2)*4096+((i)&3)*1024)); vhi[i]=vtr(vp_+(((i)>>2)*4096+((i)&3)*1024+512)); }while(0)
  #define KRD(G,j) do{ if(G){ kload2(kf,kp0+sl_next,j); SBAR(); } }while(0)
  #define STEP(C0,C1,P0,P1,t,GK,GV,GL) do{ SBAR(); \
    const lds_cptr vp_=vp0+sl_prev; \
    VRD(0); SBAR(); float sacc=(P0[0]+P0[1]); \
    GAPA(C0=__builtin_amdgcn_mfma_f32_32x32x16_bf16(kf[0],qr[0],csel<HASB>(C0,negm),0,0,0), P0[2],P0[3],P0[4],P0[5],     pw0[0]=PKW(P0,0), pw0[1]=PKW(P0,2), pw0); \
    VRD(4); SBAR(); GAPA(C1=__builtin_amdgcn_mfma_f32_32x32x16_bf16(kf[1],qr[0],csel<HASB>(C1,negm),0,0,0), P0[6],P0[7],P0[8],P0[9],     pw0[2]=PKW(P0,4), pw0[3]=PKW(P0,6), pw0); \
    VRD(1); SBAR(); GAPA(C0=__builtin_amdgcn_mfma_f32_32x32x16_bf16(kf[2],qr[1],C0,0,0,0),   P0[10],P0[11],P0[12],P0[13], pw1[0]=PKW(P0,8), pw1[1]=PKW(P0,10), pw1); \
    VRD(5); SBAR(); GAPA(C1=__builtin_amdgcn_mfma_f32_32x32x16_bf16(kf[3],qr[1],C1,0,0,0),   P0[14],P0[15],P1[0],P1[1],   pw1[2]=PKW(P0,12),pw1[3]=PKW(P0,14), pw1); \
    VRD(2); SBAR(); GAPA(C0=__builtin_amdgcn_mfma_f32_32x32x16_bf16(kf[4],qr[2],C0,0,0,0),   P1[2],P1[3],P1[4],P1[5],     pw2[0]=PKW(P1,0), pw2[1]=PKW(P1,2), pw2); \
    VRD(6); SBAR(); GAPA(C1=__builtin_amdgcn_mfma_f32_32x32x16_bf16(kf[5],qr[2],C1,0,0,0),   P1[6],P1[7],P1[8],P1[9],     pw2[2]=PKW(P1,4), pw2[3]=PKW(P1,6), pw2); \
    VRD(3); SBAR(); GAPA(C0=__builtin_amdgcn_mfma_f32_32x32x16_bf16(kf[6],qr[3],C0,0,0,0),   P1[10],P1[11],P1[12],P1[13], pw3[0]=PKW(P1,8), pw3[1]=PKW(P1,10), pw3); \
    VRD(7); SBAR(); GAPA(C1=__builtin_amdgcn_mfma_f32_32x32x16_bf16(kf[7],qr[3],C1,0,0,0),   P1[14],P1[15],0.f,0.f,       pw3[2]=PKW(P1,12),pw3[3]=PKW(P1,14), pw3); \
    l_reg+=sacc; \
    LOADB(P0,P1,(t)+1); \
    if(GK){DMA_K((t)+3,sl_cur);} if(GV){DMA_V((t)+1,sl_next);} \
    CMASK(C0,C1,t); \
    { float a=MX3(C0[0],C0[1],C1[0]),b=MX3(C0[2],C0[3],C1[1]); a=MX3(a,C1[2],C1[3]); \
      _Pragma("unroll") for(int r=4;r<16;r+=4){a=MX3(a,C0[r],C0[r+1]);b=MX3(b,C0[r+2],C0[r+3]);a=MX3(a,C1[r],C1[r+1]);b=MX3(b,C1[r+2],C1[r+3]);} \
      float rm=__builtin_fmaxf(a,b); { auto rr=__builtin_amdgcn_permlane32_swap(__float_as_uint(rm),__float_as_uint(rm),false,false); rm=__builtin_fmaxf(__uint_as_float(rr[0]),__uint_as_float(rr[1])); } \
      resc=false; \
      if(__builtin_expect(__any(rm>(float)THRL),0)){ const float dl=__builtin_fmaxf(rm,0.f); mhat+=dl; \
        _Pragma("unroll") for(int r=0;r<16;++r){C0[r]-=dl;C1[r]-=dl;} \
        if(!HASB){ _Pragma("unroll") for(int r=0;r<16;++r)negm[r]=-mhat; asm volatile("":"+v"(negm)); } \
        const float f=__builtin_amdgcn_exp2f(-dl); l_reg*=f; if(hi==0)wsf[r32]=f; resc=true; } } \
    SBAR(); \
    GAPB(o[0]=__builtin_amdgcn_mfma_f32_32x32x16_bf16(PAF(0),VFR(0),o[0],0,0,0), C0,0,P0); \
    GAPB(o[1]=__builtin_amdgcn_mfma_f32_32x32x16_bf16(PAF(0),VFR(4),o[1],0,0,0), C0,4,P0); \
    KRD(GL,0); GAPB(o[0]=__builtin_amdgcn_mfma_f32_32x32x16_bf16(PAF(1),VFR(1),o[0],0,0,0), C0,8,P0); \
    KRD(GL,1); GAPB(o[1]=__builtin_amdgcn_mfma_f32_32x32x16_bf16(PAF(1),VFR(5),o[1],0,0,0), C0,12,P0); \
    KRD(GL,2); GAPB(o[0]=__builtin_amdgcn_mfma_f32_32x32x16_bf16(PAF(2),VFR(2),o[0],0,0,0), C1,0,P1); \
    KRD(GL,3); GAPB(o[1]=__builtin_amdgcn_mfma_f32_32x32x16_bf16(PAF(2),VFR(6),o[1],0,0,0), C1,4,P1); \
    GAPB(o[0]=__builtin_amdgcn_mfma_f32_32x32x16_bf16(PAF(3),VFR(3),o[0],0,0,0), C1,8,P1); \
    GAPB(o[1]=__builtin_amdgcn_mfma_f32_32x32x16_bf16(PAF(3),VFR(7),o[1],0,0,0), C1,12,P1); \
    }while(0)
  CINIT(pB0,pB1,1);
  int t=1;
  #undef CMASK
  #define CMASK(P0,P1,t) do{}while(0)
  for(;t+5<NT;t+=2){
    STEP(pB0,pB1,pA0,pA1,t,true,true,true);     WAIT_BAR(2); RESC(); ROT();
    STEP(pA0,pA1,pB0,pB1,t+1,true,true,true);   WAIT_BAR(2); RESC(); ROT();
  }
  #undef CMASK
  #define CMASK(P0,P1,t) do{int jb_=(t)-(NT-4); if(jb_>=0)cmask(P0,P1,jb_,qrel,hi);}while(0)
  #define ENDW(tt) do{ if((tt)+3<NT){WAIT_BAR(2);} else if((tt)+2<NT){WAIT_BAR(1);} else {WAIT_BAR(0);} }while(0)
  #define PVONLY(Y0,Y1,SL) do{ float sacc_=Y0[0]+Y0[1]; _Pragma("unroll") for(int r=2;r<16;++r)sacc_+=Y0[r]; _Pragma("unroll") for(int r=0;r<16;++r)sacc_+=Y1[r]; l_reg+=sacc_; \
    pw0=(u32x4){PKW(Y0,0),PKW(Y0,2),PKW(Y0,4),PKW(Y0,6)};pw1=(u32x4){PKW(Y0,8),PKW(Y0,10),PKW(Y0,12),PKW(Y0,14)};pw2=(u32x4){PKW(Y1,0),PKW(Y1,2),PKW(Y1,4),PKW(Y1,6)};pw3=(u32x4){PKW(Y1,8),PKW(Y1,10),PKW(Y1,12),PKW(Y1,14)}; \
    SBAR(); pv(o,vb0+(SL),PAF(0),PAF(1),PAF(2),PAF(3)); }while(0)
  #define BSTEP(C0,C1,P0,P1,t,GK,GV,GL) do{ const int jb__=(t)-(NT-4); \
    if(jb__<=jl){ STEP(C0,C1,P0,P1,t,GK,GV,GL); } \
    else { if(jb__==jl+1){ PVONLY(P0,P1,sl_prev); } if(GK){DMA_K((t)+3,sl_cur);} if(GV){DMA_V((t)+1,sl_next);} resc=false; } }while(0)
  const int jl=wid>>1;
  for(;t+1<NT;t+=2){
    BSTEP(pB0,pB1,pA0,pA1,t,(t+3<NT),(t+1<NT),(t+1<NT));       ENDW(t);   RESC(); ROT();
    BSTEP(pA0,pA1,pB0,pB1,t+1,(t+4<NT),(t+2<NT),(t+2<NT));     ENDW(t+1); RESC(); ROT();
  }
  if(jl==3){
  STEP(pB0,pB1,pA0,pA1,NT-1,false,false,false); RESC();
  { float sacc=pB0[0]+pB0[1]; _Pragma("unroll") for(int r=2;r<16;++r)sacc+=pB0[r]; _Pragma("unroll") for(int r=0;r<16;++r)sacc+=pB1[r]; l_reg+=sacc;
    pw0=(u32x4){PKW(pB0,0),PKW(pB0,2),PKW(pB0,4),PKW(pB0,6)};pw1=(u32x4){PKW(pB0,8),PKW(pB0,10),PKW(pB0,12),PKW(pB0,14)};pw2=(u32x4){PKW(pB1,0),PKW(pB1,2),PKW(pB1,4),PKW(pB1,6)};pw3=(u32x4){PKW(pB1,8),PKW(pB1,10),PKW(pB1,12),PKW(pB1,14)};
    SBAR(); pv(o,vb0+sl_cur,PAF(0),PAF(1),PAF(2),PAF(3)); }
  } else if(jl==2){ PVONLY(pA0,pA1,sl_prev); }
  #undef PKW
  #undef PAF
  #undef VFR
  #undef PIN
  #undef MX3
  #undef GAPA
  #undef GAPB
  #undef LOADB
  #undef EX
  #undef VRD
  #undef KRD
  #undef STEP
  #undef ENDW
  #undef PVONLY
  #undef BSTEP
  {auto rr=__builtin_amdgcn_permlane32_swap(__float_as_uint(l_reg),__float_as_uint(l_reg),false,false);l_reg=__uint_as_float(rr[0])+__uint_as_float(rr[1]);}
  if(hi==0)wsf[32+r32]=l_reg;asm volatile("s_waitcnt lgkmcnt(0)":::"memory");
  float rli[16];
  #pragma unroll
  for(int r=0;r<16;++r)rli[r]=__builtin_amdgcn_rcpf(wsf[32+crow(r,hi)]);
  bf16*Ow=Oc+(rowbase+q0+wid*QBLK)*PO;
  { bf16*stg=(bf16*)(shm+LDS_OST)+wid*2048;
    #pragma unroll
    for(int r=0;r<16;++r){const int orow=crow(r,hi);
      #pragma unroll
      for(int d0=0;d0<2;++d0)stg[orow*64+d0*32+r32]=__float2bfloat16(o[d0][r]*rli[r]);}
    asm volatile("s_waitcnt lgkmcnt(0)":::"memory");
    #pragma unroll
    for(int i=0;i<4;++i){const int row=i*8+(lane>>3),ch=lane&7; const u32x4 v=*(const u32x4*)(stg+row*64+ch*8); ATTN_STORE16(Ow+(long)row*PO+ch*8,v);} }
  asm volatile("s_waitcnt lgkmcnt(0)\n\ts_barrier":::"memory");
  #undef CINIT
  #undef DMA_K
  #undef DMA_V
  #undef CMASK
  #undef START
  #undef RESC
  #undef ROT
}
constexpr int LDS_WS128=LDS_V+NSLOT*2*SLOTB, LDS_OST128=LDS_WS128+NW*64*4, LDS_BYTES128=LDS_OST128+NW*4096;
template<int THRL> __device__ __forceinline__ void attn_unit128(int b,int qb,const bf16*Qc,const bf16*__restrict__ Kc,const bf16*__restrict__ Vc,bf16*Oc,char*shm,const int wv){ constexpr bool HASB=false; constexpr int t0=0; const float* kbg=nullptr;
  int tid_=wv*64+mk_lane();
  const int tid=tid_,lane=tid&63,r32=lane&31,hi=lane>>5; const int wid=__builtin_amdgcn_readfirstlane(tid>>6);
  const long rowbase=(long)b*SEQ; const int q0=qb*QB;
  const bf16*Qw=Qc+(rowbase+q0+wid*QBLK)*PQ;
  const bf16*Kh=Kc+(rowbase+(long)t0*KVBLK)*PQ,*Vh=Vc+(rowbase+(long)t0*KVBLK)*PQ;
  const unsigned lds0=(unsigned)(uintptr_t)shm;
  float*wsf=(float*)(shm+LDS_WS128)+wid*64;
  const bf16*ksrc=Kh+(long)lane*PQ+wid*8;
  const bf16*vsrc=Vh+(long)(16*(wid&3)+(lane>>2))*PQ+(wid>>2)*32+(lane&3)*8;
  const unsigned kdst=lds0+LDS_K+wid*1024, vdst=lds0+LDS_V+(wid>>2)*4096+(wid&3)*1024;
  #define DMA_K(t,slot) glds16(ksrc+(long)(t)*KVBLK*PQ,(unsigned)__builtin_amdgcn_readfirstlane(kdst+(slot)))
  #define DMA_V(t,slot) do{ glds16(vsrc+(long)(t)*KVBLK*PQ,(unsigned)__builtin_amdgcn_readfirstlane(vdst+2*(slot))); glds16(vsrc+64+(long)(t)*KVBLK*PQ,(unsigned)__builtin_amdgcn_readfirstlane(vdst+8192+2*(slot))); }while(0)
  const int vb0=(int)(lds0+LDS_V)+((lane>>4)&1)*32+(lane&3)*8+(4*hi+((lane&15)>>2))*64;
  const char*Kbase=shm+LDS_K; bf16x8 kf[8];
  const lds_cptr shm3=(lds_cptr)shm; const lds_cptr kp0=shm3+LDS_K+hi*1024+r32*16; const lds_cptr vp0=shm3+LDS_V+((lane>>4)&1)*32+(lane&3)*8+(4*hi+((lane&15)>>2))*64;
  const int NT=(q0+QB)/KVBLK-t0;
  typedef __attribute__((address_space(3))) const f32x4 lds_cf4; typedef __attribute__((address_space(3))) f32x4 lds_f4;
  const __attribute__((address_space(3))) char* kbl=(const __attribute__((address_space(3))) char*)shm+LDS_KBIAS+hi*16;
  if(HASB){ const int n4=(q0+QB-t0*KVBLK)/4; for(int i=tid;i<n4;i+=NW*64){ const f32x4 v=*(const f32x4*)(kbg+t0*KVBLK+4*i); *((lds_f4*)((__attribute__((address_space(3))) char*)shm+LDS_KBIAS)+i)=v; } }
  DMA_K(0,0);DMA_V(0,0);DMA_K(1,SLOTB);
  bf16x8 qr[4];
  #pragma unroll
  for(int d0=0;d0<4;++d0)qr[d0]=*reinterpret_cast<const bf16x8*>(&Qw[(long)r32*PQ+d0*16+hi*8]);
  float mhat=0.f,l_reg=0.f;f32x16 o[4];o[0]=f32x16{};o[1]=f32x16{};o[2]=f32x16{};o[3]=f32x16{};
  const int qrel=wid*QBLK+r32;
  float mref=0.f;
  #define CINIT(C0,C1,t) do{ if(HASB){ const __attribute__((address_space(3))) char* kp_=kbl+(t)*256; \
      _Pragma("unroll") for(int g_=0;g_<4;++g_){ const f32x4 a_=*(lds_cf4*)(kp_+g_*32), b_=*(lds_cf4*)(kp_+128+g_*32); \
        _Pragma("unroll") for(int e_=0;e_<4;++e_){ C0[4*g_+e_]=a_[e_]-mhat; C1[4*g_+e_]=b_[e_]-mhat; } } } \
    }while(0)
  #define CMASK(P0,P1,t) do{int jb_=(t)-(NT-4); if(jb_>=0)cmask(P0,P1,jb_,qrel,hi);}while(0)
  bool resc=false;
  #define START(P0,P1) do{ const float rm=rowmax(P0,P1); resc=false; \
    { const float dl=__any(rm>(float)THRL)?__builtin_fmaxf(rm,0.f):0.f; mhat=fadd_s(mhat,dl); \
      _Pragma("unroll") for(int r=0;r<16;++r){P0[r]=fsub_s(P0[r],dl);P1[r]=fsub_s(P1[r],dl);} \
      } \
    _Pragma("unroll") for(int r=0;r<16;++r)P0[r]=__builtin_amdgcn_exp2f(P0[r]); }while(0)
  #define RESC() do{ if(resc){ asm volatile("s_waitcnt lgkmcnt(0)":::"memory"); \
      _Pragma("unroll") for(int d_=0;d_<4;++d_) _Pragma("unroll") for(int r=0;r<16;++r)o[d_][r]*=wsf[crow(r,hi)]; } }while(0)
  f32x16 pA0,pA1,pB0,pB1;
  int sl_prev=0,sl_cur=0,sl_next=SLOTB;
  #define ROT() do{sl_prev=sl_cur;sl_cur=sl_next;sl_next=(sl_next==(NSLOT-1)*SLOTB)?0:sl_next+SLOTB;}while(0)
  DMA_K(2,2*SLOTB);
  WAIT_BAR(4);
  { f32x16 ci0=f32x16{}; asm volatile("":"+v"(ci0)); qkt(pA0,pA1,Kbase,qr,ci0,ci0,r32,hi); } asm volatile("s_nop 15\n\ts_nop 7":"+v"(pA0),"+v"(pA1));CMASK(pA0,pA1,0);
  START(pA0,pA1);
  _Pragma("unroll") for(int r=0;r<16;++r)pA1[r]=__builtin_amdgcn_exp2f(pA1[r]);
  WAIT_BAR(0);
  DMA_K(3,0);DMA_V(1,SLOTB);
  ROT();
  kload8(kf,kp0+sl_cur);
  WAIT_BAR(3);
  s16x4 vlo[4],vhi[4]; u32x4 pw0,pw1,pw2,pw3;
  #define PKW(P,B) cvtpk_s(P[B],P[B+1])
  #define PAF(k) __builtin_bit_cast(bf16x8,pw##k)
  #define VFR(i) (bf16x8){vlo[(i)&3][0],vlo[(i)&3][1],vlo[(i)&3][2],vlo[(i)&3][3],vhi[(i)&3][0],vhi[(i)&3][1],vhi[(i)&3][2],vhi[(i)&3][3]}
  #define PIN(x) asm volatile("":"+v"(x))
  #define MX3(a,b,c) __builtin_fmaxf(__builtin_fmaxf((a),(b)),(c))
  #define GAPA(MF,A0,A1,A2,A3,W0,W1,PW) do{ MF; sacc+=A0; sacc+=A1; sacc+=A2; sacc+=A3; PIN(sacc); W0; W1; PIN(PW); SBAR(); }while(0)
  #define EX(v) __builtin_amdgcn_exp2f(v)
  #define GAPB(MF,X,B,Y) do{ MF; X[B]=EX(X[B]); X[B+1]=EX(X[B+1]); X[B+2]=EX(X[B+2]); X[B+3]=EX(X[B+3]); PIN(X); if(HASB){ Y[B]-=mhat; Y[B+1]-=mhat; Y[B+2]-=mhat; Y[B+3]-=mhat; PIN(Y); } SBAR(); }while(0)
  #define LOADB(Y0,Y1,t) do{ if(HASB){ const __attribute__((address_space(3))) char* kp_=kbl+(t)*256; \
      _Pragma("unroll") for(int g_=0;g_<4;++g_){ const f32x4 a_=*(lds_cf4*)(kp_+g_*32), b_=*(lds_cf4*)(kp_+128+g_*32); \
        _Pragma("unroll") for(int e_=0;e_<4;++e_){ Y0[4*g_+e_]=a_[e_]; Y1[4*g_+e_]=b_[e_]; } } } }while(0)
  #define VOFF(j) ((((j)>>3)*8192)+((((j)&7)&1)*4096)+((((j)&7)>>1)*1024))
  #define VRDJ(j) do{ vlo[(j)&3]=vtr(vp_+VOFF(j)); vhi[(j)&3]=vtr(vp_+VOFF(j)+512); SBAR(); }while(0)
  #define GAPC(MF,Y,B) do{ MF; SBAR(); }while(0)
  #define KRD(G,j) do{ if(G){ kload2(kf,kp0+sl_next,j); SBAR(); } }while(0)
  #define STEP(C0,C1,P0,P1,t,GK,GV,GL) do{ SBAR(); \
    const lds_cptr vp_=vp0+2*sl_prev; \
    VRDJ(0); float sacc=(P0[0]+P0[1]); \
    GAPA(C0=__builtin_amdgcn_mfma_f32_32x32x16_bf16(kf[0],qr[0],zero16,0,0,0), P0[2],P0[3],P0[4],P0[5],     pw0[0]=PKW(P0,0), pw0[1]=PKW(P0,2), pw0); \
    VRDJ(1); GAPA(C1=__builtin_amdgcn_mfma_f32_32x32x16_bf16(kf[1],qr[0],zero16,0,0,0), P0[6],P0[7],P0[8],P0[9],     pw0[2]=PKW(P0,4), pw0[3]=PKW(P0,6), pw0); \
    VRDJ(2); GAPA(C0=__builtin_amdgcn_mfma_f32_32x32x16_bf16(kf[2],qr[1],C0,0,0,0),   P0[10],P0[11],P0[12],P0[13], pw1[0]=PKW(P0,8), pw1[1]=PKW(P0,10), pw1); \
    VRDJ(3); GAPA(C1=__builtin_amdgcn_mfma_f32_32x32x16_bf16(kf[3],qr[1],C1,0,0,0),   P0[14],P0[15],P1[0],P1[1],   pw1[2]=PKW(P0,12),pw1[3]=PKW(P0,14), pw1); \
    GAPA(C0=__builtin_amdgcn_mfma_f32_32x32x16_bf16(kf[4],qr[2],C0,0,0,0),   P1[2],P1[3],P1[4],P1[5],     pw2[0]=PKW(P1,0), pw2[1]=PKW(P1,2), pw2); \
    GAPA(C1=__builtin_amdgcn_mfma_f32_32x32x16_bf16(kf[5],qr[2],C1,0,0,0),   P1[6],P1[7],P1[8],P1[9],     pw2[2]=PKW(P1,4), pw2[3]=PKW(P1,6), pw2); \
    GAPA(C0=__builtin_amdgcn_mfma_f32_32x32x16_bf16(kf[6],qr[3],C0,0,0,0),   P1[10],P1[11],P1[12],P1[13], pw3[0]=PKW(P1,8), pw3[1]=PKW(P1,10), pw3); \
    GAPA(C1=__builtin_amdgcn_mfma_f32_32x32x16_bf16(kf[7],qr[3],C1,0,0,0),   P1[14],P1[15],0.f,0.f,       pw3[2]=PKW(P1,12),pw3[3]=PKW(P1,14), pw3); \
    l_reg+=sacc; \
    if(__builtin_expect(__any(mhat!=0.f),0)){ _Pragma("unroll") for(int r=0;r<16;++r){C0[r]-=mhat;C1[r]-=mhat;} } \
    if(GK){DMA_K((t)+3,sl_cur);} if(GV){DMA_V((t)+1,sl_next);} \
    CMASK(C0,C1,t); \
    { float a=MX3(C0[0],C0[1],C1[0]),b=MX3(C0[2],C0[3],C1[1]); a=MX3(a,C1[2],C1[3]); \
      _Pragma("unroll") for(int r=4;r<16;r+=4){a=MX3(a,C0[r],C0[r+1]);b=MX3(b,C0[r+2],C0[r+3]);a=MX3(a,C1[r],C1[r+1]);b=MX3(b,C1[r+2],C1[r+3]);} \
      float rm=__builtin_fmaxf(a,b); { auto rr=__builtin_amdgcn_permlane32_swap(__float_as_uint(rm),__float_as_uint(rm),false,false); rm=__builtin_fmaxf(__uint_as_float(rr[0]),__uint_as_float(rr[1])); } \
      resc=false; \
      if(__builtin_expect(__any(rm>(float)THRL),0)){ const float dl=__builtin_fmaxf(rm,0.f); mhat+=dl; \
        _Pragma("unroll") for(int r=0;r<16;++r){C0[r]-=dl;C1[r]-=dl;} \
        const float f=__builtin_amdgcn_exp2f(-dl); l_reg*=f; if(hi==0)wsf[r32]=f; resc=true; } } \
    SBAR(); \
    GAPB(o[0]=__builtin_amdgcn_mfma_f32_32x32x16_bf16(PAF(0),VFR(0),o[0],0,0,0), C0,0,P0); VRDJ(4); \
    GAPB(o[1]=__builtin_amdgcn_mfma_f32_32x32x16_bf16(PAF(0),VFR(1),o[1],0,0,0), C0,4,P0); VRDJ(5); \
    GAPB(o[0]=__builtin_amdgcn_mfma_f32_32x32x16_bf16(PAF(1),VFR(2),o[0],0,0,0), C0,8,P0); VRDJ(6); \
    GAPB(o[1]=__builtin_amdgcn_mfma_f32_32x32x16_bf16(PAF(1),VFR(3),o[1],0,0,0), C0,12,P0); VRDJ(7); \
    GAPB(o[0]=__builtin_amdgcn_mfma_f32_32x32x16_bf16(PAF(2),VFR(4),o[0],0,0,0), C1,0,P1); VRDJ(8); \
    GAPB(o[1]=__builtin_amdgcn_mfma_f32_32x32x16_bf16(PAF(2),VFR(5),o[1],0,0,0), C1,4,P1); VRDJ(9); \
    GAPB(o[0]=__builtin_amdgcn_mfma_f32_32x32x16_bf16(PAF(3),VFR(6),o[0],0,0,0), C1,8,P1); VRDJ(10); \
    GAPB(o[1]=__builtin_amdgcn_mfma_f32_32x32x16_bf16(PAF(3),VFR(7),o[1],0,0,0), C1,12,P1); VRDJ(11); \
    GAPC(o[2]=__builtin_amdgcn_mfma_f32_32x32x16_bf16(PAF(0),VFR(8),o[2],0,0,0), P0,0); VRDJ(12); \
    GAPC(o[3]=__builtin_amdgcn_mfma_f32_32x32x16_bf16(PAF(0),VFR(9),o[3],0,0,0), P0,4); VRDJ(13); \
    KRD(GL,0); GAPC(o[2]=__builtin_amdgcn_mfma_f32_32x32x16_bf16(PAF(1),VFR(10),o[2],0,0,0), P0,8); VRDJ(14); \
    KRD(GL,1); GAPC(o[3]=__builtin_amdgcn_mfma_f32_32x32x16_bf16(PAF(1),VFR(11),o[3],0,0,0), P0,12); VRDJ(15); \
    KRD(GL,2); GAPC(o[2]=__builtin_amdgcn_mfma_f32_32x32x16_bf16(PAF(2),VFR(12),o[2],0,0,0), P1,0); \
    KRD(GL,3); GAPC(o[3]=__builtin_amdgcn_mfma_f32_32x32x16_bf16(PAF(2),VFR(13),o[3],0,0,0), P1,4); \
    GAPC(o[2]=__builtin_amdgcn_mfma_f32_32x32x16_bf16(PAF(3),VFR(14),o[2],0,0,0), P1,8); \
    GAPC(o[3]=__builtin_amdgcn_mfma_f32_32x32x16_bf16(PAF(3),VFR(15),o[3],0,0,0), P1,12); \
    }while(0)
  const f32x16 zero16=f32x16{};
  int t=1;
  #undef CMASK
  #define CMASK(P0,P1,t) do{}while(0)
  for(;t+5<NT;t+=2){
    STEP(pB0,pB1,pA0,pA1,t,true,true,true);     WAIT_BAR(3); RESC(); ROT();
    STEP(pA0,pA1,pB0,pB1,t+1,true,true,true);   WAIT_BAR(3); RESC(); ROT();
  }
  #undef CMASK
  #define CMASK(P0,P1,t) do{int jb_=(t)-(NT-4); if(jb_>=0)cmask(P0,P1,jb_,qrel,hi);}while(0)
  #define ENDW(tt) do{ if((tt)+3<NT){WAIT_BAR(3);} else if((tt)+2<NT){WAIT_BAR(2);} else {WAIT_BAR(0);} }while(0)
  for(;t+1<NT;t+=2){
    STEP(pB0,pB1,pA0,pA1,t,(t+3<NT),(t+1<NT),(t+1<NT));       ENDW(t);   RESC(); ROT();
    STEP(pA0,pA1,pB0,pB1,t+1,(t+4<NT),(t+2<NT),(t+2<NT));     ENDW(t+1); RESC(); ROT();
  }
  STEP(pB0,pB1,pA0,pA1,NT-1,false,false,false); RESC();
  { float sacc=pB0[0]+pB0[1]; _Pragma("unroll") for(int r=2;r<16;++r)sacc+=pB0[r]; _Pragma("unroll") for(int r=0;r<16;++r)sacc+=pB1[r]; l_reg+=sacc;
    pw0=(u32x4){PKW(pB0,0),PKW(pB0,2),PKW(pB0,4),PKW(pB0,6)};pw1=(u32x4){PKW(pB0,8),PKW(pB0,10),PKW(pB0,12),PKW(pB0,14)};pw2=(u32x4){PKW(pB1,0),PKW(pB1,2),PKW(pB1,4),PKW(pB1,6)};pw3=(u32x4){PKW(pB1,8),PKW(pB1,10),PKW(pB1,12),PKW(pB1,14)};
    SBAR(); pv(o,vb0+2*sl_cur,PAF(0),PAF(1),PAF(2),PAF(3)); pv(o+2,vb0+2*sl_cur+8192,PAF(0),PAF(1),PAF(2),PAF(3)); }
  #undef PKW
  #undef PAF
  #undef VFR
  #undef PIN
  #undef MX3
  #undef GAPA
  #undef GAPB
  #undef LOADB
  #undef EX
  #undef VRDJ
  #undef VOFF
  #undef GAPC
  #undef KRD
  #undef STEP
  #undef ENDW
  {auto rr=__builtin_amdgcn_permlane32_swap(__float_as_uint(l_reg),__float_as_uint(l_reg),false,false);l_reg=__uint_as_float(rr[0])+__uint_as_float(rr[1]);}
  if(hi==0)wsf[32+r32]=l_reg;asm volatile("s_waitcnt lgkmcnt(0)":::"memory");
  float rli[16];
  #pragma unroll
  for(int r=0;r<16;++r)rli[r]=__builtin_amdgcn_rcpf(wsf[32+crow(r,hi)]);
  bf16*Ow=Oc+(rowbase+q0+wid*QBLK)*PO;
  { bf16*stg=(bf16*)(shm+LDS_OST128)+wid*2048;
    #pragma unroll
    for(int hf=0;hf<2;++hf){
      #pragma unroll
      for(int r=0;r<16;++r){const int orow=crow(r,hi);
        #pragma unroll
        for(int d0=0;d0<2;++d0)stg[orow*64+d0*32+r32]=__float2bfloat16(o[2*hf+d0][r]*rli[r]);}
      asm volatile("s_waitcnt lgkmcnt(0)":::"memory");
      #pragma unroll
      for(int i=0;i<4;++i){const int row=i*8+(lane>>3),ch=lane&7; const u32x4 v=*(const u32x4*)(stg+row*64+ch*8); ATTN_STORE16(Ow+(long)row*PO+hf*64+ch*8,v);}
      asm volatile("s_waitcnt lgkmcnt(0)":::"memory"); } }
  asm volatile("s_waitcnt lgkmcnt(0)\n\ts_barrier":::"memory");
  #undef CINIT
  #undef DMA_K
  #undef DMA_V
  #undef CMASK
  #undef START
  #undef RESC
  #undef ROT
}
constexpr int ATTN_LDS_BYTES=(LDS_BYTES>LDS_BYTES128)?LDS_BYTES:LDS_BYTES128;
#undef SBAR
#undef WAIT_BAR
}

namespace xattn {
using pg8::bf16_t; using pg8::bf16x8; using pg8::u32x4; using pg8::f32x4;
using f32x16 = __attribute__((ext_vector_type(16))) float;
#define XLAS __attribute__((address_space(3)))
constexpr int XB0 = 0, XB1 = 32768, X_WSF = 65536, X_OST = X_WSF + 2048, X_LDS_BYTES = X_OST + 8 * 4096;
__device__ __forceinline__ int crow(int r, int hi) { return (r & 3) + 8 * (r >> 2) + 4 * hi; }
__device__ __forceinline__ unsigned pk(float lo, float hi) { return pg8::cvt_pk_bf16(lo, hi); }
__device__ __forceinline__ void unit(int b, int h, int qblk, const bf16_t* __restrict__ CQ, const bf16_t* __restrict__ CK, const bf16_t* __restrict__ CVT, bf16_t* __restrict__ CO, XLAS unsigned char* lds, const int wv) {
    const int tid = wv * 64 + mk_lane(), lane = tid & 63, r32 = lane & 31, hi = lane >> 5; const int wid = __builtin_amdgcn_readfirstlane(tid >> 6);
    const size_t qrow0 = (size_t)b * 4096 + (size_t)qblk * 256 + wid * 32;
    const bf16_t* Qw = CQ + (qrow0 + r32) * 1024 + h * 256 + hi * 8;
    const bf16_t* Kg = CK + ((size_t)b * 256 + lane) * 1024 + h * 256 + wid * 8;
    const bf16_t* Vg = CVT + ((size_t)h * 256 + lane) * 2048 + (size_t)b * 256 + wid * 8;
    u32x4 st[4];
#define X_LOADK(dc) do { _Pragma("unroll") for (int i_ = 0; i_ < 4; ++i_) st[i_] = *(const u32x4*)(Kg + (dc) * 64 + (size_t)i_ * 64 * 1024); } while (0)
#define X_LOADV(c)  do { _Pragma("unroll") for (int i_ = 0; i_ < 4; ++i_) st[i_] = *(const u32x4*)(Vg + (size_t)(c) * 64 * 2048 + i_ * 64); } while (0)
#define X_STOREK(buf) do { _Pragma("unroll") for (int i_ = 0; i_ < 4; ++i_) *(XLAS u32x4*)(lds + (buf) + wid * 4096 + (64 * i_ + lane) * 16) = st[i_]; } while (0)
#define X_STOREV(buf) do { _Pragma("unroll") for (int i_ = 0; i_ < 4; ++i_) *(XLAS u32x4*)(lds + (buf) + (wid + 8 * i_) * 1024 + lane * 16) = st[i_]; } while (0)
    const int kswz = (r32 & ~12) | ((r32 & 4) << 1) | ((r32 & 8) >> 1);
    const int koff = hi * 4096 + kswz * 16;
    const int voff = hi * 1024 + r32 * 16;
    f32x16 s[8];
#pragma unroll
    for (int kt = 0; kt < 8; ++kt) s[kt] = f32x16{};
    X_LOADK(0); X_STOREK(XB0);
    __syncthreads();
#pragma unroll
    for (int dc = 0; dc < 4; ++dc) {
        const int buf = (dc & 1) ? XB1 : XB0, nbuf = (dc & 1) ? XB0 : XB1;
        if (dc < 3) X_LOADK(dc + 1); else X_LOADV(0);
        bf16x8 qf[4];
#pragma unroll
        for (int ks = 0; ks < 4; ++ks) qf[ks] = *(const bf16x8*)(Qw + dc * 64 + ks * 16);
#pragma unroll
        for (int kt = 0; kt < 8; ++kt)
#pragma unroll
            for (int ks = 0; ks < 4; ++ks) {
                const bf16x8 kf = *(const XLAS bf16x8*)(lds + buf + koff + kt * 512 + ks * 8192);
                s[kt] = __builtin_amdgcn_mfma_f32_32x32x16_bf16(kf, qf[ks], s[kt], 0, 0, 0);
            }
        if (dc < 3) X_STOREK(nbuf); else X_STOREV(nbuf);
        __syncthreads();
    }
    float mx = s[0][0];
#pragma unroll
    for (int kt = 0; kt < 8; ++kt)
#pragma unroll
        for (int r = 0; r < 16; ++r) mx = fmaxf(mx, s[kt][r]);
    mx = fmaxf(mx, __shfl_xor(mx, 32));
    float l = 0.f;
#pragma unroll
    for (int kt = 0; kt < 8; ++kt)
#pragma unroll
        for (int r = 0; r < 16; ++r) { const float p = __builtin_amdgcn_exp2f(s[kt][r] - mx); s[kt][r] = p; l += p; }
    l += __shfl_xor(l, 32);
    u32x4 pw[16];
#pragma unroll
    for (int kt = 0; kt < 8; ++kt)
#pragma unroll
        for (int j2 = 0; j2 < 2; ++j2)
            pw[2 * kt + j2] = (u32x4){pk(s[kt][8 * j2 + 0], s[kt][8 * j2 + 1]), pk(s[kt][8 * j2 + 2], s[kt][8 * j2 + 3]), pk(s[kt][8 * j2 + 4], s[kt][8 * j2 + 5]), pk(s[kt][8 * j2 + 6], s[kt][8 * j2 + 7])};
    XLAS float* wsf = (XLAS float*)(lds + X_WSF) + wid * 64;
    if (hi == 0) wsf[r32] = l;
    asm volatile("s_waitcnt lgkmcnt(0)" ::: "memory");
    float rli[16];
#pragma unroll
    for (int r = 0; r < 16; ++r) rli[r] = 1.0f / wsf[crow(r, hi)];
    XLAS bf16_t* stg = (XLAS bf16_t*)(lds + X_OST) + wid * 2048;
    bf16_t* Ow = CO + qrow0 * 1024 + h * 256;
#pragma unroll
    for (int c = 0; c < 4; ++c) {
        const int buf = (c & 1) ? XB1 : XB0, nbuf = (c & 1) ? XB0 : XB1;
        if (c < 3) X_LOADV(c + 1);
        f32x16 o[2]; o[0] = f32x16{}; o[1] = f32x16{};
#pragma unroll
        for (int j = 0; j < 16; ++j)
#pragma unroll
            for (int dt = 0; dt < 2; ++dt) {
                const bf16x8 vf = *(const XLAS bf16x8*)(lds + buf + voff + dt * 512 + j * 2048);
                o[dt] = __builtin_amdgcn_mfma_f32_32x32x16_bf16(__builtin_bit_cast(bf16x8, pw[j]), vf, o[dt], 0, 0, 0);
            }
#pragma unroll
        for (int r = 0; r < 16; ++r) { const int orow = crow(r, hi);
#pragma unroll
            for (int dt = 0; dt < 2; ++dt) { const unsigned w = pk(o[dt][r] * rli[r], 0.f); stg[orow * 64 + dt * 32 + r32] = (bf16_t)(w & 0xffffu); } }
        asm volatile("s_waitcnt lgkmcnt(0)" ::: "memory");
#pragma unroll
        for (int i = 0; i < 4; ++i) { const int row = i * 8 + (lane >> 3), ch = lane & 7; const u32x4 v = *(const XLAS u32x4*)(stg + row * 64 + ch * 8); *(u32x4*)(Ow + (size_t)row * 1024 + c * 64 + ch * 8) = v; }
        asm volatile("s_waitcnt lgkmcnt(0)" ::: "memory");
        if (c < 3) X_STOREV(nbuf);
        __syncthreads();
    }
#undef X_LOADK
#undef X_LOADV
#undef X_STOREK
#undef X_STOREV
}
}

#ifndef MK_PER_PHASE
#define MK_PER_PHASE 0
#endif
constexpr int NWAVES = 8;
constexpr int BATCH = 8, SEQ = 4096, D = 1024, M = BATCH * SEQ, FF = 4096, NMEM = 256, MM = BATCH * NMEM, INW = 3080, NPROJ = 3072, NATT = 1536;
constexpr float EPS = 1e-6f, SUBLN_EPS = 1e-5f;
constexpr int N_PHASES = 11;

constexpr size_t MiB = 1u << 20;
constexpr size_t WS_ROPE = 0;
constexpr size_t WS_LOGF = 1 * MiB;
constexpr size_t WS_KB   = 2 * MiB;
constexpr size_t WS_NRM  = 3 * MiB;
constexpr size_t WS_BAR  = 3 * MiB + 65536;
constexpr size_t WS_SS1  = 4 * MiB, WS_SS2 = 6 * MiB, WS_SS3 = 8 * MiB;
constexpr size_t WS_WIN = 10 * MiB, WS_WOUT = 16 * MiB, WS_WCQ = 18 * MiB, WS_WCKV = 20 * MiB, WS_WCO = 24 * MiB, WS_WUP = 26 * MiB, WS_WDN = 34 * MiB;
constexpr size_t WS_MEMN = 42 * MiB, WS_CK = 46 * MiB, WS_CVT = 50 * MiB;
constexpr size_t WS_SA = 56 * MiB;
constexpr size_t WS_SB = 120 * MiB;
constexpr size_t WS_PROJ = 184 * MiB;
constexpr size_t WS_ATT = 376 * MiB;
constexpr size_t WS_ZH = 184 * MiB;
constexpr size_t WS_END = 472 * MiB;
static_assert(WS_ZH + (size_t)M * FF * 2 <= WS_END && WS_ATT + (size_t)M * NATT * 2 <= WS_END && WS_PROJ + (size_t)M * NPROJ * 2 <= WS_ATT, "d_ws map");

constexpr int RING_BYTES = 131072, LDS_BYTES = 147456;
static_assert(attn_body::ATTN_LDS_BYTES <= RING_BYTES && xattn::X_LDS_BYTES <= RING_BYTES && pg8::STAGE_BYTES <= RING_BYTES, "LDS map");

#define LAS __attribute__((address_space(3)))
typedef unsigned short bf16;
typedef unsigned v4u __attribute__((ext_vector_type(4)));
typedef float f32x4 __attribute__((ext_vector_type(4)));
#define LDS_WAIT() asm volatile("s_waitcnt lgkmcnt(0)" ::: "memory")
__device__ __forceinline__ unsigned f2bf(float f) { unsigned u = __builtin_bit_cast(unsigned, f); return (u + 0x7fffu + ((u >> 16) & 1u)) >> 16; }
__device__ __forceinline__ unsigned pk2(float lo, float hi) { return f2bf(lo) | (f2bf(hi) << 16); }
__device__ __forceinline__ float bflo(unsigned w) { return __builtin_bit_cast(float, w << 16); }
__device__ __forceinline__ float bfhi(unsigned w) { return __builtin_bit_cast(float, w & 0xffff0000u); }
__device__ __forceinline__ float wave_sum(float v) {
#pragma unroll
    for (int o = 1; o < 64; o <<= 1) v += __shfl_xor(v, o);
    return v;
}

#define XB_TMO      128
#define XB_XCNT(j)  (256  + 64 * (j))
#define XB_XSUB(j)  (1280 + 64 * (j))
#define XB_XGEN(j)  (2304 + 64 * (j))
#define XB_TOP      3328
#define XB_TOPGEN   3392
#define XCD_BAR_WORDS 3456
#define XB_SPIN_CAP (1u << 18)

__device__ __forceinline__ unsigned xb_ld(unsigned* p)              { return __hip_atomic_load(p, __ATOMIC_RELAXED, __HIP_MEMORY_SCOPE_AGENT); }
__device__ __forceinline__ unsigned xb_add(unsigned* p, unsigned v) { return __hip_atomic_fetch_add(p, v, __ATOMIC_RELAXED, __HIP_MEMORY_SCOPE_AGENT); }
__device__ __forceinline__ unsigned xb_xcc_id() { return (unsigned)__builtin_amdgcn_s_getreg((3 << 11) | 20) & 0xFu; }
#define XB_SPIN(cond, bar) do { unsigned _sp = 0; while (cond) { __builtin_amdgcn_s_sleep(1); \
    if ((++_sp & 255u) == 0u) { if (xb_ld(&(bar)[XB_TMO])) break; if (_sp > XB_SPIN_CAP) { atomicAdd(&(bar)[XB_TMO], 1u); break; } } } } while (0)

struct XcdBarrier {
    unsigned* bar; unsigned x;
    volatile LAS unsigned* st;
};

__device__ __forceinline__ XcdBarrier xcd_barrier_post(unsigned* bar, volatile LAS unsigned* st, bool leader) {
    XcdBarrier b; b.bar = bar; b.x = xb_xcc_id(); b.st = st;
    if (leader) (void)xb_add(&bar[XB_XCNT(b.x)], 1u);
    return b;
}
__device__ __forceinline__ void xcd_barrier_complete(unsigned* bar, unsigned x, unsigned& nloc, unsigned& nx) {
    const unsigned G = gridDim.x * gridDim.y * gridDim.z;
    unsigned sum, cnt, mine, sp = 0u;
    for (;;) {
        sum = 0u; cnt = 0u; mine = 0u;
#pragma unroll
        for (unsigned j = 0; j < 16; ++j) { const unsigned c = xb_ld(&bar[XB_XCNT(j)]); sum += c; cnt += (c > 0u) ? 1u : 0u; mine = (j == x) ? c : mine; }
        if (sum == G) break;
        __builtin_amdgcn_s_sleep(1);
        if ((++sp & 255u) == 0u) { if (xb_ld(&bar[XB_TMO])) break; if (sp > XB_SPIN_CAP) { atomicAdd(&bar[XB_TMO], 1u); break; } }
    }
    nloc = mine > 0u ? mine : 1u; nx = cnt > 0u ? cnt : 1u;
}

__device__ __forceinline__ void xcd_barrier(const XcdBarrier& b, bool leader) {
    asm volatile("s_waitcnt vmcnt(0)" ::: "memory");
    __syncthreads();
    if (leader) {
        unsigned* bar = b.bar;
        __builtin_amdgcn_s_waitcnt(0);
        unsigned nloc = b.st[0], nx = b.st[1];
        if (nloc == 0u) { xcd_barrier_complete(bar, b.x, nloc, nx); b.st[0] = nloc; b.st[1] = nx; }
        const unsigned old = xb_add(&bar[XB_XSUB(b.x)], 1u);
        const unsigned gen = old / nloc;
        if (old + 1u == (gen + 1u) * nloc) {
            __builtin_amdgcn_fence(__ATOMIC_RELEASE, "agent");
            asm volatile("s_waitcnt vmcnt(0)" ::: "memory");
            const unsigned og = xb_add(&bar[XB_TOP], 1u);
            const unsigned tg = og / nx;
            if (og + 1u == (tg + 1u) * nx) xb_add(&bar[XB_TOPGEN], 1u);
            else XB_SPIN(xb_ld(&bar[XB_TOPGEN]) == tg, bar);
            __builtin_amdgcn_fence(__ATOMIC_ACQUIRE, "agent");
            xb_add(&bar[XB_XGEN(b.x)], 1u);
            asm volatile("s_waitcnt vmcnt(0)" ::: "memory");
        } else {
            XB_SPIN(xb_ld(&bar[XB_XGEN(b.x)]) == gen, bar);
            __builtin_amdgcn_fence(__ATOMIC_ACQUIRE, "agent");
            asm volatile("s_waitcnt vmcnt(0)" ::: "memory");
        }
    }
    __syncthreads();
}

struct Params { const float* in[21]; float* out; unsigned char* ws; int ph_lo, ph_hi; };
enum { I_X = 0, I_MEM, I_GMIX, I_WIN, I_BF, I_LQ1, I_LK1, I_LQ2, I_LK2, I_GSUB, I_GFOX, I_WOUT, I_GCROSS, I_GMEM, I_WCQ, I_WCKV, I_WCO, I_GMLP, I_WUP, I_WDN, I_GFIN };

__device__ __forceinline__ void p0_transpose_item(const float* W, int K, int ldw, int nblk, bf16* WT, LAS float* scr, int item, int lane, const float* gk = nullptr  ) {
    const int kb = item / nblk, nb = item % nblk, k0 = 64 * kb, n0 = 32 * nb;
    { f32x4 v[8]; float gg[8];
#pragma unroll
        for (int it = 0; it < 8; ++it) { const int kk = 8 * it + (lane >> 3); v[it] = *(const f32x4*)(W + (size_t)(k0 + kk) * ldw + n0 + 4 * (lane & 7)); gg[it] = gk ? gk[k0 + kk] : 1.f; }
#pragma unroll
        for (int it = 0; it < 8; ++it) { const int kk = 8 * it + (lane >> 3); LAS float* d = scr + kk * 33 + 4 * (lane & 7); d[0] = v[it].x * gg[it]; d[1] = v[it].y * gg[it]; d[2] = v[it].z * gg[it]; d[3] = v[it].w * gg[it]; } }
    LDS_WAIT(); asm volatile("" ::: "memory");
    const int c = lane & 7;
#pragma unroll
    for (int j = 0; j < 4; ++j) { const int n = (lane >> 3) + 8 * j; const LAS float* s = scr + (8 * c) * 33 + n;
        v4u o; o.x = pk2(s[0 * 33], s[1 * 33]); o.y = pk2(s[2 * 33], s[3 * 33]); o.z = pk2(s[4 * 33], s[5 * 33]); o.w = pk2(s[6 * 33], s[7 * 33]);
        *(v4u*)(WT + (size_t)(n0 + n) * K + k0 + 8 * c) = o; }
    LDS_WAIT(); asm volatile("" ::: "memory");
}

__device__ __forceinline__ void rms_row(const float* xrow, const f32x4 (&gq)[4], bf16* orow, int lane, f32x4 (&v)[4]) {
    const f32x4* xr = (const f32x4*)xrow + lane; float s = 0.f;
#pragma unroll
    for (int j = 0; j < 4; ++j) { v[j] = xr[64 * j]; s += (v[j].x * v[j].x + v[j].y * v[j].y) + (v[j].z * v[j].z + v[j].w * v[j].w); }
    const float rstd = 1.0f / sqrtf(wave_sum(s) * (1.f / 1024.f) + EPS);
    unsigned long long* o8 = (unsigned long long*)orow + lane;
#pragma unroll
    for (int j = 0; j < 4; ++j) { v[j] = v[j] * rstd * gq[j]; o8[64 * j] = (unsigned long long)pk2(v[j].x, v[j].y) | ((unsigned long long)pk2(v[j].z, v[j].w) << 32); }
}

template <class Sched> __device__ __forceinline__ void build_rstd_tables(LAS unsigned char* lds, const Sched& S, const float* sspart, float eps, int wave) {
    const int lane = mk_lane(), tid = wave * 64 + lane;
    LAS int* pml = (LAS int*)(lds + RING_BYTES + 1536); LAS float* tab = (LAS float*)(lds + RING_BYTES + 2048);
    if (tid == 0) { int n = 0; pg8::Unit u; for (int i = 0; S.next(i, u); ++i) { bool f = false; for (int j = 0; j < n; ++j) f |= (pml[j] == u.pm); if (!f && n < 8) pml[n++] = u.pm; } pml[8] = n; }
    __syncthreads();
    const int n = pml[8];
    for (int idx = tid; idx < n * 256; idx += NWAVES * 64) tab[idx] = pg8::row_rstd(sspart, pml[idx >> 8] * 256 + (idx & 255), eps);
    __syncthreads();
}
__global__ void __launch_bounds__(NWAVES * 64, 2) mk_fwd(Params P) {
    extern __shared__ __attribute__((aligned(16))) unsigned char lds_raw[];
    LAS unsigned char* lds = (LAS unsigned char*)lds_raw;
    const int wave = __builtin_amdgcn_readfirstlane((int)threadIdx.x >> 6);
#define LANE_TID const int lane = mk_lane(), tid = wave * 64 + lane
    const int G = gridDim.x; const int bx = blockIdx.x; const int vcu = (G % 8 == 0) ? (bx % 8) * (G / 8) + bx / 8 : bx;
    const int gw = vcu * NWAVES + wave, NGW = G * NWAVES;
    unsigned char* const ws = P.ws;
#define ROPE ((float*)(P.ws + WS_ROPE))
#define LOGF ((float*)(P.ws + WS_LOGF))
#define KBIAS ((float*)(P.ws + WS_KB))
#define NRM ((float*)(P.ws + WS_NRM))
#define SS1 ((float*)(P.ws + WS_SS1))
#define SS2 ((float*)(P.ws + WS_SS2))
#define SS3 ((float*)(P.ws + WS_SS3))
#define Win_t ((bf16*)(P.ws + WS_WIN))
#define Wout_t ((bf16*)(P.ws + WS_WOUT))
#define Wcq_t ((bf16*)(P.ws + WS_WCQ))
#define Wckv_t ((bf16*)(P.ws + WS_WCKV))
#define Wco_t ((bf16*)(P.ws + WS_WCO))
#define Wup_t ((bf16*)(P.ws + WS_WUP))
#define Wdn_t ((bf16*)(P.ws + WS_WDN))
#define MEMN ((bf16*)(P.ws + WS_MEMN))
#define CKb ((bf16*)(P.ws + WS_CK))
#define CVT ((bf16*)(P.ws + WS_CVT))
#define XN ((bf16*)(P.ws + WS_SA))
#define MIXA ((bf16*)(P.ws + WS_SA))
#define CQ ((bf16*)(P.ws + WS_SA))
#define H2B ((bf16*)(P.ws + WS_SA))
#define H1B ((bf16*)(P.ws + WS_SB))
#define CO ((bf16*)(P.ws + WS_PROJ))
#define PROJ ((bf16*)(P.ws + WS_PROJ))
#define ATT ((bf16*)(P.ws + WS_ATT))
#define ZH ((bf16*)(P.ws + WS_ZH))
    const int lo = P.ph_lo, hi_ph = P.ph_hi;
    volatile LAS unsigned* xst = (volatile LAS unsigned*)(lds + RING_BYTES + 1024);
    { const int l0 = mk_lane(); if (wave == 0 && l0 < 2) xst[l0] = 0u; }
    __syncthreads();
    XcdBarrier bar; bar.bar = (unsigned*)(ws + WS_BAR); bar.x = 0; bar.st = xst;
    if (hi_ph - lo > 1) bar = xcd_barrier_post((unsigned*)(ws + WS_BAR), xst, wave == 0 && mk_lane() == 0);
    if (lo < 0) cg::this_grid().sync();
#define IN(k) (lo <= (k) && (k) < hi_ph)
#ifndef MK_MASK
#define MK_MASK 0x7ff
#endif
#ifndef MK_ATT_MASK
#define MK_ATT_MASK 3
#endif
#ifndef MK_REP_MASK
#define MK_REP_MASK 0
#endif
#define PH(k) (IN(k) && ((MK_MASK >> (k)) & 1))
#define REPS(k) for (int rep_ = 0; rep_ < (((MK_REP_MASK) >> (k)) & 1) + 1; ++rep_)
#define SEAM(k) do { if (IN(k) && IN((k) + 1)) { xcd_barrier(bar, wave == 0 && mk_lane() == 0); } } while (0)

    if (PH(0)) REPS(0) {
        LANE_TID;
        {
            const float* win = P.in[I_WIN];
            for (int k = tid; k < 1024; k += NWAVES * 64) { const f32x4 a = *(const f32x4*)(win + (size_t)k * INW + 3072), b = *(const f32x4*)(win + (size_t)k * INW + 3076);
                const int slot = (((k >> 8) * 4 + (k & 3)) * 64 + ((k & 255) >> 2)); *(LAS f32x4*)(lds + slot * 32) = a; *(LAS f32x4*)(lds + slot * 32 + 16) = b; }
        }
        if (bx == 0 && tid < BATCH * 32) NRM[tid] = 0.f;
        __syncthreads();
        LAS float* scr = (LAS float*)(lds + 32768 + wave * 8704);
        {
            constexpr int I_IN = 16 * 96, I_SQ = 16 * 32, I_CKV = 16 * 64, I_UP = 16 * 128, I_DN = 64 * 32;
            constexpr int NITEMS = I_IN + 3 * I_SQ + I_CKV + I_UP + I_DN;
            for (int it = gw; it < NITEMS; it += NGW) {
                int r = it;
                if (r < I_IN) { p0_transpose_item(P.in[I_WIN], D, INW, 96, Win_t, scr, r, lane); continue; } r -= I_IN;
                if (r < I_SQ) { p0_transpose_item(P.in[I_WOUT], D, D, 32, Wout_t, scr, r, lane); continue; } r -= I_SQ;
                if (r < I_SQ) { p0_transpose_item(P.in[I_WCQ], D, D, 32, Wcq_t, scr, r, lane, P.in[I_GCROSS]); continue; } r -= I_SQ;
                if (r < I_SQ) { p0_transpose_item(P.in[I_WCO], D, D, 32, Wco_t, scr, r, lane); continue; } r -= I_SQ;
                if (r < I_CKV) { p0_transpose_item(P.in[I_WCKV], D, 2 * D, 64, Wckv_t, scr, r, lane); continue; } r -= I_CKV;
                if (r < I_UP) { p0_transpose_item(P.in[I_WUP], D, FF, 128, Wup_t, scr, r, lane, P.in[I_GMLP]); continue; } r -= I_UP;
                p0_transpose_item(P.in[I_WDN], FF, D, 32, Wdn_t, scr, r, lane);
            }
        }
        {
            for (int idx = gw * 64 + lane; idx < SEQ * 8; idx += NGW * 64) {
                const int pos = idx >> 3, j = idx & 7;
                const float f = j == 0 ? 1.0f : j == 1 ? 0.1939227432012558f : j == 2 ? 0.03760603070259094f : j == 3 ? 0.007292664609849453f : j == 4 ? 0.0014142135623842478f : j == 5 ? 0.00027424818836152554f : j == 6 ? 5.318296098266728e-05f : 1.0313386155758053e-05f;
                const float ang = (float)pos * f;
                double rev = (double)ang * 0.15915494309189535; rev -= __builtin_rint(rev);
                const float x = (float)(rev * 6.283185307179586);
                ROPE[pos * 16 + j] = cosf(x); ROPE[pos * 16 + 8 + j] = sinf(x);
            }
        }
        {
            f32x4 gq[4];
#pragma unroll
            for (int j = 0; j < 4; ++j) gq[j] = ((const f32x4*)P.in[I_GMIX])[64 * j + lane];
            const float bfv = P.in[I_BF][lane & 7];
            const bool b0 = lane & 1, b1 = lane & 2, b2 = lane & 4;
            for (int m0 = gw * 4; m0 < M; m0 += NGW * 4) {
                f32x4 v[4][4]; float s[4];
#pragma unroll
                for (int r = 0; r < 4; ++r)
#pragma unroll
                    for (int jj = 0; jj < 4; ++jj) v[r][jj] = ((const f32x4*)(P.in[I_X] + (size_t)(m0 + r) * D))[64 * jj + lane];
#pragma unroll
                for (int r = 0; r < 4; ++r) { s[r] = 0.f;
#pragma unroll
                    for (int jj = 0; jj < 4; ++jj) s[r] += (v[r][jj].x * v[r][jj].x + v[r][jj].y * v[r][jj].y) + (v[r][jj].z * v[r][jj].z + v[r][jj].w * v[r][jj].w); }
#pragma unroll
                for (int r = 0; r < 4; ++r) { const float rstd = 1.0f / sqrtf(wave_sum(s[r]) * (1.f / 1024.f) + EPS);
                    unsigned long long* o8 = (unsigned long long*)(XN + (size_t)(m0 + r) * D) + lane;
#pragma unroll
                    for (int jj = 0; jj < 4; ++jj) { v[r][jj] = v[r][jj] * rstd * gq[jj]; o8[64 * jj] = (unsigned long long)pk2(v[r][jj].x, v[r][jj].y) | ((unsigned long long)pk2(v[r][jj].z, v[r][jj].w) << 32); } }
                f32x4 a0[4], a1[4];
#pragma unroll
                for (int r = 0; r < 4; ++r) { a0[r] = (f32x4){0.f, 0.f, 0.f, 0.f}; a1[r] = a0[r]; }
#pragma unroll
                for (int jj = 0; jj < 4; ++jj)
#pragma unroll
                    for (int i = 0; i < 4; ++i) { const LAS f32x4* wp = (const LAS f32x4*)(lds + ((jj * 4 + i) * 64 + lane) * 32); const f32x4 w0 = wp[0], w1 = wp[1];
#pragma unroll
                        for (int r = 0; r < 4; ++r) { a0[r] += w0 * v[r][jj][i]; a1[r] += w1 * v[r][jj][i]; } }
#pragma unroll
                for (int r = 0; r < 4; ++r) {
                    float c0, c1, c2, c3, d0, d1, z;
                    { const float k0 = b0 ? a0[r][1] : a0[r][0], g0 = b0 ? a0[r][0] : a0[r][1]; c0 = k0 + __shfl_xor(g0, 1); }
                    { const float k0 = b0 ? a0[r][3] : a0[r][2], g0 = b0 ? a0[r][2] : a0[r][3]; c1 = k0 + __shfl_xor(g0, 1); }
                    { const float k0 = b0 ? a1[r][1] : a1[r][0], g0 = b0 ? a1[r][0] : a1[r][1]; c2 = k0 + __shfl_xor(g0, 1); }
                    { const float k0 = b0 ? a1[r][3] : a1[r][2], g0 = b0 ? a1[r][2] : a1[r][3]; c3 = k0 + __shfl_xor(g0, 1); }
                    { const float k0 = b1 ? c1 : c0, g0 = b1 ? c0 : c1; d0 = k0 + __shfl_xor(g0, 2); }
                    { const float k0 = b1 ? c3 : c2, g0 = b1 ? c2 : c3; d1 = k0 + __shfl_xor(g0, 2); }
                    { const float k0 = b2 ? d1 : d0, g0 = b2 ? d0 : d1; z = k0 + __shfl_xor(g0, 4); }
                    z += __shfl_xor(z, 8); z += __shfl_xor(z, 16); z += __shfl_xor(z, 32);
                    z += bfv;
                    const float ls = fminf(z, 0.f) - __logf(1.0f + __expf(-fabsf(z)));
                    const int m = m0 + r;
                    if (lane < 8) LOGF[((size_t)(m >> 12) * 8 + lane) * SEQ + (m & 4095)] = ls;
                }
            }
        }
        {
            f32x4 gq[4];
#pragma unroll
            for (int j = 0; j < 4; ++j) gq[j] = ((const f32x4*)P.in[I_GMEM])[64 * j + lane];
            for (int m = gw; m < MM; m += NGW) { f32x4 v[4]; rms_row(P.in[I_MEM] + (size_t)m * D, gq, MEMN + (size_t)m * D, lane, v); }
        }
        __syncthreads();
    }
    SEAM(0);

    if (PH(1)) REPS(1) {
        LANE_TID;
        if (bx < BATCH * 8) {
            const float* src = LOGF + (size_t)bx * SEQ + tid * 8; float* dst = KBIAS + (size_t)bx * SEQ + tid * 8;
            const f32x4 a = *(const f32x4*)src, b = *(const f32x4*)(src + 4);
            float p[8]; p[0] = a[0]; p[1] = p[0] + a[1]; p[2] = p[1] + a[2]; p[3] = p[2] + a[3]; p[4] = p[3] + b[0]; p[5] = p[4] + b[1]; p[6] = p[5] + b[2]; p[7] = p[6] + b[3];
            float inc = p[7];
#pragma unroll
            for (int o = 1; o < 64; o <<= 1) { const float t = __shfl_up(inc, o); if (lane >= o) inc += t; }
            LAS float* wt = (LAS float*)lds;
            if (lane == 63) wt[wave] = inc;
            __syncthreads();
            float pre = inc - p[7];
            for (int w = 0; w < wave; ++w) pre += wt[w];
            const float c = -1.4426950408889634f;
            *(f32x4*)dst = (f32x4){(pre + p[0]) * c, (pre + p[1]) * c, (pre + p[2]) * c, (pre + p[3]) * c};
            *(f32x4*)(dst + 4) = (f32x4){(pre + p[4]) * c, (pre + p[5]) * c, (pre + p[6]) * c, (pre + p[7]) * c};
            __syncthreads();
        }
        { pg8::Gemm g{XN, Win_t, M, NPROJ, D}; pg8::StaticOrder S; S.init(M, NPROJ, G, bx);
          pg8::EpiProj E{PROJ, ROPE, NRM};
          pg8::gemm_phase<pg8::EpiProj, pg8::StaticOrder, true, true>(lds, g, S, E, wave); }
    }
    SEAM(1);

    if (PH(2)) REPS(2) {
        for (int p = vcu; p < 1024; p += G) {
            const int pp = p & 511, bh = pp >> 3, s = pp & 7, b = bh >> 3, hm = bh & 7;
#ifdef MK_REP_ATT
            if (rep_ == 1 && !((MK_REP_ATT) & (p < 512 ? 1 : 2))) continue;
#endif
            for (int hh = 0; hh < 2; ++hh) {
                const int qb = hh ? s : 15 - s;
                if (p < 512) { if (!(MK_ATT_MASK & 1)) continue;
                    attn_body::attn_unit128<16>(b, qb, (const attn_body::bf16*)PROJ + hm * 64, (const attn_body::bf16*)PROJ + 512 + hm * 64, (const attn_body::bf16*)PROJ + 1024 + (hm >> 1) * 128,
                                               (attn_body::bf16*)ATT + (hm & 1) * 512 + (hm >> 1) * 128, (char*)lds_raw, wave);
                } else { if (!(MK_ATT_MASK & 2)) continue; const int h = hm;
                    const float* nq = NRM + ((b * 2 + 0) * 8 + h) * 2; const float* nk = NRM + ((b * 2 + 1) * 8 + h) * 2; const float* kbr = KBIAS + (size_t)(b * 8 + h) * SEQ;
                    const float bqk = sqrtf((nq[0] + nq[1]) * (nk[0] + nk[1])) * 1.02f;
                    const int NTf = 4 * qb + 4, tc = 2 * (mk_lane() & 31);
                    const bool skip_ok = (tc >= 2) && (tc <= NTf - 4) && (2.f * bqk + kbr[64 * tc - 1 + (tc ? 0 : 1)] - kbr[256 * qb] < -40.f);
                    const unsigned long long bm = __ballot(skip_ok);
                    const int t0 = bm ? 2 * ((63 - __builtin_clzll(bm)) & 31) : 0;
                    attn_body::attn_unit<8, true>(b, qb, (const attn_body::bf16*)PROJ + 1536 + h * 64, (const attn_body::bf16*)PROJ + 2048 + h * 64, (const attn_body::bf16*)PROJ + 2560 + h * 64,
                                                  (attn_body::bf16*)ATT + 1024 + h * 64, kbr, t0, (char*)lds_raw, wave);
                }
            }
        }
    }
    SEAM(2);

    if (PH(3)) REPS(3) {
        LANE_TID;
        if (bx < 64) {
        { pg8::Gemm g{MEMN, Wckv_t, MM, D, D}; pg8::StaticOrder S; S.init(MM, D, G, bx);
          pg8::EpiBf16<0> E{CKb, D, nullptr, 0, 0, 1.f};
          pg8::gemm_phase<pg8::EpiBf16<0>, pg8::StaticOrder, true, true>(lds, g, S, E, wave); }
        { pg8::Gemm g{Wckv_t + (size_t)D * D, MEMN, D, MM, D}; pg8::StaticOrder S; S.init(D, MM, G, (bx + G - 32) % G);
          pg8::EpiBf16<0> E{CVT, MM, nullptr, 0, 0, 1.f};
          pg8::gemm_phase<pg8::EpiBf16<0>, pg8::StaticOrder, true, true>(lds, g, S, E, wave); }
        }
        const float sa = wave_sum(P.in[I_LQ1][lane] * P.in[I_LK1][lane]), sb = wave_sum(P.in[I_LQ2][lane] * P.in[I_LK2][lane]);
        const float lam = __expf(sa) - __expf(sb) + 0.2f;
        const f32x4 gs0 = *(const f32x4*)(P.in[I_GSUB] + (8 * lane) % 128), gs1 = *(const f32x4*)(P.in[I_GSUB] + (8 * lane) % 128 + 4);
        const f32x4 gf0 = *(const f32x4*)(P.in[I_GFOX] + (8 * lane) % 64), gf1 = *(const f32x4*)(P.in[I_GFOX] + (8 * lane) % 64 + 4);
        const int gw3 = (G > 64) ? (bx - 64) * NWAVES + wave : gw, NGW3 = (G > 64) ? (G - 64) * NWAVES : NGW;
        if (G <= 64 || bx >= 64)
        for (int m = gw3; m < M; m += NGW3) {
            const bf16* a = ATT + (size_t)m * NATT + 8 * lane;
            const v4u o1 = *(const v4u*)a, o2 = *(const v4u*)(a + 512), of = *(const v4u*)(a + 1024);
            float d[8], f[8];
#pragma unroll
            for (int e = 0; e < 4; ++e) { d[2 * e] = bflo(o1[e]) - lam * bflo(o2[e]); d[2 * e + 1] = bfhi(o1[e]) - lam * bfhi(o2[e]); f[2 * e] = bflo(of[e]); f[2 * e + 1] = bfhi(of[e]); }
            float sd = 0.f, sf = 0.f;
#pragma unroll
            for (int e = 0; e < 8; ++e) { sd += d[e] * d[e]; sf += f[e] * f[e]; }
            sd += __shfl_xor(sd, 1); sd += __shfl_xor(sd, 2); sd += __shfl_xor(sd, 4); sd += __shfl_xor(sd, 8);
            sf += __shfl_xor(sf, 1); sf += __shfl_xor(sf, 2); sf += __shfl_xor(sf, 4);
            const float rd = 0.8f / sqrtf(sd * (1.f / 128.f) + SUBLN_EPS), rf = 1.0f / sqrtf(sf * (1.f / 64.f) + EPS);
            v4u wd, wf;
            wd.x = pk2(d[0] * rd * gs0[0], d[1] * rd * gs0[1]); wd.y = pk2(d[2] * rd * gs0[2], d[3] * rd * gs0[3]); wd.z = pk2(d[4] * rd * gs1[0], d[5] * rd * gs1[1]); wd.w = pk2(d[6] * rd * gs1[2], d[7] * rd * gs1[3]);
            wf.x = pk2(f[0] * rf * gf0[0], f[1] * rf * gf0[1]); wf.y = pk2(f[2] * rf * gf0[2], f[3] * rf * gf0[3]); wf.z = pk2(f[4] * rf * gf1[0], f[5] * rf * gf1[1]); wf.w = pk2(f[6] * rf * gf1[2], f[7] * rf * gf1[3]);
            bf16* o = MIXA + (size_t)m * D + 8 * lane;
            *(v4u*)o = wd; *(v4u*)(o + 512) = wf;
        }
    }
    SEAM(3);

    if (PH(4)) REPS(4) { pg8::Gemm g{MIXA, Wout_t, M, D, D}; pg8::StaticOrder S; S.init(M, D, G, bx);
        pg8::EpiRes2<false, true> E{P.in[I_X], H1B, SS1};
        pg8::gemm_phase<pg8::EpiRes2<false, true>, pg8::StaticOrder, true, true>(lds, g, S, E, wave); }
    SEAM(4);

    if (PH(5)) REPS(5) { pg8::Gemm g{H1B, Wcq_t, M, D, D}; pg8::StaticOrder S; S.init(M, D, G, bx);
        build_rstd_tables(lds, S, SS1, EPS, wave);
        pg8::EpiRowScale<0> E{CQ, D, SS1, EPS, pg8::CROSS_C2, (const LAS int*)(lds + RING_BYTES + 1536), (const LAS float*)(lds + RING_BYTES + 2048)};
        pg8::gemm_phase<pg8::EpiRowScale<0>, pg8::StaticOrder, true, true>(lds, g, S, E, wave); }
    SEAM(5);

    if (PH(6)) REPS(6) {
        const int upc = (512 + G - 1) / G;
        for (int u = vcu * upc; u < (vcu + 1) * upc && u < 512; ++u) { const int bh = u >> 4, qblk = u & 15; xattn::unit(bh >> 2, bh & 3, qblk, CQ, CKb, CVT, CO, lds, wave); }
    }
    SEAM(6);

    if (PH(7)) REPS(7) { pg8::Gemm g{CO, Wco_t, M, D, D}; pg8::StaticOrder S; S.init(M, D, G, bx);
        pg8::EpiRes2<true, true> E{H1B, H2B, SS2};
        pg8::gemm_phase<pg8::EpiRes2<true, true>, pg8::StaticOrder, true, true>(lds, g, S, E, wave); }
    SEAM(7);

    if (PH(8)) REPS(8) { pg8::Gemm g{H2B, Wup_t, M, FF, D}; pg8::StaticOrder S; S.init(M, FF, G, bx);
        build_rstd_tables(lds, S, SS2, EPS, wave);
        pg8::EpiRowScale<1> E{ZH, FF, SS2, EPS, 1.f, (const LAS int*)(lds + RING_BYTES + 1536), (const LAS float*)(lds + RING_BYTES + 2048)};
        pg8::gemm_phase<pg8::EpiRowScale<1>, pg8::StaticOrder, true, true>(lds, g, S, E, wave); }
    SEAM(8);

    if (PH(9)) REPS(9) { pg8::Gemm g{ZH, Wdn_t, M, D, FF}; pg8::StaticOrder S; S.init(M, D, G, bx); S.rev = true;
        pg8::EpiRes2<true, true> E{H2B, H1B  , SS3};
        pg8::gemm_phase<pg8::EpiRes2<true, true>, pg8::StaticOrder, true, true>(lds, g, S, E, wave); }
    SEAM(9);

    if (PH(10)) REPS(10) {
        LANE_TID;
        f32x4 gq[4];
#pragma unroll
        for (int j = 0; j < 4; ++j) gq[j] = ((const f32x4*)P.in[I_GFIN])[64 * j + lane];
        for (int m0 = gw * 4; m0 < M; m0 += NGW * 4) {
            unsigned long long w[4][4]; float rr[4];
#pragma unroll
            for (int q = 0; q < 4; ++q) { const unsigned long long* hb = (const unsigned long long*)(H1B + (size_t)(m0 + q) * D) + lane;
#pragma unroll
                for (int j = 0; j < 4; ++j) w[q][j] = hb[64 * j];
                rr[q] = pg8::row_rstd(SS3, m0 + q, EPS); }
#pragma unroll
            for (int q = 0; q < 4; ++q) { f32x4* o = (f32x4*)(P.out + (size_t)(m0 + q) * D) + lane;
#pragma unroll
                for (int j = 0; j < 4; ++j) { const unsigned lo = (unsigned)w[q][j], hi2 = (unsigned)(w[q][j] >> 32);
                    const f32x4 v = {bflo(lo), bfhi(lo), bflo(hi2), bfhi(hi2)}; o[64 * j] = v * rr[q] * gq[j]; } }
        }
    }
#undef IN
#undef SEAM
#undef LANE_TID
#undef ROPE
#undef LOGF
#undef KBIAS
#undef NRM
#undef SS1
#undef SS2
#undef SS3
#undef Win_t
#undef Wout_t
#undef Wcq_t
#undef Wckv_t
#undef Wco_t
#undef Wup_t
#undef Wdn_t
#undef MEMN
#undef CKb
#undef CVT
#undef XN
#undef MIXA
#undef CQ
#undef H2B
#undef H1B
#undef CO
#undef PROJ
#undef ATT
#undef ZH
}

extern "C" void kernel_launch(void* const* d_in, const int* in_sizes, int n_in, void* d_out, int out_size, void* d_ws, size_t ws_size, hipStream_t stream) {
    static int grid = 0;
    if (grid == 0) {
        if (n_in != 21 || in_sizes[0] != M * D || out_size != M * D || ws_size < WS_END) { fprintf(stderr, "kernel_launch: unexpected shapes (n_in %d, in0 %d, out %d, ws %zu); nothing launched\n", n_in, n_in > 0 ? in_sizes[0] : -1, out_size, ws_size); grid = -1; return; }
        int dev = 0, cus = 0, per_cu = 0;
        if (hipGetDevice(&dev) != hipSuccess || hipDeviceGetAttribute(&cus, hipDeviceAttributeMultiprocessorCount, dev) != hipSuccess) { grid = -1; return; }
        if (hipFuncSetAttribute((const void*)mk_fwd, hipFuncAttributeMaxDynamicSharedMemorySize, LDS_BYTES) != hipSuccess) { fprintf(stderr, "kernel_launch: hipFuncSetAttribute failed\n"); grid = -1; return; }
        if (hipOccupancyMaxActiveBlocksPerMultiprocessor(&per_cu, (const void*)mk_fwd, NWAVES * 64, LDS_BYTES) != hipSuccess || per_cu < 1) { fprintf(stderr, "kernel_launch: occupancy query says %d blocks per CU\n", per_cu); per_cu = 1; }
        (void)hipGetLastError();
        grid = cus * per_cu;
    }
    if (grid < 0) return;
    if (hipMemsetAsync((char*)d_ws + WS_BAR, 0, XCD_BAR_WORDS * 4, stream) != hipSuccess) { fprintf(stderr, "kernel_launch: memset of the barrier words failed\n"); return; }
    Params p{};
    for (int i = 0; i < 21; ++i) p.in[i] = (const float*)d_in[i];
    p.out = (float*)d_out; p.ws = (unsigned char*)d_ws;
#if MK_PER_PHASE
    for (int ph = 0; ph < N_PHASES; ++ph) { p.ph_lo = ph; p.ph_hi = ph + 1; hipLaunchKernelGGL(mk_fwd, dim3(grid), dim3(NWAVES * 64), LDS_BYTES, stream, p); }
#else
    p.ph_lo = 0; p.ph_hi = N_PHASES;
    void* args[] = {&p};
    const hipError_t e = hipLaunchCooperativeKernel((const void*)mk_fwd, dim3(grid), dim3(NWAVES * 64), args, LDS_BYTES, stream);
    if (e != hipSuccess) fprintf(stderr, "kernel_launch: cooperative launch failed: %s (grid %d)\n", hipGetErrorString(e), grid);
#endif
}
```

```cpp
#include <hip/hip_runtime.h>
#include <hip/hip_cooperative_groups.h>
#include <hip/hip_bf16.h>
#include <cstdio>
#include <cstdint>
#include <cmath>
namespace cg = cooperative_groups;
__device__ __forceinline__ int mk_lane() { int l = (int)__builtin_amdgcn_mbcnt_hi(~0u, __builtin_amdgcn_mbcnt_lo(~0u, 0u)); asm volatile("" : "+v"(l)); return l; }
namespace pg8 {
#define PG8_LAS __attribute__((address_space(3)))
typedef unsigned short bf16_t;
typedef short bf16x8 __attribute__((ext_vector_type(8)));
typedef float f32x4 __attribute__((ext_vector_type(4)));
typedef unsigned u32x4 __attribute__((ext_vector_type(4)));
constexpr int BM = 256, BK = 64, HALF = 128, HTB = HALF * BK * 2  , STAGE_BYTES = 8 * HTB, NXCD = 8, WGM = 8;

__host__ __device__ __forceinline__ int lds_byte(int r, int c) { const int st = (r >> 4) * 2 + (c >> 5), rr = r & 15, cc = c & 31, ob = rr * 64 + cc * 2; return st * 1024 + (ob ^ (((ob >> 9) & 1) << 5)); }
__host__ __device__ __forceinline__ void stage_rc(int b, int& R, int& C) { const int st = b / 1024, sb = b % 1024, swz = sb ^ (((sb >> 9) & 1) << 5); R = (st >> 1) * 16 + swz / 64; C = (st & 1) * 32 + (swz % 64) / 2; }
__host__ __device__ __forceinline__ int perm32(int rho) { const int n = rho >> 4, i = rho & 15; return 8 * (i >> 2) + 4 * n + (i & 3); }

struct Unit { int pm, pn; };
struct Gemm { const bf16_t* A; const bf16_t* Bt; int M, N, K; };

struct StaticOrder {
    int nM, nN, nwg, G, c; bool rev = false;
    __host__ __device__ __forceinline__ void init(int M, int N, int G_, int c_) { nM = M / BM; nN = N / BM; nwg = nM * nN; G = G_; c = c_; }
    __host__ __device__ __forceinline__ bool next(int i, Unit& u) const {
        const long L = (long)i * G + c; if (L >= nwg) return false;
        int wgid = (int)L; { const int q = nwg / NXCD, r = nwg % NXCD, xcd = wgid % NXCD, off = wgid / NXCD; wgid = (xcd < r ? xcd * (q + 1) : r * (q + 1) + (xcd - r) * q) + off; }
        const int nig = WGM * nN, gid = wgid / nig, fm = gid * WGM, gsz = (nM - fm) < WGM ? (nM - fm) : WGM;
        u.pm = fm + ((wgid % nig) % gsz); u.pn = (wgid % nig) / gsz; if (rev) u.pm = nM - 1 - u.pm; return true;
    }
    __device__ __forceinline__ void a_ready(const Unit&) const {}
    __device__ __forceinline__ void done(const Unit&) const {}
};

__device__ __forceinline__ unsigned cvt_pk_bf16(float lo, float hi) { unsigned r; asm volatile("v_cvt_pk_bf16_f32 %0, %1, %2" : "=v"(r) : "v"(lo), "v"(hi)); return r; }
typedef float f32x2 __attribute__((ext_vector_type(2)));
__device__ __forceinline__ f32x2 gelu_pk(f32x2 v) {
    const f32x2 av = __builtin_elementwise_abs(v), d = av * 0.2316418882f + 1.0f;
    f32x2 t; t.x = __builtin_amdgcn_rcpf(d.x); t.y = __builtin_amdgcn_rcpf(d.y);
    f32x2 q = t * 0.5307027145f + (-0.7265760135f); q = q * t + 0.7107068705f; q = q * t + (-0.142248368f); q = q * t + 0.127414796f; q = q * t;
    const f32x2 s = (v * v) * (-0.72134752044f);
    f32x2 e; e.x = __builtin_amdgcn_exp2f(s.x); e.y = __builtin_amdgcn_exp2f(s.y);
    const f32x2 m = v * (q * e), r = v - m;
    f32x2 o; o.x = v.x < 0.f ? m.x : r.x; o.y = v.y < 0.f ? m.y : r.y; return o;
}

template <int ACT  > struct EpiBf16 {
    static constexpr bool PERM = true, AFTER_DRAIN = false; static_assert(ACT == 0 || ACT == 1, "EpiBf16: ACT is 0 (none) or 1 (gelu_pk)");
    bf16_t* O; int ldc; const float* bias; int split_cols; size_t split_stride; float scale0;
    __device__ __forceinline__ void operator()(const f32x4 (&acc)[2][2][4][2], const Unit& u, int wr, int wc, int fr, int fq) const {
        const int row0 = u.pm * BM + wr * 64 + fr; int colt = u.pn * BM; bf16_t* base = O;
        float sc = 1.f; if (split_cols) { const int t = colt / split_cols; base += (size_t)t * split_stride; colt -= t * split_cols; if (t == 0) sc = scale0; }
        const int col0 = colt + wc * 32 + 8 * fq, bcol0 = u.pn * BM + wc * 32 + 8 * fq;
        f32x4 bv[2][2];
#pragma unroll
        for (int bj = 0; bj < 2; ++bj)
#pragma unroll
            for (int n = 0; n < 2; ++n) bv[bj][n] = bias ? *(const f32x4*)(bias + bcol0 + bj * HALF + 4 * n) : (f32x4){0.f, 0.f, 0.f, 0.f};
#pragma unroll
        for (int ai = 0; ai < 2; ++ai)
#pragma unroll
            for (int m = 0; m < 4; ++m) { bf16_t* rowp = base + (size_t)(row0 + ai * HALF + m * 16) * ldc + col0;
#pragma unroll
                for (int bj = 0; bj < 2; ++bj) { f32x4 v0 = acc[ai][bj][m][0] + bv[bj][0], v1 = acc[ai][bj][m][1] + bv[bj][1];
                    if (ACT == 1) { f32x2 a = gelu_pk((f32x2){v0[0], v0[1]}), b = gelu_pk((f32x2){v0[2], v0[3]}), c = gelu_pk((f32x2){v1[0], v1[1]}), d = gelu_pk((f32x2){v1[2], v1[3]});
                        v0 = (f32x4){a.x, a.y, b.x, b.y}; v1 = (f32x4){c.x, c.y, d.x, d.y}; }
                    v0 = v0 * sc; v1 = v1 * sc; u32x4 w; w.x = cvt_pk_bf16(v0[0], v0[1]); w.y = cvt_pk_bf16(v0[2], v0[3]); w.z = cvt_pk_bf16(v1[0], v1[1]); w.w = cvt_pk_bf16(v1[2], v1[3]);
                    *(u32x4*)(rowp + bj * HALF) = w; } }
    }
};

constexpr float QK_C2 = 0.125f * 1.4426950408889634f;
constexpr float CROSS_C2 = 0.0625f * 1.4426950408889634f;
__device__ __forceinline__ float row_rstd(const float* part, int row, float eps) {
    const f32x4* p = (const f32x4*)(part + (size_t)row * 16);
    const f32x4 a = p[0], b = p[1], c = p[2], d = p[3];
    const float s = ((a[0] + a[1]) + (a[2] + a[3])) + ((b[0] + b[1]) + (b[2] + b[3])) + ((c[0] + c[1]) + (c[2] + c[3])) + ((d[0] + d[1]) + (d[2] + d[3]));
    return 1.0f / sqrtf(s * (1.0f / 1024.0f) + eps);
}
struct EpiProj {
    static constexpr bool PERM = true, AFTER_DRAIN = false;
    bf16_t* O; const float* rope; float* nrm;
    __device__ __forceinline__ void operator()(const f32x4 (&acc)[2][2][4][2], const Unit& u, int wr, int wc, int fr, int fq) const {
        const int row0 = u.pm * BM + wr * 64 + fr, col0 = u.pn * BM + wc * 32 + 8 * fq;
        const int typ = u.pn >> 1;
        const float sc = (typ == 0 || typ == 3) ? QK_C2 : 1.f;
        const bool ropew = (typ < 2) && ((wc & 1) == 0);
        const bool nrmw = (typ == 0 || typ == 1 || typ == 3 || typ == 4); float mxn[2] = {0.f, 0.f};
#pragma unroll
        for (int ai = 0; ai < 2; ++ai) {
            f32x4 rc[4][4];
            if (ropew) {
#pragma unroll
                for (int m = 0; m < 4; ++m) { const f32x4* rp = (const f32x4*)(rope + (size_t)((row0 + ai * HALF + m * 16) & 4095) * 16); rc[m][0] = rp[0]; rc[m][1] = rp[1]; rc[m][2] = rp[2]; rc[m][3] = rp[3]; }
            }
#pragma unroll
            for (int m = 0; m < 4; ++m) {
                const int row = row0 + ai * HALF + m * 16;
                bf16_t* rowp = O + (size_t)row * 3072 + col0;
                f32x4 c0 = {1.f, 1.f, 1.f, 1.f}, c1 = c0, s0 = {0.f, 0.f, 0.f, 0.f}, s1 = s0;
                if (ropew) { c0 = rc[m][0]; c1 = rc[m][1]; s0 = rc[m][2]; s1 = rc[m][3]; if (fq == 0) { s0 = -s0; s1 = -s1; } if (fq >= 2) { c0 = (f32x4){1.f, 1.f, 1.f, 1.f}; c1 = c0; s0 = (f32x4){0.f, 0.f, 0.f, 0.f}; s1 = s0; } }
#pragma unroll
                for (int bj = 0; bj < 2; ++bj) {
                    f32x4 v0 = acc[ai][bj][m][0], v1 = acc[ai][bj][m][1];
                    if (ropew) {
                        f32x4 p0, p1;
#pragma unroll
                        for (int e = 0; e < 4; ++e) { p0[e] = __shfl_xor(v0[e], 16); p1[e] = __shfl_xor(v1[e], 16); }
                        v0 = v0 * c0 + p0 * s0; v1 = v1 * c1 + p1 * s1;
                    }
                    v0 = v0 * sc; v1 = v1 * sc;
                    if (nrmw) { float q = (v0[0] * v0[0] + v0[1] * v0[1]) + (v0[2] * v0[2] + v0[3] * v0[3]) + (v1[0] * v1[0] + v1[1] * v1[1]) + (v1[2] * v1[2] + v1[3] * v1[3]);
                        q += __shfl_xor(q, 16); q += __shfl_xor(q, 32); mxn[bj] = fmaxf(mxn[bj], q); }
                    u32x4 w; w.x = cvt_pk_bf16(v0[0], v0[1]); w.y = cvt_pk_bf16(v0[2], v0[3]); w.z = cvt_pk_bf16(v1[0], v1[1]); w.w = cvt_pk_bf16(v1[2], v1[3]);
                    *(u32x4*)(rowp + bj * HALF) = w;
                }
            }
        }
        if (nrmw) {
#pragma unroll
            for (int bj = 0; bj < 2; ++bj) { float q = mxn[bj];
                q = fmaxf(q, __shfl_xor(q, 1)); q = fmaxf(q, __shfl_xor(q, 2)); q = fmaxf(q, __shfl_xor(q, 4)); q = fmaxf(q, __shfl_xor(q, 8));
                const int rel = 256 * (u.pn & 1) + 128 * bj + 32 * wc, b = (u.pm * BM) >> 12;
                if (fr == 0 && fq == 0) atomicMax((unsigned*)nrm + (typ < 2 ? 256 : 0) + ((b * 2 + ((typ == 1 || typ == 4) ? 1 : 0)) * 8 + (rel >> 6)) * 2 + ((rel >> 5) & 1), __float_as_uint(q * 1.02f)); }
        }
    }
};
template <bool BASE_BF16, bool OUT_BF16> struct EpiRes2 {
    static constexpr bool PERM = true, AFTER_DRAIN = false;
    const void* base; void* out; float* sspart;
    __device__ __forceinline__ void operator()(const f32x4 (&acc)[2][2][4][2], const Unit& u, int wr, int wc, int fr, int fq) const {
        const int row0 = u.pm * BM + wr * 64 + fr, col0 = u.pn * BM + wc * 32 + 8 * fq;
#pragma unroll
        for (int ai = 0; ai < 2; ++ai) {
            u32x4 bw[4][2]; f32x4 bf[4][2][2];
#pragma unroll
            for (int m = 0; m < 4; ++m)
#pragma unroll
                for (int bj = 0; bj < 2; ++bj) { const size_t off = (size_t)(row0 + ai * HALF + m * 16) * 1024 + col0 + bj * HALF;
                    if (BASE_BF16) bw[m][bj] = *(const u32x4*)((const bf16_t*)base + off);
                    else { bf[m][bj][0] = *(const f32x4*)((const float*)base + off); bf[m][bj][1] = *(const f32x4*)((const float*)base + off + 4); } }
#pragma unroll
            for (int m = 0; m < 4; ++m) {
                const int row = row0 + ai * HALF + m * 16; const size_t off = (size_t)row * 1024 + col0;
                float ss = 0.f;
#pragma unroll
                for (int bj = 0; bj < 2; ++bj) {
                    f32x4 b0, b1;
                    if (BASE_BF16) { const u32x4 w = bw[m][bj];
                        b0 = (f32x4){__builtin_bit_cast(float, w.x << 16), __builtin_bit_cast(float, w.x & 0xffff0000u), __builtin_bit_cast(float, w.y << 16), __builtin_bit_cast(float, w.y & 0xffff0000u)};
                        b1 = (f32x4){__builtin_bit_cast(float, w.z << 16), __builtin_bit_cast(float, w.z & 0xffff0000u), __builtin_bit_cast(float, w.w << 16), __builtin_bit_cast(float, w.w & 0xffff0000u)}; }
                    else { b0 = bf[m][bj][0]; b1 = bf[m][bj][1]; }
                    const f32x4 v0 = acc[ai][bj][m][0] + b0, v1 = acc[ai][bj][m][1] + b1;
                    ss += (v0[0] * v0[0] + v0[1] * v0[1]) + (v0[2] * v0[2] + v0[3] * v0[3]) + (v1[0] * v1[0] + v1[1] * v1[1]) + (v1[2] * v1[2] + v1[3] * v1[3]);
                    if (OUT_BF16) { u32x4 w; w.x = cvt_pk_bf16(v0[0], v0[1]); w.y = cvt_pk_bf16(v0[2], v0[3]); w.z = cvt_pk_bf16(v1[0], v1[1]); w.w = cvt_pk_bf16(v1[2], v1[3]);
                        *(u32x4*)((bf16_t*)out + off + bj * HALF) = w; }
                    else { *(f32x4*)((float*)out + off + bj * HALF) = v0; *(f32x4*)((float*)out + off + bj * HALF + 4) = v1; }
                }
                ss += __shfl_xor(ss, 16); ss += __shfl_xor(ss, 32);
                if (fq == 0) sspart[(size_t)row * 16 + u.pn * 4 + wc] = ss;
            }
        }
    }
};
template <int ACT> struct EpiRowScale {
    static constexpr bool PERM = true, AFTER_DRAIN = false;
    bf16_t* O; int ldc; const float* sspart; float eps; float sc;
    const PG8_LAS int* pml; const PG8_LAS float* tab;
    __device__ __forceinline__ void operator()(const f32x4 (&acc)[2][2][4][2], const Unit& u, int wr, int wc, int fr, int fq) const {
        const int row0 = u.pm * BM + wr * 64 + fr, col0 = u.pn * BM + wc * 32 + 8 * fq;
        int slot = -1;
        if (tab) { const int n = pml[8]; for (int j = 0; j < n; ++j) if (pml[j] == u.pm) slot = j; }
#pragma unroll
        for (int ai = 0; ai < 2; ++ai)
#pragma unroll
            for (int m = 0; m < 4; ++m) {
                const int row = row0 + ai * HALF + m * 16; bf16_t* rowp = O + (size_t)row * ldc + col0;
                const float r = (slot >= 0 ? tab[slot * 256 + (row - u.pm * BM)] : row_rstd(sspart, row, eps)) * sc;
#pragma unroll
                for (int bj = 0; bj < 2; ++bj) {
                    f32x4 v0 = acc[ai][bj][m][0] * r, v1 = acc[ai][bj][m][1] * r;
                    if (ACT == 1) {
#pragma unroll
                        for (int e = 0; e < 4; ++e) { const float a = fmaxf(v0[e], 0.f), b = fmaxf(v1[e], 0.f); v0[e] = a * a; v1[e] = b * b; }
                    }
                    u32x4 w; w.x = cvt_pk_bf16(v0[0], v0[1]); w.y = cvt_pk_bf16(v0[2], v0[3]); w.z = cvt_pk_bf16(v1[0], v1[1]); w.w = cvt_pk_bf16(v1[2], v1[3]);
                    *(u32x4*)(rowp + bj * HALF) = w;
                }
            }
    }
};
template <class Epi, class Sched, bool ALIGN_EPI = false, bool SP2 = false>
__device__ __forceinline__ void gemm_phase(PG8_LAS unsigned char* lds, const Gemm g, const Sched& S, const Epi& E, const int wv  ) {
    int tid_ = wv * 64 + mk_lane();
    const int tid = tid_, wid = __builtin_amdgcn_readfirstlane(tid >> 6), lane = tid & 63, wr = wid >> 2, wc = wid & 3, fr = lane & 15, fq = lane >> 4;
    const int K = g.K, nt = K / BK;
    unsigned voffA[2], voffB[2];
#pragma unroll
    for (int i = 0; i < 2; ++i) { int R, C; stage_rc(tid * 16 + i * 8192, R, C); const int Rb = Epi::PERM ? ((R & ~31) + perm32(R & 31)) : R;
        voffA[i] = (unsigned)(R * K + C) * 2u; voffB[i] = (unsigned)(Rb * K + C) * 2u; }
    const size_t kstep = (size_t)(BK * 2);
    const size_t hstep = (size_t)HALF * K * 2;
    const size_t tstep = 2 * hstep;
    const unsigned ldsw = (unsigned)wid * 1024u;
    const int aoff = lds_byte(wr * 64 + fr, fq * 8), boff = lds_byte(wc * 32 + fr, fq * 8);
#define PG8_SA(b, h) (((b) * 2 + (h)) * HTB)
#define PG8_SB(b, h) ((4 + (b) * 2 + (h)) * HTB)
#define PG8_STAGE(bufoff, gbase, voff) do { _Pragma("unroll") for (int _i = 0; _i < 2; ++_i) \
        __builtin_amdgcn_global_load_lds((const unsigned*)((const char*)(gbase) + (voff)[_i]), (PG8_LAS unsigned*)(lds + (bufoff) + ldsw + _i * 8192), 16, 0, 0); } while (0)
#define PG8_LDA(dst, b, h) do { _Pragma("unroll") for (int m = 0; m < 4; ++m) _Pragma("unroll") for (int k = 0; k < 2; ++k) dst[m][k] = *(const PG8_LAS bf16x8*)(lds + PG8_SA(b, h) + aoff + m * 2048 + k * 1024); } while (0)
#define PG8_LDB(dst, b, h) do { _Pragma("unroll") for (int n = 0; n < 2; ++n) _Pragma("unroll") for (int k = 0; k < 2; ++k) dst[n][k] = *(const PG8_LAS bf16x8*)(lds + PG8_SB(b, h) + boff + n * 2048 + k * 1024); } while (0)
#define PG8_MMA(ai, bj, At, Bt) do { __builtin_amdgcn_s_setprio(1); _Pragma("unroll") for (int m = 0; m < 4; ++m) _Pragma("unroll") for (int n = 0; n < 2; ++n) _Pragma("unroll") for (int k = 0; k < 2; ++k) \
        acc[ai][bj][m][n] = __builtin_amdgcn_mfma_f32_16x16x32_bf16(Bt[n][k], At[m][k], acc[ai][bj][m][n], 0, 0, 0); __builtin_amdgcn_s_setprio(0); } while (0)
#define PG8_WAIT_V(n) asm volatile("s_waitcnt vmcnt(" #n ")" ::: "memory")
#define PG8_WAIT_L(n) asm volatile("s_waitcnt lgkmcnt(" #n ")" ::: "memory")
#define PG8_BAR __builtin_amdgcn_s_barrier()
#define PG8_SCHED __builtin_amdgcn_sched_barrier(0)
    Unit cur, nxt; int ui = 0;
    if (!S.next(0, cur)) return;
    f32x4 acc[2][2][4][2];
#pragma unroll
    for (int a = 0; a < 2; ++a)
#pragma unroll
        for (int b = 0; b < 2; ++b)
#pragma unroll
            for (int m = 0; m < 4; ++m)
#pragma unroll
                for (int n = 0; n < 2; ++n) acc[a][b][m][n] = (f32x4){0.f, 0.f, 0.f, 0.f};
    bf16x8 At[4][2], B0[2][2], B1[2][2];
    const char* cA = (const char*)g.A + (size_t)cur.pm * tstep; const char* cB = (const char*)g.Bt + (size_t)cur.pn * tstep;
    S.a_ready(cur);
    if constexpr (SP2) {
        PG8_STAGE(PG8_SB(0, 0), cB, voffB); PG8_STAGE(PG8_SB(0, 1), cB + hstep, voffB); PG8_STAGE(PG8_SA(0, 0), cA, voffA); PG8_STAGE(PG8_SA(0, 1), cA + hstep, voffA);
        if (wr == 1) PG8_BAR;
        PG8_WAIT_V(2); PG8_BAR;
        PG8_STAGE(PG8_SB(1, 0), cB + kstep, voffB); PG8_STAGE(PG8_SA(1, 0), cA + kstep, voffA); PG8_STAGE(PG8_SB(1, 1), cB + hstep + kstep, voffB);
        PG8_WAIT_V(6); PG8_BAR;
    } else {
        PG8_STAGE(PG8_SB(0, 0), cB, voffB); PG8_STAGE(PG8_SA(0, 0), cA, voffA); PG8_STAGE(PG8_SB(0, 1), cB + hstep, voffB); PG8_STAGE(PG8_SA(0, 1), cA + hstep, voffA);
        if (wr == 1) PG8_BAR;
        PG8_WAIT_V(4); PG8_BAR;
        PG8_STAGE(PG8_SB(1, 0), cB + kstep, voffB); PG8_STAGE(PG8_SA(1, 0), cA + kstep, voffA); PG8_STAGE(PG8_SB(1, 1), cB + hstep + kstep, voffB);
        PG8_WAIT_V(6); PG8_BAR;
    }
    for (;;) {
        const bool has_next = S.next(ui + 1, nxt);
        const char* nA = has_next ? (const char*)g.A + (size_t)nxt.pm * tstep : cA; const char* nB = has_next ? (const char*)g.Bt + (size_t)nxt.pn * tstep : cB;
        for (int t = 0; t < nt; t += 2) {
            const bool last = (t == nt - 2);
            const char* a1 = cA + (size_t)(t + 1) * kstep;
            const char* a2 = last ? nA : cA + (size_t)(t + 2) * kstep; const char* b2 = last ? nB : cB + (size_t)(t + 2) * kstep;
            const char* a3 = a2 + kstep; const char* b3 = b2 + kstep;
            if (last && has_next) S.a_ready(nxt);
            if constexpr (SP2) {
            PG8_LDB(B0, 0, 0); PG8_LDB(B1, 0, 1); PG8_SCHED; PG8_LDA(At, 0, 0); PG8_STAGE(PG8_SA(1, 1), a1 + hstep, voffA);
            PG8_WAIT_V(8); PG8_WAIT_L(0); PG8_BAR; PG8_MMA(0, 0, At, B0); PG8_MMA(0, 1, At, B1); PG8_BAR; PG8_SCHED;
            PG8_LDA(At, 0, 1); PG8_STAGE(PG8_SB(0, 0), b2, voffB); PG8_STAGE(PG8_SB(0, 1), b2 + hstep, voffB); PG8_STAGE(PG8_SA(0, 0), a2, voffA);
            PG8_WAIT_V(8); PG8_WAIT_L(0); PG8_BAR; PG8_MMA(1, 0, At, B0); PG8_MMA(1, 1, At, B1); PG8_BAR; PG8_SCHED;
            PG8_LDB(B0, 1, 0); PG8_LDB(B1, 1, 1); PG8_SCHED; PG8_LDA(At, 1, 0); PG8_STAGE(PG8_SA(0, 1), a2 + hstep, voffA);
            PG8_WAIT_V(8); PG8_WAIT_L(0); PG8_BAR; PG8_MMA(0, 0, At, B0); PG8_MMA(0, 1, At, B1); PG8_BAR; PG8_SCHED;
            PG8_LDA(At, 1, 1); PG8_STAGE(PG8_SB(1, 0), b3, voffB); PG8_STAGE(PG8_SB(1, 1), b3 + hstep, voffB); PG8_STAGE(PG8_SA(1, 0), a3, voffA);
            PG8_WAIT_V(8); PG8_WAIT_L(0); PG8_BAR; PG8_MMA(1, 0, At, B0); PG8_MMA(1, 1, At, B1); PG8_BAR; PG8_SCHED;
            } else {
            PG8_LDB(B0, 0, 0); PG8_SCHED; PG8_LDA(At, 0, 0); PG8_STAGE(PG8_SA(1, 1), a1 + hstep, voffA);
            PG8_WAIT_L(8); PG8_BAR; PG8_WAIT_L(0); PG8_MMA(0, 0, At, B0); PG8_BAR; PG8_SCHED;
            PG8_LDB(B1, 0, 1); PG8_STAGE(PG8_SB(0, 0), b2, voffB);
            PG8_BAR; PG8_WAIT_L(0); PG8_MMA(0, 1, At, B1); PG8_BAR;
            PG8_LDA(At, 0, 1); PG8_STAGE(PG8_SA(0, 0), a2, voffA);
            PG8_BAR; PG8_WAIT_L(0); PG8_MMA(1, 0, At, B0); PG8_BAR; PG8_SCHED;
            PG8_STAGE(PG8_SB(0, 1), b2 + hstep, voffB);
            PG8_WAIT_V(6); PG8_BAR; PG8_MMA(1, 1, At, B1); PG8_BAR;
            PG8_LDB(B0, 1, 0); PG8_SCHED; PG8_LDA(At, 1, 0); PG8_STAGE(PG8_SA(0, 1), a2 + hstep, voffA);
            PG8_WAIT_L(8); PG8_BAR; PG8_WAIT_L(0); PG8_MMA(0, 0, At, B0); PG8_BAR; PG8_SCHED;
            PG8_LDB(B1, 1, 1); PG8_STAGE(PG8_SB(1, 0), b3, voffB);
            PG8_BAR; PG8_WAIT_L(0); PG8_MMA(0, 1, At, B1); PG8_BAR;
            PG8_LDA(At, 1, 1); PG8_STAGE(PG8_SA(1, 0), a3, voffA);
            PG8_BAR; PG8_WAIT_L(0); PG8_MMA(1, 0, At, B0); PG8_BAR; PG8_SCHED;
            PG8_STAGE(PG8_SB(1, 1), b3 + hstep, voffB);
            PG8_WAIT_V(6); PG8_BAR; PG8_MMA(1, 1, At, B1); PG8_BAR;
            }
        }
        if constexpr (ALIGN_EPI) { if (wr == 0) PG8_BAR; }
        if constexpr (!Epi::AFTER_DRAIN) { E(acc, cur, wr, wc, fr, fq); S.done(cur); }
        if (!has_next) break;
#pragma unroll
        for (int a = 0; a < 2; ++a)
#pragma unroll
            for (int b = 0; b < 2; ++b)
#pragma unroll
                for (int m = 0; m < 4; ++m)
#pragma unroll
                    for (int n = 0; n < 2; ++n) acc[a][b][m][n] = (f32x4){0.f, 0.f, 0.f, 0.f};
        cur = nxt; cA = nA; cB = nB; ++ui;
        if constexpr (ALIGN_EPI) { if (wr == 1) PG8_BAR; }
    }
    PG8_WAIT_V(0);
    if constexpr (!ALIGN_EPI) { if (wr == 0) PG8_BAR; }
    PG8_BAR;
    if constexpr (Epi::AFTER_DRAIN) { E.fused(acc, cur, wr, wc, fr, fq, lds, wid, lane); S.done(cur); }
#undef PG8_SA
#undef PG8_SB
#undef PG8_STAGE
#undef PG8_LDA
#undef PG8_LDB
#undef PG8_MMA
#undef PG8_WAIT_V
#undef PG8_WAIT_L
#undef PG8_BAR
#undef PG8_SCHED
}
}

#ifndef PG8_SP2
#define PG8_SP2 true
#endif
#ifndef PG8_ALIGN
#define PG8_ALIGN true
#endif
namespace attn_body {
using bf16=__hip_bfloat16;
using bf16x8=__attribute__((ext_vector_type(8)))short;
using s16x4=__attribute__((ext_vector_type(4)))short;
using f32x16=__attribute__((ext_vector_type(16)))float;
using u32x4=__attribute__((ext_vector_type(4)))unsigned; using f32x4=__attribute__((ext_vector_type(4)))float;
constexpr int SEQ=4096,D=64,PQ=3072,PO=1536;
constexpr int NW=8,QBLK=32,QB=QBLK*NW,KVBLK=64,NQB=SEQ/QB;
constexpr int ATTN_UNIT_ROWS=QB;
__device__ __forceinline__ int crow(int r,int hi){return (r&3)+8*(r>>2)+4*hi;}
#define SBAR() __builtin_amdgcn_sched_barrier(0)
__device__ __forceinline__ void cmask(f32x16&p0,f32x16&p1,int jb,int qrel,int hi){
  const float NEG=-INFINITY; int kb=64*jb+4*hi;
  #pragma unroll
  for(int r=0;r<16;++r){int kv=kb+(r&3)+8*(r>>2); if(kv>qrel)p0[r]=NEG; if(kv+32>qrel)p1[r]=NEG;}
}

template<bool B> __device__ __forceinline__ const f32x16& csel(const f32x16&a,const f32x16&b){ if constexpr(B) return a; else return b; }
constexpr int NSLOT=3, SLOTB=8192;
constexpr int LDS_K=0, LDS_V=NSLOT*SLOTB, LDS_WS=2*NSLOT*SLOTB, LDS_OST=LDS_WS+NW*64*4, LDS_KBIAS=LDS_OST+NW*4096, LDS_BYTES=LDS_KBIAS+SEQ*4;
constexpr float C2=0.125f*1.4426950408889634f;
__device__ __forceinline__ void glds16(const void*gsrc,unsigned lds_dst){unsigned keep;
  asm volatile("s_mov_b32 %0, m0\n\ts_mov_b32 m0, %2\n\ts_nop 0\n\tglobal_load_lds_dwordx4 %1, off\n\ts_mov_b32 m0, %0":"=&s"(keep):"v"(gsrc),"s"(lds_dst):"memory");}
__device__ __forceinline__ float max3f(float a,float b,float c){float r;asm("v_max3_f32 %0, %1, %2, %3":"=v"(r):"v"(a),"v"(b),"v"(c));return r;}
__device__ __forceinline__ float max2f(float a,float b){float r;asm("v_max_f32_e32 %0, %1, %2":"=v"(r):"v"(a),"v"(b));return r;}
__device__ __forceinline__ float fadd_s(float a,float b){float r;asm("v_add_f32_e32 %0, %1, %2":"=v"(r):"v"(a),"v"(b));return r;}
__device__ __forceinline__ float fsub_s(float a,float b){float r;asm("v_sub_f32_e32 %0, %1, %2":"=v"(r):"v"(a),"v"(b));return r;}
typedef float f32x2_t __attribute__((ext_vector_type(2))); typedef __bf16 bf16x2_t __attribute__((ext_vector_type(2)));
__device__ __forceinline__ unsigned cvtpk_s(float lo,float hi){f32x2_t v={lo,hi};bf16x2_t b=__builtin_convertvector(v,bf16x2_t);return __builtin_bit_cast(unsigned,b);}
#define WAIT_BAR(N) asm volatile("s_waitcnt vmcnt(" #N ") lgkmcnt(0)\n\ts_barrier":::"memory")

__device__ __forceinline__ void qkt(f32x16&p0,f32x16&p1,const char*Kslot,const bf16x8*qr,const f32x16&ci0,const f32x16&ci1,int r32,int hi){
  const char*kb=Kslot+hi*1024+r32*16;
  #pragma unroll
  for(int d0=0;d0<4;++d0){
    const bf16x8 b0=*reinterpret_cast<const bf16x8*>(kb+d0*2048);
    const bf16x8 b1=*reinterpret_cast<const bf16x8*>(kb+d0*2048+512);
    if(d0==0){p0=__builtin_amdgcn_mfma_f32_32x32x16_bf16(b0,qr[0],ci0,0,0,0);p1=__builtin_amdgcn_mfma_f32_32x32x16_bf16(b1,qr[0],ci1,0,0,0);}
    else{p0=__builtin_amdgcn_mfma_f32_32x32x16_bf16(b0,qr[d0],p0,0,0,0);p1=__builtin_amdgcn_mfma_f32_32x32x16_bf16(b1,qr[d0],p1,0,0,0);}}
}
typedef __attribute__((address_space(3))) const char* lds_cptr;
typedef short v4i16_t __attribute__((ext_vector_type(4)));
__device__ __forceinline__ void kload8(bf16x8*kf,lds_cptr kp){
  kf[0]=*(const __attribute__((address_space(3))) bf16x8*)(kp);      kf[1]=*(const __attribute__((address_space(3))) bf16x8*)(kp+512);
  kf[2]=*(const __attribute__((address_space(3))) bf16x8*)(kp+2048); kf[3]=*(const __attribute__((address_space(3))) bf16x8*)(kp+2560);
  kf[4]=*(const __attribute__((address_space(3))) bf16x8*)(kp+4096); kf[5]=*(const __attribute__((address_space(3))) bf16x8*)(kp+4608);
  kf[6]=*(const __attribute__((address_space(3))) bf16x8*)(kp+6144); kf[7]=*(const __attribute__((address_space(3))) bf16x8*)(kp+6656);
}
__device__ __forceinline__ void kload2(bf16x8*kf,lds_cptr kp,int j){ kf[2*j]=*(const __attribute__((address_space(3))) bf16x8*)(kp+j*2048); kf[2*j+1]=*(const __attribute__((address_space(3))) bf16x8*)(kp+j*2048+512); }
__device__ __forceinline__ s16x4 vtr(lds_cptr p){ return __builtin_bit_cast(s16x4,__builtin_amdgcn_ds_read_tr16_b64_v4i16((__attribute__((address_space(3))) v4i16_t*)p)); }
__device__ __forceinline__ float rowmax(const f32x16&p0,const f32x16&p1){
  float a=max3f(p0[0],p0[1],p1[0]),b=max3f(p0[2],p0[3],p1[1]);a=max3f(a,p1[2],p1[3]);
  #pragma unroll
  for(int r=4;r<16;r+=4){a=max3f(a,p0[r],p0[r+1]);b=max3f(b,p0[r+2],p0[r+3]);a=max3f(a,p1[r],p1[r+1]);b=max3f(b,p1[r+2],p1[r+3]);}
  const float m=max2f(a,b);
  auto rr=__builtin_amdgcn_permlane32_swap(__float_as_uint(m),__float_as_uint(m),false,false);
  return max2f(__uint_as_float(rr[0]),__uint_as_float(rr[1]));
}
__device__ __forceinline__ void pv(f32x16*o,int vb,bf16x8 pa0,bf16x8 pa1,bf16x8 pa2,bf16x8 pa3){
  #pragma unroll
  for(int d0=0;d0<2;++d0){s16x4 lo[4],hi[4];
    #pragma unroll
    for(int ks=0;ks<4;++ks){
      asm volatile("ds_read_b64_tr_b16 %0,%1 offset:%c2":"=&v"(lo[ks]):"v"(vb),"i"(d0*4096+ks*1024):"memory");
      asm volatile("ds_read_b64_tr_b16 %0,%1 offset:%c2":"=&v"(hi[ks]):"v"(vb),"i"(d0*4096+ks*1024+512):"memory");}
    asm volatile("s_waitcnt lgkmcnt(0)":::"memory");SBAR();
    #define PK(k) (bf16x8){lo[k][0],lo[k][1],lo[k][2],lo[k][3],hi[k][0],hi[k][1],hi[k][2],hi[k][3]}
    o[d0]=__builtin_amdgcn_mfma_f32_32x32x16_bf16(pa0,PK(0),o[d0],0,0,0);
    o[d0]=__builtin_amdgcn_mfma_f32_32x32x16_bf16(pa1,PK(1),o[d0],0,0,0);
    o[d0]=__builtin_amdgcn_mfma_f32_32x32x16_bf16(pa2,PK(2),o[d0],0,0,0);
    o[d0]=__builtin_amdgcn_mfma_f32_32x32x16_bf16(pa3,PK(3),o[d0],0,0,0);
    #undef PK
  }
}

#ifndef ATTN_STORE16
#define ATTN_STORE16(p,v) (*(u32x4*)(p)=(v))
#endif
template<int THRL,bool HASB> __device__ __forceinline__ void attn_unit(int b,int qb,const bf16*Qc,const bf16*__restrict__ Kc,const bf16*__restrict__ Vc,bf16*Oc,const float*__restrict__ kbg,int t0,char*shm,const int wv){
  int tid_=wv*64+mk_lane();
  const int tid=tid_,lane=tid&63,r32=lane&31,hi=lane>>5; const int wid=__builtin_amdgcn_readfirstlane(tid>>6);
  const long rowbase=(long)b*SEQ; const int q0=qb*QB;
  const bf16*Qw=Qc+(rowbase+q0+wid*QBLK)*PQ;
  const bf16*Kh=Kc+(rowbase+(long)t0*KVBLK)*PQ,*Vh=Vc+(rowbase+(long)t0*KVBLK)*PQ;
  const unsigned lds0=(unsigned)(uintptr_t)shm;
  float*wsf=(float*)(shm+LDS_WS)+wid*64;
  const bf16*ksrc=Kh+(long)lane*PQ+wid*8;
  const bf16*vsrc=Vh+(long)(16*(wid&3)+(lane>>2))*PQ+(wid>>2)*32+(lane&3)*8;
  const unsigned kdst=lds0+LDS_K+wid*1024, vdst=lds0+LDS_V+wid*1024;
  #define DMA_K(t,slot) glds16(ksrc+(long)(t)*KVBLK*PQ,(unsigned)__builtin_amdgcn_readfirstlane(kdst+(slot)))
  #define DMA_V(t,slot) glds16(vsrc+(long)(t)*KVBLK*PQ,(unsigned)__builtin_amdgcn_readfirstlane(vdst+(slot)))
  const int vb0=(int)(lds0+LDS_V)+((lane>>4)&1)*32+(lane&3)*8+(4*hi+((lane&15)>>2))*64;
  const char*Kbase=shm+LDS_K; bf16x8 kf[8];
  const lds_cptr shm3=(lds_cptr)shm; const lds_cptr kp0=shm3+LDS_K+hi*1024+r32*16; const lds_cptr vp0=shm3+LDS_V+((lane>>4)&1)*32+(lane&3)*8+(4*hi+((lane&15)>>2))*64;
  const int NT=(q0+QB)/KVBLK-t0;
  typedef __attribute__((address_space(3))) const f32x4 lds_cf4; typedef __attribute__((address_space(3))) f32x4 lds_f4;
  const __attribute__((address_space(3))) char* kbl=(const __attribute__((address_space(3))) char*)shm+LDS_KBIAS+hi*16;
  DMA_K(0,0);DMA_V(0,0);DMA_K(1,SLOTB);
  bf16x8 qr[4];
  #pragma unroll
  for(int d0=0;d0<4;++d0)qr[d0]=*reinterpret_cast<const bf16x8*>(&Qw[(long)r32*PQ+d0*16+hi*8]);
  float mhat=0.f,l_reg=0.f;f32x16 o[2];o[0]=f32x16{};o[1]=f32x16{};f32x16 negm=f32x16{};asm volatile("":"+v"(negm));
  const int qrel=wid*QBLK+r32;
  float mref=0.f;
  #define CINIT(C0,C1,t) do{ if(HASB){ const __attribute__((address_space(3))) char* kp_=kbl+(t)*256; \
      _Pragma("unroll") for(int g_=0;g_<4;++g_){ const f32x4 a_=*(lds_cf4*)(kp_+g_*32), b_=*(lds_cf4*)(kp_+128+g_*32); \
        _Pragma("unroll") for(int e_=0;e_<4;++e_){ C0[4*g_+e_]=a_[e_]-mhat; C1[4*g_+e_]=b_[e_]-mhat; } } } \
    }while(0)
  #define CMASK(P0,P1,t) do{int jb_=(t)-(NT-4); if(jb_>=0)cmask(P0,P1,jb_,qrel,hi);}while(0)
  bool resc=false;
  #define START(P0,P1) do{ const float rm=rowmax(P0,P1); resc=false; \
    { const float dl=HASB?__builtin_fmaxf(rm,0.f):rm; mhat=fadd_s(mhat,dl); \
      _Pragma("unroll") for(int r=0;r<16;++r){P0[r]=fsub_s(P0[r],dl);P1[r]=fsub_s(P1[r],dl);} \
      if(!HASB){ _Pragma("unroll") for(int r=0;r<16;++r)negm[r]=-mhat; asm volatile("":"+v"(negm)); } } \
    _Pragma("unroll") for(int r=0;r<16;++r)P0[r]=__builtin_amdgcn_exp2f(P0[r]); }while(0)
  #define RESC() do{ if(resc){ asm volatile("s_waitcnt lgkmcnt(0)":::"memory"); \
      _Pragma("unroll") for(int d_=0;d_<2;++d_) _Pragma("unroll") for(int r=0;r<16;++r)o[d_][r]*=wsf[crow(r,hi)]; } }while(0)
  f32x16 pA0,pA1,pB0,pB1;
  int sl_prev=0,sl_cur=0,sl_next=SLOTB;
  #define ROT() do{sl_prev=sl_cur;sl_cur=sl_next;sl_next=(sl_next==(NSLOT-1)*SLOTB)?0:sl_next+SLOTB;}while(0)
  DMA_K(2,2*SLOTB);
  if(HASB){ const int n4=(q0+QB-t0*KVBLK)/4; for(int i=tid;i<n4;i+=NW*64){ const f32x4 v=*(const f32x4*)(kbg+t0*KVBLK+4*i); *((lds_f4*)((__attribute__((address_space(3))) char*)shm+LDS_KBIAS)+i)=v; } }
  WAIT_BAR(3);
  if(HASB){ mref=*(const __attribute__((address_space(3))) float*)((const __attribute__((address_space(3))) char*)shm+LDS_KBIAS+(q0-t0*KVBLK+qrel)*4); mhat=mref; }
  { f32x16 ci0=f32x16{},ci1=f32x16{}; CINIT(ci0,ci1,0); qkt(pA0,pA1,Kbase,qr,csel<HASB>(ci0,negm),csel<HASB>(ci1,negm),r32,hi); } asm volatile("s_nop 15\n\ts_nop 7":"+v"(pA0),"+v"(pA1));CMASK(pA0,pA1,0);
  START(pA0,pA1);
  _Pragma("unroll") for(int r=0;r<16;++r)pA1[r]=__builtin_amdgcn_exp2f(pA1[r]);
  WAIT_BAR(0);
  DMA_K(3,0);DMA_V(1,SLOTB);
  ROT();
  kload8(kf,kp0+sl_cur);
  WAIT_BAR(2);
  s16x4 vlo[8],vhi[8]; u32x4 pw0,pw1,pw2,pw3;
  #define PKW(P,B) cvtpk_s(P[B],P[B+1])
  #define PAF(k) __builtin_bit_cast(bf16x8,pw##k)
  #define VFR(i) (bf16x8){vlo[i][0],vlo[i][1],vlo[i][2],vlo[i][3],vhi[i][0],vhi[i][1],vhi[i][2],vhi[i][3]}
  #define PIN(x) asm volatile("":"+v"(x))
  #define MX3(a,b,c) __builtin_fmaxf(__builtin_fmaxf((a),(b)),(c))
  #define GAPA(MF,A0,A1,A2,A3,W0,W1,PW) do{ MF; sacc+=A0; sacc+=A1; sacc+=A2; sacc+=A3; PIN(sacc); W0; W1; PIN(PW); SBAR(); }while(0)
  #define EX(v) __builtin_amdgcn_exp2f(v)
  #define GAPB(MF,X,B,Y) do{ MF; X[B]=EX(X[B]); X[B+1]=EX(X[B+1]); X[B+2]=EX(X[B+2]); X[B+3]=EX(X[B+3]); PIN(X); if(HASB){ Y[B]-=mhat; Y[B+1]-=mhat; Y[B+2]-=mhat; Y[B+3]-=mhat; PIN(Y); } SBAR(); }while(0)
  #define LOADB(Y0,Y1,t) do{ if(HASB){ const __attribute__((address_space(3))) char* kp_=kbl+(t)*256; \
      _Pragma("unroll") for(int g_=0;g_<4;++g_){ const f32x4 a_=*(lds_cf4*)(kp_+g_*32), b_=*(lds_cf4*)(kp_+128+g_*32); \
        _Pragma("unroll") for(int e_=0;e_<4;++e_){ Y0[4*g_+e_]=a_[e_]; Y1[4*g_+e_]=b_[e_]; } } } }while(0)
  #define VRD(i) do{ vlo[i]=vtr(vp_+(((i)>>2)*4096+((i)&3)*1024)); vhi[i]=vtr(vp_+(((i)>>2)*4096+((i)&3)*1024+512)); }while(0)
  #define KRD(G,j) do{ if(G){ kload2(kf,kp0+sl_next,j); SBAR(); } }while(0)
  #define STEP(C0,C1,P0,P1,t,GK,GV,GL) do{ SBAR(); \
    const lds_cptr vp_=vp0+sl_prev; \
    VRD(0); SBAR(); float sacc=(P0[0]+P0[1]); \
    GAPA(C0=__builtin_amdgcn_mfma_f32_32x32x16_bf16(kf[0],qr[0],csel<HASB>(C0,negm),0,0,0), P0[2],P0[3],P0[4],P0[5],     pw0[0]=PKW(P0,0), pw0[1]=PKW(P0,2), pw0); \
    VRD(4); SBAR(); GAPA(C1=__builtin_amdgcn_mfma_f32_32x32x16_bf16(kf[1],qr[0],csel<HASB>(C1,negm),0,0,0), P0[6],P0[7],P0[8],P0[9],     pw0[2]=PKW(P0,4), pw0[3]=PKW(P0,6), pw0); \
    VRD(1); SBAR(); GAPA(C0=__builtin_amdgcn_mfma_f32_32x32x16_bf16(kf[2],qr[1],C0,0,0,0),   P0[10],P0[11],P0[12],P0[13], pw1[0]=PKW(P0,8), pw1[1]=PKW(P0,10), pw1); \
    VRD(5); SBAR(); GAPA(C1=__builtin_amdgcn_mfma_f32_32x32x16_bf16(kf[3],qr[1],C1,0,0,0),   P0[14],P0[15],P1[0],P1[1],   pw1[2]=PKW(P0,12),pw1[3]=PKW(P0,14), pw1); \
    VRD(2); SBAR(); GAPA(C0=__builtin_amdgcn_mfma_f32_32x32x16_bf16(kf[4],qr[2],C0,0,0,0),   P1[2],P1[3],P1[4],P1[5],     pw2[0]=PKW(P1,0), pw2[1]=PKW(P1,2), pw2); \
    VRD(6); SBAR(); GAPA(C1=__builtin_amdgcn_mfma_f32_32x32x16_bf16(kf[5],qr[2],C1,0,0,0),   P1[6],P1[7],P1[8],P1[9],     pw2[2]=PKW(P1,4), pw2[3]=PKW(P1,6), pw2); \
    VRD(3); SBAR(); GAPA(C0=__builtin_amdgcn_mfma_f32_32x32x16_bf16(kf[6],qr[3],C0,0,0,0),   P1[10],P1[11],P1[12],P1[13], pw3[0]=PKW(P1,8), pw3[1]=PKW(P1,10), pw3); \
    VRD(7); SBAR(); GAPA(C1=__builtin_amdgcn_mfma_f32_32x32x16_bf16(kf[7],qr[3],C1,0,0,0),   P1[14],P1[15],0.f,0.f,       pw3[2]=PKW(P1,12),pw3[3]=PKW(P1,14), pw3); \
    l_reg+=sacc; \
    LOADB(P0,P1,(t)+1); \
    if(GK){DMA_K((t)+3,sl_cur);} if(GV){DMA_V((t)+1,sl_next);} \
    CMASK(C0,C1,t); \
    { float a=MX3(C0[0],C0[1],C1[0]),b=MX3(C0[2],C0[3],C1[1]); a=MX3(a,C1[2],C1[3]); \
      _Pragma("unroll") for(int r=4;r<16;r+=4){a=MX3(a,C0[r],C0[r+1]);b=MX3(b,C0[r+2],C0[r+3]);a=MX3(a,C1[r],C1[r+1]);b=MX3(b,C1[r+2],C1[r+3]);} \
      float rm=__builtin_fmaxf(a,b); { auto rr=__builtin_amdgcn_permlane32_swap(__float_as_uint(rm),__float_as_uint(rm),false,false); rm=__builtin_fmaxf(__uint_as_float(rr[0]),__uint_as_float(rr[1])); } \
      resc=false; \
      if(__builtin_expect(__any(rm>(float)THRL),0)){ const float dl=__builtin_fmaxf(rm,0.f); mhat+=dl; \
        _Pragma("unroll") for(int r=0;r<16;++r){C0[r]-=dl;C1[r]-=dl;} \
        if(!HASB){ _Pragma("unroll") for(int r=0;r<16;++r)negm[r]=-mhat; asm volatile("":"+v"(negm)); } \
        const float f=__builtin_amdgcn_exp2f(-dl); l_reg*=f; if(hi==0)wsf[r32]=f; resc=true; } } \
    SBAR(); \
    GAPB(o[0]=__builtin_amdgcn_mfma_f32_32x32x16_bf16(PAF(0),VFR(0),o[0],0,0,0), C0,0,P0); \
    GAPB(o[1]=__builtin_amdgcn_mfma_f32_32x32x16_bf16(PAF(0),VFR(4),o[1],0,0,0), C0,4,P0); \
    KRD(GL,0); GAPB(o[0]=__builtin_amdgcn_mfma_f32_32x32x16_bf16(PAF(1),VFR(1),o[0],0,0,0), C0,8,P0); \
    KRD(GL,1); GAPB(o[1]=__builtin_amdgcn_mfma_f32_32x32x16_bf16(PAF(1),VFR(5),o[1],0,0,0), C0,12,P0); \
    KRD(GL,2); GAPB(o[0]=__builtin_amdgcn_mfma_f32_32x32x16_bf16(PAF(2),VFR(2),o[0],0,0,0), C1,0,P1); \
    KRD(GL,3); GAPB(o[1]=__builtin_amdgcn_mfma_f32_32x32x16_bf16(PAF(2),VFR(6),o[1],0,0,0), C1,4,P1); \
    GAPB(o[0]=__builtin_amdgcn_mfma_f32_32x32x16_bf16(PAF(3),VFR(3),o[0],0,0,0), C1,8,P1); \
    GAPB(o[1]=__builtin_amdgcn_mfma_f32_32x32x16_bf16(PAF(3),VFR(7),o[1],0,0,0), C1,12,P1); \
    }while(0)
  CINIT(pB0,pB1,1);
  int t=1;
  #undef CMASK
  #define CMASK(P0,P1,t) do{}while(0)
  for(;t+5<NT;t+=2){
    STEP(pB0,pB1,pA0,pA1,t,true,true,true);     WAIT_BAR(2); RESC(); ROT();
    STEP(pA0,pA1,pB0,pB1,t+1,true,true,true);   WAIT_BAR(2); RESC(); ROT();
  }
  #undef CMASK
  #define CMASK(P0,P1,t) do{int jb_=(t)-(NT-4); if(jb_>=0)cmask(P0,P1,jb_,qrel,hi);}while(0)
  #define ENDW(tt) do{ if((tt)+3<NT){WAIT_BAR(2);} else if((tt)+2<NT){WAIT_BAR(1);} else {WAIT_BAR(0);} }while(0)
  for(;t+1<NT;t+=2){
    STEP(pB0,pB1,pA0,pA1,t,(t+3<NT),(t+1<NT),(t+1<NT));       ENDW(t);   RESC(); ROT();
    STEP(pA0,pA1,pB0,pB1,t+1,(t+4<NT),(t+2<NT),(t+2<NT));     ENDW(t+1); RESC(); ROT();
  }
  STEP(pB0,pB1,pA0,pA1,NT-1,false,false,false); RESC();
  { float sacc=pB0[0]+pB0[1]; _Pragma("unroll") for(int r=2;r<16;++r)sacc+=pB0[r]; _Pragma("unroll") for(int r=0;r<16;++r)sacc+=pB1[r]; l_reg+=sacc;
    pw0=(u32x4){PKW(pB0,0),PKW(pB0,2),PKW(pB0,4),PKW(pB0,6)};pw1=(u32x4){PKW(pB0,8),PKW(pB0,10),PKW(pB0,12),PKW(pB0,14)};pw2=(u32x4){PKW(pB1,0),PKW(pB1,2),PKW(pB1,4),PKW(pB1,6)};pw3=(u32x4){PKW(pB1,8),PKW(pB1,10),PKW(pB1,12),PKW(pB1,14)};
    SBAR(); pv(o,vb0+sl_cur,PAF(0),PAF(1),PAF(2),PAF(3)); }
  #undef PKW
  #undef PAF
  #undef VFR
  #undef PIN
  #undef MX3
  #undef GAPA
  #undef GAPB
  #undef LOADB
  #undef EX
  #undef VRD
  #undef KRD
  #undef STEP
  #undef ENDW
  {auto rr=__builtin_amdgcn_permlane32_swap(__float_as_uint(l_reg),__float_as_uint(l_reg),false,false);l_reg=__uint_as_float(rr[0])+__uint_as_float(rr[1]);}
  if(hi==0)wsf[32+r32]=l_reg;asm volatile("s_waitcnt lgkmcnt(0)":::"memory");
  float rli[16];
  #pragma unroll
  for(int r=0;r<16;++r)rli[r]=__builtin_amdgcn_rcpf(wsf[32+crow(r,hi)]);
  bf16*Ow=Oc+(rowbase+q0+wid*QBLK)*PO;
  { bf16*stg=(bf16*)(shm+LDS_OST)+wid*2048;
    #pragma unroll
    for(int r=0;r<16;++r){const int orow=crow(r,hi);
      #pragma unroll
      for(int d0=0;d0<2;++d0)stg[orow*64+d0*32+r32]=__float2bfloat16(o[d0][r]*rli[r]);}
    asm volatile("s_waitcnt lgkmcnt(0)":::"memory");
    #pragma unroll
    for(int i=0;i<4;++i){const int row=i*8+(lane>>3),ch=lane&7; const u32x4 v=*(const u32x4*)(stg+row*64+ch*8); ATTN_STORE16(Ow+(long)row*PO+ch*8,v);} }
  asm volatile("s_waitcnt lgkmcnt(0)\n\ts_barrier":::"memory");
  #undef CINIT
  #undef DMA_K
  #undef DMA_V
  #undef CMASK
  #undef START
  #undef RESC
  #undef ROT
}
constexpr int LDS_WS128=LDS_V+NSLOT*2*SLOTB, LDS_OST128=LDS_WS128+NW*64*4, LDS_BYTES128=LDS_OST128+NW*4096;
template<int THRL,bool NODEC> __device__ __forceinline__ void attn_unit128(int b,int qb,const bf16*Qc,const bf16*__restrict__ Kc,const bf16*__restrict__ Vc,bf16*Oc,char*shm,const int wv){ constexpr bool HASB=false; constexpr int t0=0; const float* kbg=nullptr;
  int tid_=wv*64+mk_lane();
  const int tid=tid_,lane=tid&63,r32=lane&31,hi=lane>>5; const int wid=__builtin_amdgcn_readfirstlane(tid>>6);
  const long rowbase=(long)b*SEQ; const int q0=qb*QB;
  const bf16*Qw=Qc+(rowbase+q0+wid*QBLK)*PQ;
  const bf16*Kh=Kc+(rowbase+(long)t0*KVBLK)*PQ,*Vh=Vc+(rowbase+(long)t0*KVBLK)*PQ;
  const unsigned lds0=(unsigned)(uintptr_t)shm;
  float*wsf=(float*)(shm+LDS_WS128)+wid*64;
  const bf16*ksrc=Kh+(long)lane*PQ+wid*8;
  const bf16*vsrc=Vh+(long)(16*(wid&3)+(lane>>2))*PQ+(wid>>2)*32+(lane&3)*8;
  const unsigned kdst=lds0+LDS_K+wid*1024, vdst=lds0+LDS_V+(wid>>2)*4096+(wid&3)*1024;
  #define DMA_K(t,slot) glds16(ksrc+(long)(t)*KVBLK*PQ,(unsigned)__builtin_amdgcn_readfirstlane(kdst+(slot)))
  #define DMA_V(t,slot) do{ glds16(vsrc+(long)(t)*KVBLK*PQ,(unsigned)__builtin_amdgcn_readfirstlane(vdst+2*(slot))); glds16(vsrc+64+(long)(t)*KVBLK*PQ,(unsigned)__builtin_amdgcn_readfirstlane(vdst+8192+2*(slot))); }while(0)
  const int vb0=(int)(lds0+LDS_V)+((lane>>4)&1)*32+(lane&3)*8+(4*hi+((lane&15)>>2))*64;
  const char*Kbase=shm+LDS_K; bf16x8 kf[8];
  const lds_cptr shm3=(lds_cptr)shm; const lds_cptr kp0=shm3+LDS_K+hi*1024+r32*16; const lds_cptr vp0=shm3+LDS_V+((lane>>4)&1)*32+(lane&3)*8+(4*hi+((lane&15)>>2))*64;
  const int NT=(q0+QB)/KVBLK-t0;
  typedef __attribute__((address_space(3))) const f32x4 lds_cf4; typedef __attribute__((address_space(3))) f32x4 lds_f4;
  const __attribute__((address_space(3))) char* kbl=(const __attribute__((address_space(3))) char*)shm+LDS_KBIAS+hi*16;
  if(HASB){ const int n4=(q0+QB-t0*KVBLK)/4; for(int i=tid;i<n4;i+=NW*64){ const f32x4 v=*(const f32x4*)(kbg+t0*KVBLK+4*i); *((lds_f4*)((__attribute__((address_space(3))) char*)shm+LDS_KBIAS)+i)=v; } }
  DMA_K(0,0);DMA_V(0,0);DMA_K(1,SLOTB);
  bf16x8 qr[4];
  #pragma unroll
  for(int d0=0;d0<4;++d0)qr[d0]=*reinterpret_cast<const bf16x8*>(&Qw[(long)r32*PQ+d0*16+hi*8]);
  float mhat=0.f,l_reg=0.f;f32x16 o[4];o[0]=f32x16{};o[1]=f32x16{};o[2]=f32x16{};o[3]=f32x16{};
  const int qrel=wid*QBLK+r32;
  float mref=0.f;
  #define CINIT(C0,C1,t) do{ if(HASB){ const __attribute__((address_space(3))) char* kp_=kbl+(t)*256; \
      _Pragma("unroll") for(int g_=0;g_<4;++g_){ const f32x4 a_=*(lds_cf4*)(kp_+g_*32), b_=*(lds_cf4*)(kp_+128+g_*32); \
        _Pragma("unroll") for(int e_=0;e_<4;++e_){ C0[4*g_+e_]=a_[e_]-mhat; C1[4*g_+e_]=b_[e_]-mhat; } } } \
    }while(0)
  #define CMASK(P0,P1,t) do{int jb_=(t)-(NT-4); if(jb_>=0)cmask(P0,P1,jb_,qrel,hi);}while(0)
  bool resc=false;
  #define START(P0,P1) do{ resc=false; \
    if(!NODEC){ const float rm=rowmax(P0,P1); const float dl=__any(rm>(float)THRL)?__builtin_fmaxf(rm,0.f):0.f; mhat=fadd_s(mhat,dl); \
      _Pragma("unroll") for(int r=0;r<16;++r){P0[r]=fsub_s(P0[r],dl);P1[r]=fsub_s(P1[r],dl);} \
      } \
    _Pragma("unroll") for(int r=0;r<16;++r)P0[r]=__builtin_amdgcn_exp2f(P0[r]); }while(0)
  #define RESC() do{ if(resc){ asm volatile("s_waitcnt lgkmcnt(0)":::"memory"); \
      _Pragma("unroll") for(int d_=0;d_<4;++d_) _Pragma("unroll") for(int r=0;r<16;++r)o[d_][r]*=wsf[crow(r,hi)]; } }while(0)
  f32x16 pA0,pA1,pB0,pB1;
  int sl_prev=0,sl_cur=0,sl_next=SLOTB;
  #define ROT() do{sl_prev=sl_cur;sl_cur=sl_next;sl_next=(sl_next==(NSLOT-1)*SLOTB)?0:sl_next+SLOTB;}while(0)
  DMA_K(2,2*SLOTB);
  WAIT_BAR(4);
  { f32x16 ci0=f32x16{}; asm volatile("":"+v"(ci0)); qkt(pA0,pA1,Kbase,qr,ci0,ci0,r32,hi); } asm volatile("s_nop 15\n\ts_nop 7":"+v"(pA0),"+v"(pA1));CMASK(pA0,pA1,0);
  START(pA0,pA1);
  _Pragma("unroll") for(int r=0;r<16;++r)pA1[r]=__builtin_amdgcn_exp2f(pA1[r]);
  WAIT_BAR(0);
  DMA_K(3,0);DMA_V(1,SLOTB);
  ROT();
  kload8(kf,kp0+sl_cur);
  WAIT_BAR(3);
  s16x4 vlo[4],vhi[4]; u32x4 pw0,pw1,pw2,pw3;
  #define PKW(P,B) cvtpk_s(P[B],P[B+1])
  #define PAF(k) __builtin_bit_cast(bf16x8,pw##k)
  #define VFR(i) (bf16x8){vlo[(i)&3][0],vlo[(i)&3][1],vlo[(i)&3][2],vlo[(i)&3][3],vhi[(i)&3][0],vhi[(i)&3][1],vhi[(i)&3][2],vhi[(i)&3][3]}
  #define PIN(x) asm volatile("":"+v"(x))
  #define MX3(a,b,c) __builtin_fmaxf(__builtin_fmaxf((a),(b)),(c))
  #define GAPA(MF,A0,A1,A2,A3,W0,W1,PW) do{ MF; sacc+=A0; sacc+=A1; sacc+=A2; sacc+=A3; PIN(sacc); W0; W1; PIN(PW); SBAR(); }while(0)
  #define EX(v) __builtin_amdgcn_exp2f(v)
  #define GAPB(MF,X,B,Y) do{ MF; X[B]=EX(X[B]); X[B+1]=EX(X[B+1]); X[B+2]=EX(X[B+2]); X[B+3]=EX(X[B+3]); PIN(X); if(HASB){ Y[B]-=mhat; Y[B+1]-=mhat; Y[B+2]-=mhat; Y[B+3]-=mhat; PIN(Y); } SBAR(); }while(0)
  #define LOADB(Y0,Y1,t) do{ if(HASB){ const __attribute__((address_space(3))) char* kp_=kbl+(t)*256; \
      _Pragma("unroll") for(int g_=0;g_<4;++g_){ const f32x4 a_=*(lds_cf4*)(kp_+g_*32), b_=*(lds_cf4*)(kp_+128+g_*32); \
        _Pragma("unroll") for(int e_=0;e_<4;++e_){ Y0[4*g_+e_]=a_[e_]; Y1[4*g_+e_]=b_[e_]; } } } }while(0)
  #define VOFF(j) ((((j)>>3)*8192)+((((j)&7)&1)*4096)+((((j)&7)>>1)*1024))
  #define VRDJ(j) do{ vlo[(j)&3]=vtr(vp_+VOFF(j)); vhi[(j)&3]=vtr(vp_+VOFF(j)+512); SBAR(); }while(0)
  #define GAPC(MF,Y,B) do{ MF; SBAR(); }while(0)
  #define KRD(G,j) do{ if(G){ kload2(kf,kp0+sl_next,j); SBAR(); } }while(0)
  #define STEP(C0,C1,P0,P1,t,GK,GV,GL) do{ SBAR(); \
    const lds_cptr vp_=vp0+2*sl_prev; \
    VRDJ(0); float sacc=(P0[0]+P0[1]); \
    GAPA(C0=__builtin_amdgcn_mfma_f32_32x32x16_bf16(kf[0],qr[0],zero16,0,0,0), P0[2],P0[3],P0[4],P0[5],     pw0[0]=PKW(P0,0), pw0[1]=PKW(P0,2), pw0); \
    VRDJ(1); GAPA(C1=__builtin_amdgcn_mfma_f32_32x32x16_bf16(kf[1],qr[0],zero16,0,0,0), P0[6],P0[7],P0[8],P0[9],     pw0[2]=PKW(P0,4), pw0[3]=PKW(P0,6), pw0); \
    VRDJ(2); GAPA(C0=__builtin_amdgcn_mfma_f32_32x32x16_bf16(kf[2],qr[1],C0,0,0,0),   P0[10],P0[11],P0[12],P0[13], pw1[0]=PKW(P0,8), pw1[1]=PKW(P0,10), pw1); \
    VRDJ(3); GAPA(C1=__builtin_amdgcn_mfma_f32_32x32x16_bf16(kf[3],qr[1],C1,0,0,0),   P0[14],P0[15],P1[0],P1[1],   pw1[2]=PKW(P0,12),pw1[3]=PKW(P0,14), pw1); \
    GAPA(C0=__builtin_amdgcn_mfma_f32_32x32x16_bf16(kf[4],qr[2],C0,0,0,0),   P1[2],P1[3],P1[4],P1[5],     pw2[0]=PKW(P1,0), pw2[1]=PKW(P1,2), pw2); \
    GAPA(C1=__builtin_amdgcn_mfma_f32_32x32x16_bf16(kf[5],qr[2],C1,0,0,0),   P1[6],P1[7],P1[8],P1[9],     pw2[2]=PKW(P1,4), pw2[3]=PKW(P1,6), pw2); \
    GAPA(C0=__builtin_amdgcn_mfma_f32_32x32x16_bf16(kf[6],qr[3],C0,0,0,0),   P1[10],P1[11],P1[12],P1[13], pw3[0]=PKW(P1,8), pw3[1]=PKW(P1,10), pw3); \
    GAPA(C1=__builtin_amdgcn_mfma_f32_32x32x16_bf16(kf[7],qr[3],C1,0,0,0),   P1[14],P1[15],0.f,0.f,       pw3[2]=PKW(P1,12),pw3[3]=PKW(P1,14), pw3); \
    l_reg+=sacc; \
    if(!NODEC){ if(__builtin_expect(__any(mhat!=0.f),0)){ _Pragma("unroll") for(int r=0;r<16;++r){C0[r]-=mhat;C1[r]-=mhat;} } } \
    if(GK){DMA_K((t)+3,sl_cur);} if(GV){DMA_V((t)+1,sl_next);} \
    CMASK(C0,C1,t); \
    resc=false; if(!NODEC){ float a=MX3(C0[0],C0[1],C1[0]),b=MX3(C0[2],C0[3],C1[1]); a=MX3(a,C1[2],C1[3]); \
      _Pragma("unroll") for(int r=4;r<16;r+=4){a=MX3(a,C0[r],C0[r+1]);b=MX3(b,C0[r+2],C0[r+3]);a=MX3(a,C1[r],C1[r+1]);b=MX3(b,C1[r+2],C1[r+3]);} \
      float rm=__builtin_fmaxf(a,b); { auto rr=__builtin_amdgcn_permlane32_swap(__float_as_uint(rm),__float_as_uint(rm),false,false); rm=__builtin_fmaxf(__uint_as_float(rr[0]),__uint_as_float(rr[1])); } \
      resc=false; \
      if(__builtin_expect(__any(rm>(float)THRL),0)){ const float dl=__builtin_fmaxf(rm,0.f); mhat+=dl; \
        _Pragma("unroll") for(int r=0;r<16;++r){C0[r]-=dl;C1[r]-=dl;} \
        const float f=__builtin_amdgcn_exp2f(-dl); l_reg*=f; if(hi==0)wsf[r32]=f; resc=true; } } \
    SBAR(); \
    GAPB(o[0]=__builtin_amdgcn_mfma_f32_32x32x16_bf16(PAF(0),VFR(0),o[0],0,0,0), C0,0,P0); VRDJ(4); \
    GAPB(o[1]=__builtin_amdgcn_mfma_f32_32x32x16_bf16(PAF(0),VFR(1),o[1],0,0,0), C0,4,P0); VRDJ(5); \
    GAPB(o[0]=__builtin_amdgcn_mfma_f32_32x32x16_bf16(PAF(1),VFR(2),o[0],0,0,0), C0,8,P0); VRDJ(6); \
    GAPB(o[1]=__builtin_amdgcn_mfma_f32_32x32x16_bf16(PAF(1),VFR(3),o[1],0,0,0), C0,12,P0); VRDJ(7); \
    GAPB(o[0]=__builtin_amdgcn_mfma_f32_32x32x16_bf16(PAF(2),VFR(4),o[0],0,0,0), C1,0,P1); VRDJ(8); \
    GAPB(o[1]=__builtin_amdgcn_mfma_f32_32x32x16_bf16(PAF(2),VFR(5),o[1],0,0,0), C1,4,P1); VRDJ(9); \
    GAPB(o[0]=__builtin_amdgcn_mfma_f32_32x32x16_bf16(PAF(3),VFR(6),o[0],0,0,0), C1,8,P1); VRDJ(10); \
    GAPB(o[1]=__builtin_amdgcn_mfma_f32_32x32x16_bf16(PAF(3),VFR(7),o[1],0,0,0), C1,12,P1); VRDJ(11); \
    GAPC(o[2]=__builtin_amdgcn_mfma_f32_32x32x16_bf16(PAF(0),VFR(8),o[2],0,0,0), P0,0); VRDJ(12); \
    GAPC(o[3]=__builtin_amdgcn_mfma_f32_32x32x16_bf16(PAF(0),VFR(9),o[3],0,0,0), P0,4); VRDJ(13); \
    KRD(GL,0); GAPC(o[2]=__builtin_amdgcn_mfma_f32_32x32x16_bf16(PAF(1),VFR(10),o[2],0,0,0), P0,8); VRDJ(14); \
    KRD(GL,1); GAPC(o[3]=__builtin_amdgcn_mfma_f32_32x32x16_bf16(PAF(1),VFR(11),o[3],0,0,0), P0,12); VRDJ(15); \
    KRD(GL,2); GAPC(o[2]=__builtin_amdgcn_mfma_f32_32x32x16_bf16(PAF(2),VFR(12),o[2],0,0,0), P1,0); \
    KRD(GL,3); GAPC(o[3]=__builtin_amdgcn_mfma_f32_32x32x16_bf16(PAF(2),VFR(13),o[3],0,0,0), P1,4); \
    GAPC(o[2]=__builtin_amdgcn_mfma_f32_32x32x16_bf16(PAF(3),VFR(14),o[2],0,0,0), P1,8); \
    GAPC(o[3]=__builtin_amdgcn_mfma_f32_32x32x16_bf16(PAF(3),VFR(15),o[3],0,0,0), P1,12); \
    }while(0)
  const f32x16 zero16=f32x16{};
  int t=1;
  #undef CMASK
  #define CMASK(P0,P1,t) do{}while(0)
  for(;t+5<NT;t+=2){
    STEP(pB0,pB1,pA0,pA1,t,true,true,true);     WAIT_BAR(3); RESC(); ROT();
    STEP(pA0,pA1,pB0,pB1,t+1,true,true,true);   WAIT_BAR(3); RESC(); ROT();
  }
  #undef CMASK
  #define CMASK(P0,P1,t) do{int jb_=(t)-(NT-4); if(jb_>=0)cmask(P0,P1,jb_,qrel,hi);}while(0)
  #define ENDW(tt) do{ if((tt)+3<NT){WAIT_BAR(3);} else if((tt)+2<NT){WAIT_BAR(2);} else {WAIT_BAR(0);} }while(0)
  for(;t+1<NT;t+=2){
    STEP(pB0,pB1,pA0,pA1,t,(t+3<NT),(t+1<NT),(t+1<NT));       ENDW(t);   RESC(); ROT();
    STEP(pA0,pA1,pB0,pB1,t+1,(t+4<NT),(t+2<NT),(t+2<NT));     ENDW(t+1); RESC(); ROT();
  }
  STEP(pB0,pB1,pA0,pA1,NT-1,false,false,false); RESC();
  { float sacc=pB0[0]+pB0[1]; _Pragma("unroll") for(int r=2;r<16;++r)sacc+=pB0[r]; _Pragma("unroll") for(int r=0;r<16;++r)sacc+=pB1[r]; l_reg+=sacc;
    pw0=(u32x4){PKW(pB0,0),PKW(pB0,2),PKW(pB0,4),PKW(pB0,6)};pw1=(u32x4){PKW(pB0,8),PKW(pB0,10),PKW(pB0,12),PKW(pB0,14)};pw2=(u32x4){PKW(pB1,0),PKW(pB1,2),PKW(pB1,4),PKW(pB1,6)};pw3=(u32x4){PKW(pB1,8),PKW(pB1,10),PKW(pB1,12),PKW(pB1,14)};
    SBAR(); pv(o,vb0+2*sl_cur,PAF(0),PAF(1),PAF(2),PAF(3)); pv(o+2,vb0+2*sl_cur+8192,PAF(0),PAF(1),PAF(2),PAF(3)); }
  #undef PKW
  #undef PAF
  #undef VFR
  #undef PIN
  #undef MX3
  #undef GAPA
  #undef GAPB
  #undef LOADB
  #undef EX
  #undef VRDJ
  #undef VOFF
  #undef GAPC
  #undef KRD
  #undef STEP
  #undef ENDW
  {auto rr=__builtin_amdgcn_permlane32_swap(__float_as_uint(l_reg),__float_as_uint(l_reg),false,false);l_reg=__uint_as_float(rr[0])+__uint_as_float(rr[1]);}
  if(hi==0)wsf[32+r32]=l_reg;asm volatile("s_waitcnt lgkmcnt(0)":::"memory");
  float rli[16];
  #pragma unroll
  for(int r=0;r<16;++r)rli[r]=__builtin_amdgcn_rcpf(wsf[32+crow(r,hi)]);
  bf16*Ow=Oc+(rowbase+q0+wid*QBLK)*PO;
  { bf16*stg=(bf16*)(shm+LDS_OST128)+wid*2048;
    #pragma unroll
    for(int hf=0;hf<2;++hf){
      #pragma unroll
      for(int r=0;r<16;++r){const int orow=crow(r,hi);
        #pragma unroll
        for(int d0=0;d0<2;++d0)stg[orow*64+d0*32+r32]=__float2bfloat16(o[2*hf+d0][r]*rli[r]);}
      asm volatile("s_waitcnt lgkmcnt(0)":::"memory");
      #pragma unroll
      for(int i=0;i<4;++i){const int row=i*8+(lane>>3),ch=lane&7; const u32x4 v=*(const u32x4*)(stg+row*64+ch*8); ATTN_STORE16(Ow+(long)row*PO+hf*64+ch*8,v);}
      asm volatile("s_waitcnt lgkmcnt(0)":::"memory"); } }
  asm volatile("s_waitcnt lgkmcnt(0)\n\ts_barrier":::"memory");
  #undef CINIT
  #undef DMA_K
  #undef DMA_V
  #undef CMASK
  #undef START
  #undef RESC
  #undef ROT
}
constexpr int ATTN_LDS_BYTES=(LDS_BYTES>LDS_BYTES128)?LDS_BYTES:LDS_BYTES128;
#undef SBAR
#undef WAIT_BAR
}

namespace xattn {
using pg8::bf16_t; using pg8::bf16x8; using pg8::u32x4; using pg8::f32x4;
using f32x16 = __attribute__((ext_vector_type(16))) float;
#define XLAS __attribute__((address_space(3)))
constexpr int XB0 = 0, XB1 = 32768, X_WSF = 65536, X_OST = X_WSF + 2048, X_LDS_BYTES = X_OST + 8 * 4096;
__device__ __forceinline__ int crow(int r, int hi) { return (r & 3) + 8 * (r >> 2) + 4 * hi; }
__device__ __forceinline__ unsigned pk(float lo, float hi) { return pg8::cvt_pk_bf16(lo, hi); }
__device__ __forceinline__ void unit(int b, int h, int qblk, const bf16_t* __restrict__ CQ, const bf16_t* __restrict__ CK, const bf16_t* __restrict__ CVT, bf16_t* __restrict__ CO, XLAS unsigned char* lds, const int wv) {
    const int tid = wv * 64 + mk_lane(), lane = tid & 63, r32 = lane & 31, hi = lane >> 5; const int wid = __builtin_amdgcn_readfirstlane(tid >> 6);
    const size_t qrow0 = (size_t)b * 4096 + (size_t)qblk * 256 + wid * 32;
    const bf16_t* Qw = CQ + (qrow0 + r32) * 1024 + h * 256 + hi * 8;
    const bf16_t* Kg = CK + ((size_t)b * 256 + lane) * 1024 + h * 256 + wid * 8;
    const bf16_t* Vg = CVT + ((size_t)h * 256 + lane) * 2048 + (size_t)b * 256 + wid * 8;
    u32x4 st[4];
#define X_LOADK(dc) do { _Pragma("unroll") for (int i_ = 0; i_ < 4; ++i_) st[i_] = *(const u32x4*)(Kg + (dc) * 64 + (size_t)i_ * 64 * 1024); } while (0)
#define X_LOADV(c)  do { _Pragma("unroll") for (int i_ = 0; i_ < 4; ++i_) st[i_] = *(const u32x4*)(Vg + (size_t)(c) * 64 * 2048 + i_ * 64); } while (0)
#define X_STOREK(buf) do { _Pragma("unroll") for (int i_ = 0; i_ < 4; ++i_) *(XLAS u32x4*)(lds + (buf) + wid * 4096 + (64 * i_ + lane) * 16) = st[i_]; } while (0)
#define X_STOREV(buf) do { _Pragma("unroll") for (int i_ = 0; i_ < 4; ++i_) *(XLAS u32x4*)(lds + (buf) + (wid + 8 * i_) * 1024 + lane * 16) = st[i_]; } while (0)
    const int kswz = (r32 & ~12) | ((r32 & 4) << 1) | ((r32 & 8) >> 1);
    const int koff = hi * 4096 + kswz * 16;
    const int voff = hi * 1024 + r32 * 16;
    f32x16 s[8];
#pragma unroll
    for (int kt = 0; kt < 8; ++kt) s[kt] = f32x16{};
    X_LOADK(0); X_STOREK(XB0);
    __syncthreads();
#pragma unroll
    for (int dc = 0; dc < 4; ++dc) {
        const int buf = (dc & 1) ? XB1 : XB0, nbuf = (dc & 1) ? XB0 : XB1;
        if (dc < 3) X_LOADK(dc + 1); else X_LOADV(0);
        bf16x8 qf[4];
#pragma unroll
        for (int ks = 0; ks < 4; ++ks) qf[ks] = *(const bf16x8*)(Qw + dc * 64 + ks * 16);
#pragma unroll
        for (int kt = 0; kt < 8; ++kt)
#pragma unroll
            for (int ks = 0; ks < 4; ++ks) {
                const bf16x8 kf = *(const XLAS bf16x8*)(lds + buf + koff + kt * 512 + ks * 8192);
                s[kt] = __builtin_amdgcn_mfma_f32_32x32x16_bf16(kf, qf[ks], s[kt], 0, 0, 0);
            }
        if (dc < 3) X_STOREK(nbuf); else X_STOREV(nbuf);
        __syncthreads();
    }
    float mx = s[0][0];
#pragma unroll
    for (int kt = 0; kt < 8; ++kt)
#pragma unroll
        for (int r = 0; r < 16; ++r) mx = fmaxf(mx, s[kt][r]);
    mx = fmaxf(mx, __shfl_xor(mx, 32));
    float l = 0.f;
#pragma unroll
    for (int kt = 0; kt < 8; ++kt)
#pragma unroll
        for (int r = 0; r < 16; ++r) { const float p = __builtin_amdgcn_exp2f(s[kt][r] - mx); s[kt][r] = p; l += p; }
    l += __shfl_xor(l, 32);
    u32x4 pw[16];
#pragma unroll
    for (int kt = 0; kt < 8; ++kt)
#pragma unroll
        for (int j2 = 0; j2 < 2; ++j2)
            pw[2 * kt + j2] = (u32x4){pk(s[kt][8 * j2 + 0], s[kt][8 * j2 + 1]), pk(s[kt][8 * j2 + 2], s[kt][8 * j2 + 3]), pk(s[kt][8 * j2 + 4], s[kt][8 * j2 + 5]), pk(s[kt][8 * j2 + 6], s[kt][8 * j2 + 7])};
    XLAS float* wsf = (XLAS float*)(lds + X_WSF) + wid * 64;
    if (hi == 0) wsf[r32] = l;
    asm volatile("s_waitcnt lgkmcnt(0)" ::: "memory");
    float rli[16];
#pragma unroll
    for (int r = 0; r < 16; ++r) rli[r] = 1.0f / wsf[crow(r, hi)];
    XLAS bf16_t* stg = (XLAS bf16_t*)(lds + X_OST) + wid * 2048;
    bf16_t* Ow = CO + qrow0 * 1024 + h * 256;
#pragma unroll
    for (int c = 0; c < 4; ++c) {
        const int buf = (c & 1) ? XB1 : XB0, nbuf = (c & 1) ? XB0 : XB1;
        if (c < 3) X_LOADV(c + 1);
        f32x16 o[2]; o[0] = f32x16{}; o[1] = f32x16{};
#pragma unroll
        for (int j = 0; j < 16; ++j)
#pragma unroll
            for (int dt = 0; dt < 2; ++dt) {
                const bf16x8 vf = *(const XLAS bf16x8*)(lds + buf + voff + dt * 512 + j * 2048);
                o[dt] = __builtin_amdgcn_mfma_f32_32x32x16_bf16(__builtin_bit_cast(bf16x8, pw[j]), vf, o[dt], 0, 0, 0);
            }
#pragma unroll
        for (int r = 0; r < 16; ++r) { const int orow = crow(r, hi);
#pragma unroll
            for (int dt = 0; dt < 2; ++dt) { const unsigned w = pk(o[dt][r] * rli[r], 0.f); stg[orow * 64 + dt * 32 + r32] = (bf16_t)(w & 0xffffu); } }
        asm volatile("s_waitcnt lgkmcnt(0)" ::: "memory");
#pragma unroll
        for (int i = 0; i < 4; ++i) { const int row = i * 8 + (lane >> 3), ch = lane & 7; const u32x4 v = *(const XLAS u32x4*)(stg + row * 64 + ch * 8); *(u32x4*)(Ow + (size_t)row * 1024 + c * 64 + ch * 8) = v; }
        asm volatile("s_waitcnt lgkmcnt(0)" ::: "memory");
        if (c < 3) X_STOREV(nbuf);
        __syncthreads();
    }
#undef X_LOADK
#undef X_LOADV
#undef X_STOREK
#undef X_STOREV
}
}

#ifndef MK_PER_PHASE
#define MK_PER_PHASE 0
#endif
constexpr int NWAVES = 8;
constexpr int BATCH = 8, SEQ = 4096, D = 1024, M = BATCH * SEQ, FF = 4096, NMEM = 256, MM = BATCH * NMEM, INW = 3080, NPROJ = 3072, NATT = 1536;
constexpr float EPS = 1e-6f, SUBLN_EPS = 1e-5f;
constexpr int N_PHASES = 11;

constexpr size_t MiB = 1u << 20;
constexpr size_t WS_ROPE = 0;
constexpr size_t WS_LOGF = 1 * MiB;
constexpr size_t WS_KB   = 2 * MiB;
constexpr size_t WS_NRM  = 3 * MiB;
constexpr size_t WS_BAR  = 3 * MiB + 65536;
constexpr size_t WS_SS1  = 4 * MiB, WS_SS2 = 6 * MiB, WS_SS3 = 8 * MiB;
constexpr size_t WS_WIN = 10 * MiB, WS_WOUT = 16 * MiB, WS_WCQ = 18 * MiB, WS_WCKV = 20 * MiB, WS_WCO = 24 * MiB, WS_WUP = 26 * MiB, WS_WDN = 34 * MiB;
constexpr size_t WS_MEMN = 42 * MiB, WS_CK = 46 * MiB, WS_CVT = 50 * MiB;
constexpr size_t WS_SA = 56 * MiB;
constexpr size_t WS_SB = 120 * MiB;
constexpr size_t WS_PROJ = 184 * MiB;
constexpr size_t WS_ATT = 376 * MiB;
constexpr size_t WS_ZH = 184 * MiB;
constexpr size_t WS_END = 472 * MiB;
static_assert(WS_ZH + (size_t)M * FF * 2 <= WS_END && WS_ATT + (size_t)M * NATT * 2 <= WS_END && WS_PROJ + (size_t)M * NPROJ * 2 <= WS_ATT, "d_ws map");

constexpr int RING_BYTES = 131072, LDS_BYTES = 147456;
static_assert(attn_body::ATTN_LDS_BYTES <= RING_BYTES && xattn::X_LDS_BYTES <= RING_BYTES && pg8::STAGE_BYTES <= RING_BYTES, "LDS map");

#define LAS __attribute__((address_space(3)))
typedef unsigned short bf16;
typedef unsigned v4u __attribute__((ext_vector_type(4)));
typedef float f32x4 __attribute__((ext_vector_type(4)));
#define LDS_WAIT() asm volatile("s_waitcnt lgkmcnt(0)" ::: "memory")
__device__ __forceinline__ unsigned f2bf(float f) { unsigned u = __builtin_bit_cast(unsigned, f); return (u + 0x7fffu + ((u >> 16) & 1u)) >> 16; }
__device__ __forceinline__ unsigned pk2(float lo, float hi) { return f2bf(lo) | (f2bf(hi) << 16); }
__device__ __forceinline__ float bflo(unsigned w) { return __builtin_bit_cast(float, w << 16); }
__device__ __forceinline__ float bfhi(unsigned w) { return __builtin_bit_cast(float, w & 0xffff0000u); }
__device__ __forceinline__ float wave_sum(float v) {
#pragma unroll
    for (int o = 1; o < 64; o <<= 1) v += __shfl_xor(v, o);
    return v;
}

#define XB_TMO      128
#define XB_XCNT(j)  (256  + 64 * (j))
#define XB_XSUB(j)  (1280 + 64 * (j))
#define XB_XGEN(j)  (2304 + 64 * (j))
#define XB_TOP      3328
#define XB_TOPGEN   3392
#define XCD_BAR_WORDS 3456
#define XB_SPIN_CAP (1u << 18)

__device__ __forceinline__ unsigned xb_ld(unsigned* p)              { return __hip_atomic_load(p, __ATOMIC_RELAXED, __HIP_MEMORY_SCOPE_AGENT); }
__device__ __forceinline__ unsigned xb_add(unsigned* p, unsigned v) { return __hip_atomic_fetch_add(p, v, __ATOMIC_RELAXED, __HIP_MEMORY_SCOPE_AGENT); }
__device__ __forceinline__ unsigned xb_xcc_id() { return (unsigned)__builtin_amdgcn_s_getreg((3 << 11) | 20) & 0xFu; }
#define XB_SPIN(cond, bar) do { unsigned _sp = 0; while (cond) { __builtin_amdgcn_s_sleep(1); \
    if ((++_sp & 255u) == 0u) { if (xb_ld(&(bar)[XB_TMO])) break; if (_sp > XB_SPIN_CAP) { atomicAdd(&(bar)[XB_TMO], 1u); break; } } } } while (0)

struct XcdBarrier {
    unsigned* bar; unsigned x;
    volatile LAS unsigned* st;
};

__device__ __forceinline__ XcdBarrier xcd_barrier_post(unsigned* bar, volatile LAS unsigned* st, bool leader) {
    XcdBarrier b; b.bar = bar; b.x = xb_xcc_id(); b.st = st;
    if (leader) (void)xb_add(&bar[XB_XCNT(b.x)], 1u);
    return b;
}
__device__ __forceinline__ void xcd_barrier_complete(unsigned* bar, unsigned x, unsigned& nloc, unsigned& nx) {
    const unsigned G = gridDim.x * gridDim.y * gridDim.z;
    unsigned sum, cnt, mine, sp = 0u;
    for (;;) {
        sum = 0u; cnt = 0u; mine = 0u;
#pragma unroll
        for (unsigned j = 0; j < 16; ++j) { const unsigned c = xb_ld(&bar[XB_XCNT(j)]); sum += c; cnt += (c > 0u) ? 1u : 0u; mine = (j == x) ? c : mine; }
        if (sum == G) break;
        __builtin_amdgcn_s_sleep(1);
        if ((++sp & 255u) == 0u) { if (xb_ld(&bar[XB_TMO])) break; if (sp > XB_SPIN_CAP) { atomicAdd(&bar[XB_TMO], 1u); break; } }
    }
    nloc = mine > 0u ? mine : 1u; nx = cnt > 0u ? cnt : 1u;
}

__device__ __forceinline__ void xcd_barrier(const XcdBarrier& b, bool leader) {
    asm volatile("s_waitcnt vmcnt(0)" ::: "memory");
    __syncthreads();
    if (leader) {
        unsigned* bar = b.bar;
        __builtin_amdgcn_s_waitcnt(0);
        unsigned nloc = b.st[0], nx = b.st[1];
        if (nloc == 0u) { xcd_barrier_complete(bar, b.x, nloc, nx); b.st[0] = nloc; b.st[1] = nx; }
        const unsigned old = xb_add(&bar[XB_XSUB(b.x)], 1u);
        const unsigned gen = old / nloc;
        if (old + 1u == (gen + 1u) * nloc) {
            __builtin_amdgcn_fence(__ATOMIC_RELEASE, "agent");
            asm volatile("s_waitcnt vmcnt(0)" ::: "memory");
            const unsigned og = xb_add(&bar[XB_TOP], 1u);
            const unsigned tg = og / nx;
            if (og + 1u == (tg + 1u) * nx) xb_add(&bar[XB_TOPGEN], 1u);
            else XB_SPIN(xb_ld(&bar[XB_TOPGEN]) == tg, bar);
            __builtin_amdgcn_fence(__ATOMIC_ACQUIRE, "agent");
            xb_add(&bar[XB_XGEN(b.x)], 1u);
            asm volatile("s_waitcnt vmcnt(0)" ::: "memory");
        } else {
            XB_SPIN(xb_ld(&bar[XB_XGEN(b.x)]) == gen, bar);
            __builtin_amdgcn_fence(__ATOMIC_ACQUIRE, "agent");
            asm volatile("s_waitcnt vmcnt(0)" ::: "memory");
        }
    }
    __syncthreads();
}

struct Params { const float* in[21]; float* out; unsigned char* ws; int ph_lo, ph_hi; };
enum { I_X = 0, I_MEM, I_GMIX, I_WIN, I_BF, I_LQ1, I_LK1, I_LQ2, I_LK2, I_GSUB, I_GFOX, I_WOUT, I_GCROSS, I_GMEM, I_WCQ, I_WCKV, I_WCO, I_GMLP, I_WUP, I_WDN, I_GFIN };

__device__ __forceinline__ void p0_transpose_item(const float* W, int K, int ldw, int nblk, bf16* WT, LAS float* scr, int item, int lane, const float* gk = nullptr  ) {
    const int kb = item / nblk, nb = item % nblk, k0 = 64 * kb, n0 = 32 * nb;
    { f32x4 v[8]; float gg[8];
#pragma unroll
        for (int it = 0; it < 8; ++it) { const int kk = 8 * it + (lane >> 3); v[it] = *(const f32x4*)(W + (size_t)(k0 + kk) * ldw + n0 + 4 * (lane & 7)); gg[it] = gk ? gk[k0 + kk] : 1.f; }
#pragma unroll
        for (int it = 0; it < 8; ++it) { const int kk = 8 * it + (lane >> 3); LAS float* d = scr + kk * 33 + 4 * (lane & 7); d[0] = v[it].x * gg[it]; d[1] = v[it].y * gg[it]; d[2] = v[it].z * gg[it]; d[3] = v[it].w * gg[it]; } }
    LDS_WAIT(); asm volatile("" ::: "memory");
    const int c = lane & 7;
#pragma unroll
    for (int j = 0; j < 4; ++j) { const int n = (lane >> 3) + 8 * j; const LAS float* s = scr + (8 * c) * 33 + n;
        v4u o; o.x = pk2(s[0 * 33], s[1 * 33]); o.y = pk2(s[2 * 33], s[3 * 33]); o.z = pk2(s[4 * 33], s[5 * 33]); o.w = pk2(s[6 * 33], s[7 * 33]);
        *(v4u*)(WT + (size_t)(n0 + n) * K + k0 + 8 * c) = o; }
    LDS_WAIT(); asm volatile("" ::: "memory");
}

__device__ __forceinline__ void rms_row(const float* xrow, const f32x4 (&gq)[4], bf16* orow, int lane, f32x4 (&v)[4]) {
    const f32x4* xr = (const f32x4*)xrow + lane; float s = 0.f;
#pragma unroll
    for (int j = 0; j < 4; ++j) { v[j] = xr[64 * j]; s += (v[j].x * v[j].x + v[j].y * v[j].y) + (v[j].z * v[j].z + v[j].w * v[j].w); }
    const float rstd = 1.0f / sqrtf(wave_sum(s) * (1.f / 1024.f) + EPS);
    unsigned long long* o8 = (unsigned long long*)orow + lane;
#pragma unroll
    for (int j = 0; j < 4; ++j) { v[j] = v[j] * rstd * gq[j]; o8[64 * j] = (unsigned long long)pk2(v[j].x, v[j].y) | ((unsigned long long)pk2(v[j].z, v[j].w) << 32); }
}

template <class Sched> __device__ __forceinline__ void build_rstd_tables(LAS unsigned char* lds, const Sched& S, const float* sspart, float eps, int wave) {
    const int lane = mk_lane(), tid = wave * 64 + lane;
    LAS int* pml = (LAS int*)(lds + RING_BYTES + 1536); LAS float* tab = (LAS float*)(lds + RING_BYTES + 2048);
    if (tid == 0) { int n = 0; pg8::Unit u; for (int i = 0; S.next(i, u); ++i) { bool f = false; for (int j = 0; j < n; ++j) f |= (pml[j] == u.pm); if (!f && n < 8) pml[n++] = u.pm; } pml[8] = n; }
    __syncthreads();
    const int n = pml[8];
    for (int idx = tid; idx < n * 256; idx += NWAVES * 64) tab[idx] = pg8::row_rstd(sspart, pml[idx >> 8] * 256 + (idx & 255), eps);
    __syncthreads();
}
__global__ void __launch_bounds__(NWAVES * 64, 2) mk_fwd(Params P) {
    extern __shared__ __attribute__((aligned(16))) unsigned char lds_raw[];
    LAS unsigned char* lds = (LAS unsigned char*)lds_raw;
    const int wave = __builtin_amdgcn_readfirstlane((int)threadIdx.x >> 6);
#define LANE_TID const int lane = mk_lane(), tid = wave * 64 + lane
    const int G = gridDim.x; const int bx = blockIdx.x; const int vcu = (G % 8 == 0) ? (bx % 8) * (G / 8) + bx / 8 : bx;
    const int gw = vcu * NWAVES + wave, NGW = G * NWAVES;
    unsigned char* const ws = P.ws;
#define ROPE ((float*)(P.ws + WS_ROPE))
#define LOGF ((float*)(P.ws + WS_LOGF))
#define KBIAS ((float*)(P.ws + WS_KB))
#define NRM ((float*)(P.ws + WS_NRM))
#define SS1 ((float*)(P.ws + WS_SS1))
#define SS2 ((float*)(P.ws + WS_SS2))
#define SS3 ((float*)(P.ws + WS_SS3))
#define Win_t ((bf16*)(P.ws + WS_WIN))
#define Wout_t ((bf16*)(P.ws + WS_WOUT))
#define Wcq_t ((bf16*)(P.ws + WS_WCQ))
#define Wckv_t ((bf16*)(P.ws + WS_WCKV))
#define Wco_t ((bf16*)(P.ws + WS_WCO))
#define Wup_t ((bf16*)(P.ws + WS_WUP))
#define Wdn_t ((bf16*)(P.ws + WS_WDN))
#define MEMN ((bf16*)(P.ws + WS_MEMN))
#define CKb ((bf16*)(P.ws + WS_CK))
#define CVT ((bf16*)(P.ws + WS_CVT))
#define XN ((bf16*)(P.ws + WS_SA))
#define MIXA ((bf16*)(P.ws + WS_SA))
#define CQ ((bf16*)(P.ws + WS_SA))
#define H2B ((bf16*)(P.ws + WS_SA))
#define H1B ((bf16*)(P.ws + WS_SB))
#define CO ((bf16*)(P.ws + WS_PROJ))
#define PROJ ((bf16*)(P.ws + WS_PROJ))
#define ATT ((bf16*)(P.ws + WS_ATT))
#define ZH ((bf16*)(P.ws + WS_ZH))
    const int lo = P.ph_lo, hi_ph = P.ph_hi;
    volatile LAS unsigned* xst = (volatile LAS unsigned*)(lds + RING_BYTES + 1024);
    { const int l0 = mk_lane(); if (wave == 0 && l0 < 2) xst[l0] = 0u; }
    __syncthreads();
    XcdBarrier bar; bar.bar = (unsigned*)(ws + WS_BAR); bar.x = 0; bar.st = xst;
    if (hi_ph - lo > 1) bar = xcd_barrier_post((unsigned*)(ws + WS_BAR), xst, wave == 0 && mk_lane() == 0);
    if (lo < 0) cg::this_grid().sync();
#define IN(k) (lo <= (k) && (k) < hi_ph)
#ifndef MK_MASK
#define MK_MASK 0x7ff
#endif
#ifndef MK_ATT_MASK
#define MK_ATT_MASK 3
#endif
#ifndef MK_REP_MASK
#define MK_REP_MASK 0
#endif
#define PH(k) (IN(k) && ((MK_MASK >> (k)) & 1))
#define REPS(k) for (int rep_ = 0; rep_ < (((MK_REP_MASK) >> (k)) & 1) + 1; ++rep_)
#define SEAM(k) do { if (IN(k) && IN((k) + 1)) { xcd_barrier(bar, wave == 0 && mk_lane() == 0); } } while (0)

    if (PH(0)) REPS(0) {
        LANE_TID;
        {
            const float* win = P.in[I_WIN];
            for (int k = tid; k < 1024; k += NWAVES * 64) { const f32x4 a = *(const f32x4*)(win + (size_t)k * INW + 3072), b = *(const f32x4*)(win + (size_t)k * INW + 3076);
                const int slot = (((k >> 8) * 4 + (k & 3)) * 64 + ((k & 255) >> 2)); *(LAS f32x4*)(lds + slot * 32) = a; *(LAS f32x4*)(lds + slot * 32 + 16) = b; }
        }
        if (bx == 0 && tid < BATCH * 64) NRM[tid] = 0.f;
        __syncthreads();
        LAS float* scr = (LAS float*)(lds + 32768 + wave * 8704);
        {
            constexpr int I_IN = 16 * 96, I_SQ = 16 * 32, I_CKV = 16 * 64, I_UP = 16 * 128, I_DN = 64 * 32;
            constexpr int NITEMS = I_IN + 3 * I_SQ + I_CKV + I_UP + I_DN;
            for (int it = gw; it < NITEMS; it += NGW) {
                int r = it;
                if (r < I_IN) { p0_transpose_item(P.in[I_WIN], D, INW, 96, Win_t, scr, r, lane); continue; } r -= I_IN;
                if (r < I_SQ) { p0_transpose_item(P.in[I_WOUT], D, D, 32, Wout_t, scr, r, lane); continue; } r -= I_SQ;
                if (r < I_SQ) { p0_transpose_item(P.in[I_WCQ], D, D, 32, Wcq_t, scr, r, lane, P.in[I_GCROSS]); continue; } r -= I_SQ;
                if (r < I_SQ) { p0_transpose_item(P.in[I_WCO], D, D, 32, Wco_t, scr, r, lane); continue; } r -= I_SQ;
                if (r < I_CKV) { p0_transpose_item(P.in[I_WCKV], D, 2 * D, 64, Wckv_t, scr, r, lane); continue; } r -= I_CKV;
                if (r < I_UP) { p0_transpose_item(P.in[I_WUP], D, FF, 128, Wup_t, scr, r, lane, P.in[I_GMLP]); continue; } r -= I_UP;
                p0_transpose_item(P.in[I_WDN], FF, D, 32, Wdn_t, scr, r, lane);
            }
        }
        {
            for (int idx = gw * 64 + lane; idx < SEQ * 8; idx += NGW * 64) {
                const int pos = idx >> 3, j = idx & 7;
                const float f = j == 0 ? 1.0f : j == 1 ? 0.1939227432012558f : j == 2 ? 0.03760603070259094f : j == 3 ? 0.007292664609849453f : j == 4 ? 0.0014142135623842478f : j == 5 ? 0.00027424818836152554f : j == 6 ? 5.318296098266728e-05f : 1.0313386155758053e-05f;
                const float ang = (float)pos * f;
                double rev = (double)ang * 0.15915494309189535; rev -= __builtin_rint(rev);
                const float x = (float)(rev * 6.283185307179586);
                ROPE[pos * 16 + j] = cosf(x); ROPE[pos * 16 + 8 + j] = sinf(x);
            }
        }
        {
            f32x4 gq[4];
#pragma unroll
            for (int j = 0; j < 4; ++j) gq[j] = ((const f32x4*)P.in[I_GMIX])[64 * j + lane];
            const float bfv = P.in[I_BF][lane & 7];
            const bool b0 = lane & 1, b1 = lane & 2, b2 = lane & 4;
            for (int m0 = gw * 4; m0 < M; m0 += NGW * 4) {
                f32x4 v[4][4]; float s[4];
#pragma unroll
                for (int r = 0; r < 4; ++r)
#pragma unroll
                    for (int jj = 0; jj < 4; ++jj) v[r][jj] = ((const f32x4*)(P.in[I_X] + (size_t)(m0 + r) * D))[64 * jj + lane];
#pragma unroll
                for (int r = 0; r < 4; ++r) { s[r] = 0.f;
#pragma unroll
                    for (int jj = 0; jj < 4; ++jj) s[r] += (v[r][jj].x * v[r][jj].x + v[r][jj].y * v[r][jj].y) + (v[r][jj].z * v[r][jj].z + v[r][jj].w * v[r][jj].w); }
#pragma unroll
                for (int r = 0; r < 4; ++r) { const float rstd = 1.0f / sqrtf(wave_sum(s[r]) * (1.f / 1024.f) + EPS);
                    unsigned long long* o8 = (unsigned long long*)(XN + (size_t)(m0 + r) * D) + lane;
#pragma unroll
                    for (int jj = 0; jj < 4; ++jj) { v[r][jj] = v[r][jj] * rstd * gq[jj]; o8[64 * jj] = (unsigned long long)pk2(v[r][jj].x, v[r][jj].y) | ((unsigned long long)pk2(v[r][jj].z, v[r][jj].w) << 32); } }
                f32x4 a0[4], a1[4];
#pragma unroll
                for (int r = 0; r < 4; ++r) { a0[r] = (f32x4){0.f, 0.f, 0.f, 0.f}; a1[r] = a0[r]; }
#pragma unroll
                for (int jj = 0; jj < 4; ++jj)
#pragma unroll
                    for (int i = 0; i < 4; ++i) { const LAS f32x4* wp = (const LAS f32x4*)(lds + ((jj * 4 + i) * 64 + lane) * 32); const f32x4 w0 = wp[0], w1 = wp[1];
#pragma unroll
                        for (int r = 0; r < 4; ++r) { a0[r] += w0 * v[r][jj][i]; a1[r] += w1 * v[r][jj][i]; } }
#pragma unroll
                for (int r = 0; r < 4; ++r) {
                    float c0, c1, c2, c3, d0, d1, z;
                    { const float k0 = b0 ? a0[r][1] : a0[r][0], g0 = b0 ? a0[r][0] : a0[r][1]; c0 = k0 + __shfl_xor(g0, 1); }
                    { const float k0 = b0 ? a0[r][3] : a0[r][2], g0 = b0 ? a0[r][2] : a0[r][3]; c1 = k0 + __shfl_xor(g0, 1); }
                    { const float k0 = b0 ? a1[r][1] : a1[r][0], g0 = b0 ? a1[r][0] : a1[r][1]; c2 = k0 + __shfl_xor(g0, 1); }
                    { const float k0 = b0 ? a1[r][3] : a1[r][2], g0 = b0 ? a1[r][2] : a1[r][3]; c3 = k0 + __shfl_xor(g0, 1); }
                    { const float k0 = b1 ? c1 : c0, g0 = b1 ? c0 : c1; d0 = k0 + __shfl_xor(g0, 2); }
                    { const float k0 = b1 ? c3 : c2, g0 = b1 ? c2 : c3; d1 = k0 + __shfl_xor(g0, 2); }
                    { const float k0 = b2 ? d1 : d0, g0 = b2 ? d0 : d1; z = k0 + __shfl_xor(g0, 4); }
                    z += __shfl_xor(z, 8); z += __shfl_xor(z, 16); z += __shfl_xor(z, 32);
                    z += bfv;
                    const float ls = fminf(z, 0.f) - __logf(1.0f + __expf(-fabsf(z)));
                    const int m = m0 + r;
                    if (lane < 8) LOGF[((size_t)(m >> 12) * 8 + lane) * SEQ + (m & 4095)] = ls;
                }
            }
        }
        {
            f32x4 gq[4];
#pragma unroll
            for (int j = 0; j < 4; ++j) gq[j] = ((const f32x4*)P.in[I_GMEM])[64 * j + lane];
            for (int m = gw; m < MM; m += NGW) { f32x4 v[4]; rms_row(P.in[I_MEM] + (size_t)m * D, gq, MEMN + (size_t)m * D, lane, v); }
        }
        __syncthreads();
    }
    SEAM(0);

    if (PH(1)) REPS(1) {
        LANE_TID;
        if (bx < BATCH * 8) {
            const float* src = LOGF + (size_t)bx * SEQ + tid * 8; float* dst = KBIAS + (size_t)bx * SEQ + tid * 8;
            const f32x4 a = *(const f32x4*)src, b = *(const f32x4*)(src + 4);
            float p[8]; p[0] = a[0]; p[1] = p[0] + a[1]; p[2] = p[1] + a[2]; p[3] = p[2] + a[3]; p[4] = p[3] + b[0]; p[5] = p[4] + b[1]; p[6] = p[5] + b[2]; p[7] = p[6] + b[3];
            float inc = p[7];
#pragma unroll
            for (int o = 1; o < 64; o <<= 1) { const float t = __shfl_up(inc, o); if (lane >= o) inc += t; }
            LAS float* wt = (LAS float*)lds;
            if (lane == 63) wt[wave] = inc;
            __syncthreads();
            float pre = inc - p[7];
            for (int w = 0; w < wave; ++w) pre += wt[w];
            const float c = -1.4426950408889634f;
            *(f32x4*)dst = (f32x4){(pre + p[0]) * c, (pre + p[1]) * c, (pre + p[2]) * c, (pre + p[3]) * c};
            *(f32x4*)(dst + 4) = (f32x4){(pre + p[4]) * c, (pre + p[5]) * c, (pre + p[6]) * c, (pre + p[7]) * c};
            __syncthreads();
        }
        { pg8::Gemm g{XN, Win_t, M, NPROJ, D}; pg8::StaticOrder S; S.init(M, NPROJ, G, bx);
          pg8::EpiProj E{PROJ, ROPE, NRM};
          pg8::gemm_phase<pg8::EpiProj, pg8::StaticOrder, true, true>(lds, g, S, E, wave); }
    }
    SEAM(1);

    if (PH(2)) REPS(2) {
        for (int p = vcu; p < 1024; p += G) {
            const int pp = p & 511, bh = pp >> 3, s = pp & 7, b = bh >> 3, hm = bh & 7;
#ifdef MK_REP_ATT
            if (rep_ == 1 && !((MK_REP_ATT) & (p < 512 ? 1 : 2))) continue;
#endif
            for (int hh = 0; hh < 2; ++hh) {
                const int qb = hh ? s : 15 - s;
                if (p < 512) { if (!(MK_ATT_MASK & 1)) continue;
                    const float* nq = NRM + 256 + ((b * 2 + 0) * 8 + hm) * 2; const float* nk = NRM + 256 + ((b * 2 + 1) * 8 + hm) * 2;
                    const float bqd = sqrtf((nq[0] + nq[1]) * (nk[0] + nk[1])) * 1.02f;
                    if (bqd < 64.f)
                        attn_body::attn_unit128<16, true>(b, qb, (const attn_body::bf16*)PROJ + hm * 64, (const attn_body::bf16*)PROJ + 512 + hm * 64, (const attn_body::bf16*)PROJ + 1024 + (hm >> 1) * 128,
                                                          (attn_body::bf16*)ATT + (hm & 1) * 512 + (hm >> 1) * 128, (char*)lds_raw, wave);
                    else
                        attn_body::attn_unit128<16, false>(b, qb, (const attn_body::bf16*)PROJ + hm * 64, (const attn_body::bf16*)PROJ + 512 + hm * 64, (const attn_body::bf16*)PROJ + 1024 + (hm >> 1) * 128,
                                                           (attn_body::bf16*)ATT + (hm & 1) * 512 + (hm >> 1) * 128, (char*)lds_raw, wave);
                } else { if (!(MK_ATT_MASK & 2)) continue; const int h = hm;
                    const float* nq = NRM + ((b * 2 + 0) * 8 + h) * 2; const float* nk = NRM + ((b * 2 + 1) * 8 + h) * 2; const float* kbr = KBIAS + (size_t)(b * 8 + h) * SEQ;
                    const float bqk = sqrtf((nq[0] + nq[1]) * (nk[0] + nk[1])) * 1.02f;
                    const int NTf = 4 * qb + 4, tc = 2 * (mk_lane() & 31);
                    const bool skip_ok = (tc >= 2) && (tc <= NTf - 4) && (2.f * bqk + kbr[64 * tc - 1 + (tc ? 0 : 1)] - kbr[256 * qb] < -40.f);
                    const unsigned long long bm = __ballot(skip_ok);
                    const int t0 = bm ? 2 * ((63 - __builtin_clzll(bm)) & 31) : 0;
                    attn_body::attn_unit<8, true>(b, qb, (const attn_body::bf16*)PROJ + 1536 + h * 64, (const attn_body::bf16*)PROJ + 2048 + h * 64, (const attn_body::bf16*)PROJ + 2560 + h * 64,
                                                  (attn_body::bf16*)ATT + 1024 + h * 64, kbr, t0, (char*)lds_raw, wave);
                }
            }
        }
    }
    SEAM(2);

    if (PH(3)) REPS(3) {
        LANE_TID;
        if (bx < 64) {
        { pg8::Gemm g{MEMN, Wckv_t, MM, D, D}; pg8::StaticOrder S; S.init(MM, D, G, bx);
          pg8::EpiBf16<0> E{CKb, D, nullptr, 0, 0, 1.f};
          pg8::gemm_phase<pg8::EpiBf16<0>, pg8::StaticOrder, true, true>(lds, g, S, E, wave); }
        { pg8::Gemm g{Wckv_t + (size_t)D * D, MEMN, D, MM, D}; pg8::StaticOrder S; S.init(D, MM, G, (bx + G - 32) % G);
          pg8::EpiBf16<0> E{CVT, MM, nullptr, 0, 0, 1.f};
          pg8::gemm_phase<pg8::EpiBf16<0>, pg8::StaticOrder, true, true>(lds, g, S, E, wave); }
        }
        const float sa = wave_sum(P.in[I_LQ1][lane] * P.in[I_LK1][lane]), sb = wave_sum(P.in[I_LQ2][lane] * P.in[I_LK2][lane]);
        const float lam = __expf(sa) - __expf(sb) + 0.2f;
        const f32x4 gs0 = *(const f32x4*)(P.in[I_GSUB] + (8 * lane) % 128), gs1 = *(const f32x4*)(P.in[I_GSUB] + (8 * lane) % 128 + 4);
        const f32x4 gf0 = *(const f32x4*)(P.in[I_GFOX] + (8 * lane) % 64), gf1 = *(const f32x4*)(P.in[I_GFOX] + (8 * lane) % 64 + 4);
        const int gw3 = (G > 64) ? (bx - 64) * NWAVES + wave : gw, NGW3 = (G > 64) ? (G - 64) * NWAVES : NGW;
        if (G <= 64 || bx >= 64)
        for (int m = gw3; m < M; m += NGW3) {
            const bf16* a = ATT + (size_t)m * NATT + 8 * lane;
            const v4u o1 = *(const v4u*)a, o2 = *(const v4u*)(a + 512), of = *(const v4u*)(a + 1024);
            float d[8], f[8];
#pragma unroll
            for (int e = 0; e < 4; ++e) { d[2 * e] = bflo(o1[e]) - lam * bflo(o2[e]); d[2 * e + 1] = bfhi(o1[e]) - lam * bfhi(o2[e]); f[2 * e] = bflo(of[e]); f[2 * e + 1] = bfhi(of[e]); }
            float sd = 0.f, sf = 0.f;
#pragma unroll
            for (int e = 0; e < 8; ++e) { sd += d[e] * d[e]; sf += f[e] * f[e]; }
            sd += __shfl_xor(sd, 1); sd += __shfl_xor(sd, 2); sd += __shfl_xor(sd, 4); sd += __shfl_xor(sd, 8);
            sf += __shfl_xor(sf, 1); sf += __shfl_xor(sf, 2); sf += __shfl_xor(sf, 4);
            const float rd = 0.8f / sqrtf(sd * (1.f / 128.f) + SUBLN_EPS), rf = 1.0f / sqrtf(sf * (1.f / 64.f) + EPS);
            v4u wd, wf;
            wd.x = pk2(d[0] * rd * gs0[0], d[1] * rd * gs0[1]); wd.y = pk2(d[2] * rd * gs0[2], d[3] * rd * gs0[3]); wd.z = pk2(d[4] * rd * gs1[0], d[5] * rd * gs1[1]); wd.w = pk2(d[6] * rd * gs1[2], d[7] * rd * gs1[3]);
            wf.x = pk2(f[0] * rf * gf0[0], f[1] * rf * gf0[1]); wf.y = pk2(f[2] * rf * gf0[2], f[3] * rf * gf0[3]); wf.z = pk2(f[4] * rf * gf1[0], f[5] * rf * gf1[1]); wf.w = pk2(f[6] * rf * gf1[2], f[7] * rf * gf1[3]);
            bf16* o = MIXA + (size_t)m * D + 8 * lane;
            *(v4u*)o = wd; *(v4u*)(o + 512) = wf;
        }
    }
    SEAM(3);

    if (PH(4)) REPS(4) { pg8::Gemm g{MIXA, Wout_t, M, D, D}; pg8::StaticOrder S; S.init(M, D, G, bx);
        pg8::EpiRes2<false, true> E{P.in[I_X], H1B, SS1};
        pg8::gemm_phase<pg8::EpiRes2<false, true>, pg8::StaticOrder, true, true>(lds, g, S, E, wave); }
    SEAM(4);

    if (PH(5)) REPS(5) { pg8::Gemm g{H1B, Wcq_t, M, D, D}; pg8::StaticOrder S; S.init(M, D, G, bx);
        build_rstd_tables(lds, S, SS1, EPS, wave);
        pg8::EpiRowScale<0> E{CQ, D, SS1, EPS, pg8::CROSS_C2, (const LAS int*)(lds + RING_BYTES + 1536), (const LAS float*)(lds + RING_BYTES + 2048)};
        pg8::gemm_phase<pg8::EpiRowScale<0>, pg8::StaticOrder, true, true>(lds, g, S, E, wave); }
    SEAM(5);

    if (PH(6)) REPS(6) {
        const int upc = (512 + G - 1) / G;
        for (int u = vcu * upc; u < (vcu + 1) * upc && u < 512; ++u) { const int bh = u >> 4, qblk = u & 15; xattn::unit(bh >> 2, bh & 3, qblk, CQ, CKb, CVT, CO, lds, wave); }
    }
    SEAM(6);

    if (PH(7)) REPS(7) { pg8::Gemm g{CO, Wco_t, M, D, D}; pg8::StaticOrder S; S.init(M, D, G, bx);
        pg8::EpiRes2<true, true> E{H1B, H2B, SS2};
        pg8::gemm_phase<pg8::EpiRes2<true, true>, pg8::StaticOrder, true, true>(lds, g, S, E, wave); }
    SEAM(7);

    if (PH(8)) REPS(8) { pg8::Gemm g{H2B, Wup_t, M, FF, D}; pg8::StaticOrder S; S.init(M, FF, G, bx);
        build_rstd_tables(lds, S, SS2, EPS, wave);
        pg8::EpiRowScale<1> E{ZH, FF, SS2, EPS, 1.f, (const LAS int*)(lds + RING_BYTES + 1536), (const LAS float*)(lds + RING_BYTES + 2048)};
        pg8::gemm_phase<pg8::EpiRowScale<1>, pg8::StaticOrder, true, true>(lds, g, S, E, wave); }
    SEAM(8);

    if (PH(9)) REPS(9) { pg8::Gemm g{ZH, Wdn_t, M, D, FF}; pg8::StaticOrder S; S.init(M, D, G, bx); S.rev = true;
        pg8::EpiRes2<true, true> E{H2B, H1B  , SS3};
        pg8::gemm_phase<pg8::EpiRes2<true, true>, pg8::StaticOrder, true, true>(lds, g, S, E, wave); }
    SEAM(9);

    if (PH(10)) REPS(10) {
        LANE_TID;
        f32x4 gq[4];
#pragma unroll
        for (int j = 0; j < 4; ++j) gq[j] = ((const f32x4*)P.in[I_GFIN])[64 * j + lane];
        for (int m0 = gw * 4; m0 < M; m0 += NGW * 4) {
            unsigned long long w[4][4]; float rr[4];
#pragma unroll
            for (int q = 0; q < 4; ++q) { const unsigned long long* hb = (const unsigned long long*)(H1B + (size_t)(m0 + q) * D) + lane;
#pragma unroll
                for (int j = 0; j < 4; ++j) w[q][j] = hb[64 * j];
                rr[q] = pg8::row_rstd(SS3, m0 + q, EPS); }
#pragma unroll
            for (int q = 0; q < 4; ++q) { f32x4* o = (f32x4*)(P.out + (size_t)(m0 + q) * D) + lane;
#pragma unroll
                for (int j = 0; j < 4; ++j) { const unsigned lo = (unsigned)w[q][j], hi2 = (unsigned)(w[q][j] >> 32);
                    const f32x4 v = {bflo(lo), bfhi(lo), bflo(hi2), bfhi(hi2)}; o[64 * j] = v * rr[q] * gq[j]; } }
        }
    }
#undef IN
#undef SEAM
#undef LANE_TID
#undef ROPE
#undef LOGF
#undef KBIAS
#undef NRM
#undef SS1
#undef SS2
#undef SS3
#undef Win_t
#undef Wout_t
#undef Wcq_t
#undef Wckv_t
#undef Wco_t
#undef Wup_t
#undef Wdn_t
#undef MEMN
#undef CKb
#undef CVT
#undef XN
#undef MIXA
#undef CQ
#undef H2B
#undef H1B
#undef CO
#undef PROJ
#undef ATT
#undef ZH
}

extern "C" void kernel_launch(void* const* d_in, const int* in_sizes, int n_in, void* d_out, int out_size, void* d_ws, size_t ws_size, hipStream_t stream) {
    static int grid = 0;
    if (grid == 0) {
        if (n_in != 21 || in_sizes[0] != M * D || out_size != M * D || ws_size < WS_END) { fprintf(stderr, "kernel_launch: unexpected shapes (n_in %d, in0 %d, out %d, ws %zu); nothing launched\n", n_in, n_in > 0 ? in_sizes[0] : -1, out_size, ws_size); grid = -1; return; }
        int dev = 0, cus = 0, per_cu = 0;
        if (hipGetDevice(&dev) != hipSuccess || hipDeviceGetAttribute(&cus, hipDeviceAttributeMultiprocessorCount, dev) != hipSuccess) { grid = -1; return; }
        if (hipFuncSetAttribute((const void*)mk_fwd, hipFuncAttributeMaxDynamicSharedMemorySize, LDS_BYTES) != hipSuccess) { fprintf(stderr, "kernel_launch: hipFuncSetAttribute failed\n"); grid = -1; return; }
        if (hipOccupancyMaxActiveBlocksPerMultiprocessor(&per_cu, (const void*)mk_fwd, NWAVES * 64, LDS_BYTES) != hipSuccess || per_cu < 1) { fprintf(stderr, "kernel_launch: occupancy query says %d blocks per CU\n", per_cu); per_cu = 1; }
        (void)hipGetLastError();
        grid = cus * per_cu;
    }
    if (grid < 0) return;
    if (hipMemsetAsync((char*)d_ws + WS_BAR, 0, XCD_BAR_WORDS * 4, stream) != hipSuccess) { fprintf(stderr, "kernel_launch: memset of the barrier words failed\n"); return; }
    Params p{};
    for (int i = 0; i < 21; ++i) p.in[i] = (const float*)d_in[i];
    p.out = (float*)d_out; p.ws = (unsigned char*)d_ws;
#if MK_PER_PHASE
    for (int ph = 0; ph < N_PHASES; ++ph) { p.ph_lo = ph; p.ph_hi = ph + 1; hipLaunchKernelGGL(mk_fwd, dim3(grid), dim3(NWAVES * 64), LDS_BYTES, stream, p); }
#else
    p.ph_lo = 0; p.ph_hi = N_PHASES;
    void* args[] = {&p};
    const hipError_t e = hipLaunchCooperativeKernel((const void*)mk_fwd, dim3(grid), dim3(NWAVES * 64), args, LDS_BYTES, stream);
    if (e != hipSuccess) fprintf(stderr, "kernel_launch: cooperative launch failed: %s (grid %d)\n", hipGetErrorString(e), grid);
#endif
}
```

```cpp
#include <hip/hip_runtime.h>
#include <hip/hip_cooperative_groups.h>
#include <hip/hip_bf16.h>
#include <cstdio>
#include <cstdint>
#include <cmath>
namespace cg = cooperative_groups;
__device__ __forceinline__ int mk_lane() { int l = (int)__builtin_amdgcn_mbcnt_hi(~0u, __builtin_amdgcn_mbcnt_lo(~0u, 0u)); asm volatile("" : "+v"(l)); return l; }
namespace pg8 {
#define PG8_LAS __attribute__((address_space(3)))
typedef unsigned short bf16_t;
typedef short bf16x8 __attribute__((ext_vector_type(8)));
typedef float f32x4 __attribute__((ext_vector_type(4)));
typedef unsigned u32x4 __attribute__((ext_vector_type(4)));
constexpr int BM = 256, BK = 64, HALF = 128, HTB = HALF * BK * 2  , STAGE_BYTES = 8 * HTB, NXCD = 8, WGM = 8;

__host__ __device__ __forceinline__ int lds_byte(int r, int c) { const int st = (r >> 4) * 2 + (c >> 5), rr = r & 15, cc = c & 31, ob = rr * 64 + cc * 2; return st * 1024 + (ob ^ (((ob >> 9) & 1) << 5)); }
__host__ __device__ __forceinline__ void stage_rc(int b, int& R, int& C) { const int st = b / 1024, sb = b % 1024, swz = sb ^ (((sb >> 9) & 1) << 5); R = (st >> 1) * 16 + swz / 64; C = (st & 1) * 32 + (swz % 64) / 2; }
__host__ __device__ __forceinline__ int perm32(int rho) { const int n = rho >> 4, i = rho & 15; return 8 * (i >> 2) + 4 * n + (i & 3); }

struct Unit { int pm, pn; };
struct Gemm { const bf16_t* A; const bf16_t* Bt; int M, N, K; };

struct StaticOrder {
    int nM, nN, nwg, G, c; bool rev = false;
    __host__ __device__ __forceinline__ void init(int M, int N, int G_, int c_) { nM = M / BM; nN = N / BM; nwg = nM * nN; G = G_; c = c_; }
    __host__ __device__ __forceinline__ bool next(int i, Unit& u) const {
        const long L = (long)i * G + c; if (L >= nwg) return false;
        int wgid = (int)L; { const int q = nwg / NXCD, r = nwg % NXCD, xcd = wgid % NXCD, off = wgid / NXCD; wgid = (xcd < r ? xcd * (q + 1) : r * (q + 1) + (xcd - r) * q) + off; }
        const int nig = WGM * nN, gid = wgid / nig, fm = gid * WGM, gsz = (nM - fm) < WGM ? (nM - fm) : WGM;
        u.pm = fm + ((wgid % nig) % gsz); u.pn = (wgid % nig) / gsz; if (rev) u.pm = nM - 1 - u.pm; return true;
    }
    __device__ __forceinline__ void a_ready(const Unit&) const {}
    __device__ __forceinline__ void done(const Unit&) const {}
};

__device__ __forceinline__ unsigned cvt_pk_bf16(float lo, float hi) { unsigned r; asm volatile("v_cvt_pk_bf16_f32 %0, %1, %2" : "=v"(r) : "v"(lo), "v"(hi)); return r; }
typedef float f32x2 __attribute__((ext_vector_type(2)));
__device__ __forceinline__ f32x2 gelu_pk(f32x2 v) {
    const f32x2 av = __builtin_elementwise_abs(v), d = av * 0.2316418882f + 1.0f;
    f32x2 t; t.x = __builtin_amdgcn_rcpf(d.x); t.y = __builtin_amdgcn_rcpf(d.y);
    f32x2 q = t * 0.5307027145f + (-0.7265760135f); q = q * t + 0.7107068705f; q = q * t + (-0.142248368f); q = q * t + 0.127414796f; q = q * t;
    const f32x2 s = (v * v) * (-0.72134752044f);
    f32x2 e; e.x = __builtin_amdgcn_exp2f(s.x); e.y = __builtin_amdgcn_exp2f(s.y);
    const f32x2 m = v * (q * e), r = v - m;
    f32x2 o; o.x = v.x < 0.f ? m.x : r.x; o.y = v.y < 0.f ? m.y : r.y; return o;
}

template <int ACT  > struct EpiBf16 {
    static constexpr bool PERM = true, AFTER_DRAIN = false; static_assert(ACT == 0 || ACT == 1, "EpiBf16: ACT is 0 (none) or 1 (gelu_pk)");
    bf16_t* O; int ldc; const float* bias; int split_cols; size_t split_stride; float scale0;
    __device__ __forceinline__ void operator()(const f32x4 (&acc)[2][2][4][2], const Unit& u, int wr, int wc, int fr, int fq) const {
        const int row0 = u.pm * BM + wr * 64 + fr; int colt = u.pn * BM; bf16_t* base = O;
        float sc = 1.f; if (split_cols) { const int t = colt / split_cols; base += (size_t)t * split_stride; colt -= t * split_cols; if (t == 0) sc = scale0; }
        const int col0 = colt + wc * 32 + 8 * fq, bcol0 = u.pn * BM + wc * 32 + 8 * fq;
        f32x4 bv[2][2];
#pragma unroll
        for (int bj = 0; bj < 2; ++bj)
#pragma unroll
            for (int n = 0; n < 2; ++n) bv[bj][n] = bias ? *(const f32x4*)(bias + bcol0 + bj * HALF + 4 * n) : (f32x4){0.f, 0.f, 0.f, 0.f};
#pragma unroll
        for (int ai = 0; ai < 2; ++ai)
#pragma unroll
            for (int m = 0; m < 4; ++m) { bf16_t* rowp = base + (size_t)(row0 + ai * HALF + m * 16) * ldc + col0;
#pragma unroll
                for (int bj = 0; bj < 2; ++bj) { f32x4 v0 = acc[ai][bj][m][0] + bv[bj][0], v1 = acc[ai][bj][m][1] + bv[bj][1];
                    if (ACT == 1) { f32x2 a = gelu_pk((f32x2){v0[0], v0[1]}), b = gelu_pk((f32x2){v0[2], v0[3]}), c = gelu_pk((f32x2){v1[0], v1[1]}), d = gelu_pk((f32x2){v1[2], v1[3]});
                        v0 = (f32x4){a.x, a.y, b.x, b.y}; v1 = (f32x4){c.x, c.y, d.x, d.y}; }
                    v0 = v0 * sc; v1 = v1 * sc; u32x4 w; w.x = cvt_pk_bf16(v0[0], v0[1]); w.y = cvt_pk_bf16(v0[2], v0[3]); w.z = cvt_pk_bf16(v1[0], v1[1]); w.w = cvt_pk_bf16(v1[2], v1[3]);
                    *(u32x4*)(rowp + bj * HALF) = w; } }
    }
};

constexpr float QK_C2 = 0.125f * 1.4426950408889634f;
constexpr float CROSS_C2 = 0.0625f * 1.4426950408889634f;
__device__ __forceinline__ float row_rstd(const float* part, int row, float eps) {
    const f32x4* p = (const f32x4*)(part + (size_t)row * 16);
    const f32x4 a = p[0], b = p[1], c = p[2], d = p[3];
    const float s = ((a[0] + a[1]) + (a[2] + a[3])) + ((b[0] + b[1]) + (b[2] + b[3])) + ((c[0] + c[1]) + (c[2] + c[3])) + ((d[0] + d[1]) + (d[2] + d[3]));
    return 1.0f / sqrtf(s * (1.0f / 1024.0f) + eps);
}
struct EpiProj {
    static constexpr bool PERM = true, AFTER_DRAIN = false;
    bf16_t* O; const float* rope; float* nrm;
    __device__ __forceinline__ void operator()(const f32x4 (&acc)[2][2][4][2], const Unit& u, int wr, int wc, int fr, int fq) const {
        const int row0 = u.pm * BM + wr * 64 + fr, col0 = u.pn * BM + wc * 32 + 8 * fq;
        const int typ = u.pn >> 1;
        const float sc = (typ == 0 || typ == 3) ? QK_C2 : 1.f;
        const bool ropew = (typ < 2) && ((wc & 1) == 0);
        const bool nrmw = (typ == 0 || typ == 1 || typ == 3 || typ == 4); float mxn[2] = {0.f, 0.f};
#pragma unroll
        for (int ai = 0; ai < 2; ++ai) {
            f32x4 rc[4][4];
            if (ropew) {
#pragma unroll
                for (int m = 0; m < 4; ++m) { const f32x4* rp = (const f32x4*)(rope + (size_t)((row0 + ai * HALF + m * 16) & 4095) * 16); rc[m][0] = rp[0]; rc[m][1] = rp[1]; rc[m][2] = rp[2]; rc[m][3] = rp[3]; }
            }
#pragma unroll
            for (int m = 0; m < 4; ++m) {
                const int row = row0 + ai * HALF + m * 16;
                bf16_t* rowp = O + (size_t)row * 3072 + col0;
                f32x4 c0 = {1.f, 1.f, 1.f, 1.f}, c1 = c0, s0 = {0.f, 0.f, 0.f, 0.f}, s1 = s0;
                if (ropew) { c0 = rc[m][0]; c1 = rc[m][1]; s0 = rc[m][2]; s1 = rc[m][3]; if (fq == 0) { s0 = -s0; s1 = -s1; } if (fq >= 2) { c0 = (f32x4){1.f, 1.f, 1.f, 1.f}; c1 = c0; s0 = (f32x4){0.f, 0.f, 0.f, 0.f}; s1 = s0; } }
#pragma unroll
                for (int bj = 0; bj < 2; ++bj) {
                    f32x4 v0 = acc[ai][bj][m][0], v1 = acc[ai][bj][m][1];
                    if (ropew) {
                        f32x4 p0, p1;
#pragma unroll
                        for (int e = 0; e < 4; ++e) { p0[e] = __shfl_xor(v0[e], 16); p1[e] = __shfl_xor(v1[e], 16); }
                        v0 = v0 * c0 + p0 * s0; v1 = v1 * c1 + p1 * s1;
                    }
                    v0 = v0 * sc; v1 = v1 * sc;
                    if (nrmw) { float q = (v0[0] * v0[0] + v0[1] * v0[1]) + (v0[2] * v0[2] + v0[3] * v0[3]) + (v1[0] * v1[0] + v1[1] * v1[1]) + (v1[2] * v1[2] + v1[3] * v1[3]);
                        q += __shfl_xor(q, 16); q += __shfl_xor(q, 32); mxn[bj] = fmaxf(mxn[bj], q); }
                    u32x4 w; w.x = cvt_pk_bf16(v0[0], v0[1]); w.y = cvt_pk_bf16(v0[2], v0[3]); w.z = cvt_pk_bf16(v1[0], v1[1]); w.w = cvt_pk_bf16(v1[2], v1[3]);
                    *(u32x4*)(rowp + bj * HALF) = w;
                }
            }
        }
        if (nrmw) {
#pragma unroll
            for (int bj = 0; bj < 2; ++bj) { float q = mxn[bj];
                q = fmaxf(q, __shfl_xor(q, 1)); q = fmaxf(q, __shfl_xor(q, 2)); q = fmaxf(q, __shfl_xor(q, 4)); q = fmaxf(q, __shfl_xor(q, 8));
                const int rel = 256 * (u.pn & 1) + 128 * bj + 32 * wc, b = (u.pm * BM) >> 12;
                if (fr == 0 && fq == 0) atomicMax((unsigned*)nrm + (typ < 2 ? 256 : 0) + ((b * 2 + ((typ == 1 || typ == 4) ? 1 : 0)) * 8 + (rel >> 6)) * 2 + ((rel >> 5) & 1), __float_as_uint(q * 1.02f)); }
        }
    }
};
template <bool BASE_BF16, bool OUT_BF16> struct EpiRes2 {
    static constexpr bool PERM = true, AFTER_DRAIN = false;
    const void* base; void* out; float* sspart;
    __device__ __forceinline__ void operator()(const f32x4 (&acc)[2][2][4][2], const Unit& u, int wr, int wc, int fr, int fq) const {
        const int row0 = u.pm * BM + wr * 64 + fr, col0 = u.pn * BM + wc * 32 + 8 * fq;
#pragma unroll
        for (int ai = 0; ai < 2; ++ai) {
            u32x4 bw[4][2]; f32x4 bf[4][2][2];
#pragma unroll
            for (int m = 0; m < 4; ++m)
#pragma unroll
                for (int bj = 0; bj < 2; ++bj) { const size_t off = (size_t)(row0 + ai * HALF + m * 16) * 1024 + col0 + bj * HALF;
                    if (BASE_BF16) bw[m][bj] = *(const u32x4*)((const bf16_t*)base + off);
                    else { bf[m][bj][0] = *(const f32x4*)((const float*)base + off); bf[m][bj][1] = *(const f32x4*)((const float*)base + off + 4); } }
#pragma unroll
            for (int m = 0; m < 4; ++m) {
                const int row = row0 + ai * HALF + m * 16; const size_t off = (size_t)row * 1024 + col0;
                float ss = 0.f;
#pragma unroll
                for (int bj = 0; bj < 2; ++bj) {
                    f32x4 b0, b1;
                    if (BASE_BF16) { const u32x4 w = bw[m][bj];
                        b0 = (f32x4){__builtin_bit_cast(float, w.x << 16), __builtin_bit_cast(float, w.x & 0xffff0000u), __builtin_bit_cast(float, w.y << 16), __builtin_bit_cast(float, w.y & 0xffff0000u)};
                        b1 = (f32x4){__builtin_bit_cast(float, w.z << 16), __builtin_bit_cast(float, w.z & 0xffff0000u), __builtin_bit_cast(float, w.w << 16), __builtin_bit_cast(float, w.w & 0xffff0000u)}; }
                    else { b0 = bf[m][bj][0]; b1 = bf[m][bj][1]; }
                    const f32x4 v0 = acc[ai][bj][m][0] + b0, v1 = acc[ai][bj][m][1] + b1;
                    ss += (v0[0] * v0[0] + v0[1] * v0[1]) + (v0[2] * v0[2] + v0[3] * v0[3]) + (v1[0] * v1[0] + v1[1] * v1[1]) + (v1[2] * v1[2] + v1[3] * v1[3]);
                    if (OUT_BF16) { u32x4 w; w.x = cvt_pk_bf16(v0[0], v0[1]); w.y = cvt_pk_bf16(v0[2], v0[3]); w.z = cvt_pk_bf16(v1[0], v1[1]); w.w = cvt_pk_bf16(v1[2], v1[3]);
                        *(u32x4*)((bf16_t*)out + off + bj * HALF) = w; }
                    else { *(f32x4*)((float*)out + off + bj * HALF) = v0; *(f32x4*)((float*)out + off + bj * HALF + 4) = v1; }
                }
                ss += __shfl_xor(ss, 16); ss += __shfl_xor(ss, 32);
                if (fq == 0) sspart[(size_t)row * 16 + u.pn * 4 + wc] = ss;
            }
        }
    }
};
template <int ACT> struct EpiRowScale {
    static constexpr bool PERM = true, AFTER_DRAIN = false;
    bf16_t* O; int ldc; const float* sspart; float eps; float sc;
    const PG8_LAS int* pml; const PG8_LAS float* tab;
    __device__ __forceinline__ void operator()(const f32x4 (&acc)[2][2][4][2], const Unit& u, int wr, int wc, int fr, int fq) const {
        const int row0 = u.pm * BM + wr * 64 + fr, col0 = u.pn * BM + wc * 32 + 8 * fq;
        int slot = -1;
        if (tab) { const int n = pml[8]; for (int j = 0; j < n; ++j) if (pml[j] == u.pm) slot = j; }
#pragma unroll
        for (int ai = 0; ai < 2; ++ai)
#pragma unroll
            for (int m = 0; m < 4; ++m) {
                const int row = row0 + ai * HALF + m * 16; bf16_t* rowp = O + (size_t)row * ldc + col0;
                const float r = (slot >= 0 ? tab[slot * 256 + (row - u.pm * BM)] : row_rstd(sspart, row, eps)) * sc;
#pragma unroll
                for (int bj = 0; bj < 2; ++bj) {
                    f32x4 v0 = acc[ai][bj][m][0] * r, v1 = acc[ai][bj][m][1] * r;
                    if (ACT == 1) {
#pragma unroll
                        for (int e = 0; e < 4; ++e) { const float a = fmaxf(v0[e], 0.f), b = fmaxf(v1[e], 0.f); v0[e] = a * a; v1[e] = b * b; }
                    }
                    u32x4 w; w.x = cvt_pk_bf16(v0[0], v0[1]); w.y = cvt_pk_bf16(v0[2], v0[3]); w.z = cvt_pk_bf16(v1[0], v1[1]); w.w = cvt_pk_bf16(v1[2], v1[3]);
                    *(u32x4*)(rowp + bj * HALF) = w;
                }
            }
    }
};
template <class Epi, class Sched, bool ALIGN_EPI = false, bool SP2 = false>
__device__ __forceinline__ void gemm_phase(PG8_LAS unsigned char* lds, const Gemm g, const Sched& S, const Epi& E, const int wv  ) {
    int tid_ = wv * 64 + mk_lane();
    const int tid = tid_, wid = __builtin_amdgcn_readfirstlane(tid >> 6), lane = tid & 63, wr = wid >> 2, wc = wid & 3, fr = lane & 15, fq = lane >> 4;
    const int K = g.K, nt = K / BK;
    unsigned voffA[2], voffB[2];
#pragma unroll
    for (int i = 0; i < 2; ++i) { int R, C; stage_rc(tid * 16 + i * 8192, R, C); const int Rb = Epi::PERM ? ((R & ~31) + perm32(R & 31)) : R;
        voffA[i] = (unsigned)(R * K + C) * 2u; voffB[i] = (unsigned)(Rb * K + C) * 2u; }
    const size_t kstep = (size_t)(BK * 2);
    const size_t hstep = (size_t)HALF * K * 2;
    const size_t tstep = 2 * hstep;
    const unsigned ldsw = (unsigned)wid * 1024u;
    const int aoff = lds_byte(wr * 64 + fr, fq * 8), boff = lds_byte(wc * 32 + fr, fq * 8);
#define PG8_SA(b, h) (((b) * 2 + (h)) * HTB)
#define PG8_SB(b, h) ((4 + (b) * 2 + (h)) * HTB)
#define PG8_STAGE(bufoff, gbase, voff) do { _Pragma("unroll") for (int _i = 0; _i < 2; ++_i) \
        __builtin_amdgcn_global_load_lds((const unsigned*)((const char*)(gbase) + (voff)[_i]), (PG8_LAS unsigned*)(lds + (bufoff) + ldsw + _i * 8192), 16, 0, 0); } while (0)
#define PG8_LDA(dst, b, h) do { _Pragma("unroll") for (int m = 0; m < 4; ++m) _Pragma("unroll") for (int k = 0; k < 2; ++k) dst[m][k] = *(const PG8_LAS bf16x8*)(lds + PG8_SA(b, h) + aoff + m * 2048 + k * 1024); } while (0)
#define PG8_LDB(dst, b, h) do { _Pragma("unroll") for (int n = 0; n < 2; ++n) _Pragma("unroll") for (int k = 0; k < 2; ++k) dst[n][k] = *(const PG8_LAS bf16x8*)(lds + PG8_SB(b, h) + boff + n * 2048 + k * 1024); } while (0)
#define PG8_MMA(ai, bj, At, Bt) do { __builtin_amdgcn_s_setprio(1); _Pragma("unroll") for (int m = 0; m < 4; ++m) _Pragma("unroll") for (int n = 0; n < 2; ++n) _Pragma("unroll") for (int k = 0; k < 2; ++k) \
        acc[ai][bj][m][n] = __builtin_amdgcn_mfma_f32_16x16x32_bf16(Bt[n][k], At[m][k], acc[ai][bj][m][n], 0, 0, 0); __builtin_amdgcn_s_setprio(0); } while (0)
#define PG8_WAIT_V(n) asm volatile("s_waitcnt vmcnt(" #n ")" ::: "memory")
#define PG8_WAIT_L(n) asm volatile("s_waitcnt lgkmcnt(" #n ")" ::: "memory")
#define PG8_BAR __builtin_amdgcn_s_barrier()
#define PG8_SCHED __builtin_amdgcn_sched_barrier(0)
    Unit cur, nxt; int ui = 0;
    if (!S.next(0, cur)) return;
    f32x4 acc[2][2][4][2];
#pragma unroll
    for (int a = 0; a < 2; ++a)
#pragma unroll
        for (int b = 0; b < 2; ++b)
#pragma unroll
            for (int m = 0; m < 4; ++m)
#pragma unroll
                for (int n = 0; n < 2; ++n) acc[a][b][m][n] = (f32x4){0.f, 0.f, 0.f, 0.f};
    bf16x8 At[4][2], B0[2][2], B1[2][2];
    const char* cA = (const char*)g.A + (size_t)cur.pm * tstep; const char* cB = (const char*)g.Bt + (size_t)cur.pn * tstep;
    S.a_ready(cur);
    if constexpr (SP2) {
        PG8_STAGE(PG8_SB(0, 0), cB, voffB); PG8_STAGE(PG8_SB(0, 1), cB + hstep, voffB); PG8_STAGE(PG8_SA(0, 0), cA, voffA); PG8_STAGE(PG8_SA(0, 1), cA + hstep, voffA);
        if (wr == 1) PG8_BAR;
        PG8_WAIT_V(2); PG8_BAR;
        PG8_STAGE(PG8_SB(1, 0), cB + kstep, voffB); PG8_STAGE(PG8_SA(1, 0), cA + kstep, voffA); PG8_STAGE(PG8_SB(1, 1), cB + hstep + kstep, voffB);
        PG8_WAIT_V(6); PG8_BAR;
    } else {
        PG8_STAGE(PG8_SB(0, 0), cB, voffB); PG8_STAGE(PG8_SA(0, 0), cA, voffA); PG8_STAGE(PG8_SB(0, 1), cB + hstep, voffB); PG8_STAGE(PG8_SA(0, 1), cA + hstep, voffA);
        if (wr == 1) PG8_BAR;
        PG8_WAIT_V(4); PG8_BAR;
        PG8_STAGE(PG8_SB(1, 0), cB + kstep, voffB); PG8_STAGE(PG8_SA(1, 0), cA + kstep, voffA); PG8_STAGE(PG8_SB(1, 1), cB + hstep + kstep, voffB);
        PG8_WAIT_V(6); PG8_BAR;
    }
    for (;;) {
        const bool has_next = S.next(ui + 1, nxt);
        const char* nA = has_next ? (const char*)g.A + (size_t)nxt.pm * tstep : cA; const char* nB = has_next ? (const char*)g.Bt + (size_t)nxt.pn * tstep : cB;
        for (int t = 0; t < nt; t += 2) {
            const bool last = (t == nt - 2);
            const char* a1 = cA + (size_t)(t + 1) * kstep;
            const char* a2 = last ? nA : cA + (size_t)(t + 2) * kstep; const char* b2 = last ? nB : cB + (size_t)(t + 2) * kstep;
            const char* a3 = a2 + kstep; const char* b3 = b2 + kstep;
            if (last && has_next) S.a_ready(nxt);
            if constexpr (SP2) {
            PG8_LDB(B0, 0, 0); PG8_LDB(B1, 0, 1); PG8_SCHED; PG8_LDA(At, 0, 0); PG8_STAGE(PG8_SA(1, 1), a1 + hstep, voffA);
            PG8_WAIT_V(8); PG8_WAIT_L(0); PG8_BAR; PG8_MMA(0, 0, At, B0); PG8_MMA(0, 1, At, B1); PG8_BAR; PG8_SCHED;
            PG8_LDA(At, 0, 1); PG8_STAGE(PG8_SB(0, 0), b2, voffB); PG8_STAGE(PG8_SB(0, 1), b2 + hstep, voffB); PG8_STAGE(PG8_SA(0, 0), a2, voffA);
            PG8_WAIT_V(8); PG8_WAIT_L(0); PG8_BAR; PG8_MMA(1, 0, At, B0); PG8_MMA(1, 1, At, B1); PG8_BAR; PG8_SCHED;
            PG8_LDB(B0, 1, 0); PG8_LDB(B1, 1, 1); PG8_SCHED; PG8_LDA(At, 1, 0); PG8_STAGE(PG8_SA(0, 1), a2 + hstep, voffA);
            PG8_WAIT_V(8); PG8_WAIT_L(0); PG8_BAR; PG8_MMA(0, 0, At, B0); PG8_MMA(0, 1, At, B1); PG8_BAR; PG8_SCHED;
            PG8_LDA(At, 1, 1); PG8_STAGE(PG8_SB(1, 0), b3, voffB); PG8_STAGE(PG8_SB(1, 1), b3 + hstep, voffB); PG8_STAGE(PG8_SA(1, 0), a3, voffA);
            PG8_WAIT_V(8); PG8_WAIT_L(0); PG8_BAR; PG8_MMA(1, 0, At, B0); PG8_MMA(1, 1, At, B1); PG8_BAR; PG8_SCHED;
            } else {
            PG8_LDB(B0, 0, 0); PG8_SCHED; PG8_LDA(At, 0, 0); PG8_STAGE(PG8_SA(1, 1), a1 + hstep, voffA);
            PG8_WAIT_L(8); PG8_BAR; PG8_WAIT_L(0); PG8_MMA(0, 0, At, B0); PG8_BAR; PG8_SCHED;
            PG8_LDB(B1, 0, 1); PG8_STAGE(PG8_SB(0, 0), b2, voffB);
            PG8_BAR; PG8_WAIT_L(0); PG8_MMA(0, 1, At, B1); PG8_BAR;
            PG8_LDA(At, 0, 1); PG8_STAGE(PG8_SA(0, 0), a2, voffA);
            PG8_BAR; PG8_WAIT_L(0); PG8_MMA(1, 0, At, B0); PG8_BAR; PG8_SCHED;
            PG8_STAGE(PG8_SB(0, 1), b2 + hstep, voffB);
            PG8_WAIT_V(6); PG8_BAR; PG8_MMA(1, 1, At, B1); PG8_BAR;
            PG8_LDB(B0, 1, 0); PG8_SCHED; PG8_LDA(At, 1, 0); PG8_STAGE(PG8_SA(0, 1), a2 + hstep, voffA);
            PG8_WAIT_L(8); PG8_BAR; PG8_WAIT_L(0); PG8_MMA(0, 0, At, B0); PG8_BAR; PG8_SCHED;
            PG8_LDB(B1, 1, 1); PG8_STAGE(PG8_SB(1, 0), b3, voffB);
            PG8_BAR; PG8_WAIT_L(0); PG8_MMA(0, 1, At, B1); PG8_BAR;
            PG8_LDA(At, 1, 1); PG8_STAGE(PG8_SA(1, 0), a3, voffA);
            PG8_BAR; PG8_WAIT_L(0); PG8_MMA(1, 0, At, B0); PG8_BAR; PG8_SCHED;
            PG8_STAGE(PG8_SB(1, 1), b3 + hstep, voffB);
            PG8_WAIT_V(6); PG8_BAR; PG8_MMA(1, 1, At, B1); PG8_BAR;
            }
        }
        if constexpr (ALIGN_EPI) { if (wr == 0) PG8_BAR; }
        if constexpr (!Epi::AFTER_DRAIN) { E(acc, cur, wr, wc, fr, fq); S.done(cur); }
        if (!has_next) break;
#pragma unroll
        for (int a = 0; a < 2; ++a)
#pragma unroll
            for (int b = 0; b < 2; ++b)
#pragma unroll
                for (int m = 0; m < 4; ++m)
#pragma unroll
                    for (int n = 0; n < 2; ++n) acc[a][b][m][n] = (f32x4){0.f, 0.f, 0.f, 0.f};
        cur = nxt; cA = nA; cB = nB; ++ui;
        if constexpr (ALIGN_EPI) { if (wr == 1) PG8_BAR; }
    }
    PG8_WAIT_V(0);
    if constexpr (!ALIGN_EPI) { if (wr == 0) PG8_BAR; }
    PG8_BAR;
    if constexpr (Epi::AFTER_DRAIN) { E.fused(acc, cur, wr, wc, fr, fq, lds, wid, lane); S.done(cur); }
#undef PG8_SA
#undef PG8_SB
#undef PG8_STAGE
#undef PG8_LDA
#undef PG8_LDB
#undef PG8_MMA
#undef PG8_WAIT_V
#undef PG8_WAIT_L
#undef PG8_BAR
#undef PG8_SCHED
}
}

#ifndef PG8_SP2
#define PG8_SP2 true
#endif
#ifndef PG8_ALIGN
#define PG8_ALIGN true
#endif
namespace attn_body {
using bf16=__hip_bfloat16;
using bf16x8=__attribute__((ext_vector_type(8)))short;
using s16x4=__attribute__((ext_vector_type(4)))short;
using f32x16=__attribute__((ext_vector_type(16)))float;
using u32x4=__attribute__((ext_vector_type(4)))unsigned; using f32x4=__attribute__((ext_vector_type(4)))float;
constexpr int SEQ=4096,D=64,PQ=3072,PO=1536;
constexpr int NW=8,QBLK=32,QB=QBLK*NW,KVBLK=64,NQB=SEQ/QB;
constexpr int ATTN_UNIT_ROWS=QB;
__device__ __forceinline__ int crow(int r,int hi){return (r&3)+8*(r>>2)+4*hi;}
#define SBAR() __builtin_amdgcn_sched_barrier(0)
__device__ __forceinline__ void cmask(f32x16&p0,f32x16&p1,int jb,int qrel,int hi){
  const float NEG=-INFINITY; int kb=64*jb+4*hi;
  #pragma unroll
  for(int r=0;r<16;++r){int kv=kb+(r&3)+8*(r>>2); if(kv>qrel)p0[r]=NEG; if(kv+32>qrel)p1[r]=NEG;}
}

template<bool B> __device__ __forceinline__ const f32x16& csel(const f32x16&a,const f32x16&b){ if constexpr(B) return a; else return b; }
constexpr int NSLOT=3, SLOTB=8192;
constexpr int LDS_K=0, LDS_V=NSLOT*SLOTB, LDS_WS=2*NSLOT*SLOTB, LDS_OST=LDS_WS+NW*64*4, LDS_KBIAS=LDS_OST+NW*4096, LDS_BYTES=LDS_KBIAS+SEQ*4;
constexpr float C2=0.125f*1.4426950408889634f;
__device__ __forceinline__ void glds16(const void*gsrc,unsigned lds_dst){unsigned keep;
  asm volatile("s_mov_b32 %0, m0\n\ts_mov_b32 m0, %2\n\ts_nop 0\n\tglobal_load_lds_dwordx4 %1, off\n\ts_mov_b32 m0, %0":"=&s"(keep):"v"(gsrc),"s"(lds_dst):"memory");}
__device__ __forceinline__ float max3f(float a,float b,float c){float r;asm("v_max3_f32 %0, %1, %2, %3":"=v"(r):"v"(a),"v"(b),"v"(c));return r;}
__device__ __forceinline__ float max2f(float a,float b){float r;asm("v_max_f32_e32 %0, %1, %2":"=v"(r):"v"(a),"v"(b));return r;}
__device__ __forceinline__ float fadd_s(float a,float b){float r;asm("v_add_f32_e32 %0, %1, %2":"=v"(r):"v"(a),"v"(b));return r;}
__device__ __forceinline__ float fsub_s(float a,float b){float r;asm("v_sub_f32_e32 %0, %1, %2":"=v"(r):"v"(a),"v"(b));return r;}
typedef float f32x2_t __attribute__((ext_vector_type(2))); typedef __bf16 bf16x2_t __attribute__((ext_vector_type(2)));
__device__ __forceinline__ unsigned cvtpk_s(float lo,float hi){f32x2_t v={lo,hi};bf16x2_t b=__builtin_convertvector(v,bf16x2_t);return __builtin_bit_cast(unsigned,b);}
#define WAIT_BAR(N) asm volatile("s_waitcnt vmcnt(" #N ") lgkmcnt(0)\n\ts_barrier":::"memory")

__device__ __forceinline__ void qkt(f32x16&p0,f32x16&p1,const char*Kslot,const bf16x8*qr,const f32x16&ci0,const f32x16&ci1,int r32,int hi){
  const char*kb=Kslot+hi*1024+r32*16;
  #pragma unroll
  for(int d0=0;d0<4;++d0){
    const bf16x8 b0=*reinterpret_cast<const bf16x8*>(kb+d0*2048);
    const bf16x8 b1=*reinterpret_cast<const bf16x8*>(kb+d0*2048+512);
    if(d0==0){p0=__builtin_amdgcn_mfma_f32_32x32x16_bf16(b0,qr[0],ci0,0,0,0);p1=__builtin_amdgcn_mfma_f32_32x32x16_bf16(b1,qr[0],ci1,0,0,0);}
    else{p0=__builtin_amdgcn_mfma_f32_32x32x16_bf16(b0,qr[d0],p0,0,0,0);p1=__builtin_amdgcn_mfma_f32_32x32x16_bf16(b1,qr[d0],p1,0,0,0);}}
}
typedef __attribute__((address_space(3))) const char* lds_cptr;
typedef short v4i16_t __attribute__((ext_vector_type(4)));
__device__ __forceinline__ void kload8(bf16x8*kf,lds_cptr kp){
  kf[0]=*(const __attribute__((address_space(3))) bf16x8*)(kp);      kf[1]=*(const __attribute__((address_space(3))) bf16x8*)(kp+512);
  kf[2]=*(const __attribute__((address_space(3))) bf16x8*)(kp+2048); kf[3]=*(const __attribute__((address_space(3))) bf16x8*)(kp+2560);
  kf[4]=*(const __attribute__((address_space(3))) bf16x8*)(kp+4096); kf[5]=*(const __attribute__((address_space(3))) bf16x8*)(kp+4608);
  kf[6]=*(const __attribute__((address_space(3))) bf16x8*)(kp+6144); kf[7]=*(const __attribute__((address_space(3))) bf16x8*)(kp+6656);
}
__device__ __forceinline__ void kload2(bf16x8*kf,lds_cptr kp,int j){ kf[2*j]=*(const __attribute__((address_space(3))) bf16x8*)(kp+j*2048); kf[2*j+1]=*(const __attribute__((address_space(3))) bf16x8*)(kp+j*2048+512); }
__device__ __forceinline__ s16x4 vtr(lds_cptr p){ return __builtin_bit_cast(s16x4,__builtin_amdgcn_ds_read_tr16_b64_v4i16((__attribute__((address_space(3))) v4i16_t*)p)); }
__device__ __forceinline__ float rowmax(const f32x16&p0,const f32x16&p1){
  float a=max3f(p0[0],p0[1],p1[0]),b=max3f(p0[2],p0[3],p1[1]);a=max3f(a,p1[2],p1[3]);
  #pragma unroll
  for(int r=4;r<16;r+=4){a=max3f(a,p0[r],p0[r+1]);b=max3f(b,p0[r+2],p0[r+3]);a=max3f(a,p1[r],p1[r+1]);b=max3f(b,p1[r+2],p1[r+3]);}
  const float m=max2f(a,b);
  auto rr=__builtin_amdgcn_permlane32_swap(__float_as_uint(m),__float_as_uint(m),false,false);
  return max2f(__uint_as_float(rr[0]),__uint_as_float(rr[1]));
}
__device__ __forceinline__ void pv(f32x16*o,int vb,bf16x8 pa0,bf16x8 pa1,bf16x8 pa2,bf16x8 pa3){
  #pragma unroll
  for(int d0=0;d0<2;++d0){s16x4 lo[4],hi[4];
    #pragma unroll
    for(int ks=0;ks<4;++ks){
      asm volatile("ds_read_b64_tr_b16 %0,%1 offset:%c2":"=&v"(lo[ks]):"v"(vb),"i"(d0*4096+ks*1024):"memory");
      asm volatile("ds_read_b64_tr_b16 %0,%1 offset:%c2":"=&v"(hi[ks]):"v"(vb),"i"(d0*4096+ks*1024+512):"memory");}
    asm volatile("s_waitcnt lgkmcnt(0)":::"memory");SBAR();
    #define PK(k) (bf16x8){lo[k][0],lo[k][1],lo[k][2],lo[k][3],hi[k][0],hi[k][1],hi[k][2],hi[k][3]}
    o[d0]=__builtin_amdgcn_mfma_f32_32x32x16_bf16(pa0,PK(0),o[d0],0,0,0);
    o[d0]=__builtin_amdgcn_mfma_f32_32x32x16_bf16(pa1,PK(1),o[d0],0,0,0);
    o[d0]=__builtin_amdgcn_mfma_f32_32x32x16_bf16(pa2,PK(2),o[d0],0,0,0);
    o[d0]=__builtin_amdgcn_mfma_f32_32x32x16_bf16(pa3,PK(3),o[d0],0,0,0);
    #undef PK
  }
}

#ifndef ATTN_STORE16
#define ATTN_STORE16(p,v) (*(u32x4*)(p)=(v))
#endif
template<int THRL,bool HASB> __device__ __forceinline__ void attn_unit(int b,int qb,const bf16*Qc,const bf16*__restrict__ Kc,const bf16*__restrict__ Vc,bf16*Oc,const float*__restrict__ kbg,int t0,char*shm,const int wv){
  int tid_=wv*64+mk_lane();
  const int tid=tid_,lane=tid&63,r32=lane&31,hi=lane>>5; const int wid=__builtin_amdgcn_readfirstlane(tid>>6);
  const long rowbase=(long)b*SEQ; const int q0=qb*QB;
  const bf16*Qw=Qc+(rowbase+q0+wid*QBLK)*PQ;
  const bf16*Kh=Kc+(rowbase+(long)t0*KVBLK)*PQ,*Vh=Vc+(rowbase+(long)t0*KVBLK)*PQ;
  const unsigned lds0=(unsigned)(uintptr_t)shm;
  float*wsf=(float*)(shm+LDS_WS)+wid*64;
  const bf16*ksrc=Kh+(long)lane*PQ+wid*8;
  const bf16*vsrc=Vh+(long)(16*(wid&3)+(lane>>2))*PQ+(wid>>2)*32+(lane&3)*8;
  const unsigned kdst=lds0+LDS_K+wid*1024, vdst=lds0+LDS_V+wid*1024;
  #define DMA_K(t,slot) glds16(ksrc+(long)(t)*KVBLK*PQ,(unsigned)__builtin_amdgcn_readfirstlane(kdst+(slot)))
  #define DMA_V(t,slot) glds16(vsrc+(long)(t)*KVBLK*PQ,(unsigned)__builtin_amdgcn_readfirstlane(vdst+(slot)))
  const int vb0=(int)(lds0+LDS_V)+((lane>>4)&1)*32+(lane&3)*8+(4*hi+((lane&15)>>2))*64;
  const char*Kbase=shm+LDS_K; bf16x8 kf[8];
  const lds_cptr shm3=(lds_cptr)shm; const lds_cptr kp0=shm3+LDS_K+hi*1024+r32*16; const lds_cptr vp0=shm3+LDS_V+((lane>>4)&1)*32+(lane&3)*8+(4*hi+((lane&15)>>2))*64;
  const int NT=(q0+QB)/KVBLK-t0;
  typedef __attribute__((address_space(3))) const f32x4 lds_cf4; typedef __attribute__((address_space(3))) f32x4 lds_f4;
  const __attribute__((address_space(3))) char* kbl=(const __attribute__((address_space(3))) char*)shm+LDS_KBIAS+hi*16;
  DMA_K(0,0);DMA_V(0,0);DMA_K(1,SLOTB);
  bf16x8 qr[4];
  #pragma unroll
  for(int d0=0;d0<4;++d0)qr[d0]=*reinterpret_cast<const bf16x8*>(&Qw[(long)r32*PQ+d0*16+hi*8]);
  float mhat=0.f,l_reg=0.f;f32x16 o[2];o[0]=f32x16{};o[1]=f32x16{};f32x16 negm=f32x16{};asm volatile("":"+v"(negm));
  const int qrel=wid*QBLK+r32;
  float mref=0.f;
  #define CINIT(C0,C1,t) do{ if(HASB){ const __attribute__((address_space(3))) char* kp_=kbl+(t)*256; \
      _Pragma("unroll") for(int g_=0;g_<4;++g_){ const f32x4 a_=*(lds_cf4*)(kp_+g_*32), b_=*(lds_cf4*)(kp_+128+g_*32); \
        _Pragma("unroll") for(int e_=0;e_<4;++e_){ C0[4*g_+e_]=a_[e_]-mhat; C1[4*g_+e_]=b_[e_]-mhat; } } } \
    }while(0)
  #define CMASK(P0,P1,t) do{int jb_=(t)-(NT-4); if(jb_>=0)cmask(P0,P1,jb_,qrel,hi);}while(0)
  bool resc=false;
  #define START(P0,P1) do{ const float rm=rowmax(P0,P1); resc=false; \
    { const float dl=HASB?__builtin_fmaxf(rm,0.f):rm; mhat=fadd_s(mhat,dl); \
      _Pragma("unroll") for(int r=0;r<16;++r){P0[r]=fsub_s(P0[r],dl);P1[r]=fsub_s(P1[r],dl);} \
      if(!HASB){ _Pragma("unroll") for(int r=0;r<16;++r)negm[r]=-mhat; asm volatile("":"+v"(negm)); } } \
    _Pragma("unroll") for(int r=0;r<16;++r)P0[r]=__builtin_amdgcn_exp2f(P0[r]); }while(0)
  #define RESC() do{ if(resc){ asm volatile("s_waitcnt lgkmcnt(0)":::"memory"); \
      _Pragma("unroll") for(int d_=0;d_<2;++d_) _Pragma("unroll") for(int r=0;r<16;++r)o[d_][r]*=wsf[crow(r,hi)]; } }while(0)
  f32x16 pA0,pA1,pB0,pB1;
  int sl_prev=0,sl_cur=0,sl_next=SLOTB;
  #define ROT() do{sl_prev=sl_cur;sl_cur=sl_next;sl_next=(sl_next==(NSLOT-1)*SLOTB)?0:sl_next+SLOTB;}while(0)
  DMA_K(2,2*SLOTB);
  if(HASB){ const int n4=(q0+QB-t0*KVBLK)/4; for(int i=tid;i<n4;i+=NW*64){ const f32x4 v=*(const f32x4*)(kbg+t0*KVBLK+4*i); *((lds_f4*)((__attribute__((address_space(3))) char*)shm+LDS_KBIAS)+i)=v; } }
  WAIT_BAR(3);
  if(HASB){ mref=*(const __attribute__((address_space(3))) float*)((const __attribute__((address_space(3))) char*)shm+LDS_KBIAS+(q0-t0*KVBLK+qrel)*4); mhat=mref; }
  { f32x16 ci0=f32x16{},ci1=f32x16{}; CINIT(ci0,ci1,0); qkt(pA0,pA1,Kbase,qr,csel<HASB>(ci0,negm),csel<HASB>(ci1,negm),r32,hi); } asm volatile("s_nop 15\n\ts_nop 7":"+v"(pA0),"+v"(pA1));CMASK(pA0,pA1,0);
  START(pA0,pA1);
  _Pragma("unroll") for(int r=0;r<16;++r)pA1[r]=__builtin_amdgcn_exp2f(pA1[r]);
  WAIT_BAR(0);
  DMA_K(3,0);DMA_V(1,SLOTB);
  ROT();
  kload8(kf,kp0+sl_cur);
  WAIT_BAR(2);
  s16x4 vlo[8],vhi[8]; u32x4 pw0,pw1,pw2,pw3;
  #define PKW(P,B) cvtpk_s(P[B],P[B+1])
  #define PAF(k) __builtin_bit_cast(bf16x8,pw##k)
  #define VFR(i) (bf16x8){vlo[i][0],vlo[i][1],vlo[i][2],vlo[i][3],vhi[i][0],vhi[i][1],vhi[i][2],vhi[i][3]}
  #define PIN(x) asm volatile("":"+v"(x))
  #define MX3(a,b,c) __builtin_fmaxf(__builtin_fmaxf((a),(b)),(c))
  #define GAPA(MF,A0,A1,A2,A3,W0,W1,PW) do{ MF; sacc+=A0; sacc+=A1; sacc+=A2; sacc+=A3; PIN(sacc); W0; W1; PIN(PW); SBAR(); }while(0)
  #define EX(v) __builtin_amdgcn_exp2f(v)
  #define GAPB(MF,X,B,Y) do{ MF; X[B]=EX(X[B]); X[B+1]=EX(X[B+1]); X[B+2]=EX(X[B+2]); X[B+3]=EX(X[B+3]); PIN(X); if(HASB){ Y[B]-=mhat; Y[B+1]-=mhat; Y[B+2]-=mhat; Y[B+3]-=mhat; PIN(Y); } SBAR(); }while(0)
  #define LOADB(Y0,Y1,t) do{ if(HASB){ const __attribute__((address_space(3))) char* kp_=kbl+(t)*256; \
      _Pragma("unroll") for(int g_=0;g_<4;++g_){ const f32x4 a_=*(lds_cf4*)(kp_+g_*32), b_=*(lds_cf4*)(kp_+128+g_*32); \
        _Pragma("unroll") for(int e_=0;e_<4;++e_){ Y0[4*g_+e_]=a_[e_]; Y1[4*g_+e_]=b_[e_]; } } } }while(0)
  #define VRD(i) do{ vlo[i]=vtr(vp_+(((i)>>2)*4096+((i)&3)*1024)); vhi[i]=vtr(vp_+(((i)>>2)*4096+((i)&3)*1024+512)); }while(0)
  #define KRD(G,j) do{ if(G){ kload2(kf,kp0+sl_next,j); SBAR(); } }while(0)
  #define STEP(C0,C1,P0,P1,t,GK,GV,GL) do{ SBAR(); \
    const lds_cptr vp_=vp0+sl_prev; \
    VRD(0); SBAR(); float sacc=(P0[0]+P0[1]); \
    GAPA(C0=__builtin_amdgcn_mfma_f32_32x32x16_bf16(kf[0],qr[0],csel<HASB>(C0,negm),0,0,0), P0[2],P0[3],P0[4],P0[5],     pw0[0]=PKW(P0,0), pw0[1]=PKW(P0,2), pw0); \
    VRD(4); SBAR(); GAPA(C1=__builtin_amdgcn_mfma_f32_32x32x16_bf16(kf[1],qr[0],csel<HASB>(C1,negm),0,0,0), P0[6],P0[7],P0[8],P0[9],     pw0[2]=PKW(P0,4), pw0[3]=PKW(P0,6), pw0); \
    VRD(1); SBAR(); GAPA(C0=__builtin_amdgcn_mfma_f32_32x32x16_bf16(kf[2],qr[1],C0,0,0,0),   P0[10],P0[11],P0[12],P0[13], pw1[0]=PKW(P0,8), pw1[1]=PKW(P0,10), pw1); \
    VRD(5); SBAR(); GAPA(C1=__builtin_amdgcn_mfma_f32_32x32x16_bf16(kf[3],qr[1],C1,0,0,0),   P0[14],P0[15],P1[0],P1[1],   pw1[2]=PKW(P0,12),pw1[3]=PKW(P0,14), pw1); \
    VRD(2); SBAR(); GAPA(C0=__builtin_amdgcn_mfma_f32_32x32x16_bf16(kf[4],qr[2],C0,0,0,0),   P1[2],P1[3],P1[4],P1[5],     pw2[0]=PKW(P1,0), pw2[1]=PKW(P1,2), pw2); \
    VRD(6); SBAR(); GAPA(C1=__builtin_amdgcn_mfma_f32_32x32x16_bf16(kf[5],qr[2],C1,0,0,0),   P1[6],P1[7],P1[8],P1[9],     pw2[2]=PKW(P1,4), pw2[3]=PKW(P1,6), pw2); \
    VRD(3); SBAR(); GAPA(C0=__builtin_amdgcn_mfma_f32_32x32x16_bf16(kf[6],qr[3],C0,0,0,0),   P1[10],P1[11],P1[12],P1[13], pw3[0]=PKW(P1,8), pw3[1]=PKW(P1,10), pw3); \
    VRD(7); SBAR(); GAPA(C1=__builtin_amdgcn_mfma_f32_32x32x16_bf16(kf[7],qr[3],C1,0,0,0),   P1[14],P1[15],0.f,0.f,       pw3[2]=PKW(P1,12),pw3[3]=PKW(P1,14), pw3); \
    l_reg+=sacc; \
    LOADB(P0,P1,(t)+1); \
    if(GK){DMA_K((t)+3,sl_cur);} if(GV){DMA_V((t)+1,sl_next);} \
    CMASK(C0,C1,t); \
    { float a=MX3(C0[0],C0[1],C1[0]),b=MX3(C0[2],C0[3],C1[1]); a=MX3(a,C1[2],C1[3]); \
      _Pragma("unroll") for(int r=4;r<16;r+=4){a=MX3(a,C0[r],C0[r+1]);b=MX3(b,C0[r+2],C0[r+3]);a=MX3(a,C1[r],C1[r+1]);b=MX3(b,C1[r+2],C1[r+3]);} \
      float rm=__builtin_fmaxf(a,b); { auto rr=__builtin_amdgcn_permlane32_swap(__float_as_uint(rm),__float_as_uint(rm),false,false); rm=__builtin_fmaxf(__uint_as_float(rr[0]),__uint_as_float(rr[1])); } \
      resc=false; \
      if(__builtin_expect(__any(rm>(float)THRL),0)){ const float dl=__builtin_fmaxf(rm,0.f); mhat+=dl; \
        _Pragma("unroll") for(int r=0;r<16;++r){C0[r]-=dl;C1[r]-=dl;} \
        if(!HASB){ _Pragma("unroll") for(int r=0;r<16;++r)negm[r]=-mhat; asm volatile("":"+v"(negm)); } \
        const float f=__builtin_amdgcn_exp2f(-dl); l_reg*=f; if(hi==0)wsf[r32]=f; resc=true; } } \
    SBAR(); \
    GAPB(o[0]=__builtin_amdgcn_mfma_f32_32x32x16_bf16(PAF(0),VFR(0),o[0],0,0,0), C0,0,P0); \
    GAPB(o[1]=__builtin_amdgcn_mfma_f32_32x32x16_bf16(PAF(0),VFR(4),o[1],0,0,0), C0,4,P0); \
    KRD(GL,0); GAPB(o[0]=__builtin_amdgcn_mfma_f32_32x32x16_bf16(PAF(1),VFR(1),o[0],0,0,0), C0,8,P0); \
    KRD(GL,1); GAPB(o[1]=__builtin_amdgcn_mfma_f32_32x32x16_bf16(PAF(1),VFR(5),o[1],0,0,0), C0,12,P0); \
    KRD(GL,2); GAPB(o[0]=__builtin_amdgcn_mfma_f32_32x32x16_bf16(PAF(2),VFR(2),o[0],0,0,0), C1,0,P1); \
    KRD(GL,3); GAPB(o[1]=__builtin_amdgcn_mfma_f32_32x32x16_bf16(PAF(2),VFR(6),o[1],0,0,0), C1,4,P1); \
    GAPB(o[0]=__builtin_amdgcn_mfma_f32_32x32x16_bf16(PAF(3),VFR(3),o[0],0,0,0), C1,8,P1); \
    GAPB(o[1]=__builtin_amdgcn_mfma_f32_32x32x16_bf16(PAF(3),VFR(7),o[1],0,0,0), C1,12,P1); \
    }while(0)
  CINIT(pB0,pB1,1);
  int t=1;
  #undef CMASK
  #define CMASK(P0,P1,t) do{}while(0)
  for(;t+5<NT;t+=2){
    STEP(pB0,pB1,pA0,pA1,t,true,true,true);     WAIT_BAR(2); RESC(); ROT();
    STEP(pA0,pA1,pB0,pB1,t+1,true,true,true);   WAIT_BAR(2); RESC(); ROT();
  }
  #undef CMASK
  #define CMASK(P0,P1,t) do{int jb_=(t)-(NT-4); if(jb_>=0)cmask(P0,P1,jb_,qrel,hi);}while(0)
  #define ENDW(tt) do{ if((tt)+3<NT){WAIT_BAR(2);} else if((tt)+2<NT){WAIT_BAR(1);} else {WAIT_BAR(0);} }while(0)
  for(;t+1<NT;t+=2){
    STEP(pB0,pB1,pA0,pA1,t,(t+3<NT),(t+1<NT),(t+1<NT));       ENDW(t);   RESC(); ROT();
    STEP(pA0,pA1,pB0,pB1,t+1,(t+4<NT),(t+2<NT),(t+2<NT));     ENDW(t+1); RESC(); ROT();
  }
  STEP(pB0,pB1,pA0,pA1,NT-1,false,false,false); RESC();
  { float sacc=pB0[0]+pB0[1]; _Pragma("unroll") for(int r=2;r<16;++r)sacc+=pB0[r]; _Pragma("unroll") for(int r=0;r<16;++r)sacc+=pB1[r]; l_reg+=sacc;
    pw0=(u32x4){PKW(pB0,0),PKW(pB0,2),PKW(pB0,4),PKW(pB0,6)};pw1=(u32x4){PKW(pB0,8),PKW(pB0,10),PKW(pB0,12),PKW(pB0,14)};pw2=(u32x4){PKW(pB1,0),PKW(pB1,2),PKW(pB1,4),PKW(pB1,6)};pw3=(u32x4){PKW(pB1,8),PKW(pB1,10),PKW(pB1,12),PKW(pB1,14)};
    SBAR(); pv(o,vb0+sl_cur,PAF(0),PAF(1),PAF(2),PAF(3)); }
  #undef PKW
  #undef PAF
  #undef VFR
  #undef PIN
  #undef MX3
  #undef GAPA
  #undef GAPB
  #undef LOADB
  #undef EX
  #undef VRD
  #undef KRD
  #undef STEP
  #undef ENDW
  {auto rr=__builtin_amdgcn_permlane32_swap(__float_as_uint(l_reg),__float_as_uint(l_reg),false,false);l_reg=__uint_as_float(rr[0])+__uint_as_float(rr[1]);}
  if(hi==0)wsf[32+r32]=l_reg;asm volatile("s_waitcnt lgkmcnt(0)":::"memory");
  float rli[16];
  #pragma unroll
  for(int r=0;r<16;++r)rli[r]=__builtin_amdgcn_rcpf(wsf[32+crow(r,hi)]);
  bf16*Ow=Oc+(rowbase+q0+wid*QBLK)*PO;
  { bf16*stg=(bf16*)(shm+LDS_OST)+wid*2048;
    #pragma unroll
    for(int r=0;r<16;++r){const int orow=crow(r,hi);
      #pragma unroll
      for(int d0=0;d0<2;++d0)stg[orow*64+d0*32+r32]=__float2bfloat16(o[d0][r]*rli[r]);}
    asm volatile("s_waitcnt lgkmcnt(0)":::"memory");
    #pragma unroll
    for(int i=0;i<4;++i){const int row=i*8+(lane>>3),ch=lane&7; const u32x4 v=*(const u32x4*)(stg+row*64+ch*8); ATTN_STORE16(Ow+(long)row*PO+ch*8,v);} }
  asm volatile("s_waitcnt lgkmcnt(0)\n\ts_barrier":::"memory");
  #undef CINIT
  #undef DMA_K
  #undef DMA_V
  #undef CMASK
  #undef START
  #undef RESC
  #undef ROT
}
constexpr int LDS_WS128=LDS_V+NSLOT*2*SLOTB, LDS_OST128=LDS_WS128+NW*64*4, LDS_BYTES128=LDS_OST128+NW*4096;
template<int THRL,bool NODEC> __device__ __forceinline__ void attn_unit128(int b,int qb,const bf16*Qc,const bf16*__restrict__ Kc,const bf16*__restrict__ Vc,bf16*Oc,char*shm,const int wv){ constexpr bool HASB=false; constexpr int t0=0; const float* kbg=nullptr;
  int tid_=wv*64+mk_lane();
  const int tid=tid_,lane=tid&63,r32=lane&31,hi=lane>>5; const int wid=__builtin_amdgcn_readfirstlane(tid>>6);
  const long rowbase=(long)b*SEQ; const int q0=qb*QB;
  const bf16*Qw=Qc+(rowbase+q0+wid*QBLK)*PQ;
  const bf16*Kh=Kc+(rowbase+(long)t0*KVBLK)*PQ,*Vh=Vc+(rowbase+(long)t0*KVBLK)*PQ;
  const unsigned lds0=(unsigned)(uintptr_t)shm;
  float*wsf=(float*)(shm+LDS_WS128)+wid*64;
  const bf16*ksrc=Kh+(long)lane*PQ+wid*8;
  const bf16*vsrc=Vh+(long)(16*(wid&3)+(lane>>2))*PQ+(wid>>2)*32+(lane&3)*8;
  const unsigned kdst=lds0+LDS_K+wid*1024, vdst=lds0+LDS_V+(wid>>2)*4096+(wid&3)*1024;
  #define DMA_K(t,slot) glds16(ksrc+(long)(t)*KVBLK*PQ,(unsigned)__builtin_amdgcn_readfirstlane(kdst+(slot)))
  #define DMA_V(t,slot) do{ glds16(vsrc+(long)(t)*KVBLK*PQ,(unsigned)__builtin_amdgcn_readfirstlane(vdst+2*(slot))); glds16(vsrc+64+(long)(t)*KVBLK*PQ,(unsigned)__builtin_amdgcn_readfirstlane(vdst+8192+2*(slot))); }while(0)
  const int vb0=(int)(lds0+LDS_V)+((lane>>4)&1)*32+(lane&3)*8+(4*hi+((lane&15)>>2))*64;
  const char*Kbase=shm+LDS_K; bf16x8 kf[8];
  const lds_cptr shm3=(lds_cptr)shm; const lds_cptr kp0=shm3+LDS_K+hi*1024+r32*16; const lds_cptr vp0=shm3+LDS_V+((lane>>4)&1)*32+(lane&3)*8+(4*hi+((lane&15)>>2))*64;
  const int NT=(q0+QB)/KVBLK-t0;
  typedef __attribute__((address_space(3))) const f32x4 lds_cf4; typedef __attribute__((address_space(3))) f32x4 lds_f4;
  const __attribute__((address_space(3))) char* kbl=(const __attribute__((address_space(3))) char*)shm+LDS_KBIAS+hi*16;
  if(HASB){ const int n4=(q0+QB-t0*KVBLK)/4; for(int i=tid;i<n4;i+=NW*64){ const f32x4 v=*(const f32x4*)(kbg+t0*KVBLK+4*i); *((lds_f4*)((__attribute__((address_space(3))) char*)shm+LDS_KBIAS)+i)=v; } }
  DMA_K(0,0);DMA_V(0,0);DMA_K(1,SLOTB);
  bf16x8 qr[4];
  #pragma unroll
  for(int d0=0;d0<4;++d0)qr[d0]=*reinterpret_cast<const bf16x8*>(&Qw[(long)r32*PQ+d0*16+hi*8]);
  float mhat=0.f,l_reg=0.f;f32x16 o[4];o[0]=f32x16{};o[1]=f32x16{};o[2]=f32x16{};o[3]=f32x16{};
  const int qrel=wid*QBLK+r32;
  float mref=0.f;
  #define CINIT(C0,C1,t) do{ if(HASB){ const __attribute__((address_space(3))) char* kp_=kbl+(t)*256; \
      _Pragma("unroll") for(int g_=0;g_<4;++g_){ const f32x4 a_=*(lds_cf4*)(kp_+g_*32), b_=*(lds_cf4*)(kp_+128+g_*32); \
        _Pragma("unroll") for(int e_=0;e_<4;++e_){ C0[4*g_+e_]=a_[e_]-mhat; C1[4*g_+e_]=b_[e_]-mhat; } } } \
    }while(0)
  #define CMASK(P0,P1,t) do{int jb_=(t)-(NT-4); if(jb_>=0)cmask(P0,P1,jb_,qrel,hi);}while(0)
  bool resc=false;
  #define START(P0,P1) do{ resc=false; \
    if(!NODEC){ const float rm=rowmax(P0,P1); const float dl=__any(rm>(float)THRL)?__builtin_fmaxf(rm,0.f):0.f; mhat=fadd_s(mhat,dl); \
      _Pragma("unroll") for(int r=0;r<16;++r){P0[r]=fsub_s(P0[r],dl);P1[r]=fsub_s(P1[r],dl);} \
      } \
    _Pragma("unroll") for(int r=0;r<16;++r)P0[r]=__builtin_amdgcn_exp2f(P0[r]); }while(0)
  #define RESC() do{ if(resc){ asm volatile("s_waitcnt lgkmcnt(0)":::"memory"); \
      _Pragma("unroll") for(int d_=0;d_<4;++d_) _Pragma("unroll") for(int r=0;r<16;++r)o[d_][r]*=wsf[crow(r,hi)]; } }while(0)
  f32x16 pA0,pA1,pB0,pB1;
  int sl_prev=0,sl_cur=0,sl_next=SLOTB;
  #define ROT() do{sl_prev=sl_cur;sl_cur=sl_next;sl_next=(sl_next==(NSLOT-1)*SLOTB)?0:sl_next+SLOTB;}while(0)
  DMA_K(2,2*SLOTB);
  WAIT_BAR(4);
  { f32x16 ci0=f32x16{}; asm volatile("":"+v"(ci0)); qkt(pA0,pA1,Kbase,qr,ci0,ci0,r32,hi); } asm volatile("s_nop 15\n\ts_nop 7":"+v"(pA0),"+v"(pA1));CMASK(pA0,pA1,0);
  START(pA0,pA1);
  _Pragma("unroll") for(int r=0;r<16;++r)pA1[r]=__builtin_amdgcn_exp2f(pA1[r]);
  WAIT_BAR(0);
  DMA_K(3,0);DMA_V(1,SLOTB);
  ROT();
  kload8(kf,kp0+sl_cur);
  WAIT_BAR(3);
  s16x4 vlo[4],vhi[4]; u32x4 pw0,pw1,pw2,pw3;
  #define PKW(P,B) cvtpk_s(P[B],P[B+1])
  #define PAF(k) __builtin_bit_cast(bf16x8,pw##k)
  #define VFR(i) (bf16x8){vlo[(i)&3][0],vlo[(i)&3][1],vlo[(i)&3][2],vlo[(i)&3][3],vhi[(i)&3][0],vhi[(i)&3][1],vhi[(i)&3][2],vhi[(i)&3][3]}
  #define PIN(x) asm volatile("":"+v"(x))
  #define MX3(a,b,c) __builtin_fmaxf(__builtin_fmaxf((a),(b)),(c))
  #define GAPA(MF,A0,A1,A2,A3,W0,W1,PW) do{ MF; sacc+=A0; sacc+=A1; sacc+=A2; sacc+=A3; PIN(sacc); W0; W1; PIN(PW); SBAR(); }while(0)
  #define EX(v) __builtin_amdgcn_exp2f(v)
  #define GAPB(MF,X,B,Y) do{ MF; X[B]=EX(X[B]); X[B+1]=EX(X[B+1]); X[B+2]=EX(X[B+2]); X[B+3]=EX(X[B+3]); PIN(X); if(HASB){ Y[B]-=mhat; Y[B+1]-=mhat; Y[B+2]-=mhat; Y[B+3]-=mhat; PIN(Y); } SBAR(); }while(0)
  #define LOADB(Y0,Y1,t) do{ if(HASB){ const __attribute__((address_space(3))) char* kp_=kbl+(t)*256; \
      _Pragma("unroll") for(int g_=0;g_<4;++g_){ const f32x4 a_=*(lds_cf4*)(kp_+g_*32), b_=*(lds_cf4*)(kp_+128+g_*32); \
        _Pragma("unroll") for(int e_=0;e_<4;++e_){ Y0[4*g_+e_]=a_[e_]; Y1[4*g_+e_]=b_[e_]; } } } }while(0)
  #define VOFF(j) ((((j)>>3)*8192)+((((j)&7)&1)*4096)+((((j)&7)>>1)*1024))
  #define VRDJ(j) do{ vlo[(j)&3]=vtr(vp_+VOFF(j)); vhi[(j)&3]=vtr(vp_+VOFF(j)+512); SBAR(); }while(0)
  #define GAPC(MF,Y,B) do{ MF; SBAR(); }while(0)
  #define KRD(G,j) do{ if(G){ kload2(kf,kp0+sl_next,j); SBAR(); } }while(0)
  #define STEP(C0,C1,P0,P1,t,GK,GV,GL) do{ SBAR(); \
    const lds_cptr vp_=vp0+2*sl_prev; \
    VRDJ(0); float sacc=(P0[0]+P0[1]); \
    GAPA(C0=__builtin_amdgcn_mfma_f32_32x32x16_bf16(kf[0],qr[0],zero16,0,0,0), P0[2],P0[3],P0[4],P0[5],     pw0[0]=PKW(P0,0), pw0[1]=PKW(P0,2), pw0); \
    VRDJ(1); GAPA(C1=__builtin_amdgcn_mfma_f32_32x32x16_bf16(kf[1],qr[0],zero16,0,0,0), P0[6],P0[7],P0[8],P0[9],     pw0[2]=PKW(P0,4), pw0[3]=PKW(P0,6), pw0); \
    VRDJ(2); GAPA(C0=__builtin_amdgcn_mfma_f32_32x32x16_bf16(kf[2],qr[1],C0,0,0,0),   P0[10],P0[11],P0[12],P0[13], pw1[0]=PKW(P0,8), pw1[1]=PKW(P0,10), pw1); \
    VRDJ(3); GAPA(C1=__builtin_amdgcn_mfma_f32_32x32x16_bf16(kf[3],qr[1],C1,0,0,0),   P0[14],P0[15],P1[0],P1[1],   pw1[2]=PKW(P0,12),pw1[3]=PKW(P0,14), pw1); \
    GAPA(C0=__builtin_amdgcn_mfma_f32_32x32x16_bf16(kf[4],qr[2],C0,0,0,0),   P1[2],P1[3],P1[4],P1[5],     pw2[0]=PKW(P1,0), pw2[1]=PKW(P1,2), pw2); \
    GAPA(C1=__builtin_amdgcn_mfma_f32_32x32x16_bf16(kf[5],qr[2],C1,0,0,0),   P1[6],P1[7],P1[8],P1[9],     pw2[2]=PKW(P1,4), pw2[3]=PKW(P1,6), pw2); \
    GAPA(C0=__builtin_amdgcn_mfma_f32_32x32x16_bf16(kf[6],qr[3],C0,0,0,0),   P1[10],P1[11],P1[12],P1[13], pw3[0]=PKW(P1,8), pw3[1]=PKW(P1,10), pw3); \
    GAPA(C1=__builtin_amdgcn_mfma_f32_32x32x16_bf16(kf[7],qr[3],C1,0,0,0),   P1[14],P1[15],0.f,0.f,       pw3[2]=PKW(P1,12),pw3[3]=PKW(P1,14), pw3); \
    l_reg+=sacc; \
    if(!NODEC){ if(__builtin_expect(__any(mhat!=0.f),0)){ _Pragma("unroll") for(int r=0;r<16;++r){C0[r]-=mhat;C1[r]-=mhat;} } } \
    if(GK){DMA_K((t)+3,sl_cur);} if(GV){DMA_V((t)+1,sl_next);} \
    CMASK(C0,C1,t); \
    resc=false; if(!NODEC){ float a=MX3(C0[0],C0[1],C1[0]),b=MX3(C0[2],C0[3],C1[1]); a=MX3(a,C1[2],C1[3]); \
      _Pragma("unroll") for(int r=4;r<16;r+=4){a=MX3(a,C0[r],C0[r+1]);b=MX3(b,C0[r+2],C0[r+3]);a=MX3(a,C1[r],C1[r+1]);b=MX3(b,C1[r+2],C1[r+3]);} \
      float rm=__builtin_fmaxf(a,b); { auto rr=__builtin_amdgcn_permlane32_swap(__float_as_uint(rm),__float_as_uint(rm),false,false); rm=__builtin_fmaxf(__uint_as_float(rr[0]),__uint_as_float(rr[1])); } \
      resc=false; \
      if(__builtin_expect(__any(rm>(float)THRL),0)){ const float dl=__builtin_fmaxf(rm,0.f); mhat+=dl; \
        _Pragma("unroll") for(int r=0;r<16;++r){C0[r]-=dl;C1[r]-=dl;} \
        const float f=__builtin_amdgcn_exp2f(-dl); l_reg*=f; if(hi==0)wsf[r32]=f; resc=true; } } \
    SBAR(); \
    GAPB(o[0]=__builtin_amdgcn_mfma_f32_32x32x16_bf16(PAF(0),VFR(0),o[0],0,0,0), C0,0,P0); VRDJ(4); \
    GAPB(o[1]=__builtin_amdgcn_mfma_f32_32x32x16_bf16(PAF(0),VFR(1),o[1],0,0,0), C0,4,P0); VRDJ(5); \
    GAPB(o[0]=__builtin_amdgcn_mfma_f32_32x32x16_bf16(PAF(1),VFR(2),o[0],0,0,0), C0,8,P0); VRDJ(6); \
    GAPB(o[1]=__builtin_amdgcn_mfma_f32_32x32x16_bf16(PAF(1),VFR(3),o[1],0,0,0), C0,12,P0); VRDJ(7); \
    GAPB(o[0]=__builtin_amdgcn_mfma_f32_32x32x16_bf16(PAF(2),VFR(4),o[0],0,0,0), C1,0,P1); VRDJ(8); \
    GAPB(o[1]=__builtin_amdgcn_mfma_f32_32x32x16_bf16(PAF(2),VFR(5),o[1],0,0,0), C1,4,P1); VRDJ(9); \
    GAPB(o[0]=__builtin_amdgcn_mfma_f32_32x32x16_bf16(PAF(3),VFR(6),o[0],0,0,0), C1,8,P1); VRDJ(10); \
    GAPB(o[1]=__builtin_amdgcn_mfma_f32_32x32x16_bf16(PAF(3),VFR(7),o[1],0,0,0), C1,12,P1); VRDJ(11); \
    GAPC(o[2]=__builtin_amdgcn_mfma_f32_32x32x16_bf16(PAF(0),VFR(8),o[2],0,0,0), P0,0); VRDJ(12); \
    GAPC(o[3]=__builtin_amdgcn_mfma_f32_32x32x16_bf16(PAF(0),VFR(9),o[3],0,0,0), P0,4); VRDJ(13); \
    KRD(GL,0); GAPC(o[2]=__builtin_amdgcn_mfma_f32_32x32x16_bf16(PAF(1),VFR(10),o[2],0,0,0), P0,8); VRDJ(14); \
    KRD(GL,1); GAPC(o[3]=__builtin_amdgcn_mfma_f32_32x32x16_bf16(PAF(1),VFR(11),o[3],0,0,0), P0,12); VRDJ(15); \
    KRD(GL,2); GAPC(o[2]=__builtin_amdgcn_mfma_f32_32x32x16_bf16(PAF(2),VFR(12),o[2],0,0,0), P1,0); \
    KRD(GL,3); GAPC(o[3]=__builtin_amdgcn_mfma_f32_32x32x16_bf16(PAF(2),VFR(13),o[3],0,0,0), P1,4); \
    GAPC(o[2]=__builtin_amdgcn_mfma_f32_32x32x16_bf16(PAF(3),VFR(14),o[2],0,0,0), P1,8); \
    GAPC(o[3]=__builtin_amdgcn_mfma_f32_32x32x16_bf16(PAF(3),VFR(15),o[3],0,0,0), P1,12); \
    }while(0)
  const f32x16 zero16=f32x16{};
  int t=1;
  #undef CMASK
  #define CMASK(P0,P1,t) do{}while(0)
  for(;t+5<NT;t+=2){
    STEP(pB0,pB1,pA0,pA1,t,true,true,true);     WAIT_BAR(3); RESC(); ROT();
    STEP(pA0,pA1,pB0,pB1,t+1,true,true,true);   WAIT_BAR(3); RESC(); ROT();
  }
  #undef CMASK
  #define CMASK(P0,P1,t) do{int jb_=(t)-(NT-4); if(jb_>=0)cmask(P0,P1,jb_,qrel,hi);}while(0)
  #define ENDW(tt) do{ if((tt)+3<NT){WAIT_BAR(3);} else if((tt)+2<NT){WAIT_BAR(2);} else {WAIT_BAR(0);} }while(0)
  for(;t+1<NT;t+=2){
    STEP(pB0,pB1,pA0,pA1,t,(t+3<NT),(t+1<NT),(t+1<NT));       ENDW(t);   RESC(); ROT();
    STEP(pA0,pA1,pB0,pB1,t+1,(t+4<NT),(t+2<NT),(t+2<NT));     ENDW(t+1); RESC(); ROT();
  }
  STEP(pB0,pB1,pA0,pA1,NT-1,false,false,false); RESC();
  { float sacc=pB0[0]+pB0[1]; _Pragma("unroll") for(int r=2;r<16;++r)sacc+=pB0[r]; _Pragma("unroll") for(int r=0;r<16;++r)sacc+=pB1[r]; l_reg+=sacc;
    pw0=(u32x4){PKW(pB0,0),PKW(pB0,2),PKW(pB0,4),PKW(pB0,6)};pw1=(u32x4){PKW(pB0,8),PKW(pB0,10),PKW(pB0,12),PKW(pB0,14)};pw2=(u32x4){PKW(pB1,0),PKW(pB1,2),PKW(pB1,4),PKW(pB1,6)};pw3=(u32x4){PKW(pB1,8),PKW(pB1,10),PKW(pB1,12),PKW(pB1,14)};
    SBAR(); pv(o,vb0+2*sl_cur,PAF(0),PAF(1),PAF(2),PAF(3)); pv(o+2,vb0+2*sl_cur+8192,PAF(0),PAF(1),PAF(2),PAF(3)); }
  #undef PKW
  #undef PAF
  #undef VFR
  #undef PIN
  #undef MX3
  #undef GAPA
  #undef GAPB
  #undef LOADB
  #undef EX
  #undef VRDJ
  #undef VOFF
  #undef GAPC
  #undef KRD
  #undef STEP
  #undef ENDW
  {auto rr=__builtin_amdgcn_permlane32_swap(__float_as_uint(l_reg),__float_as_uint(l_reg),false,false);l_reg=__uint_as_float(rr[0])+__uint_as_float(rr[1]);}
  if(hi==0)wsf[32+r32]=l_reg;asm volatile("s_waitcnt lgkmcnt(0)":::"memory");
  float rli[16];
  #pragma unroll
  for(int r=0;r<16;++r)rli[r]=__builtin_amdgcn_rcpf(wsf[32+crow(r,hi)]);
  bf16*Ow=Oc+(rowbase+q0+wid*QBLK)*PO;
  { bf16*stg=(bf16*)(shm+LDS_OST128)+wid*2048;
    #pragma unroll
    for(int hf=0;hf<2;++hf){
      #pragma unroll
      for(int r=0;r<16;++r){const int orow=crow(r,hi);
        #pragma unroll
        for(int d0=0;d0<2;++d0)stg[orow*64+d0*32+r32]=__float2bfloat16(o[2*hf+d0][r]*rli[r]);}
      asm volatile("s_waitcnt lgkmcnt(0)":::"memory");
      #pragma unroll
      for(int i=0;i<4;++i){const int row=i*8+(lane>>3),ch=lane&7; const u32x4 v=*(const u32x4*)(stg+row*64+ch*8); ATTN_STORE16(Ow+(long)row*PO+hf*64+ch*8,v);}
      asm volatile("s_waitcnt lgkmcnt(0)":::"memory"); } }
  asm volatile("s_waitcnt lgkmcnt(0)\n\ts_barrier":::"memory");
  #undef CINIT
  #undef DMA_K
  #undef DMA_V
  #undef CMASK
  #undef START
  #undef RESC
  #undef ROT
}
constexpr int ATTN_LDS_BYTES=(LDS_BYTES>LDS_BYTES128)?LDS_BYTES:LDS_BYTES128;
#undef SBAR
#undef WAIT_BAR
}

namespace xattn {
using pg8::bf16_t; using pg8::bf16x8; using pg8::u32x4; using pg8::f32x4;
using f32x16 = __attribute__((ext_vector_type(16))) float;
#define XLAS __attribute__((address_space(3)))
constexpr int XB0 = 0, XB1 = 32768, X_WSF = 65536, X_OST = X_WSF + 2048, X_LDS_BYTES = X_OST + 8 * 4096;
__device__ __forceinline__ int crow(int r, int hi) { return (r & 3) + 8 * (r >> 2) + 4 * hi; }
__device__ __forceinline__ unsigned pk(float lo, float hi) { return pg8::cvt_pk_bf16(lo, hi); }
__device__ __forceinline__ void unit(int b, int h, int qblk, const bf16_t* __restrict__ CQ, const bf16_t* __restrict__ CK, const bf16_t* __restrict__ CVT, bf16_t* __restrict__ CO, XLAS unsigned char* lds, const int wv) {
    const int tid = wv * 64 + mk_lane(), lane = tid & 63, r32 = lane & 31, hi = lane >> 5; const int wid = __builtin_amdgcn_readfirstlane(tid >> 6);
    const size_t qrow0 = (size_t)b * 4096 + (size_t)qblk * 256 + wid * 32;
    const bf16_t* Qw = CQ + (qrow0 + r32) * 1024 + h * 256 + hi * 8;
    const bf16_t* Kg = CK + ((size_t)b * 256 + lane) * 1024 + h * 256 + wid * 8;
    const bf16_t* Vg = CVT + ((size_t)h * 256 + lane) * 2048 + (size_t)b * 256 + wid * 8;
    u32x4 st[4];
#define X_LOADK(dc) do { _Pragma("unroll") for (int i_ = 0; i_ < 4; ++i_) st[i_] = *(const u32x4*)(Kg + (dc) * 64 + (size_t)i_ * 64 * 1024); } while (0)
#define X_LOADV(c)  do { _Pragma("unroll") for (int i_ = 0; i_ < 4; ++i_) st[i_] = *(const u32x4*)(Vg + (size_t)(c) * 64 * 2048 + i_ * 64); } while (0)
#define X_STOREK(buf) do { _Pragma("unroll") for (int i_ = 0; i_ < 4; ++i_) *(XLAS u32x4*)(lds + (buf) + wid * 4096 + (64 * i_ + lane) * 16) = st[i_]; } while (0)
#define X_STOREV(buf) do { _Pragma("unroll") for (int i_ = 0; i_ < 4; ++i_) *(XLAS u32x4*)(lds + (buf) + (wid + 8 * i_) * 1024 + lane * 16) = st[i_]; } while (0)
    const int kswz = (r32 & ~12) | ((r32 & 4) << 1) | ((r32 & 8) >> 1);
    const int koff = hi * 4096 + kswz * 16;
    const int voff = hi * 1024 + r32 * 16;
    f32x16 s[8];
#pragma unroll
    for (int kt = 0; kt < 8; ++kt) s[kt] = f32x16{};
    X_LOADK(0);
    bf16x8 qfa[4][4];
#pragma unroll
    for (int dc = 0; dc < 4; ++dc)
#pragma unroll
        for (int ks = 0; ks < 4; ++ks) qfa[dc][ks] = *(const bf16x8*)(Qw + dc * 64 + ks * 16);
    X_STOREK(XB0);
    __syncthreads();
#pragma unroll
    for (int dc = 0; dc < 4; ++dc) {
        const int buf = (dc & 1) ? XB1 : XB0, nbuf = (dc & 1) ? XB0 : XB1;
        if (dc < 3) X_LOADK(dc + 1); else X_LOADV(0);
#pragma unroll
        for (int kt = 0; kt < 8; ++kt)
#pragma unroll
            for (int ks = 0; ks < 4; ++ks) {
                const bf16x8 kf = *(const XLAS bf16x8*)(lds + buf + koff + kt * 512 + ks * 8192);
                s[kt] = __builtin_amdgcn_mfma_f32_32x32x16_bf16(kf, qfa[dc][ks], s[kt], 0, 0, 0);
            }
        if (dc < 3) X_STOREK(nbuf); else X_STOREV(nbuf);
        __syncthreads();
    }
    float mx = s[0][0];
#pragma unroll
    for (int kt = 0; kt < 8; ++kt)
#pragma unroll
        for (int r = 0; r < 16; ++r) mx = fmaxf(mx, s[kt][r]);
    mx = fmaxf(mx, __shfl_xor(mx, 32));
    float l = 0.f;
#pragma unroll
    for (int kt = 0; kt < 8; ++kt)
#pragma unroll
        for (int r = 0; r < 16; ++r) { const float p = __builtin_amdgcn_exp2f(s[kt][r] - mx); s[kt][r] = p; l += p; }
    l += __shfl_xor(l, 32);
    u32x4 pw[16];
#pragma unroll
    for (int kt = 0; kt < 8; ++kt)
#pragma unroll
        for (int j2 = 0; j2 < 2; ++j2)
            pw[2 * kt + j2] = (u32x4){pk(s[kt][8 * j2 + 0], s[kt][8 * j2 + 1]), pk(s[kt][8 * j2 + 2], s[kt][8 * j2 + 3]), pk(s[kt][8 * j2 + 4], s[kt][8 * j2 + 5]), pk(s[kt][8 * j2 + 6], s[kt][8 * j2 + 7])};
    XLAS float* wsf = (XLAS float*)(lds + X_WSF) + wid * 64;
    if (hi == 0) wsf[r32] = l;
    asm volatile("s_waitcnt lgkmcnt(0)" ::: "memory");
    float rli[16];
#pragma unroll
    for (int r = 0; r < 16; ++r) rli[r] = __builtin_amdgcn_rcpf(wsf[crow(r, hi)]);
    XLAS bf16_t* stg = (XLAS bf16_t*)(lds + X_OST) + wid * 2048;
    bf16_t* Ow = CO + qrow0 * 1024 + h * 256;
#pragma unroll
    for (int c = 0; c < 4; ++c) {
        const int buf = (c & 1) ? XB1 : XB0, nbuf = (c & 1) ? XB0 : XB1;
        if (c < 3) X_LOADV(c + 1);
        f32x16 o[2]; o[0] = f32x16{}; o[1] = f32x16{};
#pragma unroll
        for (int j = 0; j < 16; ++j)
#pragma unroll
            for (int dt = 0; dt < 2; ++dt) {
                const bf16x8 vf = *(const XLAS bf16x8*)(lds + buf + voff + dt * 512 + j * 2048);
                o[dt] = __builtin_amdgcn_mfma_f32_32x32x16_bf16(__builtin_bit_cast(bf16x8, pw[j]), vf, o[dt], 0, 0, 0);
            }
#pragma unroll
        for (int r = 0; r < 16; ++r) { const int orow = crow(r, hi);
#pragma unroll
            for (int dt = 0; dt < 2; ++dt) { const unsigned w = pk(o[dt][r] * rli[r], 0.f); stg[orow * 64 + dt * 32 + r32] = (bf16_t)(w & 0xffffu); } }
        asm volatile("s_waitcnt lgkmcnt(0)" ::: "memory");
#pragma unroll
        for (int i = 0; i < 4; ++i) { const int row = i * 8 + (lane >> 3), ch = lane & 7; const u32x4 v = *(const XLAS u32x4*)(stg + row * 64 + ch * 8); *(u32x4*)(Ow + (size_t)row * 1024 + c * 64 + ch * 8) = v; }
        asm volatile("s_waitcnt lgkmcnt(0)" ::: "memory");
        if (c < 3) X_STOREV(nbuf);
        __syncthreads();
    }
#undef X_LOADK
#undef X_LOADV
#undef X_STOREK
#undef X_STOREV
}
}

#ifndef MK_PER_PHASE
#define MK_PER_PHASE 0
#endif
constexpr int NWAVES = 8;
constexpr int BATCH = 8, SEQ = 4096, D = 1024, M = BATCH * SEQ, FF = 4096, NMEM = 256, MM = BATCH * NMEM, INW = 3080, NPROJ = 3072, NATT = 1536;
constexpr float EPS = 1e-6f, SUBLN_EPS = 1e-5f;
constexpr int N_PHASES = 11;

constexpr size_t MiB = 1u << 20;
constexpr size_t WS_ROPE = 0;
constexpr size_t WS_LOGF = 1 * MiB;
constexpr size_t WS_KB   = 2 * MiB;
constexpr size_t WS_NRM  = 3 * MiB;
constexpr size_t WS_BAR  = 3 * MiB + 65536;
constexpr size_t WS_SS1  = 4 * MiB, WS_SS2 = 6 * MiB, WS_SS3 = 8 * MiB;
constexpr size_t WS_WIN = 10 * MiB, WS_WOUT = 16 * MiB, WS_WCQ = 18 * MiB, WS_WCKV = 20 * MiB, WS_WCO = 24 * MiB, WS_WUP = 26 * MiB, WS_WDN = 34 * MiB;
constexpr size_t WS_MEMN = 42 * MiB, WS_CK = 46 * MiB, WS_CVT = 50 * MiB;
constexpr size_t WS_SA = 56 * MiB;
constexpr size_t WS_SB = 120 * MiB;
constexpr size_t WS_PROJ = 184 * MiB;
constexpr size_t WS_ATT = 376 * MiB;
constexpr size_t WS_ZH = 184 * MiB;
constexpr size_t WS_END = 472 * MiB;
static_assert(WS_ZH + (size_t)M * FF * 2 <= WS_END && WS_ATT + (size_t)M * NATT * 2 <= WS_END && WS_PROJ + (size_t)M * NPROJ * 2 <= WS_ATT, "d_ws map");

constexpr int RING_BYTES = 131072, LDS_BYTES = 147456;
static_assert(attn_body::ATTN_LDS_BYTES <= RING_BYTES && xattn::X_LDS_BYTES <= RING_BYTES && pg8::STAGE_BYTES <= RING_BYTES, "LDS map");

#define LAS __attribute__((address_space(3)))
typedef unsigned short bf16;
typedef unsigned v4u __attribute__((ext_vector_type(4)));
typedef float f32x4 __attribute__((ext_vector_type(4)));
#define LDS_WAIT() asm volatile("s_waitcnt lgkmcnt(0)" ::: "memory")
__device__ __forceinline__ unsigned f2bf(float f) { unsigned u = __builtin_bit_cast(unsigned, f); return (u + 0x7fffu + ((u >> 16) & 1u)) >> 16; }
__device__ __forceinline__ unsigned pk2(float lo, float hi) { return f2bf(lo) | (f2bf(hi) << 16); }
__device__ __forceinline__ float bflo(unsigned w) { return __builtin_bit_cast(float, w << 16); }
__device__ __forceinline__ float bfhi(unsigned w) { return __builtin_bit_cast(float, w & 0xffff0000u); }
__device__ __forceinline__ float wave_sum(float v) {
#pragma unroll
    for (int o = 1; o < 64; o <<= 1) v += __shfl_xor(v, o);
    return v;
}

#define XB_TMO      128
#define XB_XCNT(j)  (256  + 64 * (j))
#define XB_XSUB(j)  (1280 + 64 * (j))
#define XB_XGEN(j)  (2304 + 64 * (j))
#define XB_TOP      3328
#define XB_TOPGEN   3392
#define XCD_BAR_WORDS 3456
#define XB_SPIN_CAP (1u << 18)

__device__ __forceinline__ unsigned xb_ld(unsigned* p)              { return __hip_atomic_load(p, __ATOMIC_RELAXED, __HIP_MEMORY_SCOPE_AGENT); }
__device__ __forceinline__ unsigned xb_add(unsigned* p, unsigned v) { return __hip_atomic_fetch_add(p, v, __ATOMIC_RELAXED, __HIP_MEMORY_SCOPE_AGENT); }
__device__ __forceinline__ unsigned xb_xcc_id() { return (unsigned)__builtin_amdgcn_s_getreg((3 << 11) | 20) & 0xFu; }
#define XB_SPIN(cond, bar) do { unsigned _sp = 0; while (cond) { __builtin_amdgcn_s_sleep(1); \
    if ((++_sp & 255u) == 0u) { if (xb_ld(&(bar)[XB_TMO])) break; if (_sp > XB_SPIN_CAP) { atomicAdd(&(bar)[XB_TMO], 1u); break; } } } } while (0)

struct XcdBarrier {
    unsigned* bar; unsigned x;
    volatile LAS unsigned* st;
};

__device__ __forceinline__ XcdBarrier xcd_barrier_post(unsigned* bar, volatile LAS unsigned* st, bool leader) {
    XcdBarrier b; b.bar = bar; b.x = xb_xcc_id(); b.st = st;
    if (leader) (void)xb_add(&bar[XB_XCNT(b.x)], 1u);
    return b;
}
__device__ __forceinline__ void xcd_barrier_complete(unsigned* bar, unsigned x, unsigned& nloc, unsigned& nx) {
    const unsigned G = gridDim.x * gridDim.y * gridDim.z;
    unsigned sum, cnt, mine, sp = 0u;
    for (;;) {
        sum = 0u; cnt = 0u; mine = 0u;
#pragma unroll
        for (unsigned j = 0; j < 16; ++j) { const unsigned c = xb_ld(&bar[XB_XCNT(j)]); sum += c; cnt += (c > 0u) ? 1u : 0u; mine = (j == x) ? c : mine; }
        if (sum == G) break;
        __builtin_amdgcn_s_sleep(1);
        if ((++sp & 255u) == 0u) { if (xb_ld(&bar[XB_TMO])) break; if (sp > XB_SPIN_CAP) { atomicAdd(&bar[XB_TMO], 1u); break; } }
    }
    nloc = mine > 0u ? mine : 1u; nx = cnt > 0u ? cnt : 1u;
}

__device__ __forceinline__ void xcd_barrier(const XcdBarrier& b, bool leader) {
    asm volatile("s_waitcnt vmcnt(0)" ::: "memory");
    __syncthreads();
    if (leader) {
        unsigned* bar = b.bar;
        __builtin_amdgcn_s_waitcnt(0);
        unsigned nloc = b.st[0], nx = b.st[1];
        if (nloc == 0u) { xcd_barrier_complete(bar, b.x, nloc, nx); b.st[0] = nloc; b.st[1] = nx; }
        const unsigned old = xb_add(&bar[XB_XSUB(b.x)], 1u);
        const unsigned gen = old / nloc;
        if (old + 1u == (gen + 1u) * nloc) {
            __builtin_amdgcn_fence(__ATOMIC_RELEASE, "agent");
            asm volatile("s_waitcnt vmcnt(0)" ::: "memory");
            const unsigned og = xb_add(&bar[XB_TOP], 1u);
            const unsigned tg = og / nx;
            if (og + 1u == (tg + 1u) * nx) xb_add(&bar[XB_TOPGEN], 1u);
            else XB_SPIN(xb_ld(&bar[XB_TOPGEN]) == tg, bar);
            __builtin_amdgcn_fence(__ATOMIC_ACQUIRE, "agent");
            xb_add(&bar[XB_XGEN(b.x)], 1u);
            asm volatile("s_waitcnt vmcnt(0)" ::: "memory");
        } else {
            XB_SPIN(xb_ld(&bar[XB_XGEN(b.x)]) == gen, bar);
            __builtin_amdgcn_fence(__ATOMIC_ACQUIRE, "agent");
            asm volatile("s_waitcnt vmcnt(0)" ::: "memory");
        }
    }
    __syncthreads();
}

struct Params { const float* in[21]; float* out; unsigned char* ws; int ph_lo, ph_hi; };
enum { I_X = 0, I_MEM, I_GMIX, I_WIN, I_BF, I_LQ1, I_LK1, I_LQ2, I_LK2, I_GSUB, I_GFOX, I_WOUT, I_GCROSS, I_GMEM, I_WCQ, I_WCKV, I_WCO, I_GMLP, I_WUP, I_WDN, I_GFIN };

__device__ __forceinline__ void p0_transpose_item(const float* W, int K, int ldw, int nblk, bf16* WT, LAS float* scr, int item, int lane, const float* gk = nullptr  ) {
    const int kb = item / nblk, nb = item % nblk, k0 = 64 * kb, n0 = 32 * nb;
    { f32x4 v[8]; float gg[8];
#pragma unroll
        for (int it = 0; it < 8; ++it) { const int kk = 8 * it + (lane >> 3); v[it] = *(const f32x4*)(W + (size_t)(k0 + kk) * ldw + n0 + 4 * (lane & 7)); gg[it] = gk ? gk[k0 + kk] : 1.f; }
#pragma unroll
        for (int it = 0; it < 8; ++it) { const int kk = 8 * it + (lane >> 3); LAS float* d = scr + kk * 33 + 4 * (lane & 7); d[0] = v[it].x * gg[it]; d[1] = v[it].y * gg[it]; d[2] = v[it].z * gg[it]; d[3] = v[it].w * gg[it]; } }
    LDS_WAIT(); asm volatile("" ::: "memory");
    const int c = lane & 7;
#pragma unroll
    for (int j = 0; j < 4; ++j) { const int n = (lane >> 3) + 8 * j; const LAS float* s = scr + (8 * c) * 33 + n;
        v4u o; o.x = pk2(s[0 * 33], s[1 * 33]); o.y = pk2(s[2 * 33], s[3 * 33]); o.z = pk2(s[4 * 33], s[5 * 33]); o.w = pk2(s[6 * 33], s[7 * 33]);
        *(v4u*)(WT + (size_t)(n0 + n) * K + k0 + 8 * c) = o; }
    LDS_WAIT(); asm volatile("" ::: "memory");
}

__device__ __forceinline__ void rms_row(const float* xrow, const f32x4 (&gq)[4], bf16* orow, int lane, f32x4 (&v)[4]) {
    const f32x4* xr = (const f32x4*)xrow + lane; float s = 0.f;
#pragma unroll
    for (int j = 0; j < 4; ++j) { v[j] = xr[64 * j]; s += (v[j].x * v[j].x + v[j].y * v[j].y) + (v[j].z * v[j].z + v[j].w * v[j].w); }
    const float rstd = 1.0f / sqrtf(wave_sum(s) * (1.f / 1024.f) + EPS);
    unsigned long long* o8 = (unsigned long long*)orow + lane;
#pragma unroll
    for (int j = 0; j < 4; ++j) { v[j] = v[j] * rstd * gq[j]; o8[64 * j] = (unsigned long long)pk2(v[j].x, v[j].y) | ((unsigned long long)pk2(v[j].z, v[j].w) << 32); }
}

template <class Sched> __device__ __forceinline__ void build_rstd_tables(LAS unsigned char* lds, const Sched& S, const float* sspart, float eps, int wave) {
    const int lane = mk_lane(), tid = wave * 64 + lane;
    LAS int* pml = (LAS int*)(lds + RING_BYTES + 1536); LAS float* tab = (LAS float*)(lds + RING_BYTES + 2048);
    if (tid == 0) { int n = 0; pg8::Unit u; for (int i = 0; S.next(i, u); ++i) { bool f = false; for (int j = 0; j < n; ++j) f |= (pml[j] == u.pm); if (!f && n < 8) pml[n++] = u.pm; } pml[8] = n; }
    __syncthreads();
    const int n = pml[8];
    for (int idx = tid; idx < n * 256; idx += NWAVES * 64) tab[idx] = pg8::row_rstd(sspart, pml[idx >> 8] * 256 + (idx & 255), eps);
    __syncthreads();
}
__global__ void __launch_bounds__(NWAVES * 64, 2) mk_fwd(Params P) {
    extern __shared__ __attribute__((aligned(16))) unsigned char lds_raw[];
    LAS unsigned char* lds = (LAS unsigned char*)lds_raw;
    const int wave = __builtin_amdgcn_readfirstlane((int)threadIdx.x >> 6);
#define LANE_TID const int lane = mk_lane(), tid = wave * 64 + lane
    const int G = gridDim.x; const int bx = blockIdx.x; const int vcu = (G % 8 == 0) ? (bx % 8) * (G / 8) + bx / 8 : bx;
    const int gw = vcu * NWAVES + wave, NGW = G * NWAVES;
    unsigned char* const ws = P.ws;
#define ROPE ((float*)(P.ws + WS_ROPE))
#define LOGF ((float*)(P.ws + WS_LOGF))
#define KBIAS ((float*)(P.ws + WS_KB))
#define NRM ((float*)(P.ws + WS_NRM))
#define SS1 ((float*)(P.ws + WS_SS1))
#define SS2 ((float*)(P.ws + WS_SS2))
#define SS3 ((float*)(P.ws + WS_SS3))
#define Win_t ((bf16*)(P.ws + WS_WIN))
#define Wout_t ((bf16*)(P.ws + WS_WOUT))
#define Wcq_t ((bf16*)(P.ws + WS_WCQ))
#define Wckv_t ((bf16*)(P.ws + WS_WCKV))
#define Wco_t ((bf16*)(P.ws + WS_WCO))
#define Wup_t ((bf16*)(P.ws + WS_WUP))
#define Wdn_t ((bf16*)(P.ws + WS_WDN))
#define MEMN ((bf16*)(P.ws + WS_MEMN))
#define CKb ((bf16*)(P.ws + WS_CK))
#define CVT ((bf16*)(P.ws + WS_CVT))
#define XN ((bf16*)(P.ws + WS_SA))
#define MIXA ((bf16*)(P.ws + WS_SA))
#define CQ ((bf16*)(P.ws + WS_SA))
#define H2B ((bf16*)(P.ws + WS_SA))
#define H1B ((bf16*)(P.ws + WS_SB))
#define CO ((bf16*)(P.ws + WS_PROJ))
#define PROJ ((bf16*)(P.ws + WS_PROJ))
#define ATT ((bf16*)(P.ws + WS_ATT))
#define ZH ((bf16*)(P.ws + WS_ZH))
    const int lo = P.ph_lo, hi_ph = P.ph_hi;
    volatile LAS unsigned* xst = (volatile LAS unsigned*)(lds + RING_BYTES + 1024);
    { const int l0 = mk_lane(); if (wave == 0 && l0 < 2) xst[l0] = 0u; }
    __syncthreads();
    XcdBarrier bar; bar.bar = (unsigned*)(ws + WS_BAR); bar.x = 0; bar.st = xst;
    if (hi_ph - lo > 1) bar = xcd_barrier_post((unsigned*)(ws + WS_BAR), xst, wave == 0 && mk_lane() == 0);
    if (lo < 0) cg::this_grid().sync();
#define IN(k) (lo <= (k) && (k) < hi_ph)
#ifndef MK_MASK
#define MK_MASK 0x7ff
#endif
#ifndef MK_ATT_MASK
#define MK_ATT_MASK 3
#endif
#ifndef MK_REP_MASK
#define MK_REP_MASK 0
#endif
#define PH(k) (IN(k) && ((MK_MASK >> (k)) & 1))
#define REPS(k) for (int rep_ = 0; rep_ < (((MK_REP_MASK) >> (k)) & 1) + 1; ++rep_)
#define SEAM(k) do { if (IN(k) && IN((k) + 1)) { xcd_barrier(bar, wave == 0 && mk_lane() == 0); } } while (0)

    if (PH(0)) REPS(0) {
        LANE_TID;
        {
            const float* win = P.in[I_WIN];
            for (int k = tid; k < 1024; k += NWAVES * 64) { const f32x4 a = *(const f32x4*)(win + (size_t)k * INW + 3072), b = *(const f32x4*)(win + (size_t)k * INW + 3076);
                const int slot = (((k >> 8) * 4 + (k & 3)) * 64 + ((k & 255) >> 2)); *(LAS f32x4*)(lds + slot * 32) = a; *(LAS f32x4*)(lds + slot * 32 + 16) = b; }
        }
        if (bx == 0 && tid < BATCH * 64) NRM[tid] = 0.f;
        __syncthreads();
        LAS float* scr = (LAS float*)(lds + 32768 + wave * 8704);
        {
            constexpr int I_IN = 16 * 96, I_SQ = 16 * 32, I_CKV = 16 * 64, I_UP = 16 * 128, I_DN = 64 * 32;
            constexpr int NITEMS = I_IN + 3 * I_SQ + I_CKV + I_UP + I_DN;
            for (int it = gw; it < NITEMS; it += NGW) {
                int r = it;
                if (r < I_IN) { p0_transpose_item(P.in[I_WIN], D, INW, 96, Win_t, scr, r, lane); continue; } r -= I_IN;
                if (r < I_SQ) { p0_transpose_item(P.in[I_WOUT], D, D, 32, Wout_t, scr, r, lane); continue; } r -= I_SQ;
                if (r < I_SQ) { p0_transpose_item(P.in[I_WCQ], D, D, 32, Wcq_t, scr, r, lane, P.in[I_GCROSS]); continue; } r -= I_SQ;
                if (r < I_SQ) { p0_transpose_item(P.in[I_WCO], D, D, 32, Wco_t, scr, r, lane); continue; } r -= I_SQ;
                if (r < I_CKV) { p0_transpose_item(P.in[I_WCKV], D, 2 * D, 64, Wckv_t, scr, r, lane); continue; } r -= I_CKV;
                if (r < I_UP) { p0_transpose_item(P.in[I_WUP], D, FF, 128, Wup_t, scr, r, lane, P.in[I_GMLP]); continue; } r -= I_UP;
                p0_transpose_item(P.in[I_WDN], FF, D, 32, Wdn_t, scr, r, lane);
            }
        }
        {
            for (int idx = gw * 64 + lane; idx < SEQ * 8; idx += NGW * 64) {
                const int pos = idx >> 3, j = idx & 7;
                const float f = j == 0 ? 1.0f : j == 1 ? 0.1939227432012558f : j == 2 ? 0.03760603070259094f : j == 3 ? 0.007292664609849453f : j == 4 ? 0.0014142135623842478f : j == 5 ? 0.00027424818836152554f : j == 6 ? 5.318296098266728e-05f : 1.0313386155758053e-05f;
                const float ang = (float)pos * f;
                double rev = (double)ang * 0.15915494309189535; rev -= __builtin_rint(rev);
                const float x = (float)(rev * 6.283185307179586);
                ROPE[pos * 16 + j] = cosf(x); ROPE[pos * 16 + 8 + j] = sinf(x);
            }
        }
        {
            f32x4 gq[4];
#pragma unroll
            for (int j = 0; j < 4; ++j) gq[j] = ((const f32x4*)P.in[I_GMIX])[64 * j + lane];
            const float bfv = P.in[I_BF][lane & 7];
            const bool b0 = lane & 1, b1 = lane & 2, b2 = lane & 4;
            for (int m0 = gw * 4; m0 < M; m0 += NGW * 4) {
                f32x4 v[4][4]; float s[4];
#pragma unroll
                for (int r = 0; r < 4; ++r)
#pragma unroll
                    for (int jj = 0; jj < 4; ++jj) v[r][jj] = ((const f32x4*)(P.in[I_X] + (size_t)(m0 + r) * D))[64 * jj + lane];
#pragma unroll
                for (int r = 0; r < 4; ++r) { s[r] = 0.f;
#pragma unroll
                    for (int jj = 0; jj < 4; ++jj) s[r] += (v[r][jj].x * v[r][jj].x + v[r][jj].y * v[r][jj].y) + (v[r][jj].z * v[r][jj].z + v[r][jj].w * v[r][jj].w); }
#pragma unroll
                for (int r = 0; r < 4; ++r) { const float rstd = 1.0f / sqrtf(wave_sum(s[r]) * (1.f / 1024.f) + EPS);
                    unsigned long long* o8 = (unsigned long long*)(XN + (size_t)(m0 + r) * D) + lane;
#pragma unroll
                    for (int jj = 0; jj < 4; ++jj) { v[r][jj] = v[r][jj] * rstd * gq[jj]; o8[64 * jj] = (unsigned long long)pk2(v[r][jj].x, v[r][jj].y) | ((unsigned long long)pk2(v[r][jj].z, v[r][jj].w) << 32); } }
                f32x4 a0[4], a1[4];
#pragma unroll
                for (int r = 0; r < 4; ++r) { a0[r] = (f32x4){0.f, 0.f, 0.f, 0.f}; a1[r] = a0[r]; }
#pragma unroll
                for (int jj = 0; jj < 4; ++jj)
#pragma unroll
                    for (int i = 0; i < 4; ++i) { const LAS f32x4* wp = (const LAS f32x4*)(lds + ((jj * 4 + i) * 64 + lane) * 32); const f32x4 w0 = wp[0], w1 = wp[1];
#pragma unroll
                        for (int r = 0; r < 4; ++r) { a0[r] += w0 * v[r][jj][i]; a1[r] += w1 * v[r][jj][i]; } }
#pragma unroll
                for (int r = 0; r < 4; ++r) {
                    float c0, c1, c2, c3, d0, d1, z;
                    { const float k0 = b0 ? a0[r][1] : a0[r][0], g0 = b0 ? a0[r][0] : a0[r][1]; c0 = k0 + __shfl_xor(g0, 1); }
                    { const float k0 = b0 ? a0[r][3] : a0[r][2], g0 = b0 ? a0[r][2] : a0[r][3]; c1 = k0 + __shfl_xor(g0, 1); }
                    { const float k0 = b0 ? a1[r][1] : a1[r][0], g0 = b0 ? a1[r][0] : a1[r][1]; c2 = k0 + __shfl_xor(g0, 1); }
                    { const float k0 = b0 ? a1[r][3] : a1[r][2], g0 = b0 ? a1[r][2] : a1[r][3]; c3 = k0 + __shfl_xor(g0, 1); }
                    { const float k0 = b1 ? c1 : c0, g0 = b1 ? c0 : c1; d0 = k0 + __shfl_xor(g0, 2); }
                    { const float k0 = b1 ? c3 : c2, g0 = b1 ? c2 : c3; d1 = k0 + __shfl_xor(g0, 2); }
                    { const float k0 = b2 ? d1 : d0, g0 = b2 ? d0 : d1; z = k0 + __shfl_xor(g0, 4); }
                    z += __shfl_xor(z, 8); z += __shfl_xor(z, 16); z += __shfl_xor(z, 32);
                    z += bfv;
                    const float ls = fminf(z, 0.f) - __logf(1.0f + __expf(-fabsf(z)));
                    const int m = m0 + r;
                    if (lane < 8) LOGF[((size_t)(m >> 12) * 8 + lane) * SEQ + (m & 4095)] = ls;
                }
            }
        }
        {
            f32x4 gq[4];
#pragma unroll
            for (int j = 0; j < 4; ++j) gq[j] = ((const f32x4*)P.in[I_GMEM])[64 * j + lane];
            for (int m = gw; m < MM; m += NGW) { f32x4 v[4]; rms_row(P.in[I_MEM] + (size_t)m * D, gq, MEMN + (size_t)m * D, lane, v); }
        }
        __syncthreads();
    }
    SEAM(0);

    if (PH(1)) REPS(1) {
        LANE_TID;
        if (bx < BATCH * 8) {
            const float* src = LOGF + (size_t)bx * SEQ + tid * 8; float* dst = KBIAS + (size_t)bx * SEQ + tid * 8;
            const f32x4 a = *(const f32x4*)src, b = *(const f32x4*)(src + 4);
            float p[8]; p[0] = a[0]; p[1] = p[0] + a[1]; p[2] = p[1] + a[2]; p[3] = p[2] + a[3]; p[4] = p[3] + b[0]; p[5] = p[4] + b[1]; p[6] = p[5] + b[2]; p[7] = p[6] + b[3];
            float inc = p[7];
#pragma unroll
            for (int o = 1; o < 64; o <<= 1) { const float t = __shfl_up(inc, o); if (lane >= o) inc += t; }
            LAS float* wt = (LAS float*)lds;
            if (lane == 63) wt[wave] = inc;
            __syncthreads();
            float pre = inc - p[7];
            for (int w = 0; w < wave; ++w) pre += wt[w];
            const float c = -1.4426950408889634f;
            *(f32x4*)dst = (f32x4){(pre + p[0]) * c, (pre + p[1]) * c, (pre + p[2]) * c, (pre + p[3]) * c};
            *(f32x4*)(dst + 4) = (f32x4){(pre + p[4]) * c, (pre + p[5]) * c, (pre + p[6]) * c, (pre + p[7]) * c};
            __syncthreads();
        }
        { pg8::Gemm g{XN, Win_t, M, NPROJ, D}; pg8::StaticOrder S; S.init(M, NPROJ, G, bx);
          pg8::EpiProj E{PROJ, ROPE, NRM};
          pg8::gemm_phase<pg8::EpiProj, pg8::StaticOrder, true, true>(lds, g, S, E, wave); }
    }
    SEAM(1);

    if (PH(2)) REPS(2) {
        for (int p = vcu; p < 1024; p += G) {
            const int pp = p & 511, bh = pp >> 3, s = pp & 7, b = bh >> 3, hm = bh & 7;
#ifdef MK_REP_ATT
            if (rep_ == 1 && !((MK_REP_ATT) & (p < 512 ? 1 : 2))) continue;
#endif
            for (int hh = 0; hh < 2; ++hh) {
                const int qb = hh ? s : 15 - s;
                if (p < 512) { if (!(MK_ATT_MASK & 1)) continue;
                    const float* nq = NRM + 256 + ((b * 2 + 0) * 8 + hm) * 2; const float* nk = NRM + 256 + ((b * 2 + 1) * 8 + hm) * 2;
                    const float bqd = sqrtf((nq[0] + nq[1]) * (nk[0] + nk[1])) * 1.02f;
                    if (bqd < 64.f)
                        attn_body::attn_unit128<16, true>(b, qb, (const attn_body::bf16*)PROJ + hm * 64, (const attn_body::bf16*)PROJ + 512 + hm * 64, (const attn_body::bf16*)PROJ + 1024 + (hm >> 1) * 128,
                                                          (attn_body::bf16*)ATT + (hm & 1) * 512 + (hm >> 1) * 128, (char*)lds_raw, wave);
                    else
                        attn_body::attn_unit128<16, false>(b, qb, (const attn_body::bf16*)PROJ + hm * 64, (const attn_body::bf16*)PROJ + 512 + hm * 64, (const attn_body::bf16*)PROJ + 1024 + (hm >> 1) * 128,
                                                           (attn_body::bf16*)ATT + (hm & 1) * 512 + (hm >> 1) * 128, (char*)lds_raw, wave);
                } else { if (!(MK_ATT_MASK & 2)) continue; const int h = hm;
                    const float* nq = NRM + ((b * 2 + 0) * 8 + h) * 2; const float* nk = NRM + ((b * 2 + 1) * 8 + h) * 2; const float* kbr = KBIAS + (size_t)(b * 8 + h) * SEQ;
                    const float bqk = sqrtf((nq[0] + nq[1]) * (nk[0] + nk[1])) * 1.02f;
                    const int NTf = 4 * qb + 4, tc = 2 * (mk_lane() & 31);
                    const bool skip_ok = (tc >= 2) && (tc <= NTf - 4) && (2.f * bqk + kbr[64 * tc - 1 + (tc ? 0 : 1)] - kbr[256 * qb] < -40.f);
                    const unsigned long long bm = __ballot(skip_ok);
                    const int t0 = bm ? 2 * ((63 - __builtin_clzll(bm)) & 31) : 0;
                    attn_body::attn_unit<8, true>(b, qb, (const attn_body::bf16*)PROJ + 1536 + h * 64, (const attn_body::bf16*)PROJ + 2048 + h * 64, (const attn_body::bf16*)PROJ + 2560 + h * 64,
                                                  (attn_body::bf16*)ATT + 1024 + h * 64, kbr, t0, (char*)lds_raw, wave);
                }
            }
        }
    }
    SEAM(2);

    if (PH(3)) REPS(3) {
        LANE_TID;
        if (bx < 64) {
        { pg8::Gemm g{MEMN, Wckv_t, MM, D, D}; pg8::StaticOrder S; S.init(MM, D, G, bx);
          pg8::EpiBf16<0> E{CKb, D, nullptr, 0, 0, 1.f};
          pg8::gemm_phase<pg8::EpiBf16<0>, pg8::StaticOrder, true, true>(lds, g, S, E, wave); }
        { pg8::Gemm g{Wckv_t + (size_t)D * D, MEMN, D, MM, D}; pg8::StaticOrder S; S.init(D, MM, G, (bx + G - 32) % G);
          pg8::EpiBf16<0> E{CVT, MM, nullptr, 0, 0, 1.f};
          pg8::gemm_phase<pg8::EpiBf16<0>, pg8::StaticOrder, true, true>(lds, g, S, E, wave); }
        }
        const float sa = wave_sum(P.in[I_LQ1][lane] * P.in[I_LK1][lane]), sb = wave_sum(P.in[I_LQ2][lane] * P.in[I_LK2][lane]);
        const float lam = __expf(sa) - __expf(sb) + 0.2f;
        const f32x4 gs0 = *(const f32x4*)(P.in[I_GSUB] + (8 * lane) % 128), gs1 = *(const f32x4*)(P.in[I_GSUB] + (8 * lane) % 128 + 4);
        const f32x4 gf0 = *(const f32x4*)(P.in[I_GFOX] + (8 * lane) % 64), gf1 = *(const f32x4*)(P.in[I_GFOX] + (8 * lane) % 64 + 4);
        const int gw3 = (G > 64) ? (bx - 64) * NWAVES + wave : gw, NGW3 = (G > 64) ? (G - 64) * NWAVES : NGW;
        if (G <= 64 || bx >= 64)
        for (int m = gw3; m < M; m += NGW3) {
            const bf16* a = ATT + (size_t)m * NATT + 8 * lane;
            const v4u o1 = *(const v4u*)a, o2 = *(const v4u*)(a + 512), of = *(const v4u*)(a + 1024);
            float d[8], f[8];
#pragma unroll
            for (int e = 0; e < 4; ++e) { d[2 * e] = bflo(o1[e]) - lam * bflo(o2[e]); d[2 * e + 1] = bfhi(o1[e]) - lam * bfhi(o2[e]); f[2 * e] = bflo(of[e]); f[2 * e + 1] = bfhi(of[e]); }
            float sd = 0.f, sf = 0.f;
#pragma unroll
            for (int e = 0; e < 8; ++e) { sd += d[e] * d[e]; sf += f[e] * f[e]; }
            sd += __shfl_xor(sd, 1); sd += __shfl_xor(sd, 2); sd += __shfl_xor(sd, 4); sd += __shfl_xor(sd, 8);
            sf += __shfl_xor(sf, 1); sf += __shfl_xor(sf, 2); sf += __shfl_xor(sf, 4);
            const float rd = 0.8f / sqrtf(sd * (1.f / 128.f) + SUBLN_EPS), rf = 1.0f / sqrtf(sf * (1.f / 64.f) + EPS);
            v4u wd, wf;
            wd.x = pk2(d[0] * rd * gs0[0], d[1] * rd * gs0[1]); wd.y = pk2(d[2] * rd * gs0[2], d[3] * rd * gs0[3]); wd.z = pk2(d[4] * rd * gs1[0], d[5] * rd * gs1[1]); wd.w = pk2(d[6] * rd * gs1[2], d[7] * rd * gs1[3]);
            wf.x = pk2(f[0] * rf * gf0[0], f[1] * rf * gf0[1]); wf.y = pk2(f[2] * rf * gf0[2], f[3] * rf * gf0[3]); wf.z = pk2(f[4] * rf * gf1[0], f[5] * rf * gf1[1]); wf.w = pk2(f[6] * rf * gf1[2], f[7] * rf * gf1[3]);
            bf16* o = MIXA + (size_t)m * D + 8 * lane;
            *(v4u*)o = wd; *(v4u*)(o + 512) = wf;
        }
    }
    SEAM(3);

    if (PH(4)) REPS(4) { pg8::Gemm g{MIXA, Wout_t, M, D, D}; pg8::StaticOrder S; S.init(M, D, G, bx);
        pg8::EpiRes2<false, true> E{P.in[I_X], H1B, SS1};
        pg8::gemm_phase<pg8::EpiRes2<false, true>, pg8::StaticOrder, true, true>(lds, g, S, E, wave); }
    SEAM(4);

    if (PH(5)) REPS(5) { pg8::Gemm g{H1B, Wcq_t, M, D, D}; pg8::StaticOrder S; S.init(M, D, G, bx);
        build_rstd_tables(lds, S, SS1, EPS, wave);
        pg8::EpiRowScale<0> E{CQ, D, SS1, EPS, pg8::CROSS_C2, (const LAS int*)(lds + RING_BYTES + 1536), (const LAS float*)(lds + RING_BYTES + 2048)};
        pg8::gemm_phase<pg8::EpiRowScale<0>, pg8::StaticOrder, true, true>(lds, g, S, E, wave); }
    SEAM(5);

    if (PH(6)) REPS(6) {
        const int upc = (512 + G - 1) / G;
        for (int u = vcu * upc; u < (vcu + 1) * upc && u < 512; ++u) { const int bh = u >> 4, qblk = u & 15; xattn::unit(bh >> 2, bh & 3, qblk, CQ, CKb, CVT, CO, lds, wave); }
    }
    SEAM(6);

    if (PH(7)) REPS(7) { pg8::Gemm g{CO, Wco_t, M, D, D}; pg8::StaticOrder S; S.init(M, D, G, bx);
        pg8::EpiRes2<true, true> E{H1B, H2B, SS2};
        pg8::gemm_phase<pg8::EpiRes2<true, true>, pg8::StaticOrder, true, true>(lds, g, S, E, wave); }
    SEAM(7);

    if (PH(8)) REPS(8) { pg8::Gemm g{H2B, Wup_t, M, FF, D}; pg8::StaticOrder S; S.init(M, FF, G, bx);
        build_rstd_tables(lds, S, SS2, EPS, wave);
        pg8::EpiRowScale<1> E{ZH, FF, SS2, EPS, 1.f, (const LAS int*)(lds + RING_BYTES + 1536), (const LAS float*)(lds + RING_BYTES + 2048)};
        pg8::gemm_phase<pg8::EpiRowScale<1>, pg8::StaticOrder, true, true>(lds, g, S, E, wave); }
    SEAM(8);

    if (PH(9)) REPS(9) { pg8::Gemm g{ZH, Wdn_t, M, D, FF}; pg8::StaticOrder S; S.init(M, D, G, bx); S.rev = true;
        pg8::EpiRes2<true, true> E{H2B, H1B  , SS3};
        pg8::gemm_phase<pg8::EpiRes2<true, true>, pg8::StaticOrder, true, true>(lds, g, S, E, wave); }
    SEAM(9);

    if (PH(10)) REPS(10) {
        LANE_TID;
        f32x4 gq[4];
#pragma unroll
        for (int j = 0; j < 4; ++j) gq[j] = ((const f32x4*)P.in[I_GFIN])[64 * j + lane];
        for (int m0 = gw * 4; m0 < M; m0 += NGW * 4) {
            unsigned long long w[4][4]; float rr[4];
#pragma unroll
            for (int q = 0; q < 4; ++q) { const unsigned long long* hb = (const unsigned long long*)(H1B + (size_t)(m0 + q) * D) + lane;
#pragma unroll
                for (int j = 0; j < 4; ++j) w[q][j] = hb[64 * j];
                rr[q] = pg8::row_rstd(SS3, m0 + q, EPS); }
#pragma unroll
            for (int q = 0; q < 4; ++q) { f32x4* o = (f32x4*)(P.out + (size_t)(m0 + q) * D) + lane;
#pragma unroll
                for (int j = 0; j < 4; ++j) { const unsigned lo = (unsigned)w[q][j], hi2 = (unsigned)(w[q][j] >> 32);
                    const f32x4 v = {bflo(lo), bfhi(lo), bflo(hi2), bfhi(hi2)}; o[64 * j] = v * rr[q] * gq[j]; } }
        }
    }
#undef IN
#undef SEAM
#undef LANE_TID
#undef ROPE
#undef LOGF
#undef KBIAS
#undef NRM
#undef SS1
#undef SS2
#undef SS3
#undef Win_t
#undef Wout_t
#undef Wcq_t
#undef Wckv_t
#undef Wco_t
#undef Wup_t
#undef Wdn_t
#undef MEMN
#undef CKb
#undef CVT
#undef XN
#undef MIXA
#undef CQ
#undef H2B
#undef H1B
#undef CO
#undef PROJ
#undef ATT
#undef ZH
}

extern "C" void kernel_launch(void* const* d_in, const int* in_sizes, int n_in, void* d_out, int out_size, void* d_ws, size_t ws_size, hipStream_t stream) {
    static int grid = 0;
    if (grid == 0) {
        if (n_in != 21 || in_sizes[0] != M * D || out_size != M * D || ws_size < WS_END) { fprintf(stderr, "kernel_launch: unexpected shapes (n_in %d, in0 %d, out %d, ws %zu); nothing launched\n", n_in, n_in > 0 ? in_sizes[0] : -1, out_size, ws_size); grid = -1; return; }
        int dev = 0, cus = 0, per_cu = 0;
        if (hipGetDevice(&dev) != hipSuccess || hipDeviceGetAttribute(&cus, hipDeviceAttributeMultiprocessorCount, dev) != hipSuccess) { grid = -1; return; }
        if (hipFuncSetAttribute((const void*)mk_fwd, hipFuncAttributeMaxDynamicSharedMemorySize, LDS_BYTES) != hipSuccess) { fprintf(stderr, "kernel_launch: hipFuncSetAttribute failed\n"); grid = -1; return; }
        if (hipOccupancyMaxActiveBlocksPerMultiprocessor(&per_cu, (const void*)mk_fwd, NWAVES * 64, LDS_BYTES) != hipSuccess || per_cu < 1) { fprintf(stderr, "kernel_launch: occupancy query says %d blocks per CU\n", per_cu); per_cu = 1; }
        (void)hipGetLastError();
        grid = cus * per_cu;
    }
    if (grid < 0) return;
    if (hipMemsetAsync((char*)d_ws + WS_BAR, 0, XCD_BAR_WORDS * 4, stream) != hipSuccess) { fprintf(stderr, "kernel_launch: memset of the barrier words failed\n"); return; }
    Params p{};
    for (int i = 0; i < 21; ++i) p.in[i] = (const float*)d_in[i];
    p.out = (float*)d_out; p.ws = (unsigned char*)d_ws;
#if MK_PER_PHASE
    for (int ph = 0; ph < N_PHASES; ++ph) { p.ph_lo = ph; p.ph_hi = ph + 1; hipLaunchKernelGGL(mk_fwd, dim3(grid), dim3(NWAVES * 64), LDS_BYTES, stream, p); }
#else
    p.ph_lo = 0; p.ph_hi = N_PHASES;
    void* args[] = {&p};
    const hipError_t e = hipLaunchCooperativeKernel((const void*)mk_fwd, dim3(grid), dim3(NWAVES * 64), args, LDS_BYTES, stream);
    if (e != hipSuccess) fprintf(stderr, "kernel_launch: cooperative launch failed: %s (grid %d)\n", hipGetErrorString(e), grid);
#endif
}
```

```cpp
#include <hip/hip_runtime.h>
#include <hip/hip_cooperative_groups.h>
#include <hip/hip_bf16.h>
#include <cstdio>
#include <cstdint>
#include <cmath>
namespace cg = cooperative_groups;
__device__ __forceinline__ int mk_lane() { int l = (int)__builtin_amdgcn_mbcnt_hi(~0u, __builtin_amdgcn_mbcnt_lo(~0u, 0u)); asm volatile("" : "+v"(l)); return l; }
namespace pg8 {
#define PG8_LAS __attribute__((address_space(3)))
typedef unsigned short bf16_t;
typedef short bf16x8 __attribute__((ext_vector_type(8)));
typedef float f32x4 __attribute__((ext_vector_type(4)));
typedef unsigned u32x4 __attribute__((ext_vector_type(4)));
constexpr int BM = 256, BK = 64, HALF = 128, HTB = HALF * BK * 2  , STAGE_BYTES = 8 * HTB, NXCD = 8, WGM = 8;

__host__ __device__ __forceinline__ int lds_byte(int r, int c) { const int st = (r >> 4) * 2 + (c >> 5), rr = r & 15, cc = c & 31, ob = rr * 64 + cc * 2; return st * 1024 + (ob ^ (((ob >> 9) & 1) << 5)); }
__host__ __device__ __forceinline__ void stage_rc(int b, int& R, int& C) { const int st = b / 1024, sb = b % 1024, swz = sb ^ (((sb >> 9) & 1) << 5); R = (st >> 1) * 16 + swz / 64; C = (st & 1) * 32 + (swz % 64) / 2; }
__host__ __device__ __forceinline__ int perm32(int rho) { const int n = rho >> 4, i = rho & 15; return 8 * (i >> 2) + 4 * n + (i & 3); }

struct Unit { int pm, pn; };
struct Gemm { const bf16_t* A; const bf16_t* Bt; int M, N, K; };

struct StaticOrder {
    int nM, nN, nwg, G, c; bool rev = false;
    __host__ __device__ __forceinline__ void init(int M, int N, int G_, int c_) { nM = M / BM; nN = N / BM; nwg = nM * nN; G = G_; c = c_; }
    __host__ __device__ __forceinline__ bool next(int i, Unit& u) const {
        const long L = (long)i * G + c; if (L >= nwg) return false;
        int wgid = (int)L; { const int q = nwg / NXCD, r = nwg % NXCD, xcd = wgid % NXCD, off = wgid / NXCD; wgid = (xcd < r ? xcd * (q + 1) : r * (q + 1) + (xcd - r) * q) + off; }
        const int nig = WGM * nN, gid = wgid / nig, fm = gid * WGM, gsz = (nM - fm) < WGM ? (nM - fm) : WGM;
        u.pm = fm + ((wgid % nig) % gsz); u.pn = (wgid % nig) / gsz; if (rev) u.pm = nM - 1 - u.pm; return true;
    }
    __device__ __forceinline__ void a_ready(const Unit&) const {}
    __device__ __forceinline__ void done(const Unit&) const {}
};

__device__ __forceinline__ unsigned cvt_pk_bf16(float lo, float hi) { unsigned r; asm volatile("v_cvt_pk_bf16_f32 %0, %1, %2" : "=v"(r) : "v"(lo), "v"(hi)); return r; }
typedef float f32x2 __attribute__((ext_vector_type(2)));
__device__ __forceinline__ f32x2 gelu_pk(f32x2 v) {
    const f32x2 av = __builtin_elementwise_abs(v), d = av * 0.2316418882f + 1.0f;
    f32x2 t; t.x = __builtin_amdgcn_rcpf(d.x); t.y = __builtin_amdgcn_rcpf(d.y);
    f32x2 q = t * 0.5307027145f + (-0.7265760135f); q = q * t + 0.7107068705f; q = q * t + (-0.142248368f); q = q * t + 0.127414796f; q = q * t;
    const f32x2 s = (v * v) * (-0.72134752044f);
    f32x2 e; e.x = __builtin_amdgcn_exp2f(s.x); e.y = __builtin_amdgcn_exp2f(s.y);
    const f32x2 m = v * (q * e), r = v - m;
    f32x2 o; o.x = v.x < 0.f ? m.x : r.x; o.y = v.y < 0.f ? m.y : r.y; return o;
}

template <int ACT  > struct EpiBf16 {
    static constexpr bool PERM = true, AFTER_DRAIN = false; static_assert(ACT == 0 || ACT == 1, "EpiBf16: ACT is 0 (none) or 1 (gelu_pk)");
    bf16_t* O; int ldc; const float* bias; int split_cols; size_t split_stride; float scale0;
    __device__ __forceinline__ void operator()(const f32x4 (&acc)[2][2][4][2], const Unit& u, int wr, int wc, int fr, int fq) const {
        const int row0 = u.pm * BM + wr * 64 + fr; int colt = u.pn * BM; bf16_t* base = O;
        float sc = 1.f; if (split_cols) { const int t = colt / split_cols; base += (size_t)t * split_stride; colt -= t * split_cols; if (t == 0) sc = scale0; }
        const int col0 = colt + wc * 32 + 8 * fq, bcol0 = u.pn * BM + wc * 32 + 8 * fq;
        f32x4 bv[2][2];
#pragma unroll
        for (int bj = 0; bj < 2; ++bj)
#pragma unroll
            for (int n = 0; n < 2; ++n) bv[bj][n] = bias ? *(const f32x4*)(bias + bcol0 + bj * HALF + 4 * n) : (f32x4){0.f, 0.f, 0.f, 0.f};
#pragma unroll
        for (int ai = 0; ai < 2; ++ai)
#pragma unroll
            for (int m = 0; m < 4; ++m) { bf16_t* rowp = base + (size_t)(row0 + ai * HALF + m * 16) * ldc + col0;
#pragma unroll
                for (int bj = 0; bj < 2; ++bj) { f32x4 v0 = acc[ai][bj][m][0] + bv[bj][0], v1 = acc[ai][bj][m][1] + bv[bj][1];
                    if (ACT == 1) { f32x2 a = gelu_pk((f32x2){v0[0], v0[1]}), b = gelu_pk((f32x2){v0[2], v0[3]}), c = gelu_pk((f32x2){v1[0], v1[1]}), d = gelu_pk((f32x2){v1[2], v1[3]});
                        v0 = (f32x4){a.x, a.y, b.x, b.y}; v1 = (f32x4){c.x, c.y, d.x, d.y}; }
                    v0 = v0 * sc; v1 = v1 * sc; u32x4 w; w.x = cvt_pk_bf16(v0[0], v0[1]); w.y = cvt_pk_bf16(v0[2], v0[3]); w.z = cvt_pk_bf16(v1[0], v1[1]); w.w = cvt_pk_bf16(v1[2], v1[3]);
                    *(u32x4*)(rowp + bj * HALF) = w; } }
    }
};

constexpr float QK_C2 = 0.125f * 1.4426950408889634f;
constexpr float CROSS_C2 = 0.0625f * 1.4426950408889634f;
__device__ __forceinline__ float row_rstd(const float* part, int row, float eps) {
    const f32x4* p = (const f32x4*)(part + (size_t)row * 16);
    const f32x4 a = p[0], b = p[1], c = p[2], d = p[3];
    const float s = ((a[0] + a[1]) + (a[2] + a[3])) + ((b[0] + b[1]) + (b[2] + b[3])) + ((c[0] + c[1]) + (c[2] + c[3])) + ((d[0] + d[1]) + (d[2] + d[3]));
    return 1.0f / sqrtf(s * (1.0f / 1024.0f) + eps);
}
struct EpiProj {
    static constexpr bool PERM = true, AFTER_DRAIN = false;
    bf16_t* O; const float* rope; float* nrm; const float* ssp; const PG8_LAS int* pml; const PG8_LAS float* tab;
    __device__ __forceinline__ void operator()(const f32x4 (&acc)[2][2][4][2], const Unit& u, int wr, int wc, int fr, int fq) const {
        const int row0 = u.pm * BM + wr * 64 + fr, col0 = u.pn * BM + wc * 32 + 8 * fq;
        const int typ = u.pn >> 1;
        const float sc = (typ == 0 || typ == 3) ? QK_C2 : 1.f;
        int slot = -1;
        if (tab) { const int n = pml[8]; for (int j = 0; j < n; ++j) if (pml[j] == u.pm) slot = j; }
        const bool ropew = (typ < 2) && ((wc & 1) == 0);
        const bool nrmw = (typ == 0 || typ == 1 || typ == 3 || typ == 4); float mxn[2] = {0.f, 0.f};
#pragma unroll
        for (int ai = 0; ai < 2; ++ai) {
            f32x4 rc[4][4];
            if (ropew) {
#pragma unroll
                for (int m = 0; m < 4; ++m) { const f32x4* rp = (const f32x4*)(rope + (size_t)((row0 + ai * HALF + m * 16) & 4095) * 16); rc[m][0] = rp[0]; rc[m][1] = rp[1]; rc[m][2] = rp[2]; rc[m][3] = rp[3]; }
            }
#pragma unroll
            for (int m = 0; m < 4; ++m) {
                const int row = row0 + ai * HALF + m * 16;
                bf16_t* rowp = O + (size_t)row * 3072 + col0;
                const float scr = sc * (slot >= 0 ? tab[slot * 256 + (row - u.pm * BM)] : row_rstd(ssp, row, 1e-6f));
                f32x4 c0 = {1.f, 1.f, 1.f, 1.f}, c1 = c0, s0 = {0.f, 0.f, 0.f, 0.f}, s1 = s0;
                if (ropew) { c0 = rc[m][0]; c1 = rc[m][1]; s0 = rc[m][2]; s1 = rc[m][3]; if (fq == 0) { s0 = -s0; s1 = -s1; } if (fq >= 2) { c0 = (f32x4){1.f, 1.f, 1.f, 1.f}; c1 = c0; s0 = (f32x4){0.f, 0.f, 0.f, 0.f}; s1 = s0; } }
#pragma unroll
                for (int bj = 0; bj < 2; ++bj) {
                    f32x4 v0 = acc[ai][bj][m][0], v1 = acc[ai][bj][m][1];
                    if (ropew) {
                        f32x4 p0, p1;
#pragma unroll
                        for (int e = 0; e < 4; ++e) { p0[e] = __shfl_xor(v0[e], 16); p1[e] = __shfl_xor(v1[e], 16); }
                        v0 = v0 * c0 + p0 * s0; v1 = v1 * c1 + p1 * s1;
                    }
                    v0 = v0 * scr; v1 = v1 * scr;
                    if (nrmw) { float q = (v0[0] * v0[0] + v0[1] * v0[1]) + (v0[2] * v0[2] + v0[3] * v0[3]) + (v1[0] * v1[0] + v1[1] * v1[1]) + (v1[2] * v1[2] + v1[3] * v1[3]);
                        q += __shfl_xor(q, 16); q += __shfl_xor(q, 32); mxn[bj] = fmaxf(mxn[bj], q); }
                    u32x4 w; w.x = cvt_pk_bf16(v0[0], v0[1]); w.y = cvt_pk_bf16(v0[2], v0[3]); w.z = cvt_pk_bf16(v1[0], v1[1]); w.w = cvt_pk_bf16(v1[2], v1[3]);
                    *(u32x4*)(rowp + bj * HALF) = w;
                }
            }
        }
        if (nrmw) {
#pragma unroll
            for (int bj = 0; bj < 2; ++bj) { float q = mxn[bj];
                q = fmaxf(q, __shfl_xor(q, 1)); q = fmaxf(q, __shfl_xor(q, 2)); q = fmaxf(q, __shfl_xor(q, 4)); q = fmaxf(q, __shfl_xor(q, 8));
                const int rel = 256 * (u.pn & 1) + 128 * bj + 32 * wc, b = (u.pm * BM) >> 12;
                if (fr == 0 && fq == 0) atomicMax((unsigned*)nrm + (typ < 2 ? 256 : 0) + ((b * 2 + ((typ == 1 || typ == 4) ? 1 : 0)) * 8 + (rel >> 6)) * 2 + ((rel >> 5) & 1), __float_as_uint(q * 1.02f)); }
        }
    }
};
template <bool BASE_BF16, bool OUT_BF16> struct EpiRes2 {
    static constexpr bool PERM = true, AFTER_DRAIN = false;
    const void* base; void* out; float* sspart;
    __device__ __forceinline__ void operator()(const f32x4 (&acc)[2][2][4][2], const Unit& u, int wr, int wc, int fr, int fq) const {
        const int row0 = u.pm * BM + wr * 64 + fr, col0 = u.pn * BM + wc * 32 + 8 * fq;
#pragma unroll
        for (int ai = 0; ai < 2; ++ai) {
            u32x4 bw[4][2]; f32x4 bf[4][2][2];
#pragma unroll
            for (int m = 0; m < 4; ++m)
#pragma unroll
                for (int bj = 0; bj < 2; ++bj) { const size_t off = (size_t)(row0 + ai * HALF + m * 16) * 1024 + col0 + bj * HALF;
                    if (BASE_BF16) bw[m][bj] = *(const u32x4*)((const bf16_t*)base + off);
                    else { bf[m][bj][0] = *(const f32x4*)((const float*)base + off); bf[m][bj][1] = *(const f32x4*)((const float*)base + off + 4); } }
#pragma unroll
            for (int m = 0; m < 4; ++m) {
                const int row = row0 + ai * HALF + m * 16; const size_t off = (size_t)row * 1024 + col0;
                float ss = 0.f;
#pragma unroll
                for (int bj = 0; bj < 2; ++bj) {
                    f32x4 b0, b1;
                    if (BASE_BF16) { const u32x4 w = bw[m][bj];
                        b0 = (f32x4){__builtin_bit_cast(float, w.x << 16), __builtin_bit_cast(float, w.x & 0xffff0000u), __builtin_bit_cast(float, w.y << 16), __builtin_bit_cast(float, w.y & 0xffff0000u)};
                        b1 = (f32x4){__builtin_bit_cast(float, w.z << 16), __builtin_bit_cast(float, w.z & 0xffff0000u), __builtin_bit_cast(float, w.w << 16), __builtin_bit_cast(float, w.w & 0xffff0000u)}; }
                    else { b0 = bf[m][bj][0]; b1 = bf[m][bj][1]; }
                    const f32x4 v0 = acc[ai][bj][m][0] + b0, v1 = acc[ai][bj][m][1] + b1;
                    ss += (v0[0] * v0[0] + v0[1] * v0[1]) + (v0[2] * v0[2] + v0[3] * v0[3]) + (v1[0] * v1[0] + v1[1] * v1[1]) + (v1[2] * v1[2] + v1[3] * v1[3]);
                    if (OUT_BF16) { u32x4 w; w.x = cvt_pk_bf16(v0[0], v0[1]); w.y = cvt_pk_bf16(v0[2], v0[3]); w.z = cvt_pk_bf16(v1[0], v1[1]); w.w = cvt_pk_bf16(v1[2], v1[3]);
                        *(u32x4*)((bf16_t*)out + off + bj * HALF) = w; }
                    else { *(f32x4*)((float*)out + off + bj * HALF) = v0; *(f32x4*)((float*)out + off + bj * HALF + 4) = v1; }
                }
                ss += __shfl_xor(ss, 16); ss += __shfl_xor(ss, 32);
                if (fq == 0) sspart[(size_t)row * 16 + u.pn * 4 + wc] = ss;
            }
        }
    }
};
template <int ACT> struct EpiRowScale {
    static constexpr bool PERM = true, AFTER_DRAIN = false;
    bf16_t* O; int ldc; const float* sspart; float eps; float sc;
    const PG8_LAS int* pml; const PG8_LAS float* tab;
    __device__ __forceinline__ void operator()(const f32x4 (&acc)[2][2][4][2], const Unit& u, int wr, int wc, int fr, int fq) const {
        const int row0 = u.pm * BM + wr * 64 + fr, col0 = u.pn * BM + wc * 32 + 8 * fq;
        int slot = -1;
        if (tab) { const int n = pml[8]; for (int j = 0; j < n; ++j) if (pml[j] == u.pm) slot = j; }
#pragma unroll
        for (int ai = 0; ai < 2; ++ai)
#pragma unroll
            for (int m = 0; m < 4; ++m) {
                const int row = row0 + ai * HALF + m * 16; bf16_t* rowp = O + (size_t)row * ldc + col0;
                const float r = (slot >= 0 ? tab[slot * 256 + (row - u.pm * BM)] : row_rstd(sspart, row, eps)) * sc;
#pragma unroll
                for (int bj = 0; bj < 2; ++bj) {
                    f32x4 v0 = acc[ai][bj][m][0] * r, v1 = acc[ai][bj][m][1] * r;
                    if (ACT == 1) {
#pragma unroll
                        for (int e = 0; e < 4; ++e) { const float a = fmaxf(v0[e], 0.f), b = fmaxf(v1[e], 0.f); v0[e] = a * a; v1[e] = b * b; }
                    }
                    u32x4 w; w.x = cvt_pk_bf16(v0[0], v0[1]); w.y = cvt_pk_bf16(v0[2], v0[3]); w.z = cvt_pk_bf16(v1[0], v1[1]); w.w = cvt_pk_bf16(v1[2], v1[3]);
                    *(u32x4*)(rowp + bj * HALF) = w;
                }
            }
    }
};
template <class Epi, class Sched, bool ALIGN_EPI = false, bool SP2 = false>
__device__ __forceinline__ void gemm_phase(PG8_LAS unsigned char* lds, const Gemm g, const Sched& S, const Epi& E, const int wv  ) {
    int tid_ = wv * 64 + mk_lane();
    const int tid = tid_, wid = __builtin_amdgcn_readfirstlane(tid >> 6), lane = tid & 63, wr = wid >> 2, wc = wid & 3, fr = lane & 15, fq = lane >> 4;
    const int K = g.K, nt = K / BK;
    unsigned voffA[2], voffB[2];
#pragma unroll
    for (int i = 0; i < 2; ++i) { int R, C; stage_rc(tid * 16 + i * 8192, R, C); const int Rb = Epi::PERM ? ((R & ~31) + perm32(R & 31)) : R;
        voffA[i] = (unsigned)(R * K + C) * 2u; voffB[i] = (unsigned)(Rb * K + C) * 2u; }
    const size_t kstep = (size_t)(BK * 2);
    const size_t hstep = (size_t)HALF * K * 2;
    const size_t tstep = 2 * hstep;
    const unsigned ldsw = (unsigned)wid * 1024u;
    const int aoff = lds_byte(wr * 64 + fr, fq * 8), boff = lds_byte(wc * 32 + fr, fq * 8);
#define PG8_SA(b, h) (((b) * 2 + (h)) * HTB)
#define PG8_SB(b, h) ((4 + (b) * 2 + (h)) * HTB)
#define PG8_STAGE(bufoff, gbase, voff) do { _Pragma("unroll") for (int _i = 0; _i < 2; ++_i) \
        __builtin_amdgcn_global_load_lds((const unsigned*)((const char*)(gbase) + (voff)[_i]), (PG8_LAS unsigned*)(lds + (bufoff) + ldsw + _i * 8192), 16, 0, 0); } while (0)
#define PG8_LDA(dst, b, h) do { _Pragma("unroll") for (int m = 0; m < 4; ++m) _Pragma("unroll") for (int k = 0; k < 2; ++k) dst[m][k] = *(const PG8_LAS bf16x8*)(lds + PG8_SA(b, h) + aoff + m * 2048 + k * 1024); } while (0)
#define PG8_LDB(dst, b, h) do { _Pragma("unroll") for (int n = 0; n < 2; ++n) _Pragma("unroll") for (int k = 0; k < 2; ++k) dst[n][k] = *(const PG8_LAS bf16x8*)(lds + PG8_SB(b, h) + boff + n * 2048 + k * 1024); } while (0)
#define PG8_MMA(ai, bj, At, Bt) do { __builtin_amdgcn_s_setprio(1); _Pragma("unroll") for (int m = 0; m < 4; ++m) _Pragma("unroll") for (int n = 0; n < 2; ++n) _Pragma("unroll") for (int k = 0; k < 2; ++k) \
        acc[ai][bj][m][n] = __builtin_amdgcn_mfma_f32_16x16x32_bf16(Bt[n][k], At[m][k], acc[ai][bj][m][n], 0, 0, 0); __builtin_amdgcn_s_setprio(0); } while (0)
#define PG8_WAIT_V(n) asm volatile("s_waitcnt vmcnt(" #n ")" ::: "memory")
#define PG8_WAIT_L(n) asm volatile("s_waitcnt lgkmcnt(" #n ")" ::: "memory")
#define PG8_BAR __builtin_amdgcn_s_barrier()
#define PG8_SCHED __builtin_amdgcn_sched_barrier(0)
    Unit cur, nxt; int ui = 0;
    if (!S.next(0, cur)) return;
    f32x4 acc[2][2][4][2];
#pragma unroll
    for (int a = 0; a < 2; ++a)
#pragma unroll
        for (int b = 0; b < 2; ++b)
#pragma unroll
            for (int m = 0; m < 4; ++m)
#pragma unroll
                for (int n = 0; n < 2; ++n) acc[a][b][m][n] = (f32x4){0.f, 0.f, 0.f, 0.f};
    bf16x8 At[4][2], B0[2][2], B1[2][2];
    const char* cA = (const char*)g.A + (size_t)cur.pm * tstep; const char* cB = (const char*)g.Bt + (size_t)cur.pn * tstep;
    S.a_ready(cur);
    if constexpr (SP2) {
        PG8_STAGE(PG8_SB(0, 0), cB, voffB); PG8_STAGE(PG8_SB(0, 1), cB + hstep, voffB); PG8_STAGE(PG8_SA(0, 0), cA, voffA); PG8_STAGE(PG8_SA(0, 1), cA + hstep, voffA);
        if (wr == 1) PG8_BAR;
        PG8_WAIT_V(2); PG8_BAR;
        PG8_STAGE(PG8_SB(1, 0), cB + kstep, voffB); PG8_STAGE(PG8_SA(1, 0), cA + kstep, voffA); PG8_STAGE(PG8_SB(1, 1), cB + hstep + kstep, voffB);
        PG8_WAIT_V(6); PG8_BAR;
    } else {
        PG8_STAGE(PG8_SB(0, 0), cB, voffB); PG8_STAGE(PG8_SA(0, 0), cA, voffA); PG8_STAGE(PG8_SB(0, 1), cB + hstep, voffB); PG8_STAGE(PG8_SA(0, 1), cA + hstep, voffA);
        if (wr == 1) PG8_BAR;
        PG8_WAIT_V(4); PG8_BAR;
        PG8_STAGE(PG8_SB(1, 0), cB + kstep, voffB); PG8_STAGE(PG8_SA(1, 0), cA + kstep, voffA); PG8_STAGE(PG8_SB(1, 1), cB + hstep + kstep, voffB);
        PG8_WAIT_V(6); PG8_BAR;
    }
    for (;;) {
        const bool has_next = S.next(ui + 1, nxt);
        const char* nA = has_next ? (const char*)g.A + (size_t)nxt.pm * tstep : cA; const char* nB = has_next ? (const char*)g.Bt + (size_t)nxt.pn * tstep : cB;
        for (int t = 0; t < nt; t += 2) {
            const bool last = (t == nt - 2);
            const char* a1 = cA + (size_t)(t + 1) * kstep;
            const char* a2 = last ? nA : cA + (size_t)(t + 2) * kstep; const char* b2 = last ? nB : cB + (size_t)(t + 2) * kstep;
            const char* a3 = a2 + kstep; const char* b3 = b2 + kstep;
            if (last && has_next) S.a_ready(nxt);
            if constexpr (SP2) {
            PG8_LDB(B0, 0, 0); PG8_LDB(B1, 0, 1); PG8_SCHED; PG8_LDA(At, 0, 0); PG8_STAGE(PG8_SA(1, 1), a1 + hstep, voffA);
            PG8_WAIT_V(8); PG8_WAIT_L(0); PG8_BAR; PG8_MMA(0, 0, At, B0); PG8_MMA(0, 1, At, B1); PG8_BAR; PG8_SCHED;
            PG8_LDA(At, 0, 1); PG8_STAGE(PG8_SB(0, 0), b2, voffB); PG8_STAGE(PG8_SB(0, 1), b2 + hstep, voffB); PG8_STAGE(PG8_SA(0, 0), a2, voffA);
            PG8_WAIT_V(8); PG8_WAIT_L(0); PG8_BAR; PG8_MMA(1, 0, At, B0); PG8_MMA(1, 1, At, B1); PG8_BAR; PG8_SCHED;
            PG8_LDB(B0, 1, 0); PG8_LDB(B1, 1, 1); PG8_SCHED; PG8_LDA(At, 1, 0); PG8_STAGE(PG8_SA(0, 1), a2 + hstep, voffA);
            PG8_WAIT_V(8); PG8_WAIT_L(0); PG8_BAR; PG8_MMA(0, 0, At, B0); PG8_MMA(0, 1, At, B1); PG8_BAR; PG8_SCHED;
            PG8_LDA(At, 1, 1); PG8_STAGE(PG8_SB(1, 0), b3, voffB); PG8_STAGE(PG8_SB(1, 1), b3 + hstep, voffB); PG8_STAGE(PG8_SA(1, 0), a3, voffA);
            PG8_WAIT_V(8); PG8_WAIT_L(0); PG8_BAR; PG8_MMA(1, 0, At, B0); PG8_MMA(1, 1, At, B1); PG8_BAR; PG8_SCHED;
            } else {
            PG8_LDB(B0, 0, 0); PG8_SCHED; PG8_LDA(At, 0, 0); PG8_STAGE(PG8_SA(1, 1), a1 + hstep, voffA);
            PG8_WAIT_L(8); PG8_BAR; PG8_WAIT_L(0); PG8_MMA(0, 0, At, B0); PG8_BAR; PG8_SCHED;
            PG8_LDB(B1, 0, 1); PG8_STAGE(PG8_SB(0, 0), b2, voffB);
            PG8_BAR; PG8_WAIT_L(0); PG8_MMA(0, 1, At, B1); PG8_BAR;
            PG8_LDA(At, 0, 1); PG8_STAGE(PG8_SA(0, 0), a2, voffA);
            PG8_BAR; PG8_WAIT_L(0); PG8_MMA(1, 0, At, B0); PG8_BAR; PG8_SCHED;
            PG8_STAGE(PG8_SB(0, 1), b2 + hstep, voffB);
            PG8_WAIT_V(6); PG8_BAR; PG8_MMA(1, 1, At, B1); PG8_BAR;
            PG8_LDB(B0, 1, 0); PG8_SCHED; PG8_LDA(At, 1, 0); PG8_STAGE(PG8_SA(0, 1), a2 + hstep, voffA);
            PG8_WAIT_L(8); PG8_BAR; PG8_WAIT_L(0); PG8_MMA(0, 0, At, B0); PG8_BAR; PG8_SCHED;
            PG8_LDB(B1, 1, 1); PG8_STAGE(PG8_SB(1, 0), b3, voffB);
            PG8_BAR; PG8_WAIT_L(0); PG8_MMA(0, 1, At, B1); PG8_BAR;
            PG8_LDA(At, 1, 1); PG8_STAGE(PG8_SA(1, 0), a3, voffA);
            PG8_BAR; PG8_WAIT_L(0); PG8_MMA(1, 0, At, B0); PG8_BAR; PG8_SCHED;
            PG8_STAGE(PG8_SB(1, 1), b3 + hstep, voffB);
            PG8_WAIT_V(6); PG8_BAR; PG8_MMA(1, 1, At, B1); PG8_BAR;
            }
        }
        if constexpr (ALIGN_EPI) { if (wr == 0) PG8_BAR; }
        if constexpr (!Epi::AFTER_DRAIN) { E(acc, cur, wr, wc, fr, fq); S.done(cur); }
        if (!has_next) break;
#pragma unroll
        for (int a = 0; a < 2; ++a)
#pragma unroll
            for (int b = 0; b < 2; ++b)
#pragma unroll
                for (int m = 0; m < 4; ++m)
#pragma unroll
                    for (int n = 0; n < 2; ++n) acc[a][b][m][n] = (f32x4){0.f, 0.f, 0.f, 0.f};
        cur = nxt; cA = nA; cB = nB; ++ui;
        if constexpr (ALIGN_EPI) { if (wr == 1) PG8_BAR; }
    }
    PG8_WAIT_V(0);
    if constexpr (!ALIGN_EPI) { if (wr == 0) PG8_BAR; }
    PG8_BAR;
    if constexpr (Epi::AFTER_DRAIN) { E.fused(acc, cur, wr, wc, fr, fq, lds, wid, lane); S.done(cur); }
#undef PG8_SA
#undef PG8_SB
#undef PG8_STAGE
#undef PG8_LDA
#undef PG8_LDB
#undef PG8_MMA
#undef PG8_WAIT_V
#undef PG8_WAIT_L
#undef PG8_BAR
#undef PG8_SCHED
}
}

#ifndef PG8_SP2
#define PG8_SP2 true
#endif
#ifndef PG8_ALIGN
#define PG8_ALIGN true
#endif
namespace attn_body {
using bf16=__hip_bfloat16;
using bf16x8=__attribute__((ext_vector_type(8)))short;
using s16x4=__attribute__((ext_vector_type(4)))short;
using f32x16=__attribute__((ext_vector_type(16)))float;
using u32x4=__attribute__((ext_vector_type(4)))unsigned; using f32x4=__attribute__((ext_vector_type(4)))float;
constexpr int SEQ=4096,D=64,PQ=3072,PO=1536;
constexpr int NW=8,QBLK=32,QB=QBLK*NW,KVBLK=64,NQB=SEQ/QB;
constexpr int ATTN_UNIT_ROWS=QB;
__device__ __forceinline__ int crow(int r,int hi){return (r&3)+8*(r>>2)+4*hi;}
#define SBAR() __builtin_amdgcn_sched_barrier(0)
__device__ __forceinline__ void cmask(f32x16&p0,f32x16&p1,int jb,int qrel,int hi){
  const float NEG=-INFINITY; int kb=64*jb+4*hi;
  #pragma unroll
  for(int r=0;r<16;++r){int kv=kb+(r&3)+8*(r>>2); if(kv>qrel)p0[r]=NEG; if(kv+32>qrel)p1[r]=NEG;}
}

template<bool B> __device__ __forceinline__ const f32x16& csel(const f32x16&a,const f32x16&b){ if constexpr(B) return a; else return b; }
constexpr int NSLOT=3, SLOTB=8192;
constexpr int LDS_K=0, LDS_V=NSLOT*SLOTB, LDS_WS=2*NSLOT*SLOTB, LDS_OST=LDS_WS+NW*64*4, LDS_KBIAS=LDS_OST+NW*4096, LDS_BYTES=LDS_KBIAS+SEQ*4;
constexpr float C2=0.125f*1.4426950408889634f;
__device__ __forceinline__ void glds16(const void*gsrc,unsigned lds_dst){unsigned keep;
  asm volatile("s_mov_b32 %0, m0\n\ts_mov_b32 m0, %2\n\ts_nop 0\n\tglobal_load_lds_dwordx4 %1, off\n\ts_mov_b32 m0, %0":"=&s"(keep):"v"(gsrc),"s"(lds_dst):"memory");}
__device__ __forceinline__ float max3f(float a,float b,float c){float r;asm("v_max3_f32 %0, %1, %2, %3":"=v"(r):"v"(a),"v"(b),"v"(c));return r;}
__device__ __forceinline__ float max2f(float a,float b){float r;asm("v_max_f32_e32 %0, %1, %2":"=v"(r):"v"(a),"v"(b));return r;}
__device__ __forceinline__ float fadd_s(float a,float b){float r;asm("v_add_f32_e32 %0, %1, %2":"=v"(r):"v"(a),"v"(b));return r;}
__device__ __forceinline__ float fsub_s(float a,float b){float r;asm("v_sub_f32_e32 %0, %1, %2":"=v"(r):"v"(a),"v"(b));return r;}
typedef float f32x2_t __attribute__((ext_vector_type(2))); typedef __bf16 bf16x2_t __attribute__((ext_vector_type(2)));
__device__ __forceinline__ unsigned cvtpk_s(float lo,float hi){f32x2_t v={lo,hi};bf16x2_t b=__builtin_convertvector(v,bf16x2_t);return __builtin_bit_cast(unsigned,b);}
#define WAIT_BAR(N) asm volatile("s_waitcnt vmcnt(" #N ") lgkmcnt(0)\n\ts_barrier":::"memory")

__device__ __forceinline__ void qkt(f32x16&p0,f32x16&p1,const char*Kslot,const bf16x8*qr,const f32x16&ci0,const f32x16&ci1,int r32,int hi){
  const char*kb=Kslot+hi*1024+r32*16;
  #pragma unroll
  for(int d0=0;d0<4;++d0){
    const bf16x8 b0=*reinterpret_cast<const bf16x8*>(kb+d0*2048);
    const bf16x8 b1=*reinterpret_cast<const bf16x8*>(kb+d0*2048+512);
    if(d0==0){p0=__builtin_amdgcn_mfma_f32_32x32x16_bf16(b0,qr[0],ci0,0,0,0);p1=__builtin_amdgcn_mfma_f32_32x32x16_bf16(b1,qr[0],ci1,0,0,0);}
    else{p0=__builtin_amdgcn_mfma_f32_32x32x16_bf16(b0,qr[d0],p0,0,0,0);p1=__builtin_amdgcn_mfma_f32_32x32x16_bf16(b1,qr[d0],p1,0,0,0);}}
}
typedef __attribute__((address_space(3))) const char* lds_cptr;
typedef short v4i16_t __attribute__((ext_vector_type(4)));
__device__ __forceinline__ void kload8(bf16x8*kf,lds_cptr kp){
  kf[0]=*(const __attribute__((address_space(3))) bf16x8*)(kp);      kf[1]=*(const __attribute__((address_space(3))) bf16x8*)(kp+512);
  kf[2]=*(const __attribute__((address_space(3))) bf16x8*)(kp+2048); kf[3]=*(const __attribute__((address_space(3))) bf16x8*)(kp+2560);
  kf[4]=*(const __attribute__((address_space(3))) bf16x8*)(kp+4096); kf[5]=*(const __attribute__((address_space(3))) bf16x8*)(kp+4608);
  kf[6]=*(const __attribute__((address_space(3))) bf16x8*)(kp+6144); kf[7]=*(const __attribute__((address_space(3))) bf16x8*)(kp+6656);
}
__device__ __forceinline__ void kload2(bf16x8*kf,lds_cptr kp,int j){ kf[2*j]=*(const __attribute__((address_space(3))) bf16x8*)(kp+j*2048); kf[2*j+1]=*(const __attribute__((address_space(3))) bf16x8*)(kp+j*2048+512); }
__device__ __forceinline__ s16x4 vtr(lds_cptr p){ return __builtin_bit_cast(s16x4,__builtin_amdgcn_ds_read_tr16_b64_v4i16((__attribute__((address_space(3))) v4i16_t*)p)); }
__device__ __forceinline__ float rowmax(const f32x16&p0,const f32x16&p1){
  float a=max3f(p0[0],p0[1],p1[0]),b=max3f(p0[2],p0[3],p1[1]);a=max3f(a,p1[2],p1[3]);
  #pragma unroll
  for(int r=4;r<16;r+=4){a=max3f(a,p0[r],p0[r+1]);b=max3f(b,p0[r+2],p0[r+3]);a=max3f(a,p1[r],p1[r+1]);b=max3f(b,p1[r+2],p1[r+3]);}
  const float m=max2f(a,b);
  auto rr=__builtin_amdgcn_permlane32_swap(__float_as_uint(m),__float_as_uint(m),false,false);
  return max2f(__uint_as_float(rr[0]),__uint_as_float(rr[1]));
}
__device__ __forceinline__ void pv(f32x16*o,int vb,bf16x8 pa0,bf16x8 pa1,bf16x8 pa2,bf16x8 pa3){
  #pragma unroll
  for(int d0=0;d0<2;++d0){s16x4 lo[4],hi[4];
    #pragma unroll
    for(int ks=0;ks<4;++ks){
      asm volatile("ds_read_b64_tr_b16 %0,%1 offset:%c2":"=&v"(lo[ks]):"v"(vb),"i"(d0*4096+ks*1024):"memory");
      asm volatile("ds_read_b64_tr_b16 %0,%1 offset:%c2":"=&v"(hi[ks]):"v"(vb),"i"(d0*4096+ks*1024+512):"memory");}
    asm volatile("s_waitcnt lgkmcnt(0)":::"memory");SBAR();
    #define PK(k) (bf16x8){lo[k][0],lo[k][1],lo[k][2],lo[k][3],hi[k][0],hi[k][1],hi[k][2],hi[k][3]}
    o[d0]=__builtin_amdgcn_mfma_f32_32x32x16_bf16(pa0,PK(0),o[d0],0,0,0);
    o[d0]=__builtin_amdgcn_mfma_f32_32x32x16_bf16(pa1,PK(1),o[d0],0,0,0);
    o[d0]=__builtin_amdgcn_mfma_f32_32x32x16_bf16(pa2,PK(2),o[d0],0,0,0);
    o[d0]=__builtin_amdgcn_mfma_f32_32x32x16_bf16(pa3,PK(3),o[d0],0,0,0);
    #undef PK
  }
}

#ifndef ATTN_STORE16
#define ATTN_STORE16(p,v) (*(u32x4*)(p)=(v))
#endif
template<int THRL,bool HASB> __device__ __forceinline__ void attn_unit(int b,int qb,const bf16*Qc,const bf16*__restrict__ Kc,const bf16*__restrict__ Vc,bf16*Oc,const float*__restrict__ kbg,int t0,char*shm,const int wv){
  int tid_=wv*64+mk_lane();
  const int tid=tid_,lane=tid&63,r32=lane&31,hi=lane>>5; const int wid=__builtin_amdgcn_readfirstlane(tid>>6);
  const long rowbase=(long)b*SEQ; const int q0=qb*QB;
  const bf16*Qw=Qc+(rowbase+q0+wid*QBLK)*PQ;
  const bf16*Kh=Kc+(rowbase+(long)t0*KVBLK)*PQ,*Vh=Vc+(rowbase+(long)t0*KVBLK)*PQ;
  const unsigned lds0=(unsigned)(uintptr_t)shm;
  float*wsf=(float*)(shm+LDS_WS)+wid*64;
  const bf16*ksrc=Kh+(long)lane*PQ+wid*8;
  const bf16*vsrc=Vh+(long)(16*(wid&3)+(lane>>2))*PQ+(wid>>2)*32+(lane&3)*8;
  const unsigned kdst=lds0+LDS_K+wid*1024, vdst=lds0+LDS_V+wid*1024;
  #define DMA_K(t,slot) glds16(ksrc+(long)(t)*KVBLK*PQ,(unsigned)__builtin_amdgcn_readfirstlane(kdst+(slot)))
  #define DMA_V(t,slot) glds16(vsrc+(long)(t)*KVBLK*PQ,(unsigned)__builtin_amdgcn_readfirstlane(vdst+(slot)))
  const int vb0=(int)(lds0+LDS_V)+((lane>>4)&1)*32+(lane&3)*8+(4*hi+((lane&15)>>2))*64;
  const char*Kbase=shm+LDS_K; bf16x8 kf[8];
  const lds_cptr shm3=(lds_cptr)shm; const lds_cptr kp0=shm3+LDS_K+hi*1024+r32*16; const lds_cptr vp0=shm3+LDS_V+((lane>>4)&1)*32+(lane&3)*8+(4*hi+((lane&15)>>2))*64;
  const int NT=(q0+QB)/KVBLK-t0;
  typedef __attribute__((address_space(3))) const f32x4 lds_cf4; typedef __attribute__((address_space(3))) f32x4 lds_f4;
  const __attribute__((address_space(3))) char* kbl=(const __attribute__((address_space(3))) char*)shm+LDS_KBIAS+hi*16;
  DMA_K(0,0);DMA_V(0,0);DMA_K(1,SLOTB);
  bf16x8 qr[4];
  #pragma unroll
  for(int d0=0;d0<4;++d0)qr[d0]=*reinterpret_cast<const bf16x8*>(&Qw[(long)r32*PQ+d0*16+hi*8]);
  float mhat=0.f,l_reg=0.f;f32x16 o[2];o[0]=f32x16{};o[1]=f32x16{};f32x16 negm=f32x16{};asm volatile("":"+v"(negm));
  const int qrel=wid*QBLK+r32;
  float mref=0.f;
  #define CINIT(C0,C1,t) do{ if(HASB){ const __attribute__((address_space(3))) char* kp_=kbl+(t)*256; \
      _Pragma("unroll") for(int g_=0;g_<4;++g_){ const f32x4 a_=*(lds_cf4*)(kp_+g_*32), b_=*(lds_cf4*)(kp_+128+g_*32); \
        _Pragma("unroll") for(int e_=0;e_<4;++e_){ C0[4*g_+e_]=a_[e_]-mhat; C1[4*g_+e_]=b_[e_]-mhat; } } } \
    }while(0)
  #define CMASK(P0,P1,t) do{int jb_=(t)-(NT-4); if(jb_>=0)cmask(P0,P1,jb_,qrel,hi);}while(0)
  bool resc=false;
  #define START(P0,P1) do{ const float rm=rowmax(P0,P1); resc=false; \
    { const float dl=HASB?__builtin_fmaxf(rm,0.f):rm; mhat=fadd_s(mhat,dl); \
      _Pragma("unroll") for(int r=0;r<16;++r){P0[r]=fsub_s(P0[r],dl);P1[r]=fsub_s(P1[r],dl);} \
      if(!HASB){ _Pragma("unroll") for(int r=0;r<16;++r)negm[r]=-mhat; asm volatile("":"+v"(negm)); } } \
    _Pragma("unroll") for(int r=0;r<16;++r)P0[r]=__builtin_amdgcn_exp2f(P0[r]); }while(0)
  #define RESC() do{ if(resc){ asm volatile("s_waitcnt lgkmcnt(0)":::"memory"); \
      _Pragma("unroll") for(int d_=0;d_<2;++d_) _Pragma("unroll") for(int r=0;r<16;++r)o[d_][r]*=wsf[crow(r,hi)]; } }while(0)
  f32x16 pA0,pA1,pB0,pB1;
  int sl_prev=0,sl_cur=0,sl_next=SLOTB;
  #define ROT() do{sl_prev=sl_cur;sl_cur=sl_next;sl_next=(sl_next==(NSLOT-1)*SLOTB)?0:sl_next+SLOTB;}while(0)
  DMA_K(2,2*SLOTB);
  if(HASB){ const int n4=(q0+QB-t0*KVBLK)/4; for(int i=tid;i<n4;i+=NW*64){ const f32x4 v=*(const f32x4*)(kbg+t0*KVBLK+4*i); *((lds_f4*)((__attribute__((address_space(3))) char*)shm+LDS_KBIAS)+i)=v; } }
  WAIT_BAR(3);
  if(HASB){ mref=*(const __attribute__((address_space(3))) float*)((const __attribute__((address_space(3))) char*)shm+LDS_KBIAS+(q0-t0*KVBLK+qrel)*4); mhat=mref; }
  { f32x16 ci0=f32x16{},ci1=f32x16{}; CINIT(ci0,ci1,0); qkt(pA0,pA1,Kbase,qr,csel<HASB>(ci0,negm),csel<HASB>(ci1,negm),r32,hi); } asm volatile("s_nop 15\n\ts_nop 7":"+v"(pA0),"+v"(pA1));CMASK(pA0,pA1,0);
  START(pA0,pA1);
  _Pragma("unroll") for(int r=0;r<16;++r)pA1[r]=__builtin_amdgcn_exp2f(pA1[r]);
  WAIT_BAR(0);
  DMA_K(3,0);DMA_V(1,SLOTB);
  ROT();
  kload8(kf,kp0+sl_cur);
  WAIT_BAR(2);
  s16x4 vlo[8],vhi[8]; u32x4 pw0,pw1,pw2,pw3;
  #define PKW(P,B) cvtpk_s(P[B],P[B+1])
  #define PAF(k) __builtin_bit_cast(bf16x8,pw##k)
  #define VFR(i) (bf16x8){vlo[i][0],vlo[i][1],vlo[i][2],vlo[i][3],vhi[i][0],vhi[i][1],vhi[i][2],vhi[i][3]}
  #define PIN(x) asm volatile("":"+v"(x))
  #define MX3(a,b,c) __builtin_fmaxf(__builtin_fmaxf((a),(b)),(c))
  #define GAPA(MF,A0,A1,A2,A3,W0,W1,PW) do{ MF; sacc+=A0; sacc+=A1; sacc+=A2; sacc+=A3; PIN(sacc); W0; W1; PIN(PW); SBAR(); }while(0)
  #define EX(v) __builtin_amdgcn_exp2f(v)
  #define GAPB(MF,X,B,Y) do{ MF; X[B]=EX(X[B]); X[B+1]=EX(X[B+1]); X[B+2]=EX(X[B+2]); X[B+3]=EX(X[B+3]); PIN(X); if(HASB){ Y[B]-=mhat; Y[B+1]-=mhat; Y[B+2]-=mhat; Y[B+3]-=mhat; PIN(Y); } SBAR(); }while(0)
  #define LOADB(Y0,Y1,t) do{ if(HASB){ const __attribute__((address_space(3))) char* kp_=kbl+(t)*256; \
      _Pragma("unroll") for(int g_=0;g_<4;++g_){ const f32x4 a_=*(lds_cf4*)(kp_+g_*32), b_=*(lds_cf4*)(kp_+128+g_*32); \
        _Pragma("unroll") for(int e_=0;e_<4;++e_){ Y0[4*g_+e_]=a_[e_]; Y1[4*g_+e_]=b_[e_]; } } } }while(0)
  #define VRD(i) do{ vlo[i]=vtr(vp_+(((i)>>2)*4096+((i)&3)*1024)); vhi[i]=vtr(vp_+(((i)>>2)*4096+((i)&3)*1024+512)); }while(0)
  #define KRD(G,j) do{ if(G){ kload2(kf,kp0+sl_next,j); SBAR(); } }while(0)
  #define STEP(C0,C1,P0,P1,t,GK,GV,GL) do{ SBAR(); \
    const lds_cptr vp_=vp0+sl_prev; \
    VRD(0); SBAR(); float sacc=(P0[0]+P0[1]); \
    GAPA(C0=__builtin_amdgcn_mfma_f32_32x32x16_bf16(kf[0],qr[0],csel<HASB>(C0,negm),0,0,0), P0[2],P0[3],P0[4],P0[5],     pw0[0]=PKW(P0,0), pw0[1]=PKW(P0,2), pw0); \
    VRD(4); SBAR(); GAPA(C1=__builtin_amdgcn_mfma_f32_32x32x16_bf16(kf[1],qr[0],csel<HASB>(C1,negm),0,0,0), P0[6],P0[7],P0[8],P0[9],     pw0[2]=PKW(P0,4), pw0[3]=PKW(P0,6), pw0); \
    VRD(1); SBAR(); GAPA(C0=__builtin_amdgcn_mfma_f32_32x32x16_bf16(kf[2],qr[1],C0,0,0,0),   P0[10],P0[11],P0[12],P0[13], pw1[0]=PKW(P0,8), pw1[1]=PKW(P0,10), pw1); \
    VRD(5); SBAR(); GAPA(C1=__builtin_amdgcn_mfma_f32_32x32x16_bf16(kf[3],qr[1],C1,0,0,0),   P0[14],P0[15],P1[0],P1[1],   pw1[2]=PKW(P0,12),pw1[3]=PKW(P0,14), pw1); \
    VRD(2); SBAR(); GAPA(C0=__builtin_amdgcn_mfma_f32_32x32x16_bf16(kf[4],qr[2],C0,0,0,0),   P1[2],P1[3],P1[4],P1[5],     pw2[0]=PKW(P1,0), pw2[1]=PKW(P1,2), pw2); \
    VRD(6); SBAR(); GAPA(C1=__builtin_amdgcn_mfma_f32_32x32x16_bf16(kf[5],qr[2],C1,0,0,0),   P1[6],P1[7],P1[8],P1[9],     pw2[2]=PKW(P1,4), pw2[3]=PKW(P1,6), pw2); \
    VRD(3); SBAR(); GAPA(C0=__builtin_amdgcn_mfma_f32_32x32x16_bf16(kf[6],qr[3],C0,0,0,0),   P1[10],P1[11],P1[12],P1[13], pw3[0]=PKW(P1,8), pw3[1]=PKW(P1,10), pw3); \
    VRD(7); SBAR(); GAPA(C1=__builtin_amdgcn_mfma_f32_32x32x16_bf16(kf[7],qr[3],C1,0,0,0),   P1[14],P1[15],0.f,0.f,       pw3[2]=PKW(P1,12),pw3[3]=PKW(P1,14), pw3); \
    l_reg+=sacc; \
    LOADB(P0,P1,(t)+1); \
    if(GK){DMA_K((t)+3,sl_cur);} if(GV){DMA_V((t)+1,sl_next);} \
    CMASK(C0,C1,t); \
    { float a=MX3(C0[0],C0[1],C1[0]),b=MX3(C0[2],C0[3],C1[1]); a=MX3(a,C1[2],C1[3]); \
      _Pragma("unroll") for(int r=4;r<16;r+=4){a=MX3(a,C0[r],C0[r+1]);b=MX3(b,C0[r+2],C0[r+3]);a=MX3(a,C1[r],C1[r+1]);b=MX3(b,C1[r+2],C1[r+3]);} \
      float rm=__builtin_fmaxf(a,b); { auto rr=__builtin_amdgcn_permlane32_swap(__float_as_uint(rm),__float_as_uint(rm),false,false); rm=__builtin_fmaxf(__uint_as_float(rr[0]),__uint_as_float(rr[1])); } \
      resc=false; \
      if(__builtin_expect(__any(rm>(float)THRL),0)){ const float dl=__builtin_fmaxf(rm,0.f); mhat+=dl; \
        _Pragma("unroll") for(int r=0;r<16;++r){C0[r]-=dl;C1[r]-=dl;} \
        if(!HASB){ _Pragma("unroll") for(int r=0;r<16;++r)negm[r]=-mhat; asm volatile("":"+v"(negm)); } \
        const float f=__builtin_amdgcn_exp2f(-dl); l_reg*=f; if(hi==0)wsf[r32]=f; resc=true; } } \
    SBAR(); \
    GAPB(o[0]=__builtin_amdgcn_mfma_f32_32x32x16_bf16(PAF(0),VFR(0),o[0],0,0,0), C0,0,P0); \
    GAPB(o[1]=__builtin_amdgcn_mfma_f32_32x32x16_bf16(PAF(0),VFR(4),o[1],0,0,0), C0,4,P0); \
    KRD(GL,0); GAPB(o[0]=__builtin_amdgcn_mfma_f32_32x32x16_bf16(PAF(1),VFR(1),o[0],0,0,0), C0,8,P0); \
    KRD(GL,1); GAPB(o[1]=__builtin_amdgcn_mfma_f32_32x32x16_bf16(PAF(1),VFR(5),o[1],0,0,0), C0,12,P0); \
    KRD(GL,2); GAPB(o[0]=__builtin_amdgcn_mfma_f32_32x32x16_bf16(PAF(2),VFR(2),o[0],0,0,0), C1,0,P1); \
    KRD(GL,3); GAPB(o[1]=__builtin_amdgcn_mfma_f32_32x32x16_bf16(PAF(2),VFR(6),o[1],0,0,0), C1,4,P1); \
    GAPB(o[0]=__builtin_amdgcn_mfma_f32_32x32x16_bf16(PAF(3),VFR(3),o[0],0,0,0), C1,8,P1); \
    GAPB(o[1]=__builtin_amdgcn_mfma_f32_32x32x16_bf16(PAF(3),VFR(7),o[1],0,0,0), C1,12,P1); \
    }while(0)
  CINIT(pB0,pB1,1);
  int t=1;
  #undef CMASK
  #define CMASK(P0,P1,t) do{}while(0)
  for(;t+5<NT;t+=2){
    STEP(pB0,pB1,pA0,pA1,t,true,true,true);     WAIT_BAR(2); RESC(); ROT();
    STEP(pA0,pA1,pB0,pB1,t+1,true,true,true);   WAIT_BAR(2); RESC(); ROT();
  }
  #undef CMASK
  #define CMASK(P0,P1,t) do{int jb_=(t)-(NT-4); if(jb_>=0)cmask(P0,P1,jb_,qrel,hi);}while(0)
  #define ENDW(tt) do{ if((tt)+3<NT){WAIT_BAR(2);} else if((tt)+2<NT){WAIT_BAR(1);} else {WAIT_BAR(0);} }while(0)
  for(;t+1<NT;t+=2){
    STEP(pB0,pB1,pA0,pA1,t,(t+3<NT),(t+1<NT),(t+1<NT));       ENDW(t);   RESC(); ROT();
    STEP(pA0,pA1,pB0,pB1,t+1,(t+4<NT),(t+2<NT),(t+2<NT));     ENDW(t+1); RESC(); ROT();
  }
  STEP(pB0,pB1,pA0,pA1,NT-1,false,false,false); RESC();
  { float sacc=pB0[0]+pB0[1]; _Pragma("unroll") for(int r=2;r<16;++r)sacc+=pB0[r]; _Pragma("unroll") for(int r=0;r<16;++r)sacc+=pB1[r]; l_reg+=sacc;
    pw0=(u32x4){PKW(pB0,0),PKW(pB0,2),PKW(pB0,4),PKW(pB0,6)};pw1=(u32x4){PKW(pB0,8),PKW(pB0,10),PKW(pB0,12),PKW(pB0,14)};pw2=(u32x4){PKW(pB1,0),PKW(pB1,2),PKW(pB1,4),PKW(pB1,6)};pw3=(u32x4){PKW(pB1,8),PKW(pB1,10),PKW(pB1,12),PKW(pB1,14)};
    SBAR(); pv(o,vb0+sl_cur,PAF(0),PAF(1),PAF(2),PAF(3)); }
  #undef PKW
  #undef PAF
  #undef VFR
  #undef PIN
  #undef MX3
  #undef GAPA
  #undef GAPB
  #undef LOADB
  #undef EX
  #undef VRD
  #undef KRD
  #undef STEP
  #undef ENDW
  {auto rr=__builtin_amdgcn_permlane32_swap(__float_as_uint(l_reg),__float_as_uint(l_reg),false,false);l_reg=__uint_as_float(rr[0])+__uint_as_float(rr[1]);}
  if(hi==0)wsf[32+r32]=l_reg;asm volatile("s_waitcnt lgkmcnt(0)":::"memory");
  float rli[16];
  #pragma unroll
  for(int r=0;r<16;++r)rli[r]=__builtin_amdgcn_rcpf(wsf[32+crow(r,hi)]);
  bf16*Ow=Oc+(rowbase+q0+wid*QBLK)*PO;
  { bf16*stg=(bf16*)(shm+LDS_OST)+wid*2048;
    #pragma unroll
    for(int r=0;r<16;++r){const int orow=crow(r,hi);
      #pragma unroll
      for(int d0=0;d0<2;++d0)stg[orow*64+d0*32+r32]=__float2bfloat16(o[d0][r]*rli[r]);}
    asm volatile("s_waitcnt lgkmcnt(0)":::"memory");
    #pragma unroll
    for(int i=0;i<4;++i){const int row=i*8+(lane>>3),ch=lane&7; const u32x4 v=*(const u32x4*)(stg+row*64+ch*8); ATTN_STORE16(Ow+(long)row*PO+ch*8,v);} }
  asm volatile("s_waitcnt lgkmcnt(0)\n\ts_barrier":::"memory");
  #undef CINIT
  #undef DMA_K
  #undef DMA_V
  #undef CMASK
  #undef START
  #undef RESC
  #undef ROT
}
constexpr int LDS_WS128=LDS_V+NSLOT*2*SLOTB, LDS_OST128=LDS_WS128+NW*64*4, LDS_BYTES128=LDS_OST128+NW*4096;
template<int THRL,bool NODEC> __device__ __forceinline__ void attn_unit128(int b,int qb,const bf16*Qc,const bf16*__restrict__ Kc,const bf16*__restrict__ Vc,bf16*Oc,char*shm,const int wv){ constexpr bool HASB=false; constexpr int t0=0; const float* kbg=nullptr;
  int tid_=wv*64+mk_lane();
  const int tid=tid_,lane=tid&63,r32=lane&31,hi=lane>>5; const int wid=__builtin_amdgcn_readfirstlane(tid>>6);
  const long rowbase=(long)b*SEQ; const int q0=qb*QB;
  const bf16*Qw=Qc+(rowbase+q0+wid*QBLK)*PQ;
  const bf16*Kh=Kc+(rowbase+(long)t0*KVBLK)*PQ,*Vh=Vc+(rowbase+(long)t0*KVBLK)*PQ;
  const unsigned lds0=(unsigned)(uintptr_t)shm;
  float*wsf=(float*)(shm+LDS_WS128)+wid*64;
  const bf16*ksrc=Kh+(long)lane*PQ+wid*8;
  const bf16*vsrc=Vh+(long)(16*(wid&3)+(lane>>2))*PQ+(wid>>2)*32+(lane&3)*8;
  const unsigned kdst=lds0+LDS_K+wid*1024, vdst=lds0+LDS_V+(wid>>2)*4096+(wid&3)*1024;
  #define DMA_K(t,slot) glds16(ksrc+(long)(t)*KVBLK*PQ,(unsigned)__builtin_amdgcn_readfirstlane(kdst+(slot)))
  #define DMA_V(t,slot) do{ glds16(vsrc+(long)(t)*KVBLK*PQ,(unsigned)__builtin_amdgcn_readfirstlane(vdst+2*(slot))); glds16(vsrc+64+(long)(t)*KVBLK*PQ,(unsigned)__builtin_amdgcn_readfirstlane(vdst+8192+2*(slot))); }while(0)
  const int vb0=(int)(lds0+LDS_V)+((lane>>4)&1)*32+(lane&3)*8+(4*hi+((lane&15)>>2))*64;
  const char*Kbase=shm+LDS_K; bf16x8 kf[8];
  const lds_cptr shm3=(lds_cptr)shm; const lds_cptr kp0=shm3+LDS_K+hi*1024+r32*16; const lds_cptr vp0=shm3+LDS_V+((lane>>4)&1)*32+(lane&3)*8+(4*hi+((lane&15)>>2))*64;
  const int NT=(q0+QB)/KVBLK-t0;
  typedef __attribute__((address_space(3))) const f32x4 lds_cf4; typedef __attribute__((address_space(3))) f32x4 lds_f4;
  const __attribute__((address_space(3))) char* kbl=(const __attribute__((address_space(3))) char*)shm+LDS_KBIAS+hi*16;
  if(HASB){ const int n4=(q0+QB-t0*KVBLK)/4; for(int i=tid;i<n4;i+=NW*64){ const f32x4 v=*(const f32x4*)(kbg+t0*KVBLK+4*i); *((lds_f4*)((__attribute__((address_space(3))) char*)shm+LDS_KBIAS)+i)=v; } }
  DMA_K(0,0);DMA_V(0,0);DMA_K(1,SLOTB);
  bf16x8 qr[4];
  #pragma unroll
  for(int d0=0;d0<4;++d0)qr[d0]=*reinterpret_cast<const bf16x8*>(&Qw[(long)r32*PQ+d0*16+hi*8]);
  float mhat=0.f,l_reg=0.f;f32x16 o[4];o[0]=f32x16{};o[1]=f32x16{};o[2]=f32x16{};o[3]=f32x16{};
  const int qrel=wid*QBLK+r32;
  float mref=0.f;
  #define CINIT(C0,C1,t) do{ if(HASB){ const __attribute__((address_space(3))) char* kp_=kbl+(t)*256; \
      _Pragma("unroll") for(int g_=0;g_<4;++g_){ const f32x4 a_=*(lds_cf4*)(kp_+g_*32), b_=*(lds_cf4*)(kp_+128+g_*32); \
        _Pragma("unroll") for(int e_=0;e_<4;++e_){ C0[4*g_+e_]=a_[e_]-mhat; C1[4*g_+e_]=b_[e_]-mhat; } } } \
    }while(0)
  #define CMASK(P0,P1,t) do{int jb_=(t)-(NT-4); if(jb_>=0)cmask(P0,P1,jb_,qrel,hi);}while(0)
  bool resc=false;
  #define START(P0,P1) do{ resc=false; \
    if(!NODEC){ const float rm=rowmax(P0,P1); const float dl=__any(rm>(float)THRL)?__builtin_fmaxf(rm,0.f):0.f; mhat=fadd_s(mhat,dl); \
      _Pragma("unroll") for(int r=0;r<16;++r){P0[r]=fsub_s(P0[r],dl);P1[r]=fsub_s(P1[r],dl);} \
      } \
    _Pragma("unroll") for(int r=0;r<16;++r)P0[r]=__builtin_amdgcn_exp2f(P0[r]); }while(0)
  #define RESC() do{ if(resc){ asm volatile("s_waitcnt lgkmcnt(0)":::"memory"); \
      _Pragma("unroll") for(int d_=0;d_<4;++d_) _Pragma("unroll") for(int r=0;r<16;++r)o[d_][r]*=wsf[crow(r,hi)]; } }while(0)
  f32x16 pA0,pA1,pB0,pB1;
  int sl_prev=0,sl_cur=0,sl_next=SLOTB;
  #define ROT() do{sl_prev=sl_cur;sl_cur=sl_next;sl_next=(sl_next==(NSLOT-1)*SLOTB)?0:sl_next+SLOTB;}while(0)
  DMA_K(2,2*SLOTB);
  WAIT_BAR(4);
  { f32x16 ci0=f32x16{}; asm volatile("":"+v"(ci0)); qkt(pA0,pA1,Kbase,qr,ci0,ci0,r32,hi); } asm volatile("s_nop 15\n\ts_nop 7":"+v"(pA0),"+v"(pA1));CMASK(pA0,pA1,0);
  START(pA0,pA1);
  _Pragma("unroll") for(int r=0;r<16;++r)pA1[r]=__builtin_amdgcn_exp2f(pA1[r]);
  WAIT_BAR(0);
  DMA_K(3,0);DMA_V(1,SLOTB);
  ROT();
  kload8(kf,kp0+sl_cur);
  WAIT_BAR(3);
  s16x4 vlo[4],vhi[4]; u32x4 pw0,pw1,pw2,pw3;
  #define PKW(P,B) cvtpk_s(P[B],P[B+1])
  #define PAF(k) __builtin_bit_cast(bf16x8,pw##k)
  #define VFR(i) (bf16x8){vlo[(i)&3][0],vlo[(i)&3][1],vlo[(i)&3][2],vlo[(i)&3][3],vhi[(i)&3][0],vhi[(i)&3][1],vhi[(i)&3][2],vhi[(i)&3][3]}
  #define PIN(x) asm volatile("":"+v"(x))
  #define MX3(a,b,c) __builtin_fmaxf(__builtin_fmaxf((a),(b)),(c))
  #define GAPA(MF,A0,A1,A2,A3,W0,W1,PW) do{ MF; sacc+=A0; sacc+=A1; sacc+=A2; sacc+=A3; PIN(sacc); W0; W1; PIN(PW); SBAR(); }while(0)
  #define EX(v) __builtin_amdgcn_exp2f(v)
  #define GAPB(MF,X,B,Y) do{ MF; X[B]=EX(X[B]); X[B+1]=EX(X[B+1]); X[B+2]=EX(X[B+2]); X[B+3]=EX(X[B+3]); PIN(X); if(HASB){ Y[B]-=mhat; Y[B+1]-=mhat; Y[B+2]-=mhat; Y[B+3]-=mhat; PIN(Y); } SBAR(); }while(0)
  #define LOADB(Y0,Y1,t) do{ if(HASB){ const __attribute__((address_space(3))) char* kp_=kbl+(t)*256; \
      _Pragma("unroll") for(int g_=0;g_<4;++g_){ const f32x4 a_=*(lds_cf4*)(kp_+g_*32), b_=*(lds_cf4*)(kp_+128+g_*32); \
        _Pragma("unroll") for(int e_=0;e_<4;++e_){ Y0[4*g_+e_]=a_[e_]; Y1[4*g_+e_]=b_[e_]; } } } }while(0)
  #define VOFF(j) ((((j)>>3)*8192)+((((j)&7)&1)*4096)+((((j)&7)>>1)*1024))
  #define VRDJ(j) do{ vlo[(j)&3]=vtr(vp_+VOFF(j)); vhi[(j)&3]=vtr(vp_+VOFF(j)+512); SBAR(); }while(0)
  #define GAPC(MF,Y,B) do{ MF; SBAR(); }while(0)
  #define KRD(G,j) do{ if(G){ kload2(kf,kp0+sl_next,j); SBAR(); } }while(0)
  #define STEP(C0,C1,P0,P1,t,GK,GV,GL) do{ SBAR(); \
    const lds_cptr vp_=vp0+2*sl_prev; \
    VRDJ(0); float sacc=(P0[0]+P0[1]); \
    GAPA(C0=__builtin_amdgcn_mfma_f32_32x32x16_bf16(kf[0],qr[0],zero16,0,0,0), P0[2],P0[3],P0[4],P0[5],     pw0[0]=PKW(P0,0), pw0[1]=PKW(P0,2), pw0); \
    VRDJ(1); GAPA(C1=__builtin_amdgcn_mfma_f32_32x32x16_bf16(kf[1],qr[0],zero16,0,0,0), P0[6],P0[7],P0[8],P0[9],     pw0[2]=PKW(P0,4), pw0[3]=PKW(P0,6), pw0); \
    VRDJ(2); GAPA(C0=__builtin_amdgcn_mfma_f32_32x32x16_bf16(kf[2],qr[1],C0,0,0,0),   P0[10],P0[11],P0[12],P0[13], pw1[0]=PKW(P0,8), pw1[1]=PKW(P0,10), pw1); \
    VRDJ(3); GAPA(C1=__builtin_amdgcn_mfma_f32_32x32x16_bf16(kf[3],qr[1],C1,0,0,0),   P0[14],P0[15],P1[0],P1[1],   pw1[2]=PKW(P0,12),pw1[3]=PKW(P0,14), pw1); \
    GAPA(C0=__builtin_amdgcn_mfma_f32_32x32x16_bf16(kf[4],qr[2],C0,0,0,0),   P1[2],P1[3],P1[4],P1[5],     pw2[0]=PKW(P1,0), pw2[1]=PKW(P1,2), pw2); \
    GAPA(C1=__builtin_amdgcn_mfma_f32_32x32x16_bf16(kf[5],qr[2],C1,0,0,0),   P1[6],P1[7],P1[8],P1[9],     pw2[2]=PKW(P1,4), pw2[3]=PKW(P1,6), pw2); \
    GAPA(C0=__builtin_amdgcn_mfma_f32_32x32x16_bf16(kf[6],qr[3],C0,0,0,0),   P1[10],P1[11],P1[12],P1[13], pw3[0]=PKW(P1,8), pw3[1]=PKW(P1,10), pw3); \
    GAPA(C1=__builtin_amdgcn_mfma_f32_32x32x16_bf16(kf[7],qr[3],C1,0,0,0),   P1[14],P1[15],0.f,0.f,       pw3[2]=PKW(P1,12),pw3[3]=PKW(P1,14), pw3); \
    l_reg+=sacc; \
    if(!NODEC){ if(__builtin_expect(__any(mhat!=0.f),0)){ _Pragma("unroll") for(int r=0;r<16;++r){C0[r]-=mhat;C1[r]-=mhat;} } } \
    if(GK){DMA_K((t)+3,sl_cur);} if(GV){DMA_V((t)+1,sl_next);} \
    CMASK(C0,C1,t); \
    resc=false; if(!NODEC){ float a=MX3(C0[0],C0[1],C1[0]),b=MX3(C0[2],C0[3],C1[1]); a=MX3(a,C1[2],C1[3]); \
      _Pragma("unroll") for(int r=4;r<16;r+=4){a=MX3(a,C0[r],C0[r+1]);b=MX3(b,C0[r+2],C0[r+3]);a=MX3(a,C1[r],C1[r+1]);b=MX3(b,C1[r+2],C1[r+3]);} \
      float rm=__builtin_fmaxf(a,b); { auto rr=__builtin_amdgcn_permlane32_swap(__float_as_uint(rm),__float_as_uint(rm),false,false); rm=__builtin_fmaxf(__uint_as_float(rr[0]),__uint_as_float(rr[1])); } \
      resc=false; \
      if(__builtin_expect(__any(rm>(float)THRL),0)){ const float dl=__builtin_fmaxf(rm,0.f); mhat+=dl; \
        _Pragma("unroll") for(int r=0;r<16;++r){C0[r]-=dl;C1[r]-=dl;} \
        const float f=__builtin_amdgcn_exp2f(-dl); l_reg*=f; if(hi==0)wsf[r32]=f; resc=true; } } \
    SBAR(); \
    GAPB(o[0]=__builtin_amdgcn_mfma_f32_32x32x16_bf16(PAF(0),VFR(0),o[0],0,0,0), C0,0,P0); VRDJ(4); \
    GAPB(o[1]=__builtin_amdgcn_mfma_f32_32x32x16_bf16(PAF(0),VFR(1),o[1],0,0,0), C0,4,P0); VRDJ(5); \
    GAPB(o[0]=__builtin_amdgcn_mfma_f32_32x32x16_bf16(PAF(1),VFR(2),o[0],0,0,0), C0,8,P0); VRDJ(6); \
    GAPB(o[1]=__builtin_amdgcn_mfma_f32_32x32x16_bf16(PAF(1),VFR(3),o[1],0,0,0), C0,12,P0); VRDJ(7); \
    GAPB(o[0]=__builtin_amdgcn_mfma_f32_32x32x16_bf16(PAF(2),VFR(4),o[0],0,0,0), C1,0,P1); VRDJ(8); \
    GAPB(o[1]=__builtin_amdgcn_mfma_f32_32x32x16_bf16(PAF(2),VFR(5),o[1],0,0,0), C1,4,P1); VRDJ(9); \
    GAPB(o[0]=__builtin_amdgcn_mfma_f32_32x32x16_bf16(PAF(3),VFR(6),o[0],0,0,0), C1,8,P1); VRDJ(10); \
    GAPB(o[1]=__builtin_amdgcn_mfma_f32_32x32x16_bf16(PAF(3),VFR(7),o[1],0,0,0), C1,12,P1); VRDJ(11); \
    GAPC(o[2]=__builtin_amdgcn_mfma_f32_32x32x16_bf16(PAF(0),VFR(8),o[2],0,0,0), P0,0); VRDJ(12); \
    GAPC(o[3]=__builtin_amdgcn_mfma_f32_32x32x16_bf16(PAF(0),VFR(9),o[3],0,0,0), P0,4); VRDJ(13); \
    KRD(GL,0); GAPC(o[2]=__builtin_amdgcn_mfma_f32_32x32x16_bf16(PAF(1),VFR(10),o[2],0,0,0), P0,8); VRDJ(14); \
    KRD(GL,1); GAPC(o[3]=__builtin_amdgcn_mfma_f32_32x32x16_bf16(PAF(1),VFR(11),o[3],0,0,0), P0,12); VRDJ(15); \
    KRD(GL,2); GAPC(o[2]=__builtin_amdgcn_mfma_f32_32x32x16_bf16(PAF(2),VFR(12),o[2],0,0,0), P1,0); \
    KRD(GL,3); GAPC(o[3]=__builtin_amdgcn_mfma_f32_32x32x16_bf16(PAF(2),VFR(13),o[3],0,0,0), P1,4); \
    GAPC(o[2]=__builtin_amdgcn_mfma_f32_32x32x16_bf16(PAF(3),VFR(14),o[2],0,0,0), P1,8); \
    GAPC(o[3]=__builtin_amdgcn_mfma_f32_32x32x16_bf16(PAF(3),VFR(15),o[3],0,0,0), P1,12); \
    }while(0)
  const f32x16 zero16=f32x16{};
  int t=1;
  #undef CMASK
  #define CMASK(P0,P1,t) do{}while(0)
  for(;t+5<NT;t+=2){
    STEP(pB0,pB1,pA0,pA1,t,true,true,true);     WAIT_BAR(3); RESC(); ROT();
    STEP(pA0,pA1,pB0,pB1,t+1,true,true,true);   WAIT_BAR(3); RESC(); ROT();
  }
  #undef CMASK
  #define CMASK(P0,P1,t) do{int jb_=(t)-(NT-4); if(jb_>=0)cmask(P0,P1,jb_,qrel,hi);}while(0)
  #define ENDW(tt) do{ if((tt)+3<NT){WAIT_BAR(3);} else if((tt)+2<NT){WAIT_BAR(2);} else {WAIT_BAR(0);} }while(0)
  for(;t+1<NT;t+=2){
    STEP(pB0,pB1,pA0,pA1,t,(t+3<NT),(t+1<NT),(t+1<NT));       ENDW(t);   RESC(); ROT();
    STEP(pA0,pA1,pB0,pB1,t+1,(t+4<NT),(t+2<NT),(t+2<NT));     ENDW(t+1); RESC(); ROT();
  }
  STEP(pB0,pB1,pA0,pA1,NT-1,false,false,false); RESC();
  { float sacc=pB0[0]+pB0[1]; _Pragma("unroll") for(int r=2;r<16;++r)sacc+=pB0[r]; _Pragma("unroll") for(int r=0;r<16;++r)sacc+=pB1[r]; l_reg+=sacc;
    pw0=(u32x4){PKW(pB0,0),PKW(pB0,2),PKW(pB0,4),PKW(pB0,6)};pw1=(u32x4){PKW(pB0,8),PKW(pB0,10),PKW(pB0,12),PKW(pB0,14)};pw2=(u32x4){PKW(pB1,0),PKW(pB1,2),PKW(pB1,4),PKW(pB1,6)};pw3=(u32x4){PKW(pB1,8),PKW(pB1,10),PKW(pB1,12),PKW(pB1,14)};
    SBAR(); pv(o,vb0+2*sl_cur,PAF(0),PAF(1),PAF(2),PAF(3)); pv(o+2,vb0+2*sl_cur+8192,PAF(0),PAF(1),PAF(2),PAF(3)); }
  #undef PKW
  #undef PAF
  #undef VFR
  #undef PIN
  #undef MX3
  #undef GAPA
  #undef GAPB
  #undef LOADB
  #undef EX
  #undef VRDJ
  #undef VOFF
  #undef GAPC
  #undef KRD
  #undef STEP
  #undef ENDW
  {auto rr=__builtin_amdgcn_permlane32_swap(__float_as_uint(l_reg),__float_as_uint(l_reg),false,false);l_reg=__uint_as_float(rr[0])+__uint_as_float(rr[1]);}
  if(hi==0)wsf[32+r32]=l_reg;asm volatile("s_waitcnt lgkmcnt(0)":::"memory");
  float rli[16];
  #pragma unroll
  for(int r=0;r<16;++r)rli[r]=__builtin_amdgcn_rcpf(wsf[32+crow(r,hi)]);
  bf16*Ow=Oc+(rowbase+q0+wid*QBLK)*PO;
  { bf16*stg=(bf16*)(shm+LDS_OST128)+wid*2048;
    #pragma unroll
    for(int hf=0;hf<2;++hf){
      #pragma unroll
      for(int r=0;r<16;++r){const int orow=crow(r,hi);
        #pragma unroll
        for(int d0=0;d0<2;++d0)stg[orow*64+d0*32+r32]=__float2bfloat16(o[2*hf+d0][r]*rli[r]);}
      asm volatile("s_waitcnt lgkmcnt(0)":::"memory");
      #pragma unroll
      for(int i=0;i<4;++i){const int row=i*8+(lane>>3),ch=lane&7; const u32x4 v=*(const u32x4*)(stg+row*64+ch*8); ATTN_STORE16(Ow+(long)row*PO+hf*64+ch*8,v);}
      asm volatile("s_waitcnt lgkmcnt(0)":::"memory"); } }
  asm volatile("s_waitcnt lgkmcnt(0)\n\ts_barrier":::"memory");
  #undef CINIT
  #undef DMA_K
  #undef DMA_V
  #undef CMASK
  #undef START
  #undef RESC
  #undef ROT
}
constexpr int ATTN_LDS_BYTES=(LDS_BYTES>LDS_BYTES128)?LDS_BYTES:LDS_BYTES128;
#undef SBAR
#undef WAIT_BAR
}

namespace xattn {
using pg8::bf16_t; using pg8::bf16x8; using pg8::u32x4; using pg8::f32x4;
using f32x16 = __attribute__((ext_vector_type(16))) float;
#define XLAS __attribute__((address_space(3)))
constexpr int XB0 = 0, XB1 = 32768, X_WSF = 65536, X_OST = X_WSF + 2048, X_LDS_BYTES = X_OST + 8 * 4096;
__device__ __forceinline__ int crow(int r, int hi) { return (r & 3) + 8 * (r >> 2) + 4 * hi; }
__device__ __forceinline__ unsigned pk(float lo, float hi) { return pg8::cvt_pk_bf16(lo, hi); }
__device__ __forceinline__ void unit(int b, int h, int qblk, const bf16_t* __restrict__ CQ, const bf16_t* __restrict__ CK, const bf16_t* __restrict__ CVT, bf16_t* __restrict__ CO, XLAS unsigned char* lds, const int wv) {
    const int tid = wv * 64 + mk_lane(), lane = tid & 63, r32 = lane & 31, hi = lane >> 5; const int wid = __builtin_amdgcn_readfirstlane(tid >> 6);
    const size_t qrow0 = (size_t)b * 4096 + (size_t)qblk * 256 + wid * 32;
    const bf16_t* Qw = CQ + (qrow0 + r32) * 1024 + h * 256 + hi * 8;
    const bf16_t* Kg = CK + ((size_t)b * 256 + lane) * 1024 + h * 256 + wid * 8;
    const bf16_t* Vg = CVT + ((size_t)h * 256 + lane) * 2048 + (size_t)b * 256 + wid * 8;
    u32x4 st[4];
#define X_LOADK(dc) do { _Pragma("unroll") for (int i_ = 0; i_ < 4; ++i_) st[i_] = *(const u32x4*)(Kg + (dc) * 64 + (size_t)i_ * 64 * 1024); } while (0)
#define X_LOADV(c)  do { _Pragma("unroll") for (int i_ = 0; i_ < 4; ++i_) st[i_] = *(const u32x4*)(Vg + (size_t)(c) * 64 * 2048 + i_ * 64); } while (0)
#define X_STOREK(buf) do { _Pragma("unroll") for (int i_ = 0; i_ < 4; ++i_) *(XLAS u32x4*)(lds + (buf) + wid * 4096 + (64 * i_ + lane) * 16) = st[i_]; } while (0)
#define X_STOREV(buf) do { _Pragma("unroll") for (int i_ = 0; i_ < 4; ++i_) *(XLAS u32x4*)(lds + (buf) + (wid + 8 * i_) * 1024 + lane * 16) = st[i_]; } while (0)
    const int kswz = (r32 & ~12) | ((r32 & 4) << 1) | ((r32 & 8) >> 1);
    const int koff = hi * 4096 + kswz * 16;
    const int voff = hi * 1024 + r32 * 16;
    f32x16 s[8];
#pragma unroll
    for (int kt = 0; kt < 8; ++kt) s[kt] = f32x16{};
    X_LOADK(0);
    bf16x8 qfa[4][4];
#pragma unroll
    for (int dc = 0; dc < 4; ++dc)
#pragma unroll
        for (int ks = 0; ks < 4; ++ks) qfa[dc][ks] = *(const bf16x8*)(Qw + dc * 64 + ks * 16);
    X_STOREK(XB0);
    __syncthreads();
#pragma unroll
    for (int dc = 0; dc < 4; ++dc) {
        const int buf = (dc & 1) ? XB1 : XB0, nbuf = (dc & 1) ? XB0 : XB1;
        if (dc < 3) X_LOADK(dc + 1); else X_LOADV(0);
#pragma unroll
        for (int kt = 0; kt < 8; ++kt)
#pragma unroll
            for (int ks = 0; ks < 4; ++ks) {
                const bf16x8 kf = *(const XLAS bf16x8*)(lds + buf + koff + kt * 512 + ks * 8192);
                s[kt] = __builtin_amdgcn_mfma_f32_32x32x16_bf16(kf, qfa[dc][ks], s[kt], 0, 0, 0);
            }
        if (dc < 3) X_STOREK(nbuf); else X_STOREV(nbuf);
        __syncthreads();
    }
    float mx = s[0][0];
#pragma unroll
    for (int kt = 0; kt < 8; ++kt)
#pragma unroll
        for (int r = 0; r < 16; ++r) mx = fmaxf(mx, s[kt][r]);
    mx = fmaxf(mx, __shfl_xor(mx, 32));
    float l = 0.f;
#pragma unroll
    for (int kt = 0; kt < 8; ++kt)
#pragma unroll
        for (int r = 0; r < 16; ++r) { const float p = __builtin_amdgcn_exp2f(s[kt][r] - mx); s[kt][r] = p; l += p; }
    l += __shfl_xor(l, 32);
    u32x4 pw[16];
#pragma unroll
    for (int kt = 0; kt < 8; ++kt)
#pragma unroll
        for (int j2 = 0; j2 < 2; ++j2)
            pw[2 * kt + j2] = (u32x4){pk(s[kt][8 * j2 + 0], s[kt][8 * j2 + 1]), pk(s[kt][8 * j2 + 2], s[kt][8 * j2 + 3]), pk(s[kt][8 * j2 + 4], s[kt][8 * j2 + 5]), pk(s[kt][8 * j2 + 6], s[kt][8 * j2 + 7])};
    XLAS float* wsf = (XLAS float*)(lds + X_WSF) + wid * 64;
    if (hi == 0) wsf[r32] = l;
    asm volatile("s_waitcnt lgkmcnt(0)" ::: "memory");
    float rli[16];
#pragma unroll
    for (int r = 0; r < 16; ++r) rli[r] = __builtin_amdgcn_rcpf(wsf[crow(r, hi)]);
    XLAS bf16_t* stg = (XLAS bf16_t*)(lds + X_OST) + wid * 2048;
    bf16_t* Ow = CO + qrow0 * 1024 + h * 256;
#pragma unroll
    for (int c = 0; c < 4; ++c) {
        const int buf = (c & 1) ? XB1 : XB0, nbuf = (c & 1) ? XB0 : XB1;
        if (c < 3) X_LOADV(c + 1);
        f32x16 o[2]; o[0] = f32x16{}; o[1] = f32x16{};
#pragma unroll
        for (int j = 0; j < 16; ++j)
#pragma unroll
            for (int dt = 0; dt < 2; ++dt) {
                const bf16x8 vf = *(const XLAS bf16x8*)(lds + buf + voff + dt * 512 + j * 2048);
                o[dt] = __builtin_amdgcn_mfma_f32_32x32x16_bf16(__builtin_bit_cast(bf16x8, pw[j]), vf, o[dt], 0, 0, 0);
            }
#pragma unroll
        for (int r = 0; r < 16; ++r) { const int orow = crow(r, hi);
#pragma unroll
            for (int dt = 0; dt < 2; ++dt) { const unsigned w = pk(o[dt][r] * rli[r], 0.f); stg[orow * 64 + dt * 32 + r32] = (bf16_t)(w & 0xffffu); } }
        asm volatile("s_waitcnt lgkmcnt(0)" ::: "memory");
#pragma unroll
        for (int i = 0; i < 4; ++i) { const int row = i * 8 + (lane >> 3), ch = lane & 7; const u32x4 v = *(const XLAS u32x4*)(stg + row * 64 + ch * 8); *(u32x4*)(Ow + (size_t)row * 1024 + c * 64 + ch * 8) = v; }
        asm volatile("s_waitcnt lgkmcnt(0)" ::: "memory");
        if (c < 3) X_STOREV(nbuf);
        __syncthreads();
    }
#undef X_LOADK
#undef X_LOADV
#undef X_STOREK
#undef X_STOREV
}
}

#ifndef MK_PER_PHASE
#define MK_PER_PHASE 0
#endif
constexpr int NWAVES = 8;
constexpr int BATCH = 8, SEQ = 4096, D = 1024, M = BATCH * SEQ, FF = 4096, NMEM = 256, MM = BATCH * NMEM, INW = 3080, NPROJ = 3072, NATT = 1536;
constexpr float EPS = 1e-6f, SUBLN_EPS = 1e-5f;
constexpr int N_PHASES = 11;

constexpr size_t MiB = 1u << 20;
constexpr size_t WS_ROPE = 0;
constexpr size_t WS_LOGF = 1 * MiB;
constexpr size_t WS_KB   = 2 * MiB;
constexpr size_t WS_NRM  = 3 * MiB;
constexpr size_t WS_BAR  = 3 * MiB + 65536;
constexpr size_t WS_SS1  = 4 * MiB, WS_SS2 = 6 * MiB, WS_SS3 = 8 * MiB;
constexpr size_t WS_WIN = 10 * MiB, WS_WOUT = 16 * MiB, WS_WCQ = 18 * MiB, WS_WCKV = 20 * MiB, WS_WCO = 24 * MiB, WS_WUP = 26 * MiB, WS_WDN = 34 * MiB;
constexpr size_t WS_MEMN = 42 * MiB, WS_CK = 46 * MiB, WS_CVT = 50 * MiB;
constexpr size_t WS_SA = 56 * MiB;
constexpr size_t WS_SB = 120 * MiB;
constexpr size_t WS_PROJ = 184 * MiB;
constexpr size_t WS_ATT = 376 * MiB;
constexpr size_t WS_ZH = 184 * MiB;
constexpr size_t WS_END = 472 * MiB;
static_assert(WS_ZH + (size_t)M * FF * 2 <= WS_END && WS_ATT + (size_t)M * NATT * 2 <= WS_END && WS_PROJ + (size_t)M * NPROJ * 2 <= WS_ATT, "d_ws map");

constexpr int RING_BYTES = 131072, LDS_BYTES = 147456;
static_assert(attn_body::ATTN_LDS_BYTES <= RING_BYTES && xattn::X_LDS_BYTES <= RING_BYTES && pg8::STAGE_BYTES <= RING_BYTES, "LDS map");

#define LAS __attribute__((address_space(3)))
typedef unsigned short bf16;
typedef unsigned v4u __attribute__((ext_vector_type(4)));
typedef float f32x4 __attribute__((ext_vector_type(4)));
#define LDS_WAIT() asm volatile("s_waitcnt lgkmcnt(0)" ::: "memory")
__device__ __forceinline__ unsigned f2bf(float f) { unsigned u = __builtin_bit_cast(unsigned, f); return (u + 0x7fffu + ((u >> 16) & 1u)) >> 16; }
__device__ __forceinline__ unsigned pk2(float lo, float hi) { return f2bf(lo) | (f2bf(hi) << 16); }
__device__ __forceinline__ float bflo(unsigned w) { return __builtin_bit_cast(float, w << 16); }
__device__ __forceinline__ float bfhi(unsigned w) { return __builtin_bit_cast(float, w & 0xffff0000u); }
__device__ __forceinline__ float wave_sum(float v) {
#pragma unroll
    for (int o = 1; o < 64; o <<= 1) v += __shfl_xor(v, o);
    return v;
}

#define XB_TMO      128
#define XB_XCNT(j)  (256  + 64 * (j))
#define XB_XSUB(j)  (1280 + 64 * (j))
#define XB_XGEN(j)  (2304 + 64 * (j))
#define XB_TOP      3328
#define XB_TOPGEN   3392
#define XCD_BAR_WORDS 3456
#define XB_SPIN_CAP (1u << 18)

__device__ __forceinline__ unsigned xb_ld(unsigned* p)              { return __hip_atomic_load(p, __ATOMIC_RELAXED, __HIP_MEMORY_SCOPE_AGENT); }
__device__ __forceinline__ unsigned xb_add(unsigned* p, unsigned v) { return __hip_atomic_fetch_add(p, v, __ATOMIC_RELAXED, __HIP_MEMORY_SCOPE_AGENT); }
__device__ __forceinline__ unsigned xb_xcc_id() { return (unsigned)__builtin_amdgcn_s_getreg((3 << 11) | 20) & 0xFu; }
#define XB_SPIN(cond, bar) do { unsigned _sp = 0; while (cond) { __builtin_amdgcn_s_sleep(1); \
    if ((++_sp & 255u) == 0u) { if (xb_ld(&(bar)[XB_TMO])) break; if (_sp > XB_SPIN_CAP) { atomicAdd(&(bar)[XB_TMO], 1u); break; } } } } while (0)

struct XcdBarrier {
    unsigned* bar; unsigned x;
    volatile LAS unsigned* st;
};

__device__ __forceinline__ XcdBarrier xcd_barrier_post(unsigned* bar, volatile LAS unsigned* st, bool leader) {
    XcdBarrier b; b.bar = bar; b.x = xb_xcc_id(); b.st = st;
    if (leader) (void)xb_add(&bar[XB_XCNT(b.x)], 1u);
    return b;
}
__device__ __forceinline__ void xcd_barrier_complete(unsigned* bar, unsigned x, unsigned& nloc, unsigned& nx) {
    const unsigned G = gridDim.x * gridDim.y * gridDim.z;
    unsigned sum, cnt, mine, sp = 0u;
    for (;;) {
        sum = 0u; cnt = 0u; mine = 0u;
#pragma unroll
        for (unsigned j = 0; j < 16; ++j) { const unsigned c = xb_ld(&bar[XB_XCNT(j)]); sum += c; cnt += (c > 0u) ? 1u : 0u; mine = (j == x) ? c : mine; }
        if (sum == G) break;
        __builtin_amdgcn_s_sleep(1);
        if ((++sp & 255u) == 0u) { if (xb_ld(&bar[XB_TMO])) break; if (sp > XB_SPIN_CAP) { atomicAdd(&bar[XB_TMO], 1u); break; } }
    }
    nloc = mine > 0u ? mine : 1u; nx = cnt > 0u ? cnt : 1u;
}

__device__ __forceinline__ void xcd_barrier(const XcdBarrier& b, bool leader) {
    asm volatile("s_waitcnt vmcnt(0)" ::: "memory");
    __syncthreads();
    if (leader) {
        unsigned* bar = b.bar;
        __builtin_amdgcn_s_waitcnt(0);
        unsigned nloc = b.st[0], nx = b.st[1];
        if (nloc == 0u) { xcd_barrier_complete(bar, b.x, nloc, nx); b.st[0] = nloc; b.st[1] = nx; }
        const unsigned old = xb_add(&bar[XB_XSUB(b.x)], 1u);
        const unsigned gen = old / nloc;
        if (old + 1u == (gen + 1u) * nloc) {
            __builtin_amdgcn_fence(__ATOMIC_RELEASE, "agent");
            asm volatile("s_waitcnt vmcnt(0)" ::: "memory");
            const unsigned og = xb_add(&bar[XB_TOP], 1u);
            const unsigned tg = og / nx;
            if (og + 1u == (tg + 1u) * nx) xb_add(&bar[XB_TOPGEN], 1u);
            else XB_SPIN(xb_ld(&bar[XB_TOPGEN]) == tg, bar);
            __builtin_amdgcn_fence(__ATOMIC_ACQUIRE, "agent");
            xb_add(&bar[XB_XGEN(b.x)], 1u);
            asm volatile("s_waitcnt vmcnt(0)" ::: "memory");
        } else {
            XB_SPIN(xb_ld(&bar[XB_XGEN(b.x)]) == gen, bar);
            __builtin_amdgcn_fence(__ATOMIC_ACQUIRE, "agent");
            asm volatile("s_waitcnt vmcnt(0)" ::: "memory");
        }
    }
    __syncthreads();
}

struct Params { const float* in[21]; float* out; unsigned char* ws; int ph_lo, ph_hi; };
enum { I_X = 0, I_MEM, I_GMIX, I_WIN, I_BF, I_LQ1, I_LK1, I_LQ2, I_LK2, I_GSUB, I_GFOX, I_WOUT, I_GCROSS, I_GMEM, I_WCQ, I_WCKV, I_WCO, I_GMLP, I_WUP, I_WDN, I_GFIN };

__device__ __forceinline__ void p0_transpose_item(const float* W, int K, int ldw, int nblk, bf16* WT, LAS float* scr, int item, int lane, const float* gk = nullptr  ) {
    const int kb = item / nblk, nb = item % nblk, k0 = 64 * kb, n0 = 32 * nb;
    { f32x4 v[8]; float gg[8];
#pragma unroll
        for (int it = 0; it < 8; ++it) { const int kk = 8 * it + (lane >> 3); v[it] = *(const f32x4*)(W + (size_t)(k0 + kk) * ldw + n0 + 4 * (lane & 7)); gg[it] = gk ? gk[k0 + kk] : 1.f; }
#pragma unroll
        for (int it = 0; it < 8; ++it) { const int kk = 8 * it + (lane >> 3); LAS float* d = scr + kk * 33 + 4 * (lane & 7); d[0] = v[it].x * gg[it]; d[1] = v[it].y * gg[it]; d[2] = v[it].z * gg[it]; d[3] = v[it].w * gg[it]; } }
    LDS_WAIT(); asm volatile("" ::: "memory");
    const int c = lane & 7;
#pragma unroll
    for (int j = 0; j < 4; ++j) { const int n = (lane >> 3) + 8 * j; const LAS float* s = scr + (8 * c) * 33 + n;
        v4u o; o.x = pk2(s[0 * 33], s[1 * 33]); o.y = pk2(s[2 * 33], s[3 * 33]); o.z = pk2(s[4 * 33], s[5 * 33]); o.w = pk2(s[6 * 33], s[7 * 33]);
        *(v4u*)(WT + (size_t)(n0 + n) * K + k0 + 8 * c) = o; }
    LDS_WAIT(); asm volatile("" ::: "memory");
}

__device__ __forceinline__ void rms_row(const float* xrow, const f32x4 (&gq)[4], bf16* orow, int lane, f32x4 (&v)[4]) {
    const f32x4* xr = (const f32x4*)xrow + lane; float s = 0.f;
#pragma unroll
    for (int j = 0; j < 4; ++j) { v[j] = xr[64 * j]; s += (v[j].x * v[j].x + v[j].y * v[j].y) + (v[j].z * v[j].z + v[j].w * v[j].w); }
    const float rstd = 1.0f / sqrtf(wave_sum(s) * (1.f / 1024.f) + EPS);
    unsigned long long* o8 = (unsigned long long*)orow + lane;
#pragma unroll
    for (int j = 0; j < 4; ++j) { v[j] = v[j] * rstd * gq[j]; o8[64 * j] = (unsigned long long)pk2(v[j].x, v[j].y) | ((unsigned long long)pk2(v[j].z, v[j].w) << 32); }
}

template <class Sched> __device__ __forceinline__ void build_rstd_tables(LAS unsigned char* lds, const Sched& S, const float* sspart, float eps, int wave) {
    const int lane = mk_lane(), tid = wave * 64 + lane;
    LAS int* pml = (LAS int*)(lds + RING_BYTES + 1536); LAS float* tab = (LAS float*)(lds + RING_BYTES + 2048);
    if (tid == 0) { int n = 0; pg8::Unit u; for (int i = 0; S.next(i, u); ++i) { bool f = false; for (int j = 0; j < n; ++j) f |= (pml[j] == u.pm); if (!f && n < 8) pml[n++] = u.pm; } pml[8] = n; }
    __syncthreads();
    const int n = pml[8];
    for (int idx = tid; idx < n * 256; idx += NWAVES * 64) tab[idx] = pg8::row_rstd(sspart, pml[idx >> 8] * 256 + (idx & 255), eps);
    __syncthreads();
}
__global__ void __launch_bounds__(NWAVES * 64, 2) mk_fwd(Params P) {
    extern __shared__ __attribute__((aligned(16))) unsigned char lds_raw[];
    LAS unsigned char* lds = (LAS unsigned char*)lds_raw;
    const int wave = __builtin_amdgcn_readfirstlane((int)threadIdx.x >> 6);
#define LANE_TID const int lane = mk_lane(), tid = wave * 64 + lane
    const int G = gridDim.x; const int bx = blockIdx.x; const int vcu = (G % 8 == 0) ? (bx % 8) * (G / 8) + bx / 8 : bx;
    const int gw = vcu * NWAVES + wave, NGW = G * NWAVES;
    unsigned char* const ws = P.ws;
#define ROPE ((float*)(P.ws + WS_ROPE))
#define LOGF ((float*)(P.ws + WS_LOGF))
#define KBIAS ((float*)(P.ws + WS_KB))
#define NRM ((float*)(P.ws + WS_NRM))
#define SS1 ((float*)(P.ws + WS_SS1))
#define SS2 ((float*)(P.ws + WS_SS2))
#define SS3 ((float*)(P.ws + WS_SS3))
#define Win_t ((bf16*)(P.ws + WS_WIN))
#define Wout_t ((bf16*)(P.ws + WS_WOUT))
#define Wcq_t ((bf16*)(P.ws + WS_WCQ))
#define Wckv_t ((bf16*)(P.ws + WS_WCKV))
#define Wco_t ((bf16*)(P.ws + WS_WCO))
#define Wup_t ((bf16*)(P.ws + WS_WUP))
#define Wdn_t ((bf16*)(P.ws + WS_WDN))
#define MEMN ((bf16*)(P.ws + WS_MEMN))
#define CKb ((bf16*)(P.ws + WS_CK))
#define CVT ((bf16*)(P.ws + WS_CVT))
#define XN ((bf16*)(P.ws + WS_SB))
#define MIXA ((bf16*)(P.ws + WS_SA))
#define CQ ((bf16*)(P.ws + WS_SA))
#define H2B ((bf16*)(P.ws + WS_SA))
#define H1B ((bf16*)(P.ws + WS_SB))
#define CO ((bf16*)(P.ws + WS_PROJ))
#define PROJ ((bf16*)(P.ws + WS_PROJ))
#define ATT ((bf16*)(P.ws + WS_ATT))
#define ZH ((bf16*)(P.ws + WS_ZH))
    const int lo = P.ph_lo, hi_ph = P.ph_hi;
    volatile LAS unsigned* xst = (volatile LAS unsigned*)(lds + RING_BYTES + 1024);
    { const int l0 = mk_lane(); if (wave == 0 && l0 < 2) xst[l0] = 0u; }
    __syncthreads();
    XcdBarrier bar; bar.bar = (unsigned*)(ws + WS_BAR); bar.x = 0; bar.st = xst;
    if (hi_ph - lo > 1) bar = xcd_barrier_post((unsigned*)(ws + WS_BAR), xst, wave == 0 && mk_lane() == 0);
    if (lo < 0) cg::this_grid().sync();
#define IN(k) (lo <= (k) && (k) < hi_ph)
#ifndef MK_MASK
#define MK_MASK 0x7ff
#endif
#ifndef MK_ATT_MASK
#define MK_ATT_MASK 3
#endif
#ifndef MK_REP_MASK
#define MK_REP_MASK 0
#endif
#define PH(k) (IN(k) && ((MK_MASK >> (k)) & 1))
#define REPS(k) for (int rep_ = 0; rep_ < (((MK_REP_MASK) >> (k)) & 1) + 1; ++rep_)
#define SEAM(k) do { if (IN(k) && IN((k) + 1)) { xcd_barrier(bar, wave == 0 && mk_lane() == 0); } } while (0)

    if (PH(0)) REPS(0) {
        LANE_TID;
        {
            const float* win = P.in[I_WIN];
            for (int k = tid; k < 1024; k += NWAVES * 64) { const f32x4 a = *(const f32x4*)(win + (size_t)k * INW + 3072), b = *(const f32x4*)(win + (size_t)k * INW + 3076);
                const int slot = (((k >> 8) * 4 + (k & 3)) * 64 + ((k & 255) >> 2)); *(LAS f32x4*)(lds + slot * 32) = a; *(LAS f32x4*)(lds + slot * 32 + 16) = b; }
        }
        if (bx == 0 && tid < BATCH * 64) NRM[tid] = 0.f;
        __syncthreads();
        LAS float* scr = (LAS float*)(lds + 32768 + wave * 8704);
        {
            constexpr int I_IN = 16 * 96, I_SQ = 16 * 32, I_CKV = 16 * 64, I_UP = 16 * 128, I_DN = 64 * 32;
            constexpr int NITEMS = I_IN + 3 * I_SQ + I_CKV + I_UP + I_DN;
            for (int it = gw; it < NITEMS; it += NGW) {
                int r = it;
                if (r < I_IN) { p0_transpose_item(P.in[I_WIN], D, INW, 96, Win_t, scr, r, lane, P.in[I_GMIX]); continue; } r -= I_IN;
                if (r < I_SQ) { p0_transpose_item(P.in[I_WOUT], D, D, 32, Wout_t, scr, r, lane); continue; } r -= I_SQ;
                if (r < I_SQ) { p0_transpose_item(P.in[I_WCQ], D, D, 32, Wcq_t, scr, r, lane, P.in[I_GCROSS]); continue; } r -= I_SQ;
                if (r < I_SQ) { p0_transpose_item(P.in[I_WCO], D, D, 32, Wco_t, scr, r, lane); continue; } r -= I_SQ;
                if (r < I_CKV) { p0_transpose_item(P.in[I_WCKV], D, 2 * D, 64, Wckv_t, scr, r, lane); continue; } r -= I_CKV;
                if (r < I_UP) { p0_transpose_item(P.in[I_WUP], D, FF, 128, Wup_t, scr, r, lane, P.in[I_GMLP]); continue; } r -= I_UP;
                p0_transpose_item(P.in[I_WDN], FF, D, 32, Wdn_t, scr, r, lane);
            }
        }
        {
            for (int idx = gw * 64 + lane; idx < SEQ * 8; idx += NGW * 64) {
                const int pos = idx >> 3, j = idx & 7;
                const float f = j == 0 ? 1.0f : j == 1 ? 0.1939227432012558f : j == 2 ? 0.03760603070259094f : j == 3 ? 0.007292664609849453f : j == 4 ? 0.0014142135623842478f : j == 5 ? 0.00027424818836152554f : j == 6 ? 5.318296098266728e-05f : 1.0313386155758053e-05f;
                const float ang = (float)pos * f;
                double rev = (double)ang * 0.15915494309189535; rev -= __builtin_rint(rev);
                const float x = (float)(rev * 6.283185307179586);
                ROPE[pos * 16 + j] = cosf(x); ROPE[pos * 16 + 8 + j] = sinf(x);
            }
        }
        {
            f32x4 gq[4];
#pragma unroll
            for (int j = 0; j < 4; ++j) gq[j] = ((const f32x4*)P.in[I_GMIX])[64 * j + lane];
            const float bfv = P.in[I_BF][lane & 7];
            const bool b0 = lane & 1, b1 = lane & 2, b2 = lane & 4;
            for (int m0 = gw * 4; m0 < M; m0 += NGW * 4) {
                f32x4 v[4][4]; float s[4];
#pragma unroll
                for (int r = 0; r < 4; ++r)
#pragma unroll
                    for (int jj = 0; jj < 4; ++jj) v[r][jj] = ((const f32x4*)(P.in[I_X] + (size_t)(m0 + r) * D))[64 * jj + lane];
#pragma unroll
                for (int r = 0; r < 4; ++r) { s[r] = 0.f;
#pragma unroll
                    for (int jj = 0; jj < 4; ++jj) s[r] += (v[r][jj].x * v[r][jj].x + v[r][jj].y * v[r][jj].y) + (v[r][jj].z * v[r][jj].z + v[r][jj].w * v[r][jj].w); }
#pragma unroll
                for (int r = 0; r < 4; ++r) { const float ssum = wave_sum(s[r]); const float rstd = 1.0f / sqrtf(ssum * (1.f / 1024.f) + EPS);
                    unsigned long long* o8 = (unsigned long long*)(XN + (size_t)(m0 + r) * D) + lane;
                    if (lane < 4) ((f32x4*)(SS3 + (size_t)(m0 + r) * 16))[lane] = (f32x4){lane == 0 ? ssum : 0.f, 0.f, 0.f, 0.f};
#pragma unroll
                    for (int jj = 0; jj < 4; ++jj) { o8[64 * jj] = (unsigned long long)pk2(v[r][jj].x, v[r][jj].y) | ((unsigned long long)pk2(v[r][jj].z, v[r][jj].w) << 32);
                        v[r][jj] = v[r][jj] * rstd * gq[jj]; } }
                f32x4 a0[4], a1[4];
#pragma unroll
                for (int r = 0; r < 4; ++r) { a0[r] = (f32x4){0.f, 0.f, 0.f, 0.f}; a1[r] = a0[r]; }
#pragma unroll
                for (int jj = 0; jj < 4; ++jj)
#pragma unroll
                    for (int i = 0; i < 4; ++i) { const LAS f32x4* wp = (const LAS f32x4*)(lds + ((jj * 4 + i) * 64 + lane) * 32); const f32x4 w0 = wp[0], w1 = wp[1];
#pragma unroll
                        for (int r = 0; r < 4; ++r) { a0[r] += w0 * v[r][jj][i]; a1[r] += w1 * v[r][jj][i]; } }
#pragma unroll
                for (int r = 0; r < 4; ++r) {
                    float c0, c1, c2, c3, d0, d1, z;
                    { const float k0 = b0 ? a0[r][1] : a0[r][0], g0 = b0 ? a0[r][0] : a0[r][1]; c0 = k0 + __shfl_xor(g0, 1); }
                    { const float k0 = b0 ? a0[r][3] : a0[r][2], g0 = b0 ? a0[r][2] : a0[r][3]; c1 = k0 + __shfl_xor(g0, 1); }
                    { const float k0 = b0 ? a1[r][1] : a1[r][0], g0 = b0 ? a1[r][0] : a1[r][1]; c2 = k0 + __shfl_xor(g0, 1); }
                    { const float k0 = b0 ? a1[r][3] : a1[r][2], g0 = b0 ? a1[r][2] : a1[r][3]; c3 = k0 + __shfl_xor(g0, 1); }
                    { const float k0 = b1 ? c1 : c0, g0 = b1 ? c0 : c1; d0 = k0 + __shfl_xor(g0, 2); }
                    { const float k0 = b1 ? c3 : c2, g0 = b1 ? c2 : c3; d1 = k0 + __shfl_xor(g0, 2); }
                    { const float k0 = b2 ? d1 : d0, g0 = b2 ? d0 : d1; z = k0 + __shfl_xor(g0, 4); }
                    z += __shfl_xor(z, 8); z += __shfl_xor(z, 16); z += __shfl_xor(z, 32);
                    z += bfv;
                    const float ls = fminf(z, 0.f) - __logf(1.0f + __expf(-fabsf(z)));
                    const int m = m0 + r;
                    if (lane < 8) LOGF[((size_t)(m >> 12) * 8 + lane) * SEQ + (m & 4095)] = ls;
                }
            }
        }
        {
            f32x4 gq[4];
#pragma unroll
            for (int j = 0; j < 4; ++j) gq[j] = ((const f32x4*)P.in[I_GMEM])[64 * j + lane];
            for (int m = gw; m < MM; m += NGW) { f32x4 v[4]; rms_row(P.in[I_MEM] + (size_t)m * D, gq, MEMN + (size_t)m * D, lane, v); }
        }
        __syncthreads();
    }
    SEAM(0);

    if (PH(1)) REPS(1) {
        LANE_TID;
        if (bx < BATCH * 8) {
            const float* src = LOGF + (size_t)bx * SEQ + tid * 8; float* dst = KBIAS + (size_t)bx * SEQ + tid * 8;
            const f32x4 a = *(const f32x4*)src, b = *(const f32x4*)(src + 4);
            float p[8]; p[0] = a[0]; p[1] = p[0] + a[1]; p[2] = p[1] + a[2]; p[3] = p[2] + a[3]; p[4] = p[3] + b[0]; p[5] = p[4] + b[1]; p[6] = p[5] + b[2]; p[7] = p[6] + b[3];
            float inc = p[7];
#pragma unroll
            for (int o = 1; o < 64; o <<= 1) { const float t = __shfl_up(inc, o); if (lane >= o) inc += t; }
            LAS float* wt = (LAS float*)lds;
            if (lane == 63) wt[wave] = inc;
            __syncthreads();
            float pre = inc - p[7];
            for (int w = 0; w < wave; ++w) pre += wt[w];
            const float c = -1.4426950408889634f;
            *(f32x4*)dst = (f32x4){(pre + p[0]) * c, (pre + p[1]) * c, (pre + p[2]) * c, (pre + p[3]) * c};
            *(f32x4*)(dst + 4) = (f32x4){(pre + p[4]) * c, (pre + p[5]) * c, (pre + p[6]) * c, (pre + p[7]) * c};
            __syncthreads();
        }
        { pg8::Gemm g{XN, Win_t, M, NPROJ, D}; pg8::StaticOrder S; S.init(M, NPROJ, G, bx);
          build_rstd_tables(lds, S, SS3, EPS, wave);
          pg8::EpiProj E{PROJ, ROPE, NRM, SS3, (const LAS int*)(lds + RING_BYTES + 1536), (const LAS float*)(lds + RING_BYTES + 2048)};
          pg8::gemm_phase<pg8::EpiProj, pg8::StaticOrder, true, true>(lds, g, S, E, wave); }
    }
    SEAM(1);

    if (PH(2)) REPS(2) {
        for (int p = vcu; p < 1024; p += G) {
            const int pp = p & 511, bh = pp >> 3, s = pp & 7, b = bh >> 3, hm = bh & 7;
#ifdef MK_REP_ATT
            if (rep_ == 1 && !((MK_REP_ATT) & (p < 512 ? 1 : 2))) continue;
#endif
            for (int hh = 0; hh < 2; ++hh) {
                const int qb = hh ? s : 15 - s;
                if (p < 512) { if (!(MK_ATT_MASK & 1)) continue;
                    const float* nq = NRM + 256 + ((b * 2 + 0) * 8 + hm) * 2; const float* nk = NRM + 256 + ((b * 2 + 1) * 8 + hm) * 2;
                    const float bqd = sqrtf((nq[0] + nq[1]) * (nk[0] + nk[1])) * 1.02f;
                    if (bqd < 64.f)
                        attn_body::attn_unit128<16, true>(b, qb, (const attn_body::bf16*)PROJ + hm * 64, (const attn_body::bf16*)PROJ + 512 + hm * 64, (const attn_body::bf16*)PROJ + 1024 + (hm >> 1) * 128,
                                                          (attn_body::bf16*)ATT + (hm & 1) * 512 + (hm >> 1) * 128, (char*)lds_raw, wave);
                    else
                        attn_body::attn_unit128<16, false>(b, qb, (const attn_body::bf16*)PROJ + hm * 64, (const attn_body::bf16*)PROJ + 512 + hm * 64, (const attn_body::bf16*)PROJ + 1024 + (hm >> 1) * 128,
                                                           (attn_body::bf16*)ATT + (hm & 1) * 512 + (hm >> 1) * 128, (char*)lds_raw, wave);
                } else { if (!(MK_ATT_MASK & 2)) continue; const int h = hm;
                    const float* nq = NRM + ((b * 2 + 0) * 8 + h) * 2; const float* nk = NRM + ((b * 2 + 1) * 8 + h) * 2; const float* kbr = KBIAS + (size_t)(b * 8 + h) * SEQ;
                    const float bqk = sqrtf((nq[0] + nq[1]) * (nk[0] + nk[1])) * 1.02f;
                    const int NTf = 4 * qb + 4, tc = 2 * (mk_lane() & 31);
                    const bool skip_ok = (tc >= 2) && (tc <= NTf - 4) && (2.f * bqk + kbr[64 * tc - 1 + (tc ? 0 : 1)] - kbr[256 * qb] < -40.f);
                    const unsigned long long bm = __ballot(skip_ok);
                    const int t0 = bm ? 2 * ((63 - __builtin_clzll(bm)) & 31) : 0;
                    attn_body::attn_unit<8, true>(b, qb, (const attn_body::bf16*)PROJ + 1536 + h * 64, (const attn_body::bf16*)PROJ + 2048 + h * 64, (const attn_body::bf16*)PROJ + 2560 + h * 64,
                                                  (attn_body::bf16*)ATT + 1024 + h * 64, kbr, t0, (char*)lds_raw, wave);
                }
            }
        }
    }
    SEAM(2);

    if (PH(3)) REPS(3) {
        LANE_TID;
        if (bx < 64) {
        { pg8::Gemm g{MEMN, Wckv_t, MM, D, D}; pg8::StaticOrder S; S.init(MM, D, G, bx);
          pg8::EpiBf16<0> E{CKb, D, nullptr, 0, 0, 1.f};
          pg8::gemm_phase<pg8::EpiBf16<0>, pg8::StaticOrder, true, true>(lds, g, S, E, wave); }
        { pg8::Gemm g{Wckv_t + (size_t)D * D, MEMN, D, MM, D}; pg8::StaticOrder S; S.init(D, MM, G, (bx + G - 32) % G);
          pg8::EpiBf16<0> E{CVT, MM, nullptr, 0, 0, 1.f};
          pg8::gemm_phase<pg8::EpiBf16<0>, pg8::StaticOrder, true, true>(lds, g, S, E, wave); }
        }
        const float sa = wave_sum(P.in[I_LQ1][lane] * P.in[I_LK1][lane]), sb = wave_sum(P.in[I_LQ2][lane] * P.in[I_LK2][lane]);
        const float lam = __expf(sa) - __expf(sb) + 0.2f;
        const f32x4 gs0 = *(const f32x4*)(P.in[I_GSUB] + (8 * lane) % 128), gs1 = *(const f32x4*)(P.in[I_GSUB] + (8 * lane) % 128 + 4);
        const f32x4 gf0 = *(const f32x4*)(P.in[I_GFOX] + (8 * lane) % 64), gf1 = *(const f32x4*)(P.in[I_GFOX] + (8 * lane) % 64 + 4);
        const int gw3 = (G > 64) ? (bx - 64) * NWAVES + wave : gw, NGW3 = (G > 64) ? (G - 64) * NWAVES : NGW;
        if (G <= 64 || bx >= 64)
        for (int m = gw3; m < M; m += NGW3) {
            const bf16* a = ATT + (size_t)m * NATT + 8 * lane;
            const v4u o1 = *(const v4u*)a, o2 = *(const v4u*)(a + 512), of = *(const v4u*)(a + 1024);
            float d[8], f[8];
#pragma unroll
            for (int e = 0; e < 4; ++e) { d[2 * e] = bflo(o1[e]) - lam * bflo(o2[e]); d[2 * e + 1] = bfhi(o1[e]) - lam * bfhi(o2[e]); f[2 * e] = bflo(of[e]); f[2 * e + 1] = bfhi(of[e]); }
            float sd = 0.f, sf = 0.f;
#pragma unroll
            for (int e = 0; e < 8; ++e) { sd += d[e] * d[e]; sf += f[e] * f[e]; }
            sd += __shfl_xor(sd, 1); sd += __shfl_xor(sd, 2); sd += __shfl_xor(sd, 4); sd += __shfl_xor(sd, 8);
            sf += __shfl_xor(sf, 1); sf += __shfl_xor(sf, 2); sf += __shfl_xor(sf, 4);
            const float rd = 0.8f / sqrtf(sd * (1.f / 128.f) + SUBLN_EPS), rf = 1.0f / sqrtf(sf * (1.f / 64.f) + EPS);
            v4u wd, wf;
            wd.x = pk2(d[0] * rd * gs0[0], d[1] * rd * gs0[1]); wd.y = pk2(d[2] * rd * gs0[2], d[3] * rd * gs0[3]); wd.z = pk2(d[4] * rd * gs1[0], d[5] * rd * gs1[1]); wd.w = pk2(d[6] * rd * gs1[2], d[7] * rd * gs1[3]);
            wf.x = pk2(f[0] * rf * gf0[0], f[1] * rf * gf0[1]); wf.y = pk2(f[2] * rf * gf0[2], f[3] * rf * gf0[3]); wf.z = pk2(f[4] * rf * gf1[0], f[5] * rf * gf1[1]); wf.w = pk2(f[6] * rf * gf1[2], f[7] * rf * gf1[3]);
            bf16* o = MIXA + (size_t)m * D + 8 * lane;
            *(v4u*)o = wd; *(v4u*)(o + 512) = wf;
        }
    }
    SEAM(3);

    if (PH(4)) REPS(4) { pg8::Gemm g{MIXA, Wout_t, M, D, D}; pg8::StaticOrder S; S.init(M, D, G, bx);
        pg8::EpiRes2<true, true> E{XN, H1B, SS1};
        pg8::gemm_phase<pg8::EpiRes2<true, true>, pg8::StaticOrder, true, true>(lds, g, S, E, wave); }
    SEAM(4);

    if (PH(5)) REPS(5) { pg8::Gemm g{H1B, Wcq_t, M, D, D}; pg8::StaticOrder S; S.init(M, D, G, bx);
        build_rstd_tables(lds, S, SS1, EPS, wave);
        pg8::EpiRowScale<0> E{CQ, D, SS1, EPS, pg8::CROSS_C2, (const LAS int*)(lds + RING_BYTES + 1536), (const LAS float*)(lds + RING_BYTES + 2048)};
        pg8::gemm_phase<pg8::EpiRowScale<0>, pg8::StaticOrder, true, true>(lds, g, S, E, wave); }
    SEAM(5);

    if (PH(6)) REPS(6) {
        const int upc = (512 + G - 1) / G;
        for (int u = vcu * upc; u < (vcu + 1) * upc && u < 512; ++u) { const int bh = u >> 4, qblk = u & 15; xattn::unit(bh >> 2, bh & 3, qblk, CQ, CKb, CVT, CO, lds, wave); }
    }
    SEAM(6);

    if (PH(7)) REPS(7) { pg8::Gemm g{CO, Wco_t, M, D, D}; pg8::StaticOrder S; S.init(M, D, G, bx);
        pg8::EpiRes2<true, true> E{H1B, H2B, SS2};
        pg8::gemm_phase<pg8::EpiRes2<true, true>, pg8::StaticOrder, true, true>(lds, g, S, E, wave); }
    SEAM(7);

    if (PH(8)) REPS(8) { pg8::Gemm g{H2B, Wup_t, M, FF, D}; pg8::StaticOrder S; S.init(M, FF, G, bx);
        build_rstd_tables(lds, S, SS2, EPS, wave);
        pg8::EpiRowScale<1> E{ZH, FF, SS2, EPS, 1.f, (const LAS int*)(lds + RING_BYTES + 1536), (const LAS float*)(lds + RING_BYTES + 2048)};
        pg8::gemm_phase<pg8::EpiRowScale<1>, pg8::StaticOrder, true, true>(lds, g, S, E, wave); }
    SEAM(8);

    if (PH(9)) REPS(9) { pg8::Gemm g{ZH, Wdn_t, M, D, FF}; pg8::StaticOrder S; S.init(M, D, G, bx); S.rev = true;
        pg8::EpiRes2<true, true> E{H2B, H1B  , SS3};
        pg8::gemm_phase<pg8::EpiRes2<true, true>, pg8::StaticOrder, true, true>(lds, g, S, E, wave); }
    SEAM(9);

    if (PH(10)) REPS(10) {
        LANE_TID;
        f32x4 gq[4];
#pragma unroll
        for (int j = 0; j < 4; ++j) gq[j] = ((const f32x4*)P.in[I_GFIN])[64 * j + lane];
        for (int m0 = gw * 4; m0 < M; m0 += NGW * 4) {
            unsigned long long w[4][4]; float rr[4];
#pragma unroll
            for (int q = 0; q < 4; ++q) { const unsigned long long* hb = (const unsigned long long*)(H1B + (size_t)(m0 + q) * D) + lane;
#pragma unroll
                for (int j = 0; j < 4; ++j) w[q][j] = hb[64 * j];
                rr[q] = pg8::row_rstd(SS3, m0 + q, EPS); }
#pragma unroll
            for (int q = 0; q < 4; ++q) { f32x4* o = (f32x4*)(P.out + (size_t)(m0 + q) * D) + lane;
#pragma unroll
                for (int j = 0; j < 4; ++j) { const unsigned lo = (unsigned)w[q][j], hi2 = (unsigned)(w[q][j] >> 32);
                    const f32x4 v = {bflo(lo), bfhi(lo), bflo(hi2), bfhi(hi2)}; o[64 * j] = v * rr[q] * gq[j]; } }
        }
    }
#undef IN
#undef SEAM
#undef LANE_TID
#undef ROPE
#undef LOGF
#undef KBIAS
#undef NRM
#undef SS1
#undef SS2
#undef SS3
#undef Win_t
#undef Wout_t
#undef Wcq_t
#undef Wckv_t
#undef Wco_t
#undef Wup_t
#undef Wdn_t
#undef MEMN
#undef CKb
#undef CVT
#undef XN
#undef MIXA
#undef CQ
#undef H2B
#undef H1B
#undef CO
#undef PROJ
#undef ATT
#undef ZH
}

extern "C" void kernel_launch(void* const* d_in, const int* in_sizes, int n_in, void* d_out, int out_size, void* d_ws, size_t ws_size, hipStream_t stream) {
    static int grid = 0;
    if (grid == 0) {
        if (n_in != 21 || in_sizes[0] != M * D || out_size != M * D || ws_size < WS_END) { fprintf(stderr, "kernel_launch: unexpected shapes (n_in %d, in0 %d, out %d, ws %zu); nothing launched\n", n_in, n_in > 0 ? in_sizes[0] : -1, out_size, ws_size); grid = -1; return; }
        int dev = 0, cus = 0, per_cu = 0;
        if (hipGetDevice(&dev) != hipSuccess || hipDeviceGetAttribute(&cus, hipDeviceAttributeMultiprocessorCount, dev) != hipSuccess) { grid = -1; return; }
        if (hipFuncSetAttribute((const void*)mk_fwd, hipFuncAttributeMaxDynamicSharedMemorySize, LDS_BYTES) != hipSuccess) { fprintf(stderr, "kernel_launch: hipFuncSetAttribute failed\n"); grid = -1; return; }
        if (hipOccupancyMaxActiveBlocksPerMultiprocessor(&per_cu, (const void*)mk_fwd, NWAVES * 64, LDS_BYTES) != hipSuccess || per_cu < 1) { fprintf(stderr, "kernel_launch: occupancy query says %d blocks per CU\n", per_cu); per_cu = 1; }
        (void)hipGetLastError();
        grid = cus * per_cu;
    }
    if (grid < 0) return;
    if (hipMemsetAsync((char*)d_ws + WS_BAR, 0, XCD_BAR_WORDS * 4, stream) != hipSuccess) { fprintf(stderr, "kernel_launch: memset of the barrier words failed\n"); return; }
    Params p{};
    for (int i = 0; i < 21; ++i) p.in[i] = (const float*)d_in[i];
    p.out = (float*)d_out; p.ws = (unsigned char*)d_ws;
#if MK_PER_PHASE
    for (int ph = 0; ph < N_PHASES; ++ph) { p.ph_lo = ph; p.ph_hi = ph + 1; hipLaunchKernelGGL(mk_fwd, dim3(grid), dim3(NWAVES * 64), LDS_BYTES, stream, p); }
#else
    p.ph_lo = 0; p.ph_hi = N_PHASES;
    void* args[] = {&p};
    const hipError_t e = hipLaunchCooperativeKernel((const void*)mk_fwd, dim3(grid), dim3(NWAVES * 64), args, LDS_BYTES, stream);
    if (e != hipSuccess) fprintf(stderr, "kernel_launch: cooperative launch failed: %s (grid %d)\n", hipGetErrorString(e), grid);
#endif
}
```

```cpp
#include <hip/hip_runtime.h>
#include <hip/hip_cooperative_groups.h>
#include <hip/hip_bf16.h>
#include <cstdio>
#include <cstdint>
#include <cmath>
namespace cg = cooperative_groups;
__device__ __forceinline__ int mk_lane() { int l = (int)__builtin_amdgcn_mbcnt_hi(~0u, __builtin_amdgcn_mbcnt_lo(~0u, 0u)); asm volatile("" : "+v"(l)); return l; }
namespace pg8 {
#define PG8_LAS __attribute__((address_space(3)))
typedef unsigned short bf16_t;
typedef short bf16x8 __attribute__((ext_vector_type(8)));
typedef float f32x4 __attribute__((ext_vector_type(4)));
typedef unsigned u32x4 __attribute__((ext_vector_type(4)));
constexpr int BM = 256, BK = 64, HALF = 128, HTB = HALF * BK * 2  , STAGE_BYTES = 8 * HTB, NXCD = 8, WGM = 8;

__host__ __device__ __forceinline__ int lds_byte(int r, int c) { const int st = (r >> 4) * 2 + (c >> 5), rr = r & 15, cc = c & 31, ob = rr * 64 + cc * 2; return st * 1024 + (ob ^ (((ob >> 9) & 1) << 5)); }
__host__ __device__ __forceinline__ void stage_rc(int b, int& R, int& C) { const int st = b / 1024, sb = b % 1024, swz = sb ^ (((sb >> 9) & 1) << 5); R = (st >> 1) * 16 + swz / 64; C = (st & 1) * 32 + (swz % 64) / 2; }
__host__ __device__ __forceinline__ int perm32(int rho) { const int n = rho >> 4, i = rho & 15; return 8 * (i >> 2) + 4 * n + (i & 3); }

struct Unit { int pm, pn; };
struct Gemm { const bf16_t* A; const bf16_t* Bt; int M, N, K; };

struct StaticOrder {
    int nM, nN, nwg, G, c; bool rev = false;
    __host__ __device__ __forceinline__ void init(int M, int N, int G_, int c_) { nM = M / BM; nN = N / BM; nwg = nM * nN; G = G_; c = c_; }
    __host__ __device__ __forceinline__ bool next(int i, Unit& u) const {
        const long L = (long)i * G + c; if (L >= nwg) return false;
        int wgid = (int)L; { const int q = nwg / NXCD, r = nwg % NXCD, xcd = wgid % NXCD, off = wgid / NXCD; wgid = (xcd < r ? xcd * (q + 1) : r * (q + 1) + (xcd - r) * q) + off; }
        const int nig = WGM * nN, gid = wgid / nig, fm = gid * WGM, gsz = (nM - fm) < WGM ? (nM - fm) : WGM;
        u.pm = fm + ((wgid % nig) % gsz); u.pn = (wgid % nig) / gsz; if (rev) u.pm = nM - 1 - u.pm; return true;
    }
    __device__ __forceinline__ void a_ready(const Unit&) const {}
    __device__ __forceinline__ void done(const Unit&) const {}
};

__device__ __forceinline__ unsigned cvt_pk_bf16(float lo, float hi) { unsigned r; asm volatile("v_cvt_pk_bf16_f32 %0, %1, %2" : "=v"(r) : "v"(lo), "v"(hi)); return r; }
typedef float f32x2 __attribute__((ext_vector_type(2)));
__device__ __forceinline__ f32x2 gelu_pk(f32x2 v) {
    const f32x2 av = __builtin_elementwise_abs(v), d = av * 0.2316418882f + 1.0f;
    f32x2 t; t.x = __builtin_amdgcn_rcpf(d.x); t.y = __builtin_amdgcn_rcpf(d.y);
    f32x2 q = t * 0.5307027145f + (-0.7265760135f); q = q * t + 0.7107068705f; q = q * t + (-0.142248368f); q = q * t + 0.127414796f; q = q * t;
    const f32x2 s = (v * v) * (-0.72134752044f);
    f32x2 e; e.x = __builtin_amdgcn_exp2f(s.x); e.y = __builtin_amdgcn_exp2f(s.y);
    const f32x2 m = v * (q * e), r = v - m;
    f32x2 o; o.x = v.x < 0.f ? m.x : r.x; o.y = v.y < 0.f ? m.y : r.y; return o;
}

template <int ACT  > struct EpiBf16 {
    static constexpr bool PERM = true, AFTER_DRAIN = false; static_assert(ACT == 0 || ACT == 1, "EpiBf16: ACT is 0 (none) or 1 (gelu_pk)");
    bf16_t* O; int ldc; const float* bias; int split_cols; size_t split_stride; float scale0;
    __device__ __forceinline__ void operator()(const f32x4 (&acc)[2][2][4][2], const Unit& u, int wr, int wc, int fr, int fq) const {
        const int row0 = u.pm * BM + wr * 64 + fr; int colt = u.pn * BM; bf16_t* base = O;
        float sc = 1.f; if (split_cols) { const int t = colt / split_cols; base += (size_t)t * split_stride; colt -= t * split_cols; if (t == 0) sc = scale0; }
        const int col0 = colt + wc * 32 + 8 * fq, bcol0 = u.pn * BM + wc * 32 + 8 * fq;
        f32x4 bv[2][2];
#pragma unroll
        for (int bj = 0; bj < 2; ++bj)
#pragma unroll
            for (int n = 0; n < 2; ++n) bv[bj][n] = bias ? *(const f32x4*)(bias + bcol0 + bj * HALF + 4 * n) : (f32x4){0.f, 0.f, 0.f, 0.f};
#pragma unroll
        for (int ai = 0; ai < 2; ++ai)
#pragma unroll
            for (int m = 0; m < 4; ++m) { bf16_t* rowp = base + (size_t)(row0 + ai * HALF + m * 16) * ldc + col0;
#pragma unroll
                for (int bj = 0; bj < 2; ++bj) { f32x4 v0 = acc[ai][bj][m][0] + bv[bj][0], v1 = acc[ai][bj][m][1] + bv[bj][1];
                    if (ACT == 1) { f32x2 a = gelu_pk((f32x2){v0[0], v0[1]}), b = gelu_pk((f32x2){v0[2], v0[3]}), c = gelu_pk((f32x2){v1[0], v1[1]}), d = gelu_pk((f32x2){v1[2], v1[3]});
                        v0 = (f32x4){a.x, a.y, b.x, b.y}; v1 = (f32x4){c.x, c.y, d.x, d.y}; }
                    v0 = v0 * sc; v1 = v1 * sc; u32x4 w; w.x = cvt_pk_bf16(v0[0], v0[1]); w.y = cvt_pk_bf16(v0[2], v0[3]); w.z = cvt_pk_bf16(v1[0], v1[1]); w.w = cvt_pk_bf16(v1[2], v1[3]);
                    *(u32x4*)(rowp + bj * HALF) = w; } }
    }
};

constexpr float QK_C2 = 0.125f * 1.4426950408889634f;
constexpr float CROSS_C2 = 0.0625f * 1.4426950408889634f;
__device__ __forceinline__ float row_rstd(const float* part, int row, float eps) {
    const f32x4* p = (const f32x4*)(part + (size_t)row * 16);
    const f32x4 a = p[0], b = p[1], c = p[2], d = p[3];
    const float s = ((a[0] + a[1]) + (a[2] + a[3])) + ((b[0] + b[1]) + (b[2] + b[3])) + ((c[0] + c[1]) + (c[2] + c[3])) + ((d[0] + d[1]) + (d[2] + d[3]));
    return 1.0f / sqrtf(s * (1.0f / 1024.0f) + eps);
}
struct EpiProj {
    static constexpr bool PERM = true, AFTER_DRAIN = false;
    bf16_t* O; const float* rope; float* nrm; const float* ssp; const PG8_LAS int* pml; const PG8_LAS float* tab;
    __device__ __forceinline__ void operator()(const f32x4 (&acc)[2][2][4][2], const Unit& u, int wr, int wc, int fr, int fq) const {
        const int row0 = u.pm * BM + wr * 64 + fr, col0 = u.pn * BM + wc * 32 + 8 * fq;
        const int typ = u.pn >> 1;
        const float sc = (typ == 0 || typ == 3) ? QK_C2 : 1.f;
        int slot = -1;
        if (tab) { const int n = pml[8]; for (int j = 0; j < n; ++j) if (pml[j] == u.pm) slot = j; }
        const bool ropew = (typ < 2) && ((wc & 1) == 0);
        const bool nrmw = (typ == 0 || typ == 1 || typ == 3 || typ == 4); float mxn[2] = {0.f, 0.f};
#pragma unroll
        for (int ai = 0; ai < 2; ++ai) {
            f32x4 rc[4][4];
            if (ropew) {
#pragma unroll
                for (int m = 0; m < 4; ++m) { const f32x4* rp = (const f32x4*)(rope + (size_t)((row0 + ai * HALF + m * 16) & 4095) * 16); rc[m][0] = rp[0]; rc[m][1] = rp[1]; rc[m][2] = rp[2]; rc[m][3] = rp[3]; }
            }
#pragma unroll
            for (int m = 0; m < 4; ++m) {
                const int row = row0 + ai * HALF + m * 16;
                bf16_t* rowp = O + (size_t)row * 3072 + col0;
                const float scr = sc * (slot >= 0 ? tab[slot * 256 + (row - u.pm * BM)] : row_rstd(ssp, row, 1e-6f));
                f32x4 c0 = {1.f, 1.f, 1.f, 1.f}, c1 = c0, s0 = {0.f, 0.f, 0.f, 0.f}, s1 = s0;
                if (ropew) { c0 = rc[m][0]; c1 = rc[m][1]; s0 = rc[m][2]; s1 = rc[m][3]; if (fq == 0) { s0 = -s0; s1 = -s1; } if (fq >= 2) { c0 = (f32x4){1.f, 1.f, 1.f, 1.f}; c1 = c0; s0 = (f32x4){0.f, 0.f, 0.f, 0.f}; s1 = s0; } }
#pragma unroll
                for (int bj = 0; bj < 2; ++bj) {
                    f32x4 v0 = acc[ai][bj][m][0], v1 = acc[ai][bj][m][1];
                    if (ropew) {
                        f32x4 p0, p1;
#pragma unroll
                        for (int e = 0; e < 4; ++e) { p0[e] = __shfl_xor(v0[e], 16); p1[e] = __shfl_xor(v1[e], 16); }
                        v0 = v0 * c0 + p0 * s0; v1 = v1 * c1 + p1 * s1;
                    }
                    v0 = v0 * scr; v1 = v1 * scr;
                    if (nrmw) { float q = (v0[0] * v0[0] + v0[1] * v0[1]) + (v0[2] * v0[2] + v0[3] * v0[3]) + (v1[0] * v1[0] + v1[1] * v1[1]) + (v1[2] * v1[2] + v1[3] * v1[3]);
                        q += __shfl_xor(q, 16); q += __shfl_xor(q, 32); mxn[bj] = fmaxf(mxn[bj], q); }
                    u32x4 w; w.x = cvt_pk_bf16(v0[0], v0[1]); w.y = cvt_pk_bf16(v0[2], v0[3]); w.z = cvt_pk_bf16(v1[0], v1[1]); w.w = cvt_pk_bf16(v1[2], v1[3]);
                    *(u32x4*)(rowp + bj * HALF) = w;
                }
            }
        }
        if (nrmw) {
#pragma unroll
            for (int bj = 0; bj < 2; ++bj) { float q = mxn[bj];
                q = fmaxf(q, __shfl_xor(q, 1)); q = fmaxf(q, __shfl_xor(q, 2)); q = fmaxf(q, __shfl_xor(q, 4)); q = fmaxf(q, __shfl_xor(q, 8));
                const int rel = 256 * (u.pn & 1) + 128 * bj + 32 * wc, b = (u.pm * BM) >> 12;
                if (fr == 0 && fq == 0) atomicMax((unsigned*)nrm + (typ < 2 ? 256 : 0) + ((b * 2 + ((typ == 1 || typ == 4) ? 1 : 0)) * 8 + (rel >> 6)) * 2 + ((rel >> 5) & 1), __float_as_uint(q * 1.02f)); }
        }
    }
};
template <bool BASE_BF16, bool OUT_BF16> struct EpiRes2 {
    static constexpr bool PERM = true, AFTER_DRAIN = false;
    const void* base; void* out; float* sspart;
    __device__ __forceinline__ void operator()(const f32x4 (&acc)[2][2][4][2], const Unit& u, int wr, int wc, int fr, int fq) const {
        const int row0 = u.pm * BM + wr * 64 + fr, col0 = u.pn * BM + wc * 32 + 8 * fq;
#pragma unroll
        for (int ai = 0; ai < 2; ++ai) {
            u32x4 bw[4][2]; f32x4 bf[4][2][2];
#pragma unroll
            for (int m = 0; m < 4; ++m)
#pragma unroll
                for (int bj = 0; bj < 2; ++bj) { const size_t off = (size_t)(row0 + ai * HALF + m * 16) * 1024 + col0 + bj * HALF;
                    if (BASE_BF16) bw[m][bj] = *(const u32x4*)((const bf16_t*)base + off);
                    else { bf[m][bj][0] = *(const f32x4*)((const float*)base + off); bf[m][bj][1] = *(const f32x4*)((const float*)base + off + 4); } }
#pragma unroll
            for (int m = 0; m < 4; ++m) {
                const int row = row0 + ai * HALF + m * 16; const size_t off = (size_t)row * 1024 + col0;
                float ss = 0.f;
#pragma unroll
                for (int bj = 0; bj < 2; ++bj) {
                    f32x4 b0, b1;
                    if (BASE_BF16) { const u32x4 w = bw[m][bj];
                        b0 = (f32x4){__builtin_bit_cast(float, w.x << 16), __builtin_bit_cast(float, w.x & 0xffff0000u), __builtin_bit_cast(float, w.y << 16), __builtin_bit_cast(float, w.y & 0xffff0000u)};
                        b1 = (f32x4){__builtin_bit_cast(float, w.z << 16), __builtin_bit_cast(float, w.z & 0xffff0000u), __builtin_bit_cast(float, w.w << 16), __builtin_bit_cast(float, w.w & 0xffff0000u)}; }
                    else { b0 = bf[m][bj][0]; b1 = bf[m][bj][1]; }
                    const f32x4 v0 = acc[ai][bj][m][0] + b0, v1 = acc[ai][bj][m][1] + b1;
                    ss += (v0[0] * v0[0] + v0[1] * v0[1]) + (v0[2] * v0[2] + v0[3] * v0[3]) + (v1[0] * v1[0] + v1[1] * v1[1]) + (v1[2] * v1[2] + v1[3] * v1[3]);
                    if (OUT_BF16) { u32x4 w; w.x = cvt_pk_bf16(v0[0], v0[1]); w.y = cvt_pk_bf16(v0[2], v0[3]); w.z = cvt_pk_bf16(v1[0], v1[1]); w.w = cvt_pk_bf16(v1[2], v1[3]);
                        *(u32x4*)((bf16_t*)out + off + bj * HALF) = w; }
                    else { *(f32x4*)((float*)out + off + bj * HALF) = v0; *(f32x4*)((float*)out + off + bj * HALF + 4) = v1; }
                }
                ss += __shfl_xor(ss, 16); ss += __shfl_xor(ss, 32);
                if (fq == 0) sspart[(size_t)row * 16 + u.pn * 4 + wc] = ss;
            }
        }
    }
};
template <int ACT> struct EpiRowScale {
    static constexpr bool PERM = true, AFTER_DRAIN = false;
    bf16_t* O; int ldc; const float* sspart; float eps; float sc;
    const PG8_LAS int* pml; const PG8_LAS float* tab;
    __device__ __forceinline__ void operator()(const f32x4 (&acc)[2][2][4][2], const Unit& u, int wr, int wc, int fr, int fq) const {
        const int row0 = u.pm * BM + wr * 64 + fr, col0 = u.pn * BM + wc * 32 + 8 * fq;
        int slot = -1;
        if (tab) { const int n = pml[8]; for (int j = 0; j < n; ++j) if (pml[j] == u.pm) slot = j; }
#pragma unroll
        for (int ai = 0; ai < 2; ++ai)
#pragma unroll
            for (int m = 0; m < 4; ++m) {
                const int row = row0 + ai * HALF + m * 16; bf16_t* rowp = O + (size_t)row * ldc + col0;
                const float r = (slot >= 0 ? tab[slot * 256 + (row - u.pm * BM)] : row_rstd(sspart, row, eps)) * sc;
#pragma unroll
                for (int bj = 0; bj < 2; ++bj) {
                    f32x4 v0 = acc[ai][bj][m][0] * r, v1 = acc[ai][bj][m][1] * r;
                    if (ACT == 1) {
#pragma unroll
                        for (int e = 0; e < 4; ++e) { const float a = fmaxf(v0[e], 0.f), b = fmaxf(v1[e], 0.f); v0[e] = a * a; v1[e] = b * b; }
                    }
                    u32x4 w; w.x = cvt_pk_bf16(v0[0], v0[1]); w.y = cvt_pk_bf16(v0[2], v0[3]); w.z = cvt_pk_bf16(v1[0], v1[1]); w.w = cvt_pk_bf16(v1[2], v1[3]);
                    *(u32x4*)(rowp + bj * HALF) = w;
                }
            }
    }
};
template <class Epi, class Sched, bool ALIGN_EPI = false, bool SP2 = false>
__device__ __forceinline__ void gemm_phase(PG8_LAS unsigned char* lds, const Gemm g, const Sched& S, const Epi& E, const int wv  ) {
    int tid_ = wv * 64 + mk_lane();
    const int tid = tid_, wid = __builtin_amdgcn_readfirstlane(tid >> 6), lane = tid & 63, wr = wid >> 2, wc = wid & 3, fr = lane & 15, fq = lane >> 4;
    const int K = g.K, nt = K / BK;
    unsigned voffA[2], voffB[2];
#pragma unroll
    for (int i = 0; i < 2; ++i) { int R, C; stage_rc(tid * 16 + i * 8192, R, C); const int Rb = Epi::PERM ? ((R & ~31) + perm32(R & 31)) : R;
        voffA[i] = (unsigned)(R * K + C) * 2u; voffB[i] = (unsigned)(Rb * K + C) * 2u; }
    const size_t kstep = (size_t)(BK * 2);
    const size_t hstep = (size_t)HALF * K * 2;
    const size_t tstep = 2 * hstep;
    const unsigned ldsw = (unsigned)wid * 1024u;
    const int aoff = lds_byte(wr * 64 + fr, fq * 8), boff = lds_byte(wc * 32 + fr, fq * 8);
#define PG8_SA(b, h) (((b) * 2 + (h)) * HTB)
#define PG8_SB(b, h) ((4 + (b) * 2 + (h)) * HTB)
#define PG8_STAGE(bufoff, gbase, voff) do { _Pragma("unroll") for (int _i = 0; _i < 2; ++_i) \
        __builtin_amdgcn_global_load_lds((const unsigned*)((const char*)(gbase) + (voff)[_i]), (PG8_LAS unsigned*)(lds + (bufoff) + ldsw + _i * 8192), 16, 0, 0); } while (0)
#define PG8_LDA(dst, b, h) do { _Pragma("unroll") for (int m = 0; m < 4; ++m) _Pragma("unroll") for (int k = 0; k < 2; ++k) dst[m][k] = *(const PG8_LAS bf16x8*)(lds + PG8_SA(b, h) + aoff + m * 2048 + k * 1024); } while (0)
#define PG8_LDB(dst, b, h) do { _Pragma("unroll") for (int n = 0; n < 2; ++n) _Pragma("unroll") for (int k = 0; k < 2; ++k) dst[n][k] = *(const PG8_LAS bf16x8*)(lds + PG8_SB(b, h) + boff + n * 2048 + k * 1024); } while (0)
#define PG8_MMA(ai, bj, At, Bt) do { __builtin_amdgcn_s_setprio(1); _Pragma("unroll") for (int m = 0; m < 4; ++m) _Pragma("unroll") for (int n = 0; n < 2; ++n) _Pragma("unroll") for (int k = 0; k < 2; ++k) \
        acc[ai][bj][m][n] = __builtin_amdgcn_mfma_f32_16x16x32_bf16(Bt[n][k], At[m][k], acc[ai][bj][m][n], 0, 0, 0); __builtin_amdgcn_s_setprio(0); } while (0)
#define PG8_WAIT_V(n) asm volatile("s_waitcnt vmcnt(" #n ")" ::: "memory")
#define PG8_WAIT_L(n) asm volatile("s_waitcnt lgkmcnt(" #n ")" ::: "memory")
#define PG8_BAR __builtin_amdgcn_s_barrier()
#define PG8_SCHED __builtin_amdgcn_sched_barrier(0)
    Unit cur, nxt; int ui = 0;
    if (!S.next(0, cur)) return;
    f32x4 acc[2][2][4][2];
#pragma unroll
    for (int a = 0; a < 2; ++a)
#pragma unroll
        for (int b = 0; b < 2; ++b)
#pragma unroll
            for (int m = 0; m < 4; ++m)
#pragma unroll
                for (int n = 0; n < 2; ++n) acc[a][b][m][n] = (f32x4){0.f, 0.f, 0.f, 0.f};
    bf16x8 At[4][2], B0[2][2], B1[2][2];
    const char* cA = (const char*)g.A + (size_t)cur.pm * tstep; const char* cB = (const char*)g.Bt + (size_t)cur.pn * tstep;
    S.a_ready(cur);
    if constexpr (SP2) {
        PG8_STAGE(PG8_SB(0, 0), cB, voffB); PG8_STAGE(PG8_SB(0, 1), cB + hstep, voffB); PG8_STAGE(PG8_SA(0, 0), cA, voffA); PG8_STAGE(PG8_SA(0, 1), cA + hstep, voffA);
        if (wr == 1) PG8_BAR;
        PG8_WAIT_V(2); PG8_BAR;
        PG8_STAGE(PG8_SB(1, 0), cB + kstep, voffB); PG8_STAGE(PG8_SA(1, 0), cA + kstep, voffA); PG8_STAGE(PG8_SB(1, 1), cB + hstep + kstep, voffB);
        PG8_WAIT_V(6); PG8_BAR;
    } else {
        PG8_STAGE(PG8_SB(0, 0), cB, voffB); PG8_STAGE(PG8_SA(0, 0), cA, voffA); PG8_STAGE(PG8_SB(0, 1), cB + hstep, voffB); PG8_STAGE(PG8_SA(0, 1), cA + hstep, voffA);
        if (wr == 1) PG8_BAR;
        PG8_WAIT_V(4); PG8_BAR;
        PG8_STAGE(PG8_SB(1, 0), cB + kstep, voffB); PG8_STAGE(PG8_SA(1, 0), cA + kstep, voffA); PG8_STAGE(PG8_SB(1, 1), cB + hstep + kstep, voffB);
        PG8_WAIT_V(6); PG8_BAR;
    }
    for (;;) {
        const bool has_next = S.next(ui + 1, nxt);
        const char* nA = has_next ? (const char*)g.A + (size_t)nxt.pm * tstep : cA; const char* nB = has_next ? (const char*)g.Bt + (size_t)nxt.pn * tstep : cB;
        for (int t = 0; t < nt; t += 2) {
            const bool last = (t == nt - 2);
            const char* a1 = cA + (size_t)(t + 1) * kstep;
            const char* a2 = last ? nA : cA + (size_t)(t + 2) * kstep; const char* b2 = last ? nB : cB + (size_t)(t + 2) * kstep;
            const char* a3 = a2 + kstep; const char* b3 = b2 + kstep;
            if (last && has_next) S.a_ready(nxt);
            if constexpr (SP2) {
            PG8_LDB(B0, 0, 0); PG8_LDB(B1, 0, 1); PG8_SCHED; PG8_LDA(At, 0, 0); PG8_STAGE(PG8_SA(1, 1), a1 + hstep, voffA);
            PG8_WAIT_V(8); PG8_WAIT_L(0); PG8_BAR; PG8_MMA(0, 0, At, B0); PG8_MMA(0, 1, At, B1); PG8_BAR; PG8_SCHED;
            PG8_LDA(At, 0, 1); PG8_STAGE(PG8_SB(0, 0), b2, voffB); PG8_STAGE(PG8_SB(0, 1), b2 + hstep, voffB); PG8_STAGE(PG8_SA(0, 0), a2, voffA);
            PG8_WAIT_V(8); PG8_WAIT_L(0); PG8_BAR; PG8_MMA(1, 0, At, B0); PG8_MMA(1, 1, At, B1); PG8_BAR; PG8_SCHED;
            PG8_LDB(B0, 1, 0); PG8_LDB(B1, 1, 1); PG8_SCHED; PG8_LDA(At, 1, 0); PG8_STAGE(PG8_SA(0, 1), a2 + hstep, voffA);
            PG8_WAIT_V(8); PG8_WAIT_L(0); PG8_BAR; PG8_MMA(0, 0, At, B0); PG8_MMA(0, 1, At, B1); PG8_BAR; PG8_SCHED;
            PG8_LDA(At, 1, 1); PG8_STAGE(PG8_SB(1, 0), b3, voffB); PG8_STAGE(PG8_SB(1, 1), b3 + hstep, voffB); PG8_STAGE(PG8_SA(1, 0), a3, voffA);
            PG8_WAIT_V(8); PG8_WAIT_L(0); PG8_BAR; PG8_MMA(1, 0, At, B0); PG8_MMA(1, 1, At, B1); PG8_BAR; PG8_SCHED;
            } else {
            PG8_LDB(B0, 0, 0); PG8_SCHED; PG8_LDA(At, 0, 0); PG8_STAGE(PG8_SA(1, 1), a1 + hstep, voffA);
            PG8_WAIT_L(8); PG8_BAR; PG8_WAIT_L(0); PG8_MMA(0, 0, At, B0); PG8_BAR; PG8_SCHED;
            PG8_LDB(B1, 0, 1); PG8_STAGE(PG8_SB(0, 0), b2, voffB);
            PG8_BAR; PG8_WAIT_L(0); PG8_MMA(0, 1, At, B1); PG8_BAR;
            PG8_LDA(At, 0, 1); PG8_STAGE(PG8_SA(0, 0), a2, voffA);
            PG8_BAR; PG8_WAIT_L(0); PG8_MMA(1, 0, At, B0); PG8_BAR; PG8_SCHED;
            PG8_STAGE(PG8_SB(0, 1), b2 + hstep, voffB);
            PG8_WAIT_V(6); PG8_BAR; PG8_MMA(1, 1, At, B1); PG8_BAR;
            PG8_LDB(B0, 1, 0); PG8_SCHED; PG8_LDA(At, 1, 0); PG8_STAGE(PG8_SA(0, 1), a2 + hstep, voffA);
            PG8_WAIT_L(8); PG8_BAR; PG8_WAIT_L(0); PG8_MMA(0, 0, At, B0); PG8_BAR; PG8_SCHED;
            PG8_LDB(B1, 1, 1); PG8_STAGE(PG8_SB(1, 0), b3, voffB);
            PG8_BAR; PG8_WAIT_L(0); PG8_MMA(0, 1, At, B1); PG8_BAR;
            PG8_LDA(At, 1, 1); PG8_STAGE(PG8_SA(1, 0), a3, voffA);
            PG8_BAR; PG8_WAIT_L(0); PG8_MMA(1, 0, At, B0); PG8_BAR; PG8_SCHED;
            PG8_STAGE(PG8_SB(1, 1), b3 + hstep, voffB);
            PG8_WAIT_V(6); PG8_BAR; PG8_MMA(1, 1, At, B1); PG8_BAR;
            }
        }
        if constexpr (ALIGN_EPI) { if (wr == 0) PG8_BAR; }
        if constexpr (!Epi::AFTER_DRAIN) { E(acc, cur, wr, wc, fr, fq); S.done(cur); }
        if (!has_next) break;
#pragma unroll
        for (int a = 0; a < 2; ++a)
#pragma unroll
            for (int b = 0; b < 2; ++b)
#pragma unroll
                for (int m = 0; m < 4; ++m)
#pragma unroll
                    for (int n = 0; n < 2; ++n) acc[a][b][m][n] = (f32x4){0.f, 0.f, 0.f, 0.f};
        cur = nxt; cA = nA; cB = nB; ++ui;
        if constexpr (ALIGN_EPI) { if (wr == 1) PG8_BAR; }
    }
    PG8_WAIT_V(0);
    if constexpr (!ALIGN_EPI) { if (wr == 0) PG8_BAR; }
    PG8_BAR;
    if constexpr (Epi::AFTER_DRAIN) { E.fused(acc, cur, wr, wc, fr, fq, lds, wid, lane); S.done(cur); }
#undef PG8_SA
#undef PG8_SB
#undef PG8_STAGE
#undef PG8_LDA
#undef PG8_LDB
#undef PG8_MMA
#undef PG8_WAIT_V
#undef PG8_WAIT_L
#undef PG8_BAR
#undef PG8_SCHED
}
}

#ifndef PG8_SP2
#define PG8_SP2 true
#endif
#ifndef PG8_ALIGN
#define PG8_ALIGN true
#endif
namespace attn_body {
using bf16=__hip_bfloat16;
using bf16x8=__attribute__((ext_vector_type(8)))short;
using s16x4=__attribute__((ext_vector_type(4)))short;
using f32x16=__attribute__((ext_vector_type(16)))float;
using u32x4=__attribute__((ext_vector_type(4)))unsigned; using f32x4=__attribute__((ext_vector_type(4)))float;
constexpr int SEQ=4096,D=64,PQ=3072,PO=1536;
constexpr int NW=8,QBLK=32,QB=QBLK*NW,KVBLK=64,NQB=SEQ/QB;
constexpr int ATTN_UNIT_ROWS=QB;
__device__ __forceinline__ int crow(int r,int hi){return (r&3)+8*(r>>2)+4*hi;}
#define SBAR() __builtin_amdgcn_sched_barrier(0)
__device__ __forceinline__ void cmask(f32x16&p0,f32x16&p1,int jb,int qrel,int hi){
  const float NEG=-INFINITY; int kb=64*jb+4*hi;
  #pragma unroll
  for(int r=0;r<16;++r){int kv=kb+(r&3)+8*(r>>2); if(kv>qrel)p0[r]=NEG; if(kv+32>qrel)p1[r]=NEG;}
}

template<bool B> __device__ __forceinline__ const f32x16& csel(const f32x16&a,const f32x16&b){ if constexpr(B) return a; else return b; }
constexpr int NSLOT=3, SLOTB=8192;
constexpr int LDS_K=0, LDS_V=NSLOT*SLOTB, LDS_WS=2*NSLOT*SLOTB, LDS_OST=LDS_WS+NW*64*4, LDS_KBIAS=LDS_OST+NW*4096, LDS_BYTES=LDS_KBIAS+SEQ*4;
constexpr float C2=0.125f*1.4426950408889634f;
__device__ __forceinline__ void glds16(const void*gsrc,unsigned lds_dst){unsigned keep;
  asm volatile("s_mov_b32 %0, m0\n\ts_mov_b32 m0, %2\n\ts_nop 0\n\tglobal_load_lds_dwordx4 %1, off\n\ts_mov_b32 m0, %0":"=&s"(keep):"v"(gsrc),"s"(lds_dst):"memory");}
__device__ __forceinline__ float max3f(float a,float b,float c){float r;asm("v_max3_f32 %0, %1, %2, %3":"=v"(r):"v"(a),"v"(b),"v"(c));return r;}
__device__ __forceinline__ float max2f(float a,float b){float r;asm("v_max_f32_e32 %0, %1, %2":"=v"(r):"v"(a),"v"(b));return r;}
__device__ __forceinline__ float fadd_s(float a,float b){float r;asm("v_add_f32_e32 %0, %1, %2":"=v"(r):"v"(a),"v"(b));return r;}
__device__ __forceinline__ float fsub_s(float a,float b){float r;asm("v_sub_f32_e32 %0, %1, %2":"=v"(r):"v"(a),"v"(b));return r;}
typedef float f32x2_t __attribute__((ext_vector_type(2))); typedef __bf16 bf16x2_t __attribute__((ext_vector_type(2)));
__device__ __forceinline__ unsigned cvtpk_s(float lo,float hi){f32x2_t v={lo,hi};bf16x2_t b=__builtin_convertvector(v,bf16x2_t);return __builtin_bit_cast(unsigned,b);}
#define WAIT_BAR(N) asm volatile("s_waitcnt vmcnt(" #N ") lgkmcnt(0)\n\ts_barrier":::"memory")

__device__ __forceinline__ void qkt(f32x16&p0,f32x16&p1,const char*Kslot,const bf16x8*qr,const f32x16&ci0,const f32x16&ci1,int r32,int hi){
  const char*kb=Kslot+hi*1024+r32*16;
  #pragma unroll
  for(int d0=0;d0<4;++d0){
    const bf16x8 b0=*reinterpret_cast<const bf16x8*>(kb+d0*2048);
    const bf16x8 b1=*reinterpret_cast<const bf16x8*>(kb+d0*2048+512);
    if(d0==0){p0=__builtin_amdgcn_mfma_f32_32x32x16_bf16(b0,qr[0],ci0,0,0,0);p1=__builtin_amdgcn_mfma_f32_32x32x16_bf16(b1,qr[0],ci1,0,0,0);}
    else{p0=__builtin_amdgcn_mfma_f32_32x32x16_bf16(b0,qr[d0],p0,0,0,0);p1=__builtin_amdgcn_mfma_f32_32x32x16_bf16(b1,qr[d0],p1,0,0,0);}}
}
typedef __attribute__((address_space(3))) const char* lds_cptr;
typedef short v4i16_t __attribute__((ext_vector_type(4)));
__device__ __forceinline__ void kload8(bf16x8*kf,lds_cptr kp){
  kf[0]=*(const __attribute__((address_space(3))) bf16x8*)(kp);      kf[1]=*(const __attribute__((address_space(3))) bf16x8*)(kp+512);
  kf[2]=*(const __attribute__((address_space(3))) bf16x8*)(kp+2048); kf[3]=*(const __attribute__((address_space(3))) bf16x8*)(kp+2560);
  kf[4]=*(const __attribute__((address_space(3))) bf16x8*)(kp+4096); kf[5]=*(const __attribute__((address_space(3))) bf16x8*)(kp+4608);
  kf[6]=*(const __attribute__((address_space(3))) bf16x8*)(kp+6144); kf[7]=*(const __attribute__((address_space(3))) bf16x8*)(kp+6656);
}
__device__ __forceinline__ void kload2(bf16x8*kf,lds_cptr kp,int j){ kf[2*j]=*(const __attribute__((address_space(3))) bf16x8*)(kp+j*2048); kf[2*j+1]=*(const __attribute__((address_space(3))) bf16x8*)(kp+j*2048+512); }
__device__ __forceinline__ s16x4 vtr(lds_cptr p){ return __builtin_bit_cast(s16x4,__builtin_amdgcn_ds_read_tr16_b64_v4i16((__attribute__((address_space(3))) v4i16_t*)p)); }
__device__ __forceinline__ float rowmax(const f32x16&p0,const f32x16&p1){
  float a=max3f(p0[0],p0[1],p1[0]),b=max3f(p0[2],p0[3],p1[1]);a=max3f(a,p1[2],p1[3]);
  #pragma unroll
  for(int r=4;r<16;r+=4){a=max3f(a,p0[r],p0[r+1]);b=max3f(b,p0[r+2],p0[r+3]);a=max3f(a,p1[r],p1[r+1]);b=max3f(b,p1[r+2],p1[r+3]);}
  const float m=max2f(a,b);
  auto rr=__builtin_amdgcn_permlane32_swap(__float_as_uint(m),__float_as_uint(m),false,false);
  return max2f(__uint_as_float(rr[0]),__uint_as_float(rr[1]));
}
__device__ __forceinline__ void pv(f32x16*o,int vb,bf16x8 pa0,bf16x8 pa1,bf16x8 pa2,bf16x8 pa3){
  #pragma unroll
  for(int d0=0;d0<2;++d0){s16x4 lo[4],hi[4];
    #pragma unroll
    for(int ks=0;ks<4;++ks){
      asm volatile("ds_read_b64_tr_b16 %0,%1 offset:%c2":"=&v"(lo[ks]):"v"(vb),"i"(d0*4096+ks*1024):"memory");
      asm volatile("ds_read_b64_tr_b16 %0,%1 offset:%c2":"=&v"(hi[ks]):"v"(vb),"i"(d0*4096+ks*1024+512):"memory");}
    asm volatile("s_waitcnt lgkmcnt(0)":::"memory");SBAR();
    #define PK(k) (bf16x8){lo[k][0],lo[k][1],lo[k][2],lo[k][3],hi[k][0],hi[k][1],hi[k][2],hi[k][3]}
    o[d0]=__builtin_amdgcn_mfma_f32_32x32x16_bf16(pa0,PK(0),o[d0],0,0,0);
    o[d0]=__builtin_amdgcn_mfma_f32_32x32x16_bf16(pa1,PK(1),o[d0],0,0,0);
    o[d0]=__builtin_amdgcn_mfma_f32_32x32x16_bf16(pa2,PK(2),o[d0],0,0,0);
    o[d0]=__builtin_amdgcn_mfma_f32_32x32x16_bf16(pa3,PK(3),o[d0],0,0,0);
    #undef PK
  }
}

#ifndef ATTN_STORE16
#define ATTN_STORE16(p,v) (*(u32x4*)(p)=(v))
#endif
template<int THRL,bool HASB> __device__ __forceinline__ void attn_unit(int b,int qb,const bf16*Qc,const bf16*__restrict__ Kc,const bf16*__restrict__ Vc,bf16*Oc,const float*__restrict__ kbg,int t0,char*shm,const int wv){
  int tid_=wv*64+mk_lane();
  const int tid=tid_,lane=tid&63,r32=lane&31,hi=lane>>5; const int wid=__builtin_amdgcn_readfirstlane(tid>>6);
  const long rowbase=(long)b*SEQ; const int q0=qb*QB;
  const bf16*Qw=Qc+(rowbase+q0+wid*QBLK)*PQ;
  const bf16*Kh=Kc+(rowbase+(long)t0*KVBLK)*PQ,*Vh=Vc+(rowbase+(long)t0*KVBLK)*PQ;
  const unsigned lds0=(unsigned)(uintptr_t)shm;
  float*wsf=(float*)(shm+LDS_WS)+wid*64;
  const bf16*ksrc=Kh+(long)lane*PQ+wid*8;
  const bf16*vsrc=Vh+(long)(16*(wid&3)+(lane>>2))*PQ+(wid>>2)*32+(lane&3)*8;
  const unsigned kdst=lds0+LDS_K+wid*1024, vdst=lds0+LDS_V+wid*1024;
  #define DMA_K(t,slot) glds16(ksrc+(long)(t)*KVBLK*PQ,(unsigned)__builtin_amdgcn_readfirstlane(kdst+(slot)))
  #define DMA_V(t,slot) glds16(vsrc+(long)(t)*KVBLK*PQ,(unsigned)__builtin_amdgcn_readfirstlane(vdst+(slot)))
  const int vb0=(int)(lds0+LDS_V)+((lane>>4)&1)*32+(lane&3)*8+(4*hi+((lane&15)>>2))*64;
  const char*Kbase=shm+LDS_K; bf16x8 kf[8];
  const lds_cptr shm3=(lds_cptr)shm; const lds_cptr kp0=shm3+LDS_K+hi*1024+r32*16; const lds_cptr vp0=shm3+LDS_V+((lane>>4)&1)*32+(lane&3)*8+(4*hi+((lane&15)>>2))*64;
  const int NT=(q0+QB)/KVBLK-t0;
  typedef __attribute__((address_space(3))) const f32x4 lds_cf4; typedef __attribute__((address_space(3))) f32x4 lds_f4;
  const __attribute__((address_space(3))) char* kbl=(const __attribute__((address_space(3))) char*)shm+LDS_KBIAS+hi*16;
  DMA_K(0,0);DMA_V(0,0);DMA_K(1,SLOTB);
  bf16x8 qr[4];
  #pragma unroll
  for(int d0=0;d0<4;++d0)qr[d0]=*reinterpret_cast<const bf16x8*>(&Qw[(long)r32*PQ+d0*16+hi*8]);
  float mhat=0.f,l_reg=0.f;f32x16 o[2];o[0]=f32x16{};o[1]=f32x16{};f32x16 negm=f32x16{};asm volatile("":"+v"(negm));
  const int qrel=wid*QBLK+r32;
  float mref=0.f;
  #define CINIT(C0,C1,t) do{ if(HASB){ const __attribute__((address_space(3))) char* kp_=kbl+(t)*256; \
      _Pragma("unroll") for(int g_=0;g_<4;++g_){ const f32x4 a_=*(lds_cf4*)(kp_+g_*32), b_=*(lds_cf4*)(kp_+128+g_*32); \
        _Pragma("unroll") for(int e_=0;e_<4;++e_){ C0[4*g_+e_]=a_[e_]-mhat; C1[4*g_+e_]=b_[e_]-mhat; } } } \
    }while(0)
  #define CMASK(P0,P1,t) do{int jb_=(t)-(NT-4); if(jb_>=0)cmask(P0,P1,jb_,qrel,hi);}while(0)
  bool resc=false;
  #define START(P0,P1) do{ const float rm=rowmax(P0,P1); resc=false; \
    { const float dl=HASB?__builtin_fmaxf(rm,0.f):rm; mhat=fadd_s(mhat,dl); \
      _Pragma("unroll") for(int r=0;r<16;++r){P0[r]=fsub_s(P0[r],dl);P1[r]=fsub_s(P1[r],dl);} \
      if(!HASB){ _Pragma("unroll") for(int r=0;r<16;++r)negm[r]=-mhat; asm volatile("":"+v"(negm)); } } \
    _Pragma("unroll") for(int r=0;r<16;++r)P0[r]=__builtin_amdgcn_exp2f(P0[r]); }while(0)
  #define RESC() do{ if(resc){ asm volatile("s_waitcnt lgkmcnt(0)":::"memory"); \
      _Pragma("unroll") for(int d_=0;d_<2;++d_) _Pragma("unroll") for(int r=0;r<16;++r)o[d_][r]*=wsf[crow(r,hi)]; } }while(0)
  f32x16 pA0,pA1,pB0,pB1;
  int sl_prev=0,sl_cur=0,sl_next=SLOTB;
  #define ROT() do{sl_prev=sl_cur;sl_cur=sl_next;sl_next=(sl_next==(NSLOT-1)*SLOTB)?0:sl_next+SLOTB;}while(0)
  DMA_K(2,2*SLOTB);
  if(HASB){ const int n4=(q0+QB-t0*KVBLK)/4; for(int i=tid;i<n4;i+=NW*64){ const f32x4 v=*(const f32x4*)(kbg+t0*KVBLK+4*i); *((lds_f4*)((__attribute__((address_space(3))) char*)shm+LDS_KBIAS)+i)=v; } }
  WAIT_BAR(3);
  if(HASB){ mref=*(const __attribute__((address_space(3))) float*)((const __attribute__((address_space(3))) char*)shm+LDS_KBIAS+(q0-t0*KVBLK+qrel)*4); mhat=mref; }
  { f32x16 ci0=f32x16{},ci1=f32x16{}; CINIT(ci0,ci1,0); qkt(pA0,pA1,Kbase,qr,csel<HASB>(ci0,negm),csel<HASB>(ci1,negm),r32,hi); } asm volatile("s_nop 15\n\ts_nop 7":"+v"(pA0),"+v"(pA1));CMASK(pA0,pA1,0);
  START(pA0,pA1);
  _Pragma("unroll") for(int r=0;r<16;++r)pA1[r]=__builtin_amdgcn_exp2f(pA1[r]);
  WAIT_BAR(0);
  DMA_K(3,0);DMA_V(1,SLOTB);
  ROT();
  kload8(kf,kp0+sl_cur);
  WAIT_BAR(2);
  s16x4 vlo[8],vhi[8]; u32x4 pw0,pw1,pw2,pw3;
  #define PKW(P,B) cvtpk_s(P[B],P[B+1])
  #define PAF(k) __builtin_bit_cast(bf16x8,pw##k)
  #define VFR(i) (bf16x8){vlo[i][0],vlo[i][1],vlo[i][2],vlo[i][3],vhi[i][0],vhi[i][1],vhi[i][2],vhi[i][3]}
  #define PIN(x) asm volatile("":"+v"(x))
  #define MX3(a,b,c) __builtin_fmaxf(__builtin_fmaxf((a),(b)),(c))
  #define GAPA(MF,A0,A1,A2,A3,W0,W1,PW) do{ MF; sacc+=A0; sacc+=A1; sacc+=A2; sacc+=A3; PIN(sacc); W0; W1; PIN(PW); SBAR(); }while(0)
  #define EX(v) __builtin_amdgcn_exp2f(v)
  #define GAPB(MF,X,B,Y) do{ MF; X[B]=EX(X[B]); X[B+1]=EX(X[B+1]); X[B+2]=EX(X[B+2]); X[B+3]=EX(X[B+3]); PIN(X); if(HASB){ Y[B]-=mhat; Y[B+1]-=mhat; Y[B+2]-=mhat; Y[B+3]-=mhat; PIN(Y); } SBAR(); }while(0)
  #define LOADB(Y0,Y1,t) do{ if(HASB){ const __attribute__((address_space(3))) char* kp_=kbl+(t)*256; \
      _Pragma("unroll") for(int g_=0;g_<4;++g_){ const f32x4 a_=*(lds_cf4*)(kp_+g_*32), b_=*(lds_cf4*)(kp_+128+g_*32); \
        _Pragma("unroll") for(int e_=0;e_<4;++e_){ Y0[4*g_+e_]=a_[e_]; Y1[4*g_+e_]=b_[e_]; } } } }while(0)
  #define VRD(i) do{ vlo[i]=vtr(vp_+(((i)>>2)*4096+((i)&3)*1024)); vhi[i]=vtr(vp_+(((i)>>2)*4096+((i)&3)*1024+512)); }while(0)
  #define KRD(G,j) do{ if(G){ kload2(kf,kp0+sl_next,j); SBAR(); } }while(0)
  #define STEP(C0,C1,P0,P1,t,GK,GV,GL) do{ SBAR(); \
    const lds_cptr vp_=vp0+sl_prev; \
    VRD(0); SBAR(); float sacc=(P0[0]+P0[1]); \
    GAPA(C0=__builtin_amdgcn_mfma_f32_32x32x16_bf16(kf[0],qr[0],csel<HASB>(C0,negm),0,0,0), P0[2],P0[3],P0[4],P0[5],     pw0[0]=PKW(P0,0), pw0[1]=PKW(P0,2), pw0); \
    VRD(4); SBAR(); GAPA(C1=__builtin_amdgcn_mfma_f32_32x32x16_bf16(kf[1],qr[0],csel<HASB>(C1,negm),0,0,0), P0[6],P0[7],P0[8],P0[9],     pw0[2]=PKW(P0,4), pw0[3]=PKW(P0,6), pw0); \
    VRD(1); SBAR(); GAPA(C0=__builtin_amdgcn_mfma_f32_32x32x16_bf16(kf[2],qr[1],C0,0,0,0),   P0[10],P0[11],P0[12],P0[13], pw1[0]=PKW(P0,8), pw1[1]=PKW(P0,10), pw1); \
    VRD(5); SBAR(); GAPA(C1=__builtin_amdgcn_mfma_f32_32x32x16_bf16(kf[3],qr[1],C1,0,0,0),   P0[14],P0[15],P1[0],P1[1],   pw1[2]=PKW(P0,12),pw1[3]=PKW(P0,14), pw1); \
    VRD(2); SBAR(); GAPA(C0=__builtin_amdgcn_mfma_f32_32x32x16_bf16(kf[4],qr[2],C0,0,0,0),   P1[2],P1[3],P1[4],P1[5],     pw2[0]=PKW(P1,0), pw2[1]=PKW(P1,2), pw2); \
    VRD(6); SBAR(); GAPA(C1=__builtin_amdgcn_mfma_f32_32x32x16_bf16(kf[5],qr[2],C1,0,0,0),   P1[6],P1[7],P1[8],P1[9],     pw2[2]=PKW(P1,4), pw2[3]=PKW(P1,6), pw2); \
    VRD(3); SBAR(); GAPA(C0=__builtin_amdgcn_mfma_f32_32x32x16_bf16(kf[6],qr[3],C0,0,0,0),   P1[10],P1[11],P1[12],P1[13], pw3[0]=PKW(P1,8), pw3[1]=PKW(P1,10), pw3); \
    VRD(7); SBAR(); GAPA(C1=__builtin_amdgcn_mfma_f32_32x32x16_bf16(kf[7],qr[3],C1,0,0,0),   P1[14],P1[15],0.f,0.f,       pw3[2]=PKW(P1,12),pw3[3]=PKW(P1,14), pw3); \
    l_reg+=sacc; \
    LOADB(P0,P1,(t)+1); \
    if(GK){DMA_K((t)+3,sl_cur);} if(GV){DMA_V((t)+1,sl_next);} \
    CMASK(C0,C1,t); \
    { float a=MX3(C0[0],C0[1],C1[0]),b=MX3(C0[2],C0[3],C1[1]); a=MX3(a,C1[2],C1[3]); \
      _Pragma("unroll") for(int r=4;r<16;r+=4){a=MX3(a,C0[r],C0[r+1]);b=MX3(b,C0[r+2],C0[r+3]);a=MX3(a,C1[r],C1[r+1]);b=MX3(b,C1[r+2],C1[r+3]);} \
      float rm=__builtin_fmaxf(a,b); { auto rr=__builtin_amdgcn_permlane32_swap(__float_as_uint(rm),__float_as_uint(rm),false,false); rm=__builtin_fmaxf(__uint_as_float(rr[0]),__uint_as_float(rr[1])); } \
      resc=false; \
      if(__builtin_expect(__any(rm>(float)THRL),0)){ const float dl=__builtin_fmaxf(rm,0.f); mhat+=dl; \
        _Pragma("unroll") for(int r=0;r<16;++r){C0[r]-=dl;C1[r]-=dl;} \
        if(!HASB){ _Pragma("unroll") for(int r=0;r<16;++r)negm[r]=-mhat; asm volatile("":"+v"(negm)); } \
        const float f=__builtin_amdgcn_exp2f(-dl); l_reg*=f; if(hi==0)wsf[r32]=f; resc=true; } } \
    SBAR(); \
    GAPB(o[0]=__builtin_amdgcn_mfma_f32_32x32x16_bf16(PAF(0),VFR(0),o[0],0,0,0), C0,0,P0); \
    GAPB(o[1]=__builtin_amdgcn_mfma_f32_32x32x16_bf16(PAF(0),VFR(4),o[1],0,0,0), C0,4,P0); \
    KRD(GL,0); GAPB(o[0]=__builtin_amdgcn_mfma_f32_32x32x16_bf16(PAF(1),VFR(1),o[0],0,0,0), C0,8,P0); \
    KRD(GL,1); GAPB(o[1]=__builtin_amdgcn_mfma_f32_32x32x16_bf16(PAF(1),VFR(5),o[1],0,0,0), C0,12,P0); \
    KRD(GL,2); GAPB(o[0]=__builtin_amdgcn_mfma_f32_32x32x16_bf16(PAF(2),VFR(2),o[0],0,0,0), C1,0,P1); \
    KRD(GL,3); GAPB(o[1]=__builtin_amdgcn_mfma_f32_32x32x16_bf16(PAF(2),VFR(6),o[1],0,0,0), C1,4,P1); \
    GAPB(o[0]=__builtin_amdgcn_mfma_f32_32x32x16_bf16(PAF(3),VFR(3),o[0],0,0,0), C1,8,P1); \
    GAPB(o[1]=__builtin_amdgcn_mfma_f32_32x32x16_bf16(PAF(3),VFR(7),o[1],0,0,0), C1,12,P1); \
    }while(0)
  CINIT(pB0,pB1,1);
  int t=1;
  #undef CMASK
  #define CMASK(P0,P1,t) do{}while(0)
  for(;t+5<NT;t+=2){
    STEP(pB0,pB1,pA0,pA1,t,true,true,true);     WAIT_BAR(2); RESC(); ROT();
    STEP(pA0,pA1,pB0,pB1,t+1,true,true,true);   WAIT_BAR(2); RESC(); ROT();
  }
  #undef CMASK
  #define CMASK(P0,P1,t) do{int jb_=(t)-(NT-4); if(jb_>=0)cmask(P0,P1,jb_,qrel,hi);}while(0)
  #define ENDW(tt) do{ if((tt)+3<NT){WAIT_BAR(2);} else if((tt)+2<NT){WAIT_BAR(1);} else {WAIT_BAR(0);} }while(0)
  for(;t+1<NT;t+=2){
    STEP(pB0,pB1,pA0,pA1,t,(t+3<NT),(t+1<NT),(t+1<NT));       ENDW(t);   RESC(); ROT();
    STEP(pA0,pA1,pB0,pB1,t+1,(t+4<NT),(t+2<NT),(t+2<NT));     ENDW(t+1); RESC(); ROT();
  }
  STEP(pB0,pB1,pA0,pA1,NT-1,false,false,false); RESC();
  { float sacc=pB0[0]+pB0[1]; _Pragma("unroll") for(int r=2;r<16;++r)sacc+=pB0[r]; _Pragma("unroll") for(int r=0;r<16;++r)sacc+=pB1[r]; l_reg+=sacc;
    pw0=(u32x4){PKW(pB0,0),PKW(pB0,2),PKW(pB0,4),PKW(pB0,6)};pw1=(u32x4){PKW(pB0,8),PKW(pB0,10),PKW(pB0,12),PKW(pB0,14)};pw2=(u32x4){PKW(pB1,0),PKW(pB1,2),PKW(pB1,4),PKW(pB1,6)};pw3=(u32x4){PKW(pB1,8),PKW(pB1,10),PKW(pB1,12),PKW(pB1,14)};
    SBAR(); pv(o,vb0+sl_cur,PAF(0),PAF(1),PAF(2),PAF(3)); }
  #undef PKW
  #undef PAF
  #undef VFR
  #undef PIN
  #undef MX3
  #undef GAPA
  #undef GAPB
  #undef LOADB
  #undef EX
  #undef VRD
  #undef KRD
  #undef STEP
  #undef ENDW
  {auto rr=__builtin_amdgcn_permlane32_swap(__float_as_uint(l_reg),__float_as_uint(l_reg),false,false);l_reg=__uint_as_float(rr[0])+__uint_as_float(rr[1]);}
  if(hi==0)wsf[32+r32]=l_reg;asm volatile("s_waitcnt lgkmcnt(0)":::"memory");
  float rli[16];
  #pragma unroll
  for(int r=0;r<16;++r)rli[r]=__builtin_amdgcn_rcpf(wsf[32+crow(r,hi)]);
  bf16*Ow=Oc+(rowbase+q0+wid*QBLK)*PO;
  { bf16*stg=(bf16*)(shm+LDS_OST)+wid*2048;
    #pragma unroll
    for(int r=0;r<16;++r){const int orow=crow(r,hi);
      #pragma unroll
      for(int d0=0;d0<2;++d0)stg[orow*64+d0*32+r32]=__float2bfloat16(o[d0][r]*rli[r]);}
    asm volatile("s_waitcnt lgkmcnt(0)":::"memory");
    #pragma unroll
    for(int i=0;i<4;++i){const int row=i*8+(lane>>3),ch=lane&7; const u32x4 v=*(const u32x4*)(stg+row*64+ch*8); ATTN_STORE16(Ow+(long)row*PO+ch*8,v);} }
  asm volatile("s_waitcnt lgkmcnt(0)\n\ts_barrier":::"memory");
  #undef CINIT
  #undef DMA_K
  #undef DMA_V
  #undef CMASK
  #undef START
  #undef RESC
  #undef ROT
}
constexpr int LDS_WS128=LDS_V+NSLOT*2*SLOTB, LDS_OST128=LDS_WS128+NW*64*4, LDS_BYTES128=LDS_OST128+NW*4096;
template<int THRL,bool NODEC> __device__ __forceinline__ void attn_unit128(int b,int qb,const bf16*Qc,const bf16*__restrict__ Kc,const bf16*__restrict__ Vc,bf16*Oc,char*shm,const int wv){ constexpr bool HASB=false; constexpr int t0=0; const float* kbg=nullptr;
  int tid_=wv*64+mk_lane();
  const int tid=tid_,lane=tid&63,r32=lane&31,hi=lane>>5; const int wid=__builtin_amdgcn_readfirstlane(tid>>6);
  const long rowbase=(long)b*SEQ; const int q0=qb*QB;
  const bf16*Qw=Qc+(rowbase+q0+wid*QBLK)*PQ;
  const bf16*Kh=Kc+(rowbase+(long)t0*KVBLK)*PQ,*Vh=Vc+(rowbase+(long)t0*KVBLK)*PQ;
  const unsigned lds0=(unsigned)(uintptr_t)shm;
  float*wsf=(float*)(shm+LDS_WS128)+wid*64;
  const bf16*ksrc=Kh+(long)lane*PQ+wid*8;
  const bf16*vsrc=Vh+(long)(16*(wid&3)+(lane>>2))*PQ+(wid>>2)*32+(lane&3)*8;
  const unsigned kdst=lds0+LDS_K+wid*1024, vdst=lds0+LDS_V+(wid>>2)*4096+(wid&3)*1024;
  #define DMA_K(t,slot) glds16(ksrc+(long)(t)*KVBLK*PQ,(unsigned)__builtin_amdgcn_readfirstlane(kdst+(slot)))
  #define DMA_V(t,slot) do{ glds16(vsrc+(long)(t)*KVBLK*PQ,(unsigned)__builtin_amdgcn_readfirstlane(vdst+2*(slot))); glds16(vsrc+64+(long)(t)*KVBLK*PQ,(unsigned)__builtin_amdgcn_readfirstlane(vdst+8192+2*(slot))); }while(0)
  const int vb0=(int)(lds0+LDS_V)+((lane>>4)&1)*32+(lane&3)*8+(4*hi+((lane&15)>>2))*64;
  const char*Kbase=shm+LDS_K; bf16x8 kf[8];
  const lds_cptr shm3=(lds_cptr)shm; const lds_cptr kp0=shm3+LDS_K+hi*1024+r32*16; const lds_cptr vp0=shm3+LDS_V+((lane>>4)&1)*32+(lane&3)*8+(4*hi+((lane&15)>>2))*64;
  const int NT=(q0+QB)/KVBLK-t0;
  typedef __attribute__((address_space(3))) const f32x4 lds_cf4; typedef __attribute__((address_space(3))) f32x4 lds_f4;
  const __attribute__((address_space(3))) char* kbl=(const __attribute__((address_space(3))) char*)shm+LDS_KBIAS+hi*16;
  if(HASB){ const int n4=(q0+QB-t0*KVBLK)/4; for(int i=tid;i<n4;i+=NW*64){ const f32x4 v=*(const f32x4*)(kbg+t0*KVBLK+4*i); *((lds_f4*)((__attribute__((address_space(3))) char*)shm+LDS_KBIAS)+i)=v; } }
  DMA_K(0,0);DMA_V(0,0);DMA_K(1,SLOTB);
  bf16x8 qr[4];
  #pragma unroll
  for(int d0=0;d0<4;++d0)qr[d0]=*reinterpret_cast<const bf16x8*>(&Qw[(long)r32*PQ+d0*16+hi*8]);
  float mhat=0.f,l_reg=0.f;f32x16 o[4];o[0]=f32x16{};o[1]=f32x16{};o[2]=f32x16{};o[3]=f32x16{};
  const int qrel=wid*QBLK+r32;
  float mref=0.f;
  #define CINIT(C0,C1,t) do{ if(HASB){ const __attribute__((address_space(3))) char* kp_=kbl+(t)*256; \
      _Pragma("unroll") for(int g_=0;g_<4;++g_){ const f32x4 a_=*(lds_cf4*)(kp_+g_*32), b_=*(lds_cf4*)(kp_+128+g_*32); \
        _Pragma("unroll") for(int e_=0;e_<4;++e_){ C0[4*g_+e_]=a_[e_]-mhat; C1[4*g_+e_]=b_[e_]-mhat; } } } \
    }while(0)
  #define CMASK(P0,P1,t) do{int jb_=(t)-(NT-4); if(jb_>=0)cmask(P0,P1,jb_,qrel,hi);}while(0)
  bool resc=false;
  #define START(P0,P1) do{ resc=false; \
    if(!NODEC){ const float rm=rowmax(P0,P1); const float dl=__any(rm>(float)THRL)?__builtin_fmaxf(rm,0.f):0.f; mhat=fadd_s(mhat,dl); \
      _Pragma("unroll") for(int r=0;r<16;++r){P0[r]=fsub_s(P0[r],dl);P1[r]=fsub_s(P1[r],dl);} \
      } \
    _Pragma("unroll") for(int r=0;r<16;++r)P0[r]=__builtin_amdgcn_exp2f(P0[r]); }while(0)
  #define RESC() do{ if(resc){ asm volatile("s_waitcnt lgkmcnt(0)":::"memory"); \
      _Pragma("unroll") for(int d_=0;d_<4;++d_) _Pragma("unroll") for(int r=0;r<16;++r)o[d_][r]*=wsf[crow(r,hi)]; } }while(0)
  f32x16 pA0,pA1,pB0,pB1;
  int sl_prev=0,sl_cur=0,sl_next=SLOTB;
  #define ROT() do{sl_prev=sl_cur;sl_cur=sl_next;sl_next=(sl_next==(NSLOT-1)*SLOTB)?0:sl_next+SLOTB;}while(0)
  DMA_K(2,2*SLOTB);
  WAIT_BAR(4);
  { f32x16 ci0=f32x16{}; asm volatile("":"+v"(ci0)); qkt(pA0,pA1,Kbase,qr,ci0,ci0,r32,hi); } asm volatile("s_nop 15\n\ts_nop 7":"+v"(pA0),"+v"(pA1));CMASK(pA0,pA1,0);
  START(pA0,pA1);
  _Pragma("unroll") for(int r=0;r<16;++r)pA1[r]=__builtin_amdgcn_exp2f(pA1[r]);
  WAIT_BAR(0);
  DMA_K(3,0);DMA_V(1,SLOTB);
  ROT();
  kload8(kf,kp0+sl_cur);
  WAIT_BAR(3);
  s16x4 vlo[4],vhi[4]; u32x4 pw0,pw1,pw2,pw3;
  #define PKW(P,B) cvtpk_s(P[B],P[B+1])
  #define PAF(k) __builtin_bit_cast(bf16x8,pw##k)
  #define VFR(i) (bf16x8){vlo[(i)&3][0],vlo[(i)&3][1],vlo[(i)&3][2],vlo[(i)&3][3],vhi[(i)&3][0],vhi[(i)&3][1],vhi[(i)&3][2],vhi[(i)&3][3]}
  #define PIN(x) asm volatile("":"+v"(x))
  #define MX3(a,b,c) __builtin_fmaxf(__builtin_fmaxf((a),(b)),(c))
  #define GAPA(MF,A0,A1,A2,A3,W0,W1,PW) do{ MF; sacc+=A0; sacc+=A1; sacc+=A2; sacc+=A3; PIN(sacc); W0; W1; PIN(PW); SBAR(); }while(0)
  #define EX(v) __builtin_amdgcn_exp2f(v)
  #define GAPB(MF,X,B,Y) do{ MF; X[B]=EX(X[B]); X[B+1]=EX(X[B+1]); X[B+2]=EX(X[B+2]); X[B+3]=EX(X[B+3]); PIN(X); if(HASB){ Y[B]-=mhat; Y[B+1]-=mhat; Y[B+2]-=mhat; Y[B+3]-=mhat; PIN(Y); } SBAR(); }while(0)
  #define LOADB(Y0,Y1,t) do{ if(HASB){ const __attribute__((address_space(3))) char* kp_=kbl+(t)*256; \
      _Pragma("unroll") for(int g_=0;g_<4;++g_){ const f32x4 a_=*(lds_cf4*)(kp_+g_*32), b_=*(lds_cf4*)(kp_+128+g_*32); \
        _Pragma("unroll") for(int e_=0;e_<4;++e_){ Y0[4*g_+e_]=a_[e_]; Y1[4*g_+e_]=b_[e_]; } } } }while(0)
  #define VOFF(j) ((((j)>>3)*8192)+((((j)&7)&1)*4096)+((((j)&7)>>1)*1024))
  #define VRDJ(j) do{ vlo[(j)&3]=vtr(vp_+VOFF(j)); vhi[(j)&3]=vtr(vp_+VOFF(j)+512); SBAR(); }while(0)
  #define GAPC(MF,Y,B) do{ MF; SBAR(); }while(0)
  #define KRD(G,j) do{ if(G){ kload2(kf,kp0+sl_next,j); SBAR(); } }while(0)
  #define STEP(C0,C1,P0,P1,t,GK,GV,GL) do{ SBAR(); \
    const lds_cptr vp_=vp0+2*sl_prev; \
    VRDJ(0); float sacc=(P0[0]+P0[1]); \
    GAPA(C0=__builtin_amdgcn_mfma_f32_32x32x16_bf16(kf[0],qr[0],zero16,0,0,0), P0[2],P0[3],P0[4],P0[5],     pw0[0]=PKW(P0,0), pw0[1]=PKW(P0,2), pw0); \
    VRDJ(1); GAPA(C1=__builtin_amdgcn_mfma_f32_32x32x16_bf16(kf[1],qr[0],zero16,0,0,0), P0[6],P0[7],P0[8],P0[9],     pw0[2]=PKW(P0,4), pw0[3]=PKW(P0,6), pw0); \
    VRDJ(2); GAPA(C0=__builtin_amdgcn_mfma_f32_32x32x16_bf16(kf[2],qr[1],C0,0,0,0),   P0[10],P0[11],P0[12],P0[13], pw1[0]=PKW(P0,8), pw1[1]=PKW(P0,10), pw1); \
    VRDJ(3); GAPA(C1=__builtin_amdgcn_mfma_f32_32x32x16_bf16(kf[3],qr[1],C1,0,0,0),   P0[14],P0[15],P1[0],P1[1],   pw1[2]=PKW(P0,12),pw1[3]=PKW(P0,14), pw1); \
    GAPA(C0=__builtin_amdgcn_mfma_f32_32x32x16_bf16(kf[4],qr[2],C0,0,0,0),   P1[2],P1[3],P1[4],P1[5],     pw2[0]=PKW(P1,0), pw2[1]=PKW(P1,2), pw2); \
    GAPA(C1=__builtin_amdgcn_mfma_f32_32x32x16_bf16(kf[5],qr[2],C1,0,0,0),   P1[6],P1[7],P1[8],P1[9],     pw2[2]=PKW(P1,4), pw2[3]=PKW(P1,6), pw2); \
    GAPA(C0=__builtin_amdgcn_mfma_f32_32x32x16_bf16(kf[6],qr[3],C0,0,0,0),   P1[10],P1[11],P1[12],P1[13], pw3[0]=PKW(P1,8), pw3[1]=PKW(P1,10), pw3); \
    GAPA(C1=__builtin_amdgcn_mfma_f32_32x32x16_bf16(kf[7],qr[3],C1,0,0,0),   P1[14],P1[15],0.f,0.f,       pw3[2]=PKW(P1,12),pw3[3]=PKW(P1,14), pw3); \
    l_reg+=sacc; \
    if(!NODEC){ if(__builtin_expect(__any(mhat!=0.f),0)){ _Pragma("unroll") for(int r=0;r<16;++r){C0[r]-=mhat;C1[r]-=mhat;} } } \
    if(GK){DMA_K((t)+3,sl_cur);} if(GV){DMA_V((t)+1,sl_next);} \
    CMASK(C0,C1,t); \
    resc=false; if(!NODEC){ float a=MX3(C0[0],C0[1],C1[0]),b=MX3(C0[2],C0[3],C1[1]); a=MX3(a,C1[2],C1[3]); \
      _Pragma("unroll") for(int r=4;r<16;r+=4){a=MX3(a,C0[r],C0[r+1]);b=MX3(b,C0[r+2],C0[r+3]);a=MX3(a,C1[r],C1[r+1]);b=MX3(b,C1[r+2],C1[r+3]);} \
      float rm=__builtin_fmaxf(a,b); { auto rr=__builtin_amdgcn_permlane32_swap(__float_as_uint(rm),__float_as_uint(rm),false,false); rm=__builtin_fmaxf(__uint_as_float(rr[0]),__uint_as_float(rr[1])); } \
      resc=false; \
      if(__builtin_expect(__any(rm>(float)THRL),0)){ const float dl=__builtin_fmaxf(rm,0.f); mhat+=dl; \
        _Pragma("unroll") for(int r=0;r<16;++r){C0[r]-=dl;C1[r]-=dl;} \
        const float f=__builtin_amdgcn_exp2f(-dl); l_reg*=f; if(hi==0)wsf[r32]=f; resc=true; } } \
    SBAR(); \
    GAPB(o[0]=__builtin_amdgcn_mfma_f32_32x32x16_bf16(PAF(0),VFR(0),o[0],0,0,0), C0,0,P0); VRDJ(4); \
    GAPB(o[1]=__builtin_amdgcn_mfma_f32_32x32x16_bf16(PAF(0),VFR(1),o[1],0,0,0), C0,4,P0); VRDJ(5); \
    GAPB(o[0]=__builtin_amdgcn_mfma_f32_32x32x16_bf16(PAF(1),VFR(2),o[0],0,0,0), C0,8,P0); VRDJ(6); \
    GAPB(o[1]=__builtin_amdgcn_mfma_f32_32x32x16_bf16(PAF(1),VFR(3),o[1],0,0,0), C0,12,P0); VRDJ(7); \
    GAPB(o[0]=__builtin_amdgcn_mfma_f32_32x32x16_bf16(PAF(2),VFR(4),o[0],0,0,0), C1,0,P1); VRDJ(8); \
    GAPB(o[1]=__builtin_amdgcn_mfma_f32_32x32x16_bf16(PAF(2),VFR(5),o[1],0,0,0), C1,4,P1); VRDJ(9); \
    GAPB(o[0]=__builtin_amdgcn_mfma_f32_32x32x16_bf16(PAF(3),VFR(6),o[0],0,0,0), C1,8,P1); VRDJ(10); \
    GAPB(o[1]=__builtin_amdgcn_mfma_f32_32x32x16_bf16(PAF(3),VFR(7),o[1],0,0,0), C1,12,P1); VRDJ(11); \
    GAPC(o[2]=__builtin_amdgcn_mfma_f32_32x32x16_bf16(PAF(0),VFR(8),o[2],0,0,0), P0,0); VRDJ(12); \
    GAPC(o[3]=__builtin_amdgcn_mfma_f32_32x32x16_bf16(PAF(0),VFR(9),o[3],0,0,0), P0,4); VRDJ(13); \
    KRD(GL,0); GAPC(o[2]=__builtin_amdgcn_mfma_f32_32x32x16_bf16(PAF(1),VFR(10),o[2],0,0,0), P0,8); VRDJ(14); \
    KRD(GL,1); GAPC(o[3]=__builtin_amdgcn_mfma_f32_32x32x16_bf16(PAF(1),VFR(11),o[3],0,0,0), P0,12); VRDJ(15); \
    KRD(GL,2); GAPC(o[2]=__builtin_amdgcn_mfma_f32_32x32x16_bf16(PAF(2),VFR(12),o[2],0,0,0), P1,0); \
    KRD(GL,3); GAPC(o[3]=__builtin_amdgcn_mfma_f32_32x32x16_bf16(PAF(2),VFR(13),o[3],0,0,0), P1,4); \
    GAPC(o[2]=__builtin_amdgcn_mfma_f32_32x32x16_bf16(PAF(3),VFR(14),o[2],0,0,0), P1,8); \
    GAPC(o[3]=__builtin_amdgcn_mfma_f32_32x32x16_bf16(PAF(3),VFR(15),o[3],0,0,0), P1,12); \
    }while(0)
  const f32x16 zero16=f32x16{};
  int t=1;
  #undef CMASK
  #define CMASK(P0,P1,t) do{}while(0)
  for(;t+5<NT;t+=2){
    STEP(pB0,pB1,pA0,pA1,t,true,true,true);     WAIT_BAR(3); RESC(); ROT();
    STEP(pA0,pA1,pB0,pB1,t+1,true,true,true);   WAIT_BAR(3); RESC(); ROT();
  }
  #undef CMASK
  #define CMASK(P0,P1,t) do{int jb_=(t)-(NT-4); if(jb_>=0)cmask(P0,P1,jb_,qrel,hi);}while(0)
  #define ENDW(tt) do{ if((tt)+3<NT){WAIT_BAR(3);} else if((tt)+2<NT){WAIT_BAR(2);} else {WAIT_BAR(0);} }while(0)
  for(;t+1<NT;t+=2){
    STEP(pB0,pB1,pA0,pA1,t,(t+3<NT),(t+1<NT),(t+1<NT));       ENDW(t);   RESC(); ROT();
    STEP(pA0,pA1,pB0,pB1,t+1,(t+4<NT),(t+2<NT),(t+2<NT));     ENDW(t+1); RESC(); ROT();
  }
  STEP(pB0,pB1,pA0,pA1,NT-1,false,false,false); RESC();
  { float sacc=pB0[0]+pB0[1]; _Pragma("unroll") for(int r=2;r<16;++r)sacc+=pB0[r]; _Pragma("unroll") for(int r=0;r<16;++r)sacc+=pB1[r]; l_reg+=sacc;
    pw0=(u32x4){PKW(pB0,0),PKW(pB0,2),PKW(pB0,4),PKW(pB0,6)};pw1=(u32x4){PKW(pB0,8),PKW(pB0,10),PKW(pB0,12),PKW(pB0,14)};pw2=(u32x4){PKW(pB1,0),PKW(pB1,2),PKW(pB1,4),PKW(pB1,6)};pw3=(u32x4){PKW(pB1,8),PKW(pB1,10),PKW(pB1,12),PKW(pB1,14)};
    SBAR(); pv(o,vb0+2*sl_cur,PAF(0),PAF(1),PAF(2),PAF(3)); pv(o+2,vb0+2*sl_cur+8192,PAF(0),PAF(1),PAF(2),PAF(3)); }
  #undef PKW
  #undef PAF
  #undef VFR
  #undef PIN
  #undef MX3
  #undef GAPA
  #undef GAPB
  #undef LOADB
  #undef EX
  #undef VRDJ
  #undef VOFF
  #undef GAPC
  #undef KRD
  #undef STEP
  #undef ENDW
  {auto rr=__builtin_amdgcn_permlane32_swap(__float_as_uint(l_reg),__float_as_uint(l_reg),false,false);l_reg=__uint_as_float(rr[0])+__uint_as_float(rr[1]);}
  if(hi==0)wsf[32+r32]=l_reg;asm volatile("s_waitcnt lgkmcnt(0)":::"memory");
  float rli[16];
  #pragma unroll
  for(int r=0;r<16;++r)rli[r]=__builtin_amdgcn_rcpf(wsf[32+crow(r,hi)]);
  bf16*Ow=Oc+(rowbase+q0+wid*QBLK)*PO;
  { bf16*stg=(bf16*)(shm+LDS_OST128)+wid*2048;
    #pragma unroll
    for(int hf=0;hf<2;++hf){
      #pragma unroll
      for(int r=0;r<16;++r){const int orow=crow(r,hi);
        #pragma unroll
        for(int d0=0;d0<2;++d0)stg[orow*64+d0*32+r32]=__float2bfloat16(o[2*hf+d0][r]*rli[r]);}
      asm volatile("s_waitcnt lgkmcnt(0)":::"memory");
      #pragma unroll
      for(int i=0;i<4;++i){const int row=i*8+(lane>>3),ch=lane&7; const u32x4 v=*(const u32x4*)(stg+row*64+ch*8); ATTN_STORE16(Ow+(long)row*PO+hf*64+ch*8,v);}
      asm volatile("s_waitcnt lgkmcnt(0)":::"memory"); } }
  asm volatile("s_waitcnt lgkmcnt(0)\n\ts_barrier":::"memory");
  #undef CINIT
  #undef DMA_K
  #undef DMA_V
  #undef CMASK
  #undef START
  #undef RESC
  #undef ROT
}
constexpr int ATTN_LDS_BYTES=(LDS_BYTES>LDS_BYTES128)?LDS_BYTES:LDS_BYTES128;
#undef SBAR
#undef WAIT_BAR
}

namespace xattn {
using pg8::bf16_t; using pg8::bf16x8; using pg8::u32x4; using pg8::f32x4;
using f32x16 = __attribute__((ext_vector_type(16))) float;
#define XLAS __attribute__((address_space(3)))
constexpr int XB0 = 0, XB1 = 32768, X_WSF = 65536, X_OST = X_WSF + 2048, X_LDS_BYTES = X_OST + 8 * 4096;
__device__ __forceinline__ int crow(int r, int hi) { return (r & 3) + 8 * (r >> 2) + 4 * hi; }
__device__ __forceinline__ unsigned pk(float lo, float hi) { return pg8::cvt_pk_bf16(lo, hi); }
__device__ __forceinline__ void unit(int b, int h, int qblk, const bf16_t* __restrict__ CQ, const bf16_t* __restrict__ CK, const bf16_t* __restrict__ CVT, bf16_t* __restrict__ CO, XLAS unsigned char* lds, const int wv) {
    const int tid = wv * 64 + mk_lane(), lane = tid & 63, r32 = lane & 31, hi = lane >> 5; const int wid = __builtin_amdgcn_readfirstlane(tid >> 6);
    const size_t qrow0 = (size_t)b * 4096 + (size_t)qblk * 256 + wid * 32;
    const bf16_t* Qw = CQ + (qrow0 + r32) * 1024 + h * 256 + hi * 8;
    const bf16_t* Kg = CK + ((size_t)b * 256 + lane) * 1024 + h * 256 + wid * 8;
    const bf16_t* Vg = CVT + ((size_t)h * 256 + lane) * 2048 + (size_t)b * 256 + wid * 8;
    u32x4 st[4];
#define X_LOADK(dc) do { _Pragma("unroll") for (int i_ = 0; i_ < 4; ++i_) st[i_] = *(const u32x4*)(Kg + (dc) * 64 + (size_t)i_ * 64 * 1024); } while (0)
#define X_LOADV(c)  do { _Pragma("unroll") for (int i_ = 0; i_ < 4; ++i_) st[i_] = *(const u32x4*)(Vg + (size_t)(c) * 64 * 2048 + i_ * 64); } while (0)
#define X_STOREK(buf) do { _Pragma("unroll") for (int i_ = 0; i_ < 4; ++i_) *(XLAS u32x4*)(lds + (buf) + wid * 4096 + (64 * i_ + lane) * 16) = st[i_]; } while (0)
#define X_STOREV(buf) do { _Pragma("unroll") for (int i_ = 0; i_ < 4; ++i_) *(XLAS u32x4*)(lds + (buf) + (wid + 8 * i_) * 1024 + lane * 16) = st[i_]; } while (0)
    const int kswz = (r32 & ~12) | ((r32 & 4) << 1) | ((r32 & 8) >> 1);
    const int koff = hi * 4096 + kswz * 16;
    const int voff = hi * 1024 + r32 * 16;
    f32x16 s[8];
#pragma unroll
    for (int kt = 0; kt < 8; ++kt) s[kt] = f32x16{};
    X_LOADK(0);
    bf16x8 qfa[4][4];
#pragma unroll
    for (int dc = 0; dc < 4; ++dc)
#pragma unroll
        for (int ks = 0; ks < 4; ++ks) qfa[dc][ks] = *(const bf16x8*)(Qw + dc * 64 + ks * 16);
    X_STOREK(XB0);
    __syncthreads();
#pragma unroll
    for (int dc = 0; dc < 4; ++dc) {
        const int buf = (dc & 1) ? XB1 : XB0, nbuf = (dc & 1) ? XB0 : XB1;
        if (dc < 3) X_LOADK(dc + 1); else X_LOADV(0);
#pragma unroll
        for (int kt = 0; kt < 8; ++kt)
#pragma unroll
            for (int ks = 0; ks < 4; ++ks) {
                const bf16x8 kf = *(const XLAS bf16x8*)(lds + buf + koff + kt * 512 + ks * 8192);
                s[kt] = __builtin_amdgcn_mfma_f32_32x32x16_bf16(kf, qfa[dc][ks], s[kt], 0, 0, 0);
            }
        if (dc < 3) X_STOREK(nbuf); else X_STOREV(nbuf);
        __syncthreads();
    }
    float mx = s[0][0];
#pragma unroll
    for (int kt = 0; kt < 8; ++kt)
#pragma unroll
        for (int r = 0; r < 16; ++r) mx = fmaxf(mx, s[kt][r]);
    mx = fmaxf(mx, __shfl_xor(mx, 32));
    float l = 0.f;
#pragma unroll
    for (int kt = 0; kt < 8; ++kt)
#pragma unroll
        for (int r = 0; r < 16; ++r) { const float p = __builtin_amdgcn_exp2f(s[kt][r] - mx); s[kt][r] = p; l += p; }
    l += __shfl_xor(l, 32);
    u32x4 pw[16];
#pragma unroll
    for (int kt = 0; kt < 8; ++kt)
#pragma unroll
        for (int j2 = 0; j2 < 2; ++j2)
            pw[2 * kt + j2] = (u32x4){pk(s[kt][8 * j2 + 0], s[kt][8 * j2 + 1]), pk(s[kt][8 * j2 + 2], s[kt][8 * j2 + 3]), pk(s[kt][8 * j2 + 4], s[kt][8 * j2 + 5]), pk(s[kt][8 * j2 + 6], s[kt][8 * j2 + 7])};
    XLAS float* wsf = (XLAS float*)(lds + X_WSF) + wid * 64;
    if (hi == 0) wsf[r32] = l;
    asm volatile("s_waitcnt lgkmcnt(0)" ::: "memory");
    float rli[16];
#pragma unroll
    for (int r = 0; r < 16; ++r) rli[r] = __builtin_amdgcn_rcpf(wsf[crow(r, hi)]);
    XLAS bf16_t* stg = (XLAS bf16_t*)(lds + X_OST) + wid * 2048;
    bf16_t* Ow = CO + qrow0 * 1024 + h * 256;
#pragma unroll
    for (int c = 0; c < 4; ++c) {
        const int buf = (c & 1) ? XB1 : XB0, nbuf = (c & 1) ? XB0 : XB1;
        if (c < 3) X_LOADV(c + 1);
        f32x16 o[2]; o[0] = f32x16{}; o[1] = f32x16{};
#pragma unroll
        for (int j = 0; j < 16; ++j)
#pragma unroll
            for (int dt = 0; dt < 2; ++dt) {
                const bf16x8 vf = *(const XLAS bf16x8*)(lds + buf + voff + dt * 512 + j * 2048);
                o[dt] = __builtin_amdgcn_mfma_f32_32x32x16_bf16(__builtin_bit_cast(bf16x8, pw[j]), vf, o[dt], 0, 0, 0);
            }
#pragma unroll
        for (int r = 0; r < 16; ++r) { const int orow = crow(r, hi);
#pragma unroll
            for (int dt = 0; dt < 2; ++dt) { const unsigned w = pk(o[dt][r] * rli[r], 0.f); stg[orow * 64 + dt * 32 + r32] = (bf16_t)(w & 0xffffu); } }
        asm volatile("s_waitcnt lgkmcnt(0)" ::: "memory");
#pragma unroll
        for (int i = 0; i < 4; ++i) { const int row = i * 8 + (lane >> 3), ch = lane & 7; const u32x4 v = *(const XLAS u32x4*)(stg + row * 64 + ch * 8); *(u32x4*)(Ow + (size_t)row * 1024 + c * 64 + ch * 8) = v; }
        asm volatile("s_waitcnt lgkmcnt(0)" ::: "memory");
        if (c < 3) X_STOREV(nbuf);
        __syncthreads();
    }
#undef X_LOADK
#undef X_LOADV
#undef X_STOREK
#undef X_STOREV
}
}

#ifndef MK_PER_PHASE
#define MK_PER_PHASE 0
#endif
constexpr int NWAVES = 8;
constexpr int BATCH = 8, SEQ = 4096, D = 1024, M = BATCH * SEQ, FF = 4096, NMEM = 256, MM = BATCH * NMEM, INW = 3080, NPROJ = 3072, NATT = 1536;
constexpr float EPS = 1e-6f, SUBLN_EPS = 1e-5f;
constexpr int N_PHASES = 11;

constexpr size_t MiB = 1u << 20;
constexpr size_t WS_ROPE = 0;
constexpr size_t WS_LOGF = 1 * MiB;
constexpr size_t WS_KB   = 2 * MiB;
constexpr size_t WS_NRM  = 3 * MiB;
constexpr size_t WS_BAR  = 3 * MiB + 65536;
constexpr size_t WS_SS1  = 4 * MiB, WS_SS2 = 6 * MiB, WS_SS3 = 8 * MiB;
constexpr size_t WS_WIN = 10 * MiB, WS_WOUT = 16 * MiB, WS_WCQ = 18 * MiB, WS_WCKV = 20 * MiB, WS_WCO = 24 * MiB, WS_WUP = 26 * MiB, WS_WDN = 34 * MiB;
constexpr size_t WS_MEMN = 42 * MiB, WS_CK = 46 * MiB, WS_CVT = 50 * MiB;
constexpr size_t WS_SA = 56 * MiB;
constexpr size_t WS_SB = 120 * MiB;
constexpr size_t WS_PROJ = 184 * MiB;
constexpr size_t WS_ATT = 376 * MiB;
constexpr size_t WS_ZH = 184 * MiB;
constexpr size_t WS_END = 472 * MiB;
static_assert(WS_ZH + (size_t)M * FF * 2 <= WS_END && WS_ATT + (size_t)M * NATT * 2 <= WS_END && WS_PROJ + (size_t)M * NPROJ * 2 <= WS_ATT, "d_ws map");

constexpr int RING_BYTES = 131072, LDS_BYTES = 147456;
static_assert(attn_body::ATTN_LDS_BYTES <= RING_BYTES && xattn::X_LDS_BYTES <= RING_BYTES && pg8::STAGE_BYTES <= RING_BYTES, "LDS map");

#define LAS __attribute__((address_space(3)))
typedef unsigned short bf16;
typedef unsigned v4u __attribute__((ext_vector_type(4)));
typedef float f32x4 __attribute__((ext_vector_type(4)));
#define LDS_WAIT() asm volatile("s_waitcnt lgkmcnt(0)" ::: "memory")
__device__ __forceinline__ unsigned f2bf(float f) { unsigned u = __builtin_bit_cast(unsigned, f); return (u + 0x7fffu + ((u >> 16) & 1u)) >> 16; }
__device__ __forceinline__ unsigned pk2(float lo, float hi) { return f2bf(lo) | (f2bf(hi) << 16); }
__device__ __forceinline__ float bflo(unsigned w) { return __builtin_bit_cast(float, w << 16); }
__device__ __forceinline__ float bfhi(unsigned w) { return __builtin_bit_cast(float, w & 0xffff0000u); }
__device__ __forceinline__ float wave_sum(float v) {
#pragma unroll
    for (int o = 1; o < 64; o <<= 1) v += __shfl_xor(v, o);
    return v;
}

#define XB_TMO      128
#define XB_XCNT(j)  (256  + 64 * (j))
#define XB_XSUB(j)  (1280 + 64 * (j))
#define XB_XGEN(j)  (2304 + 64 * (j))
#define XB_TOP      3328
#define XB_TOPGEN   3392
#define XCD_BAR_WORDS 3456
#define XB_SPIN_CAP (1u << 18)

__device__ __forceinline__ unsigned xb_ld(unsigned* p)              { return __hip_atomic_load(p, __ATOMIC_RELAXED, __HIP_MEMORY_SCOPE_AGENT); }
__device__ __forceinline__ unsigned xb_add(unsigned* p, unsigned v) { return __hip_atomic_fetch_add(p, v, __ATOMIC_RELAXED, __HIP_MEMORY_SCOPE_AGENT); }
__device__ __forceinline__ unsigned xb_xcc_id() { return (unsigned)__builtin_amdgcn_s_getreg((3 << 11) | 20) & 0xFu; }
#define XB_SPIN(cond, bar) do { unsigned _sp = 0; while (cond) { __builtin_amdgcn_s_sleep(1); \
    if ((++_sp & 255u) == 0u) { if (xb_ld(&(bar)[XB_TMO])) break; if (_sp > XB_SPIN_CAP) { atomicAdd(&(bar)[XB_TMO], 1u); break; } } } } while (0)

struct XcdBarrier {
    unsigned* bar; unsigned x;
    volatile LAS unsigned* st;
};

__device__ __forceinline__ XcdBarrier xcd_barrier_post(unsigned* bar, volatile LAS unsigned* st, bool leader) {
    XcdBarrier b; b.bar = bar; b.x = xb_xcc_id(); b.st = st;
    if (leader) (void)xb_add(&bar[XB_XCNT(b.x)], 1u);
    return b;
}
__device__ __forceinline__ void xcd_barrier_complete(unsigned* bar, unsigned x, unsigned& nloc, unsigned& nx) {
    const unsigned G = gridDim.x * gridDim.y * gridDim.z;
    unsigned sum, cnt, mine, sp = 0u;
    for (;;) {
        sum = 0u; cnt = 0u; mine = 0u;
#pragma unroll
        for (unsigned j = 0; j < 16; ++j) { const unsigned c = xb_ld(&bar[XB_XCNT(j)]); sum += c; cnt += (c > 0u) ? 1u : 0u; mine = (j == x) ? c : mine; }
        if (sum == G) break;
        __builtin_amdgcn_s_sleep(1);
        if ((++sp & 255u) == 0u) { if (xb_ld(&bar[XB_TMO])) break; if (sp > XB_SPIN_CAP) { atomicAdd(&bar[XB_TMO], 1u); break; } }
    }
    nloc = mine > 0u ? mine : 1u; nx = cnt > 0u ? cnt : 1u;
}

__device__ __forceinline__ void xcd_barrier(const XcdBarrier& b, bool leader) {
    asm volatile("s_waitcnt vmcnt(0)" ::: "memory");
    __syncthreads();
    if (leader) {
        unsigned* bar = b.bar;
        __builtin_amdgcn_s_waitcnt(0);
        unsigned nloc = b.st[0], nx = b.st[1];
        if (nloc == 0u) { xcd_barrier_complete(bar, b.x, nloc, nx); b.st[0] = nloc; b.st[1] = nx; }
        const unsigned old = xb_add(&bar[XB_XSUB(b.x)], 1u);
        const unsigned gen = old / nloc;
        if (old + 1u == (gen + 1u) * nloc) {
            __builtin_amdgcn_fence(__ATOMIC_RELEASE, "agent");
            asm volatile("s_waitcnt vmcnt(0)" ::: "memory");
            const unsigned og = xb_add(&bar[XB_TOP], 1u);
            const unsigned tg = og / nx;
            if (og + 1u == (tg + 1u) * nx) xb_add(&bar[XB_TOPGEN], 1u);
            else XB_SPIN(xb_ld(&bar[XB_TOPGEN]) == tg, bar);
            __builtin_amdgcn_fence(__ATOMIC_ACQUIRE, "agent");
            xb_add(&bar[XB_XGEN(b.x)], 1u);
            asm volatile("s_waitcnt vmcnt(0)" ::: "memory");
        } else {
            XB_SPIN(xb_ld(&bar[XB_XGEN(b.x)]) == gen, bar);
            __builtin_amdgcn_fence(__ATOMIC_ACQUIRE, "agent");
            asm volatile("s_waitcnt vmcnt(0)" ::: "memory");
        }
    }
    __syncthreads();
}

struct Params { const float* in[21]; float* out; unsigned char* ws; int ph_lo, ph_hi; };
enum { I_X = 0, I_MEM, I_GMIX, I_WIN, I_BF, I_LQ1, I_LK1, I_LQ2, I_LK2, I_GSUB, I_GFOX, I_WOUT, I_GCROSS, I_GMEM, I_WCQ, I_WCKV, I_WCO, I_GMLP, I_WUP, I_WDN, I_GFIN };

__device__ __forceinline__ void p0_transpose_item(const float* W, int K, int ldw, int nblk, bf16* WT, LAS float* scr, int item, int lane, const float* gk = nullptr  ) {
    const int kb = item / nblk, nb = item % nblk, k0 = 64 * kb, n0 = 32 * nb;
    { f32x4 v[8]; float gg[8];
#pragma unroll
        for (int it = 0; it < 8; ++it) { const int kk = 8 * it + (lane >> 3); v[it] = *(const f32x4*)(W + (size_t)(k0 + kk) * ldw + n0 + 4 * (lane & 7)); gg[it] = gk ? gk[k0 + kk] : 1.f; }
#pragma unroll
        for (int it = 0; it < 8; ++it) { const int kk = 8 * it + (lane >> 3); LAS float* d = scr + kk * 33 + 4 * (lane & 7); d[0] = v[it].x * gg[it]; d[1] = v[it].y * gg[it]; d[2] = v[it].z * gg[it]; d[3] = v[it].w * gg[it]; } }
    LDS_WAIT(); asm volatile("" ::: "memory");
    const int c = lane & 7;
#pragma unroll
    for (int j = 0; j < 4; ++j) { const int n = (lane >> 3) + 8 * j; const LAS float* s = scr + (8 * c) * 33 + n;
        v4u o; o.x = pk2(s[0 * 33], s[1 * 33]); o.y = pk2(s[2 * 33], s[3 * 33]); o.z = pk2(s[4 * 33], s[5 * 33]); o.w = pk2(s[6 * 33], s[7 * 33]);
        *(v4u*)(WT + (size_t)(n0 + n) * K + k0 + 8 * c) = o; }
    LDS_WAIT(); asm volatile("" ::: "memory");
}

__device__ __forceinline__ void rms_row(const float* xrow, const f32x4 (&gq)[4], bf16* orow, int lane, f32x4 (&v)[4]) {
    const f32x4* xr = (const f32x4*)xrow + lane; float s = 0.f;
#pragma unroll
    for (int j = 0; j < 4; ++j) { v[j] = xr[64 * j]; s += (v[j].x * v[j].x + v[j].y * v[j].y) + (v[j].z * v[j].z + v[j].w * v[j].w); }
    const float rstd = 1.0f / sqrtf(wave_sum(s) * (1.f / 1024.f) + EPS);
    unsigned long long* o8 = (unsigned long long*)orow + lane;
#pragma unroll
    for (int j = 0; j < 4; ++j) { v[j] = v[j] * rstd * gq[j]; o8[64 * j] = (unsigned long long)pk2(v[j].x, v[j].y) | ((unsigned long long)pk2(v[j].z, v[j].w) << 32); }
}

template <class Sched> __device__ __forceinline__ void build_rstd_tables(LAS unsigned char* lds, const Sched& S, const float* sspart, float eps, int wave) {
    const int lane = mk_lane(), tid = wave * 64 + lane;
    LAS int* pml = (LAS int*)(lds + RING_BYTES + 1536); LAS float* tab = (LAS float*)(lds + RING_BYTES + 2048);
    if (tid == 0) { int n = 0; pg8::Unit u; for (int i = 0; S.next(i, u); ++i) { bool f = false; for (int j = 0; j < n; ++j) f |= (pml[j] == u.pm); if (!f && n < 8) pml[n++] = u.pm; } pml[8] = n; }
    __syncthreads();
    const int n = pml[8];
    for (int idx = tid; idx < n * 256; idx += NWAVES * 64) tab[idx] = pg8::row_rstd(sspart, pml[idx >> 8] * 256 + (idx & 255), eps);
    __syncthreads();
}
__global__ void __launch_bounds__(NWAVES * 64, 2) mk_fwd(Params P) {
    extern __shared__ __attribute__((aligned(16))) unsigned char lds_raw[];
    LAS unsigned char* lds = (LAS unsigned char*)lds_raw;
    const int wave = __builtin_amdgcn_readfirstlane((int)threadIdx.x >> 6);
#define LANE_TID const int lane = mk_lane(), tid = wave * 64 + lane
    const int G = gridDim.x; const int bx = blockIdx.x; const int vcu = (G % 8 == 0) ? (bx % 8) * (G / 8) + bx / 8 : bx;
    const int gw = vcu * NWAVES + wave, NGW = G * NWAVES;
    unsigned char* const ws = P.ws;
#define ROPE ((float*)(P.ws + WS_ROPE))
#define LOGF ((float*)(P.ws + WS_LOGF))
#define KBIAS ((float*)(P.ws + WS_KB))
#define NRM ((float*)(P.ws + WS_NRM))
#define SS1 ((float*)(P.ws + WS_SS1))
#define SS2 ((float*)(P.ws + WS_SS2))
#define SS3 ((float*)(P.ws + WS_SS3))
#define Win_t ((bf16*)(P.ws + WS_WIN))
#define Wout_t ((bf16*)(P.ws + WS_WOUT))
#define Wcq_t ((bf16*)(P.ws + WS_WCQ))
#define Wckv_t ((bf16*)(P.ws + WS_WCKV))
#define Wco_t ((bf16*)(P.ws + WS_WCO))
#define Wup_t ((bf16*)(P.ws + WS_WUP))
#define Wdn_t ((bf16*)(P.ws + WS_WDN))
#define MEMN ((bf16*)(P.ws + WS_MEMN))
#define CKb ((bf16*)(P.ws + WS_CK))
#define CVT ((bf16*)(P.ws + WS_CVT))
#define XN ((bf16*)(P.ws + WS_SB))
#define MIXA ((bf16*)(P.ws + WS_SA))
#define CQ ((bf16*)(P.ws + WS_SA))
#define H2B ((bf16*)(P.ws + WS_SA))
#define H1B ((bf16*)(P.ws + WS_SB))
#define CO ((bf16*)(P.ws + WS_PROJ))
#define PROJ ((bf16*)(P.ws + WS_PROJ))
#define ATT ((bf16*)(P.ws + WS_ATT))
#define ZH ((bf16*)(P.ws + WS_ZH))
    const int lo = P.ph_lo, hi_ph = P.ph_hi;
    volatile LAS unsigned* xst = (volatile LAS unsigned*)(lds + RING_BYTES + 1024);
    { const int l0 = mk_lane(); if (wave == 0 && l0 < 2) xst[l0] = 0u; }
    __syncthreads();
    XcdBarrier bar; bar.bar = (unsigned*)(ws + WS_BAR); bar.x = 0; bar.st = xst;
    if (hi_ph - lo > 1) bar = xcd_barrier_post((unsigned*)(ws + WS_BAR), xst, wave == 0 && mk_lane() == 0);
    if (lo < 0) cg::this_grid().sync();
#define IN(k) (lo <= (k) && (k) < hi_ph)
#ifndef MK_MASK
#define MK_MASK 0x7ff
#endif
#ifndef MK_ATT_MASK
#define MK_ATT_MASK 3
#endif
#ifndef MK_REP_MASK
#define MK_REP_MASK 0
#endif
#define PH(k) (IN(k) && ((MK_MASK >> (k)) & 1))
#define REPS(k) for (int rep_ = 0; rep_ < (((MK_REP_MASK) >> (k)) & 1) + 1; ++rep_)
#define SEAM(k) do { if (IN(k) && IN((k) + 1)) { xcd_barrier(bar, wave == 0 && mk_lane() == 0); } } while (0)

    if (PH(0)) REPS(0) {
        LANE_TID;
        {
            const float* win = P.in[I_WIN];
            for (int k = tid; k < 1024; k += NWAVES * 64) { const f32x4 a = *(const f32x4*)(win + (size_t)k * INW + 3072), b = *(const f32x4*)(win + (size_t)k * INW + 3076);
                const int slot = (((k >> 8) * 4 + (k & 3)) * 64 + ((k & 255) >> 2)); *(LAS f32x4*)(lds + slot * 32) = a; *(LAS f32x4*)(lds + slot * 32 + 16) = b; }
        }
        if (bx == 0 && tid < BATCH * 64) NRM[tid] = 0.f;
        __syncthreads();
        LAS float* scr = (LAS float*)(lds + 32768 + wave * 8704);
        {
            constexpr int I_IN = 16 * 96, I_SQ = 16 * 32, I_CKV = 16 * 64, I_UP = 16 * 128, I_DN = 64 * 32;
            constexpr int NITEMS = I_IN + 3 * I_SQ + I_CKV + I_UP + I_DN;
            for (int it = gw; it < NITEMS; it += NGW) {
                int r = it;
                if (r < I_IN) { p0_transpose_item(P.in[I_WIN], D, INW, 96, Win_t, scr, r, lane, P.in[I_GMIX]); continue; } r -= I_IN;
                if (r < I_SQ) { p0_transpose_item(P.in[I_WOUT], D, D, 32, Wout_t, scr, r, lane); continue; } r -= I_SQ;
                if (r < I_SQ) { p0_transpose_item(P.in[I_WCQ], D, D, 32, Wcq_t, scr, r, lane, P.in[I_GCROSS]); continue; } r -= I_SQ;
                if (r < I_SQ) { p0_transpose_item(P.in[I_WCO], D, D, 32, Wco_t, scr, r, lane); continue; } r -= I_SQ;
                if (r < I_CKV) { p0_transpose_item(P.in[I_WCKV], D, 2 * D, 64, Wckv_t, scr, r, lane); continue; } r -= I_CKV;
                if (r < I_UP) { p0_transpose_item(P.in[I_WUP], D, FF, 128, Wup_t, scr, r, lane, P.in[I_GMLP]); continue; } r -= I_UP;
                p0_transpose_item(P.in[I_WDN], FF, D, 32, Wdn_t, scr, r, lane);
            }
        }
        {
            for (int idx = gw * 64 + lane; idx < SEQ * 8; idx += NGW * 64) {
                const int pos = idx >> 3, j = idx & 7;
                const float f = j == 0 ? 1.0f : j == 1 ? 0.1939227432012558f : j == 2 ? 0.03760603070259094f : j == 3 ? 0.007292664609849453f : j == 4 ? 0.0014142135623842478f : j == 5 ? 0.00027424818836152554f : j == 6 ? 5.318296098266728e-05f : 1.0313386155758053e-05f;
                const float ang = (float)pos * f;
                double rev = (double)ang * 0.15915494309189535; rev -= __builtin_rint(rev);
                const float x = (float)(rev * 6.283185307179586);
                ROPE[pos * 16 + j] = cosf(x); ROPE[pos * 16 + 8 + j] = sinf(x);
            }
        }
        {
            f32x4 gq[4];
#pragma unroll
            for (int j = 0; j < 4; ++j) gq[j] = ((const f32x4*)P.in[I_GMIX])[64 * j + lane];
            const float bfv = P.in[I_BF][lane & 7];
            const bool b0 = lane & 1, b1 = lane & 2, b2 = lane & 4;
            const bool xal = (G == 256); const int mstart = xal ? (bx & 7) * SEQ + ((bx >> 3) * NWAVES + wave) * 4 : gw * 4, mstep = xal ? 1024 : NGW * 4, mend = xal ? (bx & 7) * SEQ + SEQ : M;
            for (int m0 = mstart; m0 < mend; m0 += mstep) {
                f32x4 v[4][4]; float s[4];
#pragma unroll
                for (int r = 0; r < 4; ++r)
#pragma unroll
                    for (int jj = 0; jj < 4; ++jj) v[r][jj] = ((const f32x4*)(P.in[I_X] + (size_t)(m0 + r) * D))[64 * jj + lane];
#pragma unroll
                for (int r = 0; r < 4; ++r) { s[r] = 0.f;
#pragma unroll
                    for (int jj = 0; jj < 4; ++jj) s[r] += (v[r][jj].x * v[r][jj].x + v[r][jj].y * v[r][jj].y) + (v[r][jj].z * v[r][jj].z + v[r][jj].w * v[r][jj].w); }
#pragma unroll
                for (int r = 0; r < 4; ++r) { const float ssum = wave_sum(s[r]); const float rstd = 1.0f / sqrtf(ssum * (1.f / 1024.f) + EPS);
                    unsigned long long* o8 = (unsigned long long*)(XN + (size_t)(m0 + r) * D) + lane;
                    if (lane < 4) ((f32x4*)(SS3 + (size_t)(m0 + r) * 16))[lane] = (f32x4){lane == 0 ? ssum : 0.f, 0.f, 0.f, 0.f};
#pragma unroll
                    for (int jj = 0; jj < 4; ++jj) { o8[64 * jj] = (unsigned long long)pk2(v[r][jj].x, v[r][jj].y) | ((unsigned long long)pk2(v[r][jj].z, v[r][jj].w) << 32);
                        v[r][jj] = v[r][jj] * rstd * gq[jj]; } }
                f32x4 a0[4], a1[4];
#pragma unroll
                for (int r = 0; r < 4; ++r) { a0[r] = (f32x4){0.f, 0.f, 0.f, 0.f}; a1[r] = a0[r]; }
#pragma unroll
                for (int jj = 0; jj < 4; ++jj)
#pragma unroll
                    for (int i = 0; i < 4; ++i) { const LAS f32x4* wp = (const LAS f32x4*)(lds + ((jj * 4 + i) * 64 + lane) * 32); const f32x4 w0 = wp[0], w1 = wp[1];
#pragma unroll
                        for (int r = 0; r < 4; ++r) { a0[r] += w0 * v[r][jj][i]; a1[r] += w1 * v[r][jj][i]; } }
#pragma unroll
                for (int r = 0; r < 4; ++r) {
                    float c0, c1, c2, c3, d0, d1, z;
                    { const float k0 = b0 ? a0[r][1] : a0[r][0], g0 = b0 ? a0[r][0] : a0[r][1]; c0 = k0 + __shfl_xor(g0, 1); }
                    { const float k0 = b0 ? a0[r][3] : a0[r][2], g0 = b0 ? a0[r][2] : a0[r][3]; c1 = k0 + __shfl_xor(g0, 1); }
                    { const float k0 = b0 ? a1[r][1] : a1[r][0], g0 = b0 ? a1[r][0] : a1[r][1]; c2 = k0 + __shfl_xor(g0, 1); }
                    { const float k0 = b0 ? a1[r][3] : a1[r][2], g0 = b0 ? a1[r][2] : a1[r][3]; c3 = k0 + __shfl_xor(g0, 1); }
                    { const float k0 = b1 ? c1 : c0, g0 = b1 ? c0 : c1; d0 = k0 + __shfl_xor(g0, 2); }
                    { const float k0 = b1 ? c3 : c2, g0 = b1 ? c2 : c3; d1 = k0 + __shfl_xor(g0, 2); }
                    { const float k0 = b2 ? d1 : d0, g0 = b2 ? d0 : d1; z = k0 + __shfl_xor(g0, 4); }
                    z += __shfl_xor(z, 8); z += __shfl_xor(z, 16); z += __shfl_xor(z, 32);
                    z += bfv;
                    const float ls = fminf(z, 0.f) - __logf(1.0f + __expf(-fabsf(z)));
                    const int m = m0 + r;
                    if (lane < 8) LOGF[((size_t)(m >> 12) * 8 + lane) * SEQ + (m & 4095)] = ls;
                }
            }
        }
        {
            f32x4 gq[4];
#pragma unroll
            for (int j = 0; j < 4; ++j) gq[j] = ((const f32x4*)P.in[I_GMEM])[64 * j + lane];
            for (int m = gw; m < MM; m += NGW) { f32x4 v[4]; rms_row(P.in[I_MEM] + (size_t)m * D, gq, MEMN + (size_t)m * D, lane, v); }
        }
        __syncthreads();
    }
    SEAM(0);

    if (PH(1)) REPS(1) {
        LANE_TID;
        if (bx < BATCH * 8) {
            const float* src = LOGF + (size_t)bx * SEQ + tid * 8; float* dst = KBIAS + (size_t)bx * SEQ + tid * 8;
            const f32x4 a = *(const f32x4*)src, b = *(const f32x4*)(src + 4);
            float p[8]; p[0] = a[0]; p[1] = p[0] + a[1]; p[2] = p[1] + a[2]; p[3] = p[2] + a[3]; p[4] = p[3] + b[0]; p[5] = p[4] + b[1]; p[6] = p[5] + b[2]; p[7] = p[6] + b[3];
            float inc = p[7];
#pragma unroll
            for (int o = 1; o < 64; o <<= 1) { const float t = __shfl_up(inc, o); if (lane >= o) inc += t; }
            LAS float* wt = (LAS float*)lds;
            if (lane == 63) wt[wave] = inc;
            __syncthreads();
            float pre = inc - p[7];
            for (int w = 0; w < wave; ++w) pre += wt[w];
            const float c = -1.4426950408889634f;
            *(f32x4*)dst = (f32x4){(pre + p[0]) * c, (pre + p[1]) * c, (pre + p[2]) * c, (pre + p[3]) * c};
            *(f32x4*)(dst + 4) = (f32x4){(pre + p[4]) * c, (pre + p[5]) * c, (pre + p[6]) * c, (pre + p[7]) * c};
            __syncthreads();
        }
        { pg8::Gemm g{XN, Win_t, M, NPROJ, D}; pg8::StaticOrder S; S.init(M, NPROJ, G, bx);
          build_rstd_tables(lds, S, SS3, EPS, wave);
          pg8::EpiProj E{PROJ, ROPE, NRM, SS3, (const LAS int*)(lds + RING_BYTES + 1536), (const LAS float*)(lds + RING_BYTES + 2048)};
          pg8::gemm_phase<pg8::EpiProj, pg8::StaticOrder, true, true>(lds, g, S, E, wave); }
    }
    SEAM(1);

    if (PH(2)) REPS(2) {
        for (int p = vcu; p < 1024; p += G) {
            const int pp = p & 511, bh = pp >> 3, s = pp & 7, b = bh >> 3, hm = bh & 7;
#ifdef MK_REP_ATT
            if (rep_ == 1 && !((MK_REP_ATT) & (p < 512 ? 1 : 2))) continue;
#endif
            for (int hh = 0; hh < 2; ++hh) {
                const int qb = hh ? s : 15 - s;
                if (p < 512) { if (!(MK_ATT_MASK & 1)) continue;
                    const float* nq = NRM + 256 + ((b * 2 + 0) * 8 + hm) * 2; const float* nk = NRM + 256 + ((b * 2 + 1) * 8 + hm) * 2;
                    const float bqd = sqrtf((nq[0] + nq[1]) * (nk[0] + nk[1])) * 1.02f;
                    if (bqd < 64.f)
                        attn_body::attn_unit128<16, true>(b, qb, (const attn_body::bf16*)PROJ + hm * 64, (const attn_body::bf16*)PROJ + 512 + hm * 64, (const attn_body::bf16*)PROJ + 1024 + (hm >> 1) * 128,
                                                          (attn_body::bf16*)ATT + (hm & 1) * 512 + (hm >> 1) * 128, (char*)lds_raw, wave);
                    else
                        attn_body::attn_unit128<16, false>(b, qb, (const attn_body::bf16*)PROJ + hm * 64, (const attn_body::bf16*)PROJ + 512 + hm * 64, (const attn_body::bf16*)PROJ + 1024 + (hm >> 1) * 128,
                                                           (attn_body::bf16*)ATT + (hm & 1) * 512 + (hm >> 1) * 128, (char*)lds_raw, wave);
                } else { if (!(MK_ATT_MASK & 2)) continue; const int h = hm;
                    const float* nq = NRM + ((b * 2 + 0) * 8 + h) * 2; const float* nk = NRM + ((b * 2 + 1) * 8 + h) * 2; const float* kbr = KBIAS + (size_t)(b * 8 + h) * SEQ;
                    const float bqk = sqrtf((nq[0] + nq[1]) * (nk[0] + nk[1])) * 1.02f;
                    const int NTf = 4 * qb + 4, tc = 2 * (mk_lane() & 31);
                    const bool skip_ok = (tc >= 2) && (tc <= NTf - 4) && (2.f * bqk + kbr[64 * tc - 1 + (tc ? 0 : 1)] - kbr[256 * qb] < -40.f);
                    const unsigned long long bm = __ballot(skip_ok);
                    const int t0 = bm ? 2 * ((63 - __builtin_clzll(bm)) & 31) : 0;
                    attn_body::attn_unit<8, true>(b, qb, (const attn_body::bf16*)PROJ + 1536 + h * 64, (const attn_body::bf16*)PROJ + 2048 + h * 64, (const attn_body::bf16*)PROJ + 2560 + h * 64,
                                                  (attn_body::bf16*)ATT + 1024 + h * 64, kbr, t0, (char*)lds_raw, wave);
                }
            }
        }
    }
    SEAM(2);

    if (PH(3)) REPS(3) {
        LANE_TID;
        if (bx < 64) {
        { pg8::Gemm g{MEMN, Wckv_t, MM, D, D}; pg8::StaticOrder S; S.init(MM, D, G, bx);
          pg8::EpiBf16<0> E{CKb, D, nullptr, 0, 0, 1.f};
          pg8::gemm_phase<pg8::EpiBf16<0>, pg8::StaticOrder, true, true>(lds, g, S, E, wave); }
        { pg8::Gemm g{Wckv_t + (size_t)D * D, MEMN, D, MM, D}; pg8::StaticOrder S; S.init(D, MM, G, (bx + G - 32) % G);
          pg8::EpiBf16<0> E{CVT, MM, nullptr, 0, 0, 1.f};
          pg8::gemm_phase<pg8::EpiBf16<0>, pg8::StaticOrder, true, true>(lds, g, S, E, wave); }
        }
        const float sa = wave_sum(P.in[I_LQ1][lane] * P.in[I_LK1][lane]), sb = wave_sum(P.in[I_LQ2][lane] * P.in[I_LK2][lane]);
        const float lam = __expf(sa) - __expf(sb) + 0.2f;
        const f32x4 gs0 = *(const f32x4*)(P.in[I_GSUB] + (8 * lane) % 128), gs1 = *(const f32x4*)(P.in[I_GSUB] + (8 * lane) % 128 + 4);
        const f32x4 gf0 = *(const f32x4*)(P.in[I_GFOX] + (8 * lane) % 64), gf1 = *(const f32x4*)(P.in[I_GFOX] + (8 * lane) % 64 + 4);
        const int gw3 = (G > 64) ? (bx - 64) * NWAVES + wave : gw, NGW3 = (G > 64) ? (G - 64) * NWAVES : NGW;
        const bool xal3 = (G == 256); const int m3start = xal3 ? (bx & 7) * SEQ + ((bx - 64) >> 3) * NWAVES + wave : gw3, m3step = xal3 ? 24 * NWAVES : NGW3, m3end = xal3 ? (bx & 7) * SEQ + SEQ : M;
        if (G <= 64 || bx >= 64)
        for (int m = m3start; m < m3end; m += m3step) {
            const bf16* a = ATT + (size_t)m * NATT + 8 * lane;
            const v4u o1 = *(const v4u*)a, o2 = *(const v4u*)(a + 512), of = *(const v4u*)(a + 1024);
            float d[8], f[8];
#pragma unroll
            for (int e = 0; e < 4; ++e) { d[2 * e] = bflo(o1[e]) - lam * bflo(o2[e]); d[2 * e + 1] = bfhi(o1[e]) - lam * bfhi(o2[e]); f[2 * e] = bflo(of[e]); f[2 * e + 1] = bfhi(of[e]); }
            float sd = 0.f, sf = 0.f;
#pragma unroll
            for (int e = 0; e < 8; ++e) { sd += d[e] * d[e]; sf += f[e] * f[e]; }
            sd += __shfl_xor(sd, 1); sd += __shfl_xor(sd, 2); sd += __shfl_xor(sd, 4); sd += __shfl_xor(sd, 8);
            sf += __shfl_xor(sf, 1); sf += __shfl_xor(sf, 2); sf += __shfl_xor(sf, 4);
            const float rd = 0.8f / sqrtf(sd * (1.f / 128.f) + SUBLN_EPS), rf = 1.0f / sqrtf(sf * (1.f / 64.f) + EPS);
            v4u wd, wf;
            wd.x = pk2(d[0] * rd * gs0[0], d[1] * rd * gs0[1]); wd.y = pk2(d[2] * rd * gs0[2], d[3] * rd * gs0[3]); wd.z = pk2(d[4] * rd * gs1[0], d[5] * rd * gs1[1]); wd.w = pk2(d[6] * rd * gs1[2], d[7] * rd * gs1[3]);
            wf.x = pk2(f[0] * rf * gf0[0], f[1] * rf * gf0[1]); wf.y = pk2(f[2] * rf * gf0[2], f[3] * rf * gf0[3]); wf.z = pk2(f[4] * rf * gf1[0], f[5] * rf * gf1[1]); wf.w = pk2(f[6] * rf * gf1[2], f[7] * rf * gf1[3]);
            bf16* o = MIXA + (size_t)m * D + 8 * lane;
            *(v4u*)o = wd; *(v4u*)(o + 512) = wf;
        }
    }
    SEAM(3);

    if (PH(4)) REPS(4) { pg8::Gemm g{MIXA, Wout_t, M, D, D}; pg8::StaticOrder S; S.init(M, D, G, bx);
        pg8::EpiRes2<true, true> E{XN, H1B, SS1};
        pg8::gemm_phase<pg8::EpiRes2<true, true>, pg8::StaticOrder, true, true>(lds, g, S, E, wave); }
    SEAM(4);

    if (PH(5)) REPS(5) { pg8::Gemm g{H1B, Wcq_t, M, D, D}; pg8::StaticOrder S; S.init(M, D, G, bx);
        build_rstd_tables(lds, S, SS1, EPS, wave);
        pg8::EpiRowScale<0> E{CQ, D, SS1, EPS, pg8::CROSS_C2, (const LAS int*)(lds + RING_BYTES + 1536), (const LAS float*)(lds + RING_BYTES + 2048)};
        pg8::gemm_phase<pg8::EpiRowScale<0>, pg8::StaticOrder, true, true>(lds, g, S, E, wave); }
    SEAM(5);

    if (PH(6)) REPS(6) {
        const int upc = (512 + G - 1) / G;
        for (int u = vcu * upc; u < (vcu + 1) * upc && u < 512; ++u) { const int bh = u >> 4, qblk = u & 15; xattn::unit(bh >> 2, bh & 3, qblk, CQ, CKb, CVT, CO, lds, wave); }
    }
    SEAM(6);

    if (PH(7)) REPS(7) { pg8::Gemm g{CO, Wco_t, M, D, D}; pg8::StaticOrder S; S.init(M, D, G, bx);
        pg8::EpiRes2<true, true> E{H1B, H2B, SS2};
        pg8::gemm_phase<pg8::EpiRes2<true, true>, pg8::StaticOrder, true, true>(lds, g, S, E, wave); }
    SEAM(7);

    if (PH(8)) REPS(8) { pg8::Gemm g{H2B, Wup_t, M, FF, D}; pg8::StaticOrder S; S.init(M, FF, G, bx);
        build_rstd_tables(lds, S, SS2, EPS, wave);
        pg8::EpiRowScale<1> E{ZH, FF, SS2, EPS, 1.f, (const LAS int*)(lds + RING_BYTES + 1536), (const LAS float*)(lds + RING_BYTES + 2048)};
        pg8::gemm_phase<pg8::EpiRowScale<1>, pg8::StaticOrder, true, true>(lds, g, S, E, wave); }
    SEAM(8);

    if (PH(9)) REPS(9) { pg8::Gemm g{ZH, Wdn_t, M, D, FF}; pg8::StaticOrder S; S.init(M, D, G, bx); S.rev = true;
        pg8::EpiRes2<true, true> E{H2B, H1B  , SS3};
        pg8::gemm_phase<pg8::EpiRes2<true, true>, pg8::StaticOrder, true, true>(lds, g, S, E, wave); }
    SEAM(9);

    if (PH(10)) REPS(10) {
        LANE_TID;
        f32x4 gq[4];
#pragma unroll
        for (int j = 0; j < 4; ++j) gq[j] = ((const f32x4*)P.in[I_GFIN])[64 * j + lane];
        const bool xal = (G == 256); const int mstart = xal ? (bx & 7) * SEQ + ((bx >> 3) * NWAVES + wave) * 4 : gw * 4, mstep = xal ? 1024 : NGW * 4, mend = xal ? (bx & 7) * SEQ + SEQ : M;
        for (int m0 = mstart; m0 < mend; m0 += mstep) {
            unsigned long long w[4][4]; float rr[4];
#pragma unroll
            for (int q = 0; q < 4; ++q) { const unsigned long long* hb = (const unsigned long long*)(H1B + (size_t)(m0 + q) * D) + lane;
#pragma unroll
                for (int j = 0; j < 4; ++j) w[q][j] = hb[64 * j];
                rr[q] = pg8::row_rstd(SS3, m0 + q, EPS); }
#pragma unroll
            for (int q = 0; q < 4; ++q) { f32x4* o = (f32x4*)(P.out + (size_t)(m0 + q) * D) + lane;
#pragma unroll
                for (int j = 0; j < 4; ++j) { const unsigned lo = (unsigned)w[q][j], hi2 = (unsigned)(w[q][j] >> 32);
                    const f32x4 v = {bflo(lo), bfhi(lo), bflo(hi2), bfhi(hi2)}; o[64 * j] = v * rr[q] * gq[j]; } }
        }
    }
#undef IN
#undef SEAM
#undef LANE_TID
#undef ROPE
#undef LOGF
#undef KBIAS
#undef NRM
#undef SS1
#undef SS2
#undef SS3
#undef Win_t
#undef Wout_t
#undef Wcq_t
#undef Wckv_t
#undef Wco_t
#undef Wup_t
#undef Wdn_t
#undef MEMN
#undef CKb
#undef CVT
#undef XN
#undef MIXA
#undef CQ
#undef H2B
#undef H1B
#undef CO
#undef PROJ
#undef ATT
#undef ZH
}

extern "C" void kernel_launch(void* const* d_in, const int* in_sizes, int n_in, void* d_out, int out_size, void* d_ws, size_t ws_size, hipStream_t stream) {
    static int grid = 0;
    if (grid == 0) {
        if (n_in != 21 || in_sizes[0] != M * D || out_size != M * D || ws_size < WS_END) { fprintf(stderr, "kernel_launch: unexpected shapes (n_in %d, in0 %d, out %d, ws %zu); nothing launched\n", n_in, n_in > 0 ? in_sizes[0] : -1, out_size, ws_size); grid = -1; return; }
        int dev = 0, cus = 0, per_cu = 0;
        if (hipGetDevice(&dev) != hipSuccess || hipDeviceGetAttribute(&cus, hipDeviceAttributeMultiprocessorCount, dev) != hipSuccess) { grid = -1; return; }
        if (hipFuncSetAttribute((const void*)mk_fwd, hipFuncAttributeMaxDynamicSharedMemorySize, LDS_BYTES) != hipSuccess) { fprintf(stderr, "kernel_launch: hipFuncSetAttribute failed\n"); grid = -1; return; }
        if (hipOccupancyMaxActiveBlocksPerMultiprocessor(&per_cu, (const void*)mk_fwd, NWAVES * 64, LDS_BYTES) != hipSuccess || per_cu < 1) { fprintf(stderr, "kernel_launch: occupancy query says %d blocks per CU\n", per_cu); per_cu = 1; }
        (void)hipGetLastError();
        grid = cus * per_cu;
    }
    if (grid < 0) return;
    if (hipMemsetAsync((char*)d_ws + WS_BAR, 0, XCD_BAR_WORDS * 4, stream) != hipSuccess) { fprintf(stderr, "kernel_launch: memset of the barrier words failed\n"); return; }
    Params p{};
    for (int i = 0; i < 21; ++i) p.in[i] = (const float*)d_in[i];
    p.out = (float*)d_out; p.ws = (unsigned char*)d_ws;
#if MK_PER_PHASE
    for (int ph = 0; ph < N_PHASES; ++ph) { p.ph_lo = ph; p.ph_hi = ph + 1; hipLaunchKernelGGL(mk_fwd, dim3(grid), dim3(NWAVES * 64), LDS_BYTES, stream, p); }
#else
    p.ph_lo = 0; p.ph_hi = N_PHASES;
    void* args[] = {&p};
    const hipError_t e = hipLaunchCooperativeKernel((const void*)mk_fwd, dim3(grid), dim3(NWAVES * 64), args, LDS_BYTES, stream);
    if (e != hipSuccess) fprintf(stderr, "kernel_launch: cooperative launch failed: %s (grid %d)\n", hipGetErrorString(e), grid);
#endif
}
```

```cpp
#include <hip/hip_runtime.h>
#include <hip/hip_cooperative_groups.h>
#include <hip/hip_bf16.h>
#include <cstdio>
#include <cstdint>
#include <cmath>
namespace cg = cooperative_groups;
__device__ __forceinline__ int mk_lane() { int l = (int)__builtin_amdgcn_mbcnt_hi(~0u, __builtin_amdgcn_mbcnt_lo(~0u, 0u)); asm volatile("" : "+v"(l)); return l; }
namespace pg8 {
#define PG8_LAS __attribute__((address_space(3)))
typedef unsigned short bf16_t;
typedef short bf16x8 __attribute__((ext_vector_type(8)));
typedef float f32x4 __attribute__((ext_vector_type(4)));
typedef unsigned u32x4 __attribute__((ext_vector_type(4)));
constexpr int BM = 256, BK = 64, HALF = 128, HTB = HALF * BK * 2  , STAGE_BYTES = 8 * HTB, NXCD = 8, WGM = 8;

__host__ __device__ __forceinline__ int lds_byte(int r, int c) { const int st = (r >> 4) * 2 + (c >> 5), rr = r & 15, cc = c & 31, ob = rr * 64 + cc * 2; return st * 1024 + (ob ^ (((ob >> 9) & 1) << 5)); }
__host__ __device__ __forceinline__ void stage_rc(int b, int& R, int& C) { const int st = b / 1024, sb = b % 1024, swz = sb ^ (((sb >> 9) & 1) << 5); R = (st >> 1) * 16 + swz / 64; C = (st & 1) * 32 + (swz % 64) / 2; }
__host__ __device__ __forceinline__ int perm32(int rho) { const int n = rho >> 4, i = rho & 15; return 8 * (i >> 2) + 4 * n + (i & 3); }

struct Unit { int pm, pn; };
struct Gemm { const bf16_t* A; const bf16_t* Bt; int M, N, K; };

struct StaticOrder {
    int nM, nN, nwg, G, c; bool rev = false;
    __host__ __device__ __forceinline__ void init(int M, int N, int G_, int c_) { nM = M / BM; nN = N / BM; nwg = nM * nN; G = G_; c = c_; }
    __host__ __device__ __forceinline__ bool next(int i, Unit& u) const {
        const long L = (long)i * G + c; if (L >= nwg) return false;
        int wgid = (int)L; { const int q = nwg / NXCD, r = nwg % NXCD, xcd = wgid % NXCD, off = wgid / NXCD; wgid = (xcd < r ? xcd * (q + 1) : r * (q + 1) + (xcd - r) * q) + off; }
        const int nig = WGM * nN, gid = wgid / nig, fm = gid * WGM, gsz = (nM - fm) < WGM ? (nM - fm) : WGM;
        u.pm = fm + ((wgid % nig) % gsz); u.pn = (wgid % nig) / gsz; if (rev) u.pm = nM - 1 - u.pm; return true;
    }
    __device__ __forceinline__ void a_ready(const Unit&) const {}
    __device__ __forceinline__ void done(const Unit&) const {}
};

__device__ __forceinline__ unsigned cvt_pk_bf16(float lo, float hi) { unsigned r; asm volatile("v_cvt_pk_bf16_f32 %0, %1, %2" : "=v"(r) : "v"(lo), "v"(hi)); return r; }
typedef float f32x2 __attribute__((ext_vector_type(2)));
__device__ __forceinline__ f32x2 gelu_pk(f32x2 v) {
    const f32x2 av = __builtin_elementwise_abs(v), d = av * 0.2316418882f + 1.0f;
    f32x2 t; t.x = __builtin_amdgcn_rcpf(d.x); t.y = __builtin_amdgcn_rcpf(d.y);
    f32x2 q = t * 0.5307027145f + (-0.7265760135f); q = q * t + 0.7107068705f; q = q * t + (-0.142248368f); q = q * t + 0.127414796f; q = q * t;
    const f32x2 s = (v * v) * (-0.72134752044f);
    f32x2 e; e.x = __builtin_amdgcn_exp2f(s.x); e.y = __builtin_amdgcn_exp2f(s.y);
    const f32x2 m = v * (q * e), r = v - m;
    f32x2 o; o.x = v.x < 0.f ? m.x : r.x; o.y = v.y < 0.f ? m.y : r.y; return o;
}

template <int ACT  > struct EpiBf16 {
    static constexpr bool PERM = true, AFTER_DRAIN = false; static_assert(ACT == 0 || ACT == 1, "EpiBf16: ACT is 0 (none) or 1 (gelu_pk)");
    bf16_t* O; int ldc; const float* bias; int split_cols; size_t split_stride; float scale0;
    __device__ __forceinline__ void operator()(const f32x4 (&acc)[2][2][4][2], const Unit& u, int wr, int wc, int fr, int fq) const {
        const int row0 = u.pm * BM + wr * 64 + fr; int colt = u.pn * BM; bf16_t* base = O;
        float sc = 1.f; if (split_cols) { const int t = colt / split_cols; base += (size_t)t * split_stride; colt -= t * split_cols; if (t == 0) sc = scale0; }
        const int col0 = colt + wc * 32 + 8 * fq, bcol0 = u.pn * BM + wc * 32 + 8 * fq;
        f32x4 bv[2][2];
#pragma unroll
        for (int bj = 0; bj < 2; ++bj)
#pragma unroll
            for (int n = 0; n < 2; ++n) bv[bj][n] = bias ? *(const f32x4*)(bias + bcol0 + bj * HALF + 4 * n) : (f32x4){0.f, 0.f, 0.f, 0.f};
#pragma unroll
        for (int ai = 0; ai < 2; ++ai)
#pragma unroll
            for (int m = 0; m < 4; ++m) { bf16_t* rowp = base + (size_t)(row0 + ai * HALF + m * 16) * ldc + col0;
#pragma unroll
                for (int bj = 0; bj < 2; ++bj) { f32x4 v0 = acc[ai][bj][m][0] + bv[bj][0], v1 = acc[ai][bj][m][1] + bv[bj][1];
                    if (ACT == 1) { f32x2 a = gelu_pk((f32x2){v0[0], v0[1]}), b = gelu_pk((f32x2){v0[2], v0[3]}), c = gelu_pk((f32x2){v1[0], v1[1]}), d = gelu_pk((f32x2){v1[2], v1[3]});
                        v0 = (f32x4){a.x, a.y, b.x, b.y}; v1 = (f32x4){c.x, c.y, d.x, d.y}; }
                    v0 = v0 * sc; v1 = v1 * sc; u32x4 w; w.x = cvt_pk_bf16(v0[0], v0[1]); w.y = cvt_pk_bf16(v0[2], v0[3]); w.z = cvt_pk_bf16(v1[0], v1[1]); w.w = cvt_pk_bf16(v1[2], v1[3]);
                    *(u32x4*)(rowp + bj * HALF) = w; } }
    }
};

constexpr float QK_C2 = 0.125f * 1.4426950408889634f;
constexpr float CROSS_C2 = 0.0625f * 1.4426950408889634f;
__device__ __forceinline__ float row_rstd(const float* part, int row, float eps) {
    const f32x4* p = (const f32x4*)(part + (size_t)row * 16);
    const f32x4 a = p[0], b = p[1], c = p[2], d = p[3];
    const float s = ((a[0] + a[1]) + (a[2] + a[3])) + ((b[0] + b[1]) + (b[2] + b[3])) + ((c[0] + c[1]) + (c[2] + c[3])) + ((d[0] + d[1]) + (d[2] + d[3]));
    return 1.0f / sqrtf(s * (1.0f / 1024.0f) + eps);
}
struct EpiProj {
    static constexpr bool PERM = true, AFTER_DRAIN = false;
    bf16_t* O; const float* rope; float* nrm; const float* ssp; const PG8_LAS int* pml; const PG8_LAS float* tab;
    __device__ __forceinline__ void operator()(const f32x4 (&acc)[2][2][4][2], const Unit& u, int wr, int wc, int fr, int fq) const {
        const int row0 = u.pm * BM + wr * 64 + fr, col0 = u.pn * BM + wc * 32 + 8 * fq;
        const int typ = u.pn >> 1;
        const float sc = (typ == 0 || typ == 3) ? QK_C2 : 1.f;
        int slot = -1;
        if (tab) { const int n = pml[8]; for (int j = 0; j < n; ++j) if (pml[j] == u.pm) slot = j; }
        const bool ropew = (typ < 2) && ((wc & 1) == 0);
        const bool nrmw = (typ == 0 || typ == 1 || typ == 3 || typ == 4); float mxn[2] = {0.f, 0.f};
#pragma unroll
        for (int ai = 0; ai < 2; ++ai) {
            f32x4 rc[4][4];
            if (ropew) {
#pragma unroll
                for (int m = 0; m < 4; ++m) { const f32x4* rp = (const f32x4*)(rope + (size_t)((row0 + ai * HALF + m * 16) & 4095) * 16); rc[m][0] = rp[0]; rc[m][1] = rp[1]; rc[m][2] = rp[2]; rc[m][3] = rp[3]; }
            }
#pragma unroll
            for (int m = 0; m < 4; ++m) {
                const int row = row0 + ai * HALF + m * 16;
                bf16_t* rowp = O + (size_t)row * 3072 + col0;
                const float scr = sc * (slot >= 0 ? tab[slot * 256 + (row - u.pm * BM)] : row_rstd(ssp, row, 1e-6f));
                f32x4 c0 = {1.f, 1.f, 1.f, 1.f}, c1 = c0, s0 = {0.f, 0.f, 0.f, 0.f}, s1 = s0;
                if (ropew) { c0 = rc[m][0]; c1 = rc[m][1]; s0 = rc[m][2]; s1 = rc[m][3]; if (fq == 0) { s0 = -s0; s1 = -s1; } if (fq >= 2) { c0 = (f32x4){1.f, 1.f, 1.f, 1.f}; c1 = c0; s0 = (f32x4){0.f, 0.f, 0.f, 0.f}; s1 = s0; } }
#pragma unroll
                for (int bj = 0; bj < 2; ++bj) {
                    f32x4 v0 = acc[ai][bj][m][0], v1 = acc[ai][bj][m][1];
                    if (ropew) {
                        f32x4 p0, p1;
#pragma unroll
                        for (int e = 0; e < 4; ++e) { p0[e] = __shfl_xor(v0[e], 16); p1[e] = __shfl_xor(v1[e], 16); }
                        v0 = v0 * c0 + p0 * s0; v1 = v1 * c1 + p1 * s1;
                    }
                    v0 = v0 * scr; v1 = v1 * scr;
                    if (nrmw) { float q = (v0[0] * v0[0] + v0[1] * v0[1]) + (v0[2] * v0[2] + v0[3] * v0[3]) + (v1[0] * v1[0] + v1[1] * v1[1]) + (v1[2] * v1[2] + v1[3] * v1[3]);
                        q += __shfl_xor(q, 16); q += __shfl_xor(q, 32); mxn[bj] = fmaxf(mxn[bj], q); }
                    u32x4 w; w.x = cvt_pk_bf16(v0[0], v0[1]); w.y = cvt_pk_bf16(v0[2], v0[3]); w.z = cvt_pk_bf16(v1[0], v1[1]); w.w = cvt_pk_bf16(v1[2], v1[3]);
                    *(u32x4*)(rowp + bj * HALF) = w;
                }
            }
        }
        if (nrmw) {
#pragma unroll
            for (int bj = 0; bj < 2; ++bj) { float q = mxn[bj];
                q = fmaxf(q, __shfl_xor(q, 1)); q = fmaxf(q, __shfl_xor(q, 2)); q = fmaxf(q, __shfl_xor(q, 4)); q = fmaxf(q, __shfl_xor(q, 8));
                const int rel = 256 * (u.pn & 1) + 128 * bj + 32 * wc, b = (u.pm * BM) >> 12;
                if (fr == 0 && fq == 0) atomicMax((unsigned*)nrm + (typ < 2 ? 256 : 0) + ((b * 2 + ((typ == 1 || typ == 4) ? 1 : 0)) * 8 + (rel >> 6)) * 2 + ((rel >> 5) & 1), __float_as_uint(q * 1.02f)); }
        }
    }
};
template <bool BASE_BF16, bool OUT_BF16> struct EpiRes2 {
    static constexpr bool PERM = true, AFTER_DRAIN = false;
    const void* base; void* out; float* sspart;
    __device__ __forceinline__ void operator()(const f32x4 (&acc)[2][2][4][2], const Unit& u, int wr, int wc, int fr, int fq) const {
        const int row0 = u.pm * BM + wr * 64 + fr, col0 = u.pn * BM + wc * 32 + 8 * fq;
#pragma unroll
        for (int ai = 0; ai < 2; ++ai) {
            u32x4 bw[4][2]; f32x4 bf[4][2][2];
#pragma unroll
            for (int m = 0; m < 4; ++m)
#pragma unroll
                for (int bj = 0; bj < 2; ++bj) { const size_t off = (size_t)(row0 + ai * HALF + m * 16) * 1024 + col0 + bj * HALF;
                    if (BASE_BF16) bw[m][bj] = *(const u32x4*)((const bf16_t*)base + off);
                    else { bf[m][bj][0] = *(const f32x4*)((const float*)base + off); bf[m][bj][1] = *(const f32x4*)((const float*)base + off + 4); } }
#pragma unroll
            for (int m = 0; m < 4; ++m) {
                const int row = row0 + ai * HALF + m * 16; const size_t off = (size_t)row * 1024 + col0;
                float ss = 0.f;
#pragma unroll
                for (int bj = 0; bj < 2; ++bj) {
                    f32x4 b0, b1;
                    if (BASE_BF16) { const u32x4 w = bw[m][bj];
                        b0 = (f32x4){__builtin_bit_cast(float, w.x << 16), __builtin_bit_cast(float, w.x & 0xffff0000u), __builtin_bit_cast(float, w.y << 16), __builtin_bit_cast(float, w.y & 0xffff0000u)};
                        b1 = (f32x4){__builtin_bit_cast(float, w.z << 16), __builtin_bit_cast(float, w.z & 0xffff0000u), __builtin_bit_cast(float, w.w << 16), __builtin_bit_cast(float, w.w & 0xffff0000u)}; }
                    else { b0 = bf[m][bj][0]; b1 = bf[m][bj][1]; }
                    const f32x4 v0 = acc[ai][bj][m][0] + b0, v1 = acc[ai][bj][m][1] + b1;
                    ss += (v0[0] * v0[0] + v0[1] * v0[1]) + (v0[2] * v0[2] + v0[3] * v0[3]) + (v1[0] * v1[0] + v1[1] * v1[1]) + (v1[2] * v1[2] + v1[3] * v1[3]);
                    if (OUT_BF16) { u32x4 w; w.x = cvt_pk_bf16(v0[0], v0[1]); w.y = cvt_pk_bf16(v0[2], v0[3]); w.z = cvt_pk_bf16(v1[0], v1[1]); w.w = cvt_pk_bf16(v1[2], v1[3]);
                        *(u32x4*)((bf16_t*)out + off + bj * HALF) = w; }
                    else { *(f32x4*)((float*)out + off + bj * HALF) = v0; *(f32x4*)((float*)out + off + bj * HALF + 4) = v1; }
                }
                ss += __shfl_xor(ss, 16); ss += __shfl_xor(ss, 32);
                if (fq == 0) sspart[(size_t)row * 16 + u.pn * 4 + wc] = ss;
            }
        }
    }
};
template <int ACT> struct EpiRowScale {
    static constexpr bool PERM = true, AFTER_DRAIN = false;
    bf16_t* O; int ldc; const float* sspart; float eps; float sc;
    const PG8_LAS int* pml; const PG8_LAS float* tab;
    __device__ __forceinline__ void operator()(const f32x4 (&acc)[2][2][4][2], const Unit& u, int wr, int wc, int fr, int fq) const {
        const int row0 = u.pm * BM + wr * 64 + fr, col0 = u.pn * BM + wc * 32 + 8 * fq;
        int slot = -1;
        if (tab) { const int n = pml[8]; for (int j = 0; j < n; ++j) if (pml[j] == u.pm) slot = j; }
#pragma unroll
        for (int ai = 0; ai < 2; ++ai)
#pragma unroll
            for (int m = 0; m < 4; ++m) {
                const int row = row0 + ai * HALF + m * 16; bf16_t* rowp = O + (size_t)row * ldc + col0;
                const float r = (slot >= 0 ? tab[slot * 256 + (row - u.pm * BM)] : row_rstd(sspart, row, eps)) * sc;
#pragma unroll
                for (int bj = 0; bj < 2; ++bj) {
                    f32x4 v0 = acc[ai][bj][m][0] * r, v1 = acc[ai][bj][m][1] * r;
                    if (ACT == 1) {
#pragma unroll
                        for (int e = 0; e < 4; ++e) { const float a = fmaxf(v0[e], 0.f), b = fmaxf(v1[e], 0.f); v0[e] = a * a; v1[e] = b * b; }
                    }
                    u32x4 w; w.x = cvt_pk_bf16(v0[0], v0[1]); w.y = cvt_pk_bf16(v0[2], v0[3]); w.z = cvt_pk_bf16(v1[0], v1[1]); w.w = cvt_pk_bf16(v1[2], v1[3]);
                    *(u32x4*)(rowp + bj * HALF) = w;
                }
            }
    }
};
template <class Epi, class Sched, bool ALIGN_EPI = false, bool SP2 = false>
__device__ __forceinline__ void gemm_phase(PG8_LAS unsigned char* lds, const Gemm g, const Sched& S, const Epi& E, const int wv  ) {
    int tid_ = wv * 64 + mk_lane();
    const int tid = tid_, wid = __builtin_amdgcn_readfirstlane(tid >> 6), lane = tid & 63, wr = wid >> 2, wc = wid & 3, fr = lane & 15, fq = lane >> 4;
    const int K = g.K, nt = K / BK;
    unsigned voffA[2], voffB[2];
#pragma unroll
    for (int i = 0; i < 2; ++i) { int R, C; stage_rc(tid * 16 + i * 8192, R, C); const int Rb = Epi::PERM ? ((R & ~31) + perm32(R & 31)) : R;
        voffA[i] = (unsigned)(R * K + C) * 2u; voffB[i] = (unsigned)(Rb * K + C) * 2u; }
    const size_t kstep = (size_t)(BK * 2);
    const size_t hstep = (size_t)HALF * K * 2;
    const size_t tstep = 2 * hstep;
    const unsigned ldsw = (unsigned)wid * 1024u;
    const int aoff = lds_byte(wr * 64 + fr, fq * 8), boff = lds_byte(wc * 32 + fr, fq * 8);
#define PG8_SA(b, h) (((b) * 2 + (h)) * HTB)
#define PG8_SB(b, h) ((4 + (b) * 2 + (h)) * HTB)
#define PG8_STAGE(bufoff, gbase, voff) do { _Pragma("unroll") for (int _i = 0; _i < 2; ++_i) \
        __builtin_amdgcn_global_load_lds((const unsigned*)((const char*)(gbase) + (voff)[_i]), (PG8_LAS unsigned*)(lds + (bufoff) + ldsw + _i * 8192), 16, 0, 0); } while (0)
#define PG8_LDA(dst, b, h) do { _Pragma("unroll") for (int m = 0; m < 4; ++m) _Pragma("unroll") for (int k = 0; k < 2; ++k) dst[m][k] = *(const PG8_LAS bf16x8*)(lds + PG8_SA(b, h) + aoff + m * 2048 + k * 1024); } while (0)
#define PG8_LDB(dst, b, h) do { _Pragma("unroll") for (int n = 0; n < 2; ++n) _Pragma("unroll") for (int k = 0; k < 2; ++k) dst[n][k] = *(const PG8_LAS bf16x8*)(lds + PG8_SB(b, h) + boff + n * 2048 + k * 1024); } while (0)
#define PG8_MMA(ai, bj, At, Bt) do { __builtin_amdgcn_s_setprio(1); _Pragma("unroll") for (int m = 0; m < 4; ++m) _Pragma("unroll") for (int n = 0; n < 2; ++n) _Pragma("unroll") for (int k = 0; k < 2; ++k) \
        acc[ai][bj][m][n] = __builtin_amdgcn_mfma_f32_16x16x32_bf16(Bt[n][k], At[m][k], acc[ai][bj][m][n], 0, 0, 0); __builtin_amdgcn_s_setprio(0); } while (0)
#define PG8_WAIT_V(n) asm volatile("s_waitcnt vmcnt(" #n ")" ::: "memory")
#define PG8_WAIT_L(n) asm volatile("s_waitcnt lgkmcnt(" #n ")" ::: "memory")
#define PG8_BAR __builtin_amdgcn_s_barrier()
#define PG8_SCHED __builtin_amdgcn_sched_barrier(0)
    Unit cur, nxt; int ui = 0;
    if (!S.next(0, cur)) return;
    f32x4 acc[2][2][4][2];
#pragma unroll
    for (int a = 0; a < 2; ++a)
#pragma unroll
        for (int b = 0; b < 2; ++b)
#pragma unroll
            for (int m = 0; m < 4; ++m)
#pragma unroll
                for (int n = 0; n < 2; ++n) acc[a][b][m][n] = (f32x4){0.f, 0.f, 0.f, 0.f};
    bf16x8 At[4][2], B0[2][2], B1[2][2];
    const char* cA = (const char*)g.A + (size_t)cur.pm * tstep; const char* cB = (const char*)g.Bt + (size_t)cur.pn * tstep;
    S.a_ready(cur);
    if constexpr (SP2) {
        PG8_STAGE(PG8_SB(0, 0), cB, voffB); PG8_STAGE(PG8_SB(0, 1), cB + hstep, voffB); PG8_STAGE(PG8_SA(0, 0), cA, voffA); PG8_STAGE(PG8_SA(0, 1), cA + hstep, voffA);
        if (wr == 1) PG8_BAR;
        PG8_WAIT_V(2); PG8_BAR;
        PG8_STAGE(PG8_SB(1, 0), cB + kstep, voffB); PG8_STAGE(PG8_SA(1, 0), cA + kstep, voffA); PG8_STAGE(PG8_SB(1, 1), cB + hstep + kstep, voffB);
        PG8_WAIT_V(6); PG8_BAR;
    } else {
        PG8_STAGE(PG8_SB(0, 0), cB, voffB); PG8_STAGE(PG8_SA(0, 0), cA, voffA); PG8_STAGE(PG8_SB(0, 1), cB + hstep, voffB); PG8_STAGE(PG8_SA(0, 1), cA + hstep, voffA);
        if (wr == 1) PG8_BAR;
        PG8_WAIT_V(4); PG8_BAR;
        PG8_STAGE(PG8_SB(1, 0), cB + kstep, voffB); PG8_STAGE(PG8_SA(1, 0), cA + kstep, voffA); PG8_STAGE(PG8_SB(1, 1), cB + hstep + kstep, voffB);
        PG8_WAIT_V(6); PG8_BAR;
    }
    for (;;) {
        const bool has_next = S.next(ui + 1, nxt);
        const char* nA = has_next ? (const char*)g.A + (size_t)nxt.pm * tstep : cA; const char* nB = has_next ? (const char*)g.Bt + (size_t)nxt.pn * tstep : cB;
        for (int t = 0; t < nt; t += 2) {
            const bool last = (t == nt - 2);
            const char* a1 = cA + (size_t)(t + 1) * kstep;
            const char* a2 = last ? nA : cA + (size_t)(t + 2) * kstep; const char* b2 = last ? nB : cB + (size_t)(t + 2) * kstep;
            const char* a3 = a2 + kstep; const char* b3 = b2 + kstep;
            if (last && has_next) S.a_ready(nxt);
            if constexpr (SP2) {
            PG8_LDB(B0, 0, 0); PG8_LDB(B1, 0, 1); PG8_SCHED; PG8_LDA(At, 0, 0); PG8_STAGE(PG8_SA(1, 1), a1 + hstep, voffA);
            PG8_WAIT_V(8); PG8_WAIT_L(0); PG8_BAR; PG8_MMA(0, 0, At, B0); PG8_MMA(0, 1, At, B1); PG8_BAR; PG8_SCHED;
            PG8_LDA(At, 0, 1); PG8_STAGE(PG8_SB(0, 0), b2, voffB); PG8_STAGE(PG8_SB(0, 1), b2 + hstep, voffB); PG8_STAGE(PG8_SA(0, 0), a2, voffA);
            PG8_WAIT_V(8); PG8_WAIT_L(0); PG8_BAR; PG8_MMA(1, 0, At, B0); PG8_MMA(1, 1, At, B1); PG8_BAR; PG8_SCHED;
            PG8_LDB(B0, 1, 0); PG8_LDB(B1, 1, 1); PG8_SCHED; PG8_LDA(At, 1, 0); PG8_STAGE(PG8_SA(0, 1), a2 + hstep, voffA);
            PG8_WAIT_V(8); PG8_WAIT_L(0); PG8_BAR; PG8_MMA(0, 0, At, B0); PG8_MMA(0, 1, At, B1); PG8_BAR; PG8_SCHED;
            PG8_LDA(At, 1, 1); PG8_STAGE(PG8_SB(1, 0), b3, voffB); PG8_STAGE(PG8_SB(1, 1), b3 + hstep, voffB); PG8_STAGE(PG8_SA(1, 0), a3, voffA);
            PG8_WAIT_V(8); PG8_WAIT_L(0); PG8_BAR; PG8_MMA(1, 0, At, B0); PG8_MMA(1, 1, At, B1); PG8_BAR; PG8_SCHED;
            } else {
            PG8_LDB(B0, 0, 0); PG8_SCHED; PG8_LDA(At, 0, 0); PG8_STAGE(PG8_SA(1, 1), a1 + hstep, voffA);
            PG8_WAIT_L(8); PG8_BAR; PG8_WAIT_L(0); PG8_MMA(0, 0, At, B0); PG8_BAR; PG8_SCHED;
            PG8_LDB(B1, 0, 1); PG8_STAGE(PG8_SB(0, 0), b2, voffB);
            PG8_BAR; PG8_WAIT_L(0); PG8_MMA(0, 1, At, B1); PG8_BAR;
            PG8_LDA(At, 0, 1); PG8_STAGE(PG8_SA(0, 0), a2, voffA);
            PG8_BAR; PG8_WAIT_L(0); PG8_MMA(1, 0, At, B0); PG8_BAR; PG8_SCHED;
            PG8_STAGE(PG8_SB(0, 1), b2 + hstep, voffB);
            PG8_WAIT_V(6); PG8_BAR; PG8_MMA(1, 1, At, B1); PG8_BAR;
            PG8_LDB(B0, 1, 0); PG8_SCHED; PG8_LDA(At, 1, 0); PG8_STAGE(PG8_SA(0, 1), a2 + hstep, voffA);
            PG8_WAIT_L(8); PG8_BAR; PG8_WAIT_L(0); PG8_MMA(0, 0, At, B0); PG8_BAR; PG8_SCHED;
            PG8_LDB(B1, 1, 1); PG8_STAGE(PG8_SB(1, 0), b3, voffB);
            PG8_BAR; PG8_WAIT_L(0); PG8_MMA(0, 1, At, B1); PG8_BAR;
            PG8_LDA(At, 1, 1); PG8_STAGE(PG8_SA(1, 0), a3, voffA);
            PG8_BAR; PG8_WAIT_L(0); PG8_MMA(1, 0, At, B0); PG8_BAR; PG8_SCHED;
            PG8_STAGE(PG8_SB(1, 1), b3 + hstep, voffB);
            PG8_WAIT_V(6); PG8_BAR; PG8_MMA(1, 1, At, B1); PG8_BAR;
            }
        }
        if constexpr (ALIGN_EPI) { if (wr == 0) PG8_BAR; }
        if constexpr (!Epi::AFTER_DRAIN) { E(acc, cur, wr, wc, fr, fq); S.done(cur); }
        if (!has_next) break;
#pragma unroll
        for (int a = 0; a < 2; ++a)
#pragma unroll
            for (int b = 0; b < 2; ++b)
#pragma unroll
                for (int m = 0; m < 4; ++m)
#pragma unroll
                    for (int n = 0; n < 2; ++n) acc[a][b][m][n] = (f32x4){0.f, 0.f, 0.f, 0.f};
        cur = nxt; cA = nA; cB = nB; ++ui;
        if constexpr (ALIGN_EPI) { if (wr == 1) PG8_BAR; }
    }
    PG8_WAIT_V(0);
    if constexpr (!ALIGN_EPI) { if (wr == 0) PG8_BAR; }
    PG8_BAR;
    if constexpr (Epi::AFTER_DRAIN) { E.fused(acc, cur, wr, wc, fr, fq, lds, wid, lane); S.done(cur); }
#undef PG8_SA
#undef PG8_SB
#undef PG8_STAGE
#undef PG8_LDA
#undef PG8_LDB
#undef PG8_MMA
#undef PG8_WAIT_V
#undef PG8_WAIT_L
#undef PG8_BAR
#undef PG8_SCHED
}
}

#ifndef PG8_SP2
#define PG8_SP2 true
#endif
#ifndef PG8_ALIGN
#define PG8_ALIGN true
#endif
namespace attn_body {
using bf16=__hip_bfloat16;
using bf16x8=__attribute__((ext_vector_type(8)))short;
using s16x4=__attribute__((ext_vector_type(4)))short;
using f32x16=__attribute__((ext_vector_type(16)))float;
using u32x4=__attribute__((ext_vector_type(4)))unsigned; using f32x4=__attribute__((ext_vector_type(4)))float;
constexpr int SEQ=4096,D=64,PQ=3072,PO=1536;
constexpr int NW=8,QBLK=32,QB=QBLK*NW,KVBLK=64,NQB=SEQ/QB;
constexpr int ATTN_UNIT_ROWS=QB;
__device__ __forceinline__ int crow(int r,int hi){return (r&3)+8*(r>>2)+4*hi;}
#define SBAR() __builtin_amdgcn_sched_barrier(0)
__device__ __forceinline__ void cmask(f32x16&p0,f32x16&p1,int jb,int qrel,int hi){
  const float NEG=-INFINITY; int kb=64*jb+4*hi;
  #pragma unroll
  for(int r=0;r<16;++r){int kv=kb+(r&3)+8*(r>>2); if(kv>qrel)p0[r]=NEG; if(kv+32>qrel)p1[r]=NEG;}
}

template<bool B> __device__ __forceinline__ const f32x16& csel(const f32x16&a,const f32x16&b){ if constexpr(B) return a; else return b; }
constexpr int NSLOT=3, SLOTB=8192;
constexpr int LDS_K=0, LDS_V=NSLOT*SLOTB, LDS_WS=2*NSLOT*SLOTB, LDS_OST=LDS_WS+NW*64*4, LDS_KBIAS=LDS_OST+NW*4096, LDS_BYTES=LDS_KBIAS+SEQ*4;
constexpr float C2=0.125f*1.4426950408889634f;
__device__ __forceinline__ void glds16(const void*gsrc,unsigned lds_dst){unsigned keep;
  asm volatile("s_mov_b32 %0, m0\n\ts_mov_b32 m0, %2\n\ts_nop 0\n\tglobal_load_lds_dwordx4 %1, off\n\ts_mov_b32 m0, %0":"=&s"(keep):"v"(gsrc),"s"(lds_dst):"memory");}
__device__ __forceinline__ float max3f(float a,float b,float c){float r;asm("v_max3_f32 %0, %1, %2, %3":"=v"(r):"v"(a),"v"(b),"v"(c));return r;}
__device__ __forceinline__ float max2f(float a,float b){float r;asm("v_max_f32_e32 %0, %1, %2":"=v"(r):"v"(a),"v"(b));return r;}
__device__ __forceinline__ float fadd_s(float a,float b){float r;asm("v_add_f32_e32 %0, %1, %2":"=v"(r):"v"(a),"v"(b));return r;}
__device__ __forceinline__ float fsub_s(float a,float b){float r;asm("v_sub_f32_e32 %0, %1, %2":"=v"(r):"v"(a),"v"(b));return r;}
typedef float f32x2_t __attribute__((ext_vector_type(2))); typedef __bf16 bf16x2_t __attribute__((ext_vector_type(2)));
__device__ __forceinline__ unsigned cvtpk_s(float lo,float hi){f32x2_t v={lo,hi};bf16x2_t b=__builtin_convertvector(v,bf16x2_t);return __builtin_bit_cast(unsigned,b);}
#define WAIT_BAR(N) asm volatile("s_waitcnt vmcnt(" #N ") lgkmcnt(0)\n\ts_barrier":::"memory")

__device__ __forceinline__ void qkt(f32x16&p0,f32x16&p1,const char*Kslot,const bf16x8*qr,const f32x16&ci0,const f32x16&ci1,int r32,int hi){
  const char*kb=Kslot+hi*1024+r32*16;
  #pragma unroll
  for(int d0=0;d0<4;++d0){
    const bf16x8 b0=*reinterpret_cast<const bf16x8*>(kb+d0*2048);
    const bf16x8 b1=*reinterpret_cast<const bf16x8*>(kb+d0*2048+512);
    if(d0==0){p0=__builtin_amdgcn_mfma_f32_32x32x16_bf16(b0,qr[0],ci0,0,0,0);p1=__builtin_amdgcn_mfma_f32_32x32x16_bf16(b1,qr[0],ci1,0,0,0);}
    else{p0=__builtin_amdgcn_mfma_f32_32x32x16_bf16(b0,qr[d0],p0,0,0,0);p1=__builtin_amdgcn_mfma_f32_32x32x16_bf16(b1,qr[d0],p1,0,0,0);}}
}
typedef __attribute__((address_space(3))) const char* lds_cptr;
typedef short v4i16_t __attribute__((ext_vector_type(4)));
__device__ __forceinline__ void kload8(bf16x8*kf,lds_cptr kp){
  kf[0]=*(const __attribute__((address_space(3))) bf16x8*)(kp);      kf[1]=*(const __attribute__((address_space(3))) bf16x8*)(kp+512);
  kf[2]=*(const __attribute__((address_space(3))) bf16x8*)(kp+2048); kf[3]=*(const __attribute__((address_space(3))) bf16x8*)(kp+2560);
  kf[4]=*(const __attribute__((address_space(3))) bf16x8*)(kp+4096); kf[5]=*(const __attribute__((address_space(3))) bf16x8*)(kp+4608);
  kf[6]=*(const __attribute__((address_space(3))) bf16x8*)(kp+6144); kf[7]=*(const __attribute__((address_space(3))) bf16x8*)(kp+6656);
}
__device__ __forceinline__ void kload2(bf16x8*kf,lds_cptr kp,int j){ kf[2*j]=*(const __attribute__((address_space(3))) bf16x8*)(kp+j*2048); kf[2*j+1]=*(const __attribute__((address_space(3))) bf16x8*)(kp+j*2048+512); }
__device__ __forceinline__ s16x4 vtr(lds_cptr p){ return __builtin_bit_cast(s16x4,__builtin_amdgcn_ds_read_tr16_b64_v4i16((__attribute__((address_space(3))) v4i16_t*)p)); }
__device__ __forceinline__ float rowmax(const f32x16&p0,const f32x16&p1){
  float a=max3f(p0[0],p0[1],p1[0]),b=max3f(p0[2],p0[3],p1[1]);a=max3f(a,p1[2],p1[3]);
  #pragma unroll
  for(int r=4;r<16;r+=4){a=max3f(a,p0[r],p0[r+1]);b=max3f(b,p0[r+2],p0[r+3]);a=max3f(a,p1[r],p1[r+1]);b=max3f(b,p1[r+2],p1[r+3]);}
  const float m=max2f(a,b);
  auto rr=__builtin_amdgcn_permlane32_swap(__float_as_uint(m),__float_as_uint(m),false,false);
  return max2f(__uint_as_float(rr[0]),__uint_as_float(rr[1]));
}
__device__ __forceinline__ void pv(f32x16*o,int vb,bf16x8 pa0,bf16x8 pa1,bf16x8 pa2,bf16x8 pa3){
  #pragma unroll
  for(int d0=0;d0<2;++d0){s16x4 lo[4],hi[4];
    #pragma unroll
    for(int ks=0;ks<4;++ks){
      asm volatile("ds_read_b64_tr_b16 %0,%1 offset:%c2":"=&v"(lo[ks]):"v"(vb),"i"(d0*4096+ks*1024):"memory");
      asm volatile("ds_read_b64_tr_b16 %0,%1 offset:%c2":"=&v"(hi[ks]):"v"(vb),"i"(d0*4096+ks*1024+512):"memory");}
    asm volatile("s_waitcnt lgkmcnt(0)":::"memory");SBAR();
    #define PK(k) (bf16x8){lo[k][0],lo[k][1],lo[k][2],lo[k][3],hi[k][0],hi[k][1],hi[k][2],hi[k][3]}
    o[d0]=__builtin_amdgcn_mfma_f32_32x32x16_bf16(pa0,PK(0),o[d0],0,0,0);
    o[d0]=__builtin_amdgcn_mfma_f32_32x32x16_bf16(pa1,PK(1),o[d0],0,0,0);
    o[d0]=__builtin_amdgcn_mfma_f32_32x32x16_bf16(pa2,PK(2),o[d0],0,0,0);
    o[d0]=__builtin_amdgcn_mfma_f32_32x32x16_bf16(pa3,PK(3),o[d0],0,0,0);
    #undef PK
  }
}

#ifndef ATTN_STORE16
#define ATTN_STORE16(p,v) (*(u32x4*)(p)=(v))
#endif
template<int THRL,bool HASB> __device__ __forceinline__ void attn_unit(int b,int qb,const bf16*Qc,const bf16*__restrict__ Kc,const bf16*__restrict__ Vc,bf16*Oc,const float*__restrict__ kbg,int t0,char*shm,const int wv){
  int tid_=wv*64+mk_lane();
  const int tid=tid_,lane=tid&63,r32=lane&31,hi=lane>>5; const int wid=__builtin_amdgcn_readfirstlane(tid>>6);
  const long rowbase=(long)b*SEQ; const int q0=qb*QB;
  const bf16*Qw=Qc+(rowbase+q0+wid*QBLK)*PQ;
  const bf16*Kh=Kc+(rowbase+(long)t0*KVBLK)*PQ,*Vh=Vc+(rowbase+(long)t0*KVBLK)*PQ;
  const unsigned lds0=(unsigned)(uintptr_t)shm;
  float*wsf=(float*)(shm+LDS_WS)+wid*64;
  const bf16*ksrc=Kh+(long)lane*PQ+wid*8;
  const bf16*vsrc=Vh+(long)(16*(wid&3)+(lane>>2))*PQ+(wid>>2)*32+(lane&3)*8;
  const unsigned kdst=lds0+LDS_K+wid*1024, vdst=lds0+LDS_V+wid*1024;
  #define DMA_K(t,slot) glds16(ksrc+(long)(t)*KVBLK*PQ,(unsigned)__builtin_amdgcn_readfirstlane(kdst+(slot)))
  #define DMA_V(t,slot) glds16(vsrc+(long)(t)*KVBLK*PQ,(unsigned)__builtin_amdgcn_readfirstlane(vdst+(slot)))
  const int vb0=(int)(lds0+LDS_V)+((lane>>4)&1)*32+(lane&3)*8+(4*hi+((lane&15)>>2))*64;
  const char*Kbase=shm+LDS_K; bf16x8 kf[8];
  const lds_cptr shm3=(lds_cptr)shm; const lds_cptr kp0=shm3+LDS_K+hi*1024+r32*16; const lds_cptr vp0=shm3+LDS_V+((lane>>4)&1)*32+(lane&3)*8+(4*hi+((lane&15)>>2))*64;
  const int NT=(q0+QB)/KVBLK-t0;
  typedef __attribute__((address_space(3))) const f32x4 lds_cf4; typedef __attribute__((address_space(3))) f32x4 lds_f4;
  const __attribute__((address_space(3))) char* kbl=(const __attribute__((address_space(3))) char*)shm+LDS_KBIAS+hi*16;
  DMA_K(0,0);DMA_V(0,0);DMA_K(1,SLOTB);
  bf16x8 qr[4];
  #pragma unroll
  for(int d0=0;d0<4;++d0)qr[d0]=*reinterpret_cast<const bf16x8*>(&Qw[(long)r32*PQ+d0*16+hi*8]);
  float mhat=0.f,l_reg=0.f;f32x16 o[2];o[0]=f32x16{};o[1]=f32x16{};f32x16 negm=f32x16{};asm volatile("":"+v"(negm));
  const int qrel=wid*QBLK+r32;
  float mref=0.f;
  #define CINIT(C0,C1,t) do{ if(HASB){ const __attribute__((address_space(3))) char* kp_=kbl+(t)*256; \
      _Pragma("unroll") for(int g_=0;g_<4;++g_){ const f32x4 a_=*(lds_cf4*)(kp_+g_*32), b_=*(lds_cf4*)(kp_+128+g_*32); \
        _Pragma("unroll") for(int e_=0;e_<4;++e_){ C0[4*g_+e_]=a_[e_]-mhat; C1[4*g_+e_]=b_[e_]-mhat; } } } \
    }while(0)
  #define CMASK(P0,P1,t) do{int jb_=(t)-(NT-4); if(jb_>=0)cmask(P0,P1,jb_,qrel,hi);}while(0)
  bool resc=false;
  #define START(P0,P1) do{ const float rm=rowmax(P0,P1); resc=false; \
    { const float dl=HASB?__builtin_fmaxf(rm,0.f):rm; mhat=fadd_s(mhat,dl); \
      _Pragma("unroll") for(int r=0;r<16;++r){P0[r]=fsub_s(P0[r],dl);P1[r]=fsub_s(P1[r],dl);} \
      if(!HASB){ _Pragma("unroll") for(int r=0;r<16;++r)negm[r]=-mhat; asm volatile("":"+v"(negm)); } } \
    _Pragma("unroll") for(int r=0;r<16;++r)P0[r]=__builtin_amdgcn_exp2f(P0[r]); }while(0)
  #define RESC() do{ if(resc){ asm volatile("s_waitcnt lgkmcnt(0)":::"memory"); \
      _Pragma("unroll") for(int d_=0;d_<2;++d_) _Pragma("unroll") for(int r=0;r<16;++r)o[d_][r]*=wsf[crow(r,hi)]; } }while(0)
  f32x16 pA0,pA1,pB0,pB1;
  int sl_prev=0,sl_cur=0,sl_next=SLOTB;
  #define ROT() do{sl_prev=sl_cur;sl_cur=sl_next;sl_next=(sl_next==(NSLOT-1)*SLOTB)?0:sl_next+SLOTB;}while(0)
  DMA_K(2,2*SLOTB);
  if(HASB){ const int n4=(q0+QB-t0*KVBLK)/4; for(int i=tid;i<n4;i+=NW*64){ const f32x4 v=*(const f32x4*)(kbg+t0*KVBLK+4*i); *((lds_f4*)((__attribute__((address_space(3))) char*)shm+LDS_KBIAS)+i)=v; } }
  WAIT_BAR(3);
  if(HASB){ mref=*(const __attribute__((address_space(3))) float*)((const __attribute__((address_space(3))) char*)shm+LDS_KBIAS+(q0-t0*KVBLK+qrel)*4); mhat=mref; }
  { f32x16 ci0=f32x16{},ci1=f32x16{}; CINIT(ci0,ci1,0); qkt(pA0,pA1,Kbase,qr,csel<HASB>(ci0,negm),csel<HASB>(ci1,negm),r32,hi); } asm volatile("s_nop 15\n\ts_nop 7":"+v"(pA0),"+v"(pA1));CMASK(pA0,pA1,0);
  START(pA0,pA1);
  _Pragma("unroll") for(int r=0;r<16;++r)pA1[r]=__builtin_amdgcn_exp2f(pA1[r]);
  WAIT_BAR(0);
  DMA_K(3,0);DMA_V(1,SLOTB);
  ROT();
  kload8(kf,kp0+sl_cur);
  WAIT_BAR(2);
  s16x4 vlo[8],vhi[8]; u32x4 pw0,pw1,pw2,pw3;
  #define PKW(P,B) cvtpk_s(P[B],P[B+1])
  #define PAF(k) __builtin_bit_cast(bf16x8,pw##k)
  #define VFR(i) (bf16x8){vlo[i][0],vlo[i][1],vlo[i][2],vlo[i][3],vhi[i][0],vhi[i][1],vhi[i][2],vhi[i][3]}
  #define PIN(x) asm volatile("":"+v"(x))
  #define MX3(a,b,c) __builtin_fmaxf(__builtin_fmaxf((a),(b)),(c))
  #define GAPA(MF,A0,A1,A2,A3,W0,W1,PW) do{ MF; sacc+=A0; sacc+=A1; sacc+=A2; sacc+=A3; PIN(sacc); W0; W1; PIN(PW); SBAR(); }while(0)
  #define EX(v) __builtin_amdgcn_exp2f(v)
  #define GAPB(MF,X,B,Y) do{ MF; X[B]=EX(X[B]); X[B+1]=EX(X[B+1]); X[B+2]=EX(X[B+2]); X[B+3]=EX(X[B+3]); PIN(X); if(HASB){ Y[B]-=mhat; Y[B+1]-=mhat; Y[B+2]-=mhat; Y[B+3]-=mhat; PIN(Y); } SBAR(); }while(0)
  #define LOADB(Y0,Y1,t) do{ if(HASB){ const __attribute__((address_space(3))) char* kp_=kbl+(t)*256; \
      _Pragma("unroll") for(int g_=0;g_<4;++g_){ const f32x4 a_=*(lds_cf4*)(kp_+g_*32), b_=*(lds_cf4*)(kp_+128+g_*32); \
        _Pragma("unroll") for(int e_=0;e_<4;++e_){ Y0[4*g_+e_]=a_[e_]; Y1[4*g_+e_]=b_[e_]; } } } }while(0)
  #define VRD(i) do{ vlo[i]=vtr(vp_+(((i)>>2)*4096+((i)&3)*1024)); vhi[i]=vtr(vp_+(((i)>>2)*4096+((i)&3)*1024+512)); }while(0)
  #define KRD(G,j) do{ if(G){ kload2(kf,kp0+sl_next,j); SBAR(); } }while(0)
  #define STEP(C0,C1,P0,P1,t,GK,GV,GL) do{ SBAR(); \
    const lds_cptr vp_=vp0+sl_prev; \
    VRD(0); SBAR(); float sacc=(P0[0]+P0[1]); \
    GAPA(C0=__builtin_amdgcn_mfma_f32_32x32x16_bf16(kf[0],qr[0],csel<HASB>(C0,negm),0,0,0), P0[2],P0[3],P0[4],P0[5],     pw0[0]=PKW(P0,0), pw0[1]=PKW(P0,2), pw0); \
    VRD(4); SBAR(); GAPA(C1=__builtin_amdgcn_mfma_f32_32x32x16_bf16(kf[1],qr[0],csel<HASB>(C1,negm),0,0,0), P0[6],P0[7],P0[8],P0[9],     pw0[2]=PKW(P0,4), pw0[3]=PKW(P0,6), pw0); \
    VRD(1); SBAR(); GAPA(C0=__builtin_amdgcn_mfma_f32_32x32x16_bf16(kf[2],qr[1],C0,0,0,0),   P0[10],P0[11],P0[12],P0[13], pw1[0]=PKW(P0,8), pw1[1]=PKW(P0,10), pw1); \
    VRD(5); SBAR(); GAPA(C1=__builtin_amdgcn_mfma_f32_32x32x16_bf16(kf[3],qr[1],C1,0,0,0),   P0[14],P0[15],P1[0],P1[1],   pw1[2]=PKW(P0,12),pw1[3]=PKW(P0,14), pw1); \
    VRD(2); SBAR(); GAPA(C0=__builtin_amdgcn_mfma_f32_32x32x16_bf16(kf[4],qr[2],C0,0,0,0),   P1[2],P1[3],P1[4],P1[5],     pw2[0]=PKW(P1,0), pw2[1]=PKW(P1,2), pw2); \
    VRD(6); SBAR(); GAPA(C1=__builtin_amdgcn_mfma_f32_32x32x16_bf16(kf[5],qr[2],C1,0,0,0),   P1[6],P1[7],P1[8],P1[9],     pw2[2]=PKW(P1,4), pw2[3]=PKW(P1,6), pw2); \
    VRD(3); SBAR(); GAPA(C0=__builtin_amdgcn_mfma_f32_32x32x16_bf16(kf[6],qr[3],C0,0,0,0),   P1[10],P1[11],P1[12],P1[13], pw3[0]=PKW(P1,8), pw3[1]=PKW(P1,10), pw3); \
    VRD(7); SBAR(); GAPA(C1=__builtin_amdgcn_mfma_f32_32x32x16_bf16(kf[7],qr[3],C1,0,0,0),   P1[14],P1[15],0.f,0.f,       pw3[2]=PKW(P1,12),pw3[3]=PKW(P1,14), pw3); \
    l_reg+=sacc; \
    LOADB(P0,P1,(t)+1); \
    if(GK){DMA_K((t)+3,sl_cur);} if(GV){DMA_V((t)+1,sl_next);} \
    CMASK(C0,C1,t); \
    { float a=MX3(C0[0],C0[1],C1[0]),b=MX3(C0[2],C0[3],C1[1]); a=MX3(a,C1[2],C1[3]); \
      _Pragma("unroll") for(int r=4;r<16;r+=4){a=MX3(a,C0[r],C0[r+1]);b=MX3(b,C0[r+2],C0[r+3]);a=MX3(a,C1[r],C1[r+1]);b=MX3(b,C1[r+2],C1[r+3]);} \
      float rm=__builtin_fmaxf(a,b); { auto rr=__builtin_amdgcn_permlane32_swap(__float_as_uint(rm),__float_as_uint(rm),false,false); rm=__builtin_fmaxf(__uint_as_float(rr[0]),__uint_as_float(rr[1])); } \
      resc=false; \
      if(__builtin_expect(__any(rm>(float)THRL),0)){ const float dl=__builtin_fmaxf(rm,0.f); mhat+=dl; \
        _Pragma("unroll") for(int r=0;r<16;++r){C0[r]-=dl;C1[r]-=dl;} \
        if(!HASB){ _Pragma("unroll") for(int r=0;r<16;++r)negm[r]=-mhat; asm volatile("":"+v"(negm)); } \
        const float f=__builtin_amdgcn_exp2f(-dl); l_reg*=f; if(hi==0)wsf[r32]=f; resc=true; } } \
    SBAR(); \
    GAPB(o[0]=__builtin_amdgcn_mfma_f32_32x32x16_bf16(PAF(0),VFR(0),o[0],0,0,0), C0,0,P0); \
    GAPB(o[1]=__builtin_amdgcn_mfma_f32_32x32x16_bf16(PAF(0),VFR(4),o[1],0,0,0), C0,4,P0); \
    KRD(GL,0); GAPB(o[0]=__builtin_amdgcn_mfma_f32_32x32x16_bf16(PAF(1),VFR(1),o[0],0,0,0), C0,8,P0); \
    KRD(GL,1); GAPB(o[1]=__builtin_amdgcn_mfma_f32_32x32x16_bf16(PAF(1),VFR(5),o[1],0,0,0), C0,12,P0); \
    KRD(GL,2); GAPB(o[0]=__builtin_amdgcn_mfma_f32_32x32x16_bf16(PAF(2),VFR(2),o[0],0,0,0), C1,0,P1); \
    KRD(GL,3); GAPB(o[1]=__builtin_amdgcn_mfma_f32_32x32x16_bf16(PAF(2),VFR(6),o[1],0,0,0), C1,4,P1); \
    GAPB(o[0]=__builtin_amdgcn_mfma_f32_32x32x16_bf16(PAF(3),VFR(3),o[0],0,0,0), C1,8,P1); \
    GAPB(o[1]=__builtin_amdgcn_mfma_f32_32x32x16_bf16(PAF(3),VFR(7),o[1],0,0,0), C1,12,P1); \
    }while(0)
  CINIT(pB0,pB1,1);
  int t=1;
  #undef CMASK
  #define CMASK(P0,P1,t) do{}while(0)
  for(;t+5<NT;t+=2){
    STEP(pB0,pB1,pA0,pA1,t,true,true,true);     WAIT_BAR(2); RESC(); ROT();
    STEP(pA0,pA1,pB0,pB1,t+1,true,true,true);   WAIT_BAR(2); RESC(); ROT();
  }
  #undef CMASK
  #define CMASK(P0,P1,t) do{int jb_=(t)-(NT-4); if(jb_>=0)cmask(P0,P1,jb_,qrel,hi);}while(0)
  #define ENDW(tt) do{ if((tt)+3<NT){WAIT_BAR(2);} else if((tt)+2<NT){WAIT_BAR(1);} else {WAIT_BAR(0);} }while(0)
  for(;t+1<NT;t+=2){
    STEP(pB0,pB1,pA0,pA1,t,(t+3<NT),(t+1<NT),(t+1<NT));       ENDW(t);   RESC(); ROT();
    STEP(pA0,pA1,pB0,pB1,t+1,(t+4<NT),(t+2<NT),(t+2<NT));     ENDW(t+1); RESC(); ROT();
  }
  STEP(pB0,pB1,pA0,pA1,NT-1,false,false,false); RESC();
  { float sacc=pB0[0]+pB0[1]; _Pragma("unroll") for(int r=2;r<16;++r)sacc+=pB0[r]; _Pragma("unroll") for(int r=0;r<16;++r)sacc+=pB1[r]; l_reg+=sacc;
    pw0=(u32x4){PKW(pB0,0),PKW(pB0,2),PKW(pB0,4),PKW(pB0,6)};pw1=(u32x4){PKW(pB0,8),PKW(pB0,10),PKW(pB0,12),PKW(pB0,14)};pw2=(u32x4){PKW(pB1,0),PKW(pB1,2),PKW(pB1,4),PKW(pB1,6)};pw3=(u32x4){PKW(pB1,8),PKW(pB1,10),PKW(pB1,12),PKW(pB1,14)};
    SBAR(); pv(o,vb0+sl_cur,PAF(0),PAF(1),PAF(2),PAF(3)); }
  #undef PKW
  #undef PAF
  #undef VFR
  #undef PIN
  #undef MX3
  #undef GAPA
  #undef GAPB
  #undef LOADB
  #undef EX
  #undef VRD
  #undef KRD
  #undef STEP
  #undef ENDW
  {auto rr=__builtin_amdgcn_permlane32_swap(__float_as_uint(l_reg),__float_as_uint(l_reg),false,false);l_reg=__uint_as_float(rr[0])+__uint_as_float(rr[1]);}
  if(hi==0)wsf[32+r32]=l_reg;asm volatile("s_waitcnt lgkmcnt(0)":::"memory");
  float rli[16];
  #pragma unroll
  for(int r=0;r<16;++r)rli[r]=__builtin_amdgcn_rcpf(wsf[32+crow(r,hi)]);
  bf16*Ow=Oc+(rowbase+q0+wid*QBLK)*PO;
  { bf16*stg=(bf16*)(shm+LDS_OST)+wid*2048;
    #pragma unroll
    for(int r=0;r<16;++r){const int orow=crow(r,hi);
      #pragma unroll
      for(int d0=0;d0<2;++d0)stg[orow*64+d0*32+r32]=__float2bfloat16(o[d0][r]*rli[r]);}
    asm volatile("s_waitcnt lgkmcnt(0)":::"memory");
    #pragma unroll
    for(int i=0;i<4;++i){const int row=i*8+(lane>>3),ch=lane&7; const u32x4 v=*(const u32x4*)(stg+row*64+ch*8); ATTN_STORE16(Ow+(long)row*PO+ch*8,v);} }
  asm volatile("s_waitcnt lgkmcnt(0)\n\ts_barrier":::"memory");
  #undef CINIT
  #undef DMA_K
  #undef DMA_V
  #undef CMASK
  #undef START
  #undef RESC
  #undef ROT
}
constexpr int LDS_WS128=LDS_V+NSLOT*2*SLOTB, LDS_OST128=LDS_WS128+NW*64*4, LDS_BYTES128=LDS_OST128+NW*4096;
template<int THRL,bool NODEC> __device__ __forceinline__ void attn_unit128(int b,int qb,const bf16*Qc,const bf16*__restrict__ Kc,const bf16*__restrict__ Vc,bf16*Oc,char*shm,const int wv){ constexpr bool HASB=false; constexpr int t0=0; const float* kbg=nullptr;
  int tid_=wv*64+mk_lane();
  const int tid=tid_,lane=tid&63,r32=lane&31,hi=lane>>5; const int wid=__builtin_amdgcn_readfirstlane(tid>>6);
  const long rowbase=(long)b*SEQ; const int q0=qb*QB;
  const bf16*Qw=Qc+(rowbase+q0+wid*QBLK)*PQ;
  const bf16*Kh=Kc+(rowbase+(long)t0*KVBLK)*PQ,*Vh=Vc+(rowbase+(long)t0*KVBLK)*PQ;
  const unsigned lds0=(unsigned)(uintptr_t)shm;
  float*wsf=(float*)(shm+LDS_WS128)+wid*64;
  const bf16*ksrc=Kh+(long)lane*PQ+wid*8;
  const bf16*vsrc=Vh+(long)(16*(wid&3)+(lane>>2))*PQ+(wid>>2)*32+(lane&3)*8;
  const unsigned kdst=lds0+LDS_K+wid*1024, vdst=lds0+LDS_V+(wid>>2)*4096+(wid&3)*1024;
  #define DMA_K(t,slot) glds16(ksrc+(long)(t)*KVBLK*PQ,(unsigned)__builtin_amdgcn_readfirstlane(kdst+(slot)))
  #define DMA_V(t,slot) do{ glds16(vsrc+(long)(t)*KVBLK*PQ,(unsigned)__builtin_amdgcn_readfirstlane(vdst+2*(slot))); glds16(vsrc+64+(long)(t)*KVBLK*PQ,(unsigned)__builtin_amdgcn_readfirstlane(vdst+8192+2*(slot))); }while(0)
  const int vb0=(int)(lds0+LDS_V)+((lane>>4)&1)*32+(lane&3)*8+(4*hi+((lane&15)>>2))*64;
  const char*Kbase=shm+LDS_K; bf16x8 kf[8];
  const lds_cptr shm3=(lds_cptr)shm; const lds_cptr kp0=shm3+LDS_K+hi*1024+r32*16; const lds_cptr vp0=shm3+LDS_V+((lane>>4)&1)*32+(lane&3)*8+(4*hi+((lane&15)>>2))*64;
  const int NT=(q0+QB)/KVBLK-t0;
  typedef __attribute__((address_space(3))) const f32x4 lds_cf4; typedef __attribute__((address_space(3))) f32x4 lds_f4;
  const __attribute__((address_space(3))) char* kbl=(const __attribute__((address_space(3))) char*)shm+LDS_KBIAS+hi*16;
  if(HASB){ const int n4=(q0+QB-t0*KVBLK)/4; for(int i=tid;i<n4;i+=NW*64){ const f32x4 v=*(const f32x4*)(kbg+t0*KVBLK+4*i); *((lds_f4*)((__attribute__((address_space(3))) char*)shm+LDS_KBIAS)+i)=v; } }
  DMA_K(0,0);DMA_V(0,0);DMA_K(1,SLOTB);
  bf16x8 qr[4];
  #pragma unroll
  for(int d0=0;d0<4;++d0)qr[d0]=*reinterpret_cast<const bf16x8*>(&Qw[(long)r32*PQ+d0*16+hi*8]);
  float mhat=0.f,l_reg=0.f;f32x16 o[4];o[0]=f32x16{};o[1]=f32x16{};o[2]=f32x16{};o[3]=f32x16{};
  const int qrel=wid*QBLK+r32;
  float mref=0.f;
  #define CINIT(C0,C1,t) do{ if(HASB){ const __attribute__((address_space(3))) char* kp_=kbl+(t)*256; \
      _Pragma("unroll") for(int g_=0;g_<4;++g_){ const f32x4 a_=*(lds_cf4*)(kp_+g_*32), b_=*(lds_cf4*)(kp_+128+g_*32); \
        _Pragma("unroll") for(int e_=0;e_<4;++e_){ C0[4*g_+e_]=a_[e_]-mhat; C1[4*g_+e_]=b_[e_]-mhat; } } } \
    }while(0)
  #define CMASK(P0,P1,t) do{int jb_=(t)-(NT-4); if(jb_>=0)cmask(P0,P1,jb_,qrel,hi);}while(0)
  bool resc=false;
  #define START(P0,P1) do{ resc=false; \
    if(!NODEC){ const float rm=rowmax(P0,P1); const float dl=__any(rm>(float)THRL)?__builtin_fmaxf(rm,0.f):0.f; mhat=fadd_s(mhat,dl); \
      _Pragma("unroll") for(int r=0;r<16;++r){P0[r]=fsub_s(P0[r],dl);P1[r]=fsub_s(P1[r],dl);} \
      } \
    _Pragma("unroll") for(int r=0;r<16;++r)P0[r]=__builtin_amdgcn_exp2f(P0[r]); }while(0)
  #define RESC() do{ if(resc){ asm volatile("s_waitcnt lgkmcnt(0)":::"memory"); \
      _Pragma("unroll") for(int d_=0;d_<4;++d_) _Pragma("unroll") for(int r=0;r<16;++r)o[d_][r]*=wsf[crow(r,hi)]; } }while(0)
  f32x16 pA0,pA1,pB0,pB1;
  int sl_prev=0,sl_cur=0,sl_next=SLOTB;
  #define ROT() do{sl_prev=sl_cur;sl_cur=sl_next;sl_next=(sl_next==(NSLOT-1)*SLOTB)?0:sl_next+SLOTB;}while(0)
  DMA_K(2,2*SLOTB);
  WAIT_BAR(4);
  { f32x16 ci0=f32x16{}; asm volatile("":"+v"(ci0)); qkt(pA0,pA1,Kbase,qr,ci0,ci0,r32,hi); } asm volatile("s_nop 15\n\ts_nop 7":"+v"(pA0),"+v"(pA1));CMASK(pA0,pA1,0);
  START(pA0,pA1);
  _Pragma("unroll") for(int r=0;r<16;++r)pA1[r]=__builtin_amdgcn_exp2f(pA1[r]);
  WAIT_BAR(0);
  DMA_K(3,0);DMA_V(1,SLOTB);
  ROT();
  kload8(kf,kp0+sl_cur);
  WAIT_BAR(3);
  s16x4 vlo[4],vhi[4]; u32x4 pw0,pw1,pw2,pw3;
  #define PKW(P,B) cvtpk_s(P[B],P[B+1])
  #define PAF(k) __builtin_bit_cast(bf16x8,pw##k)
  #define VFR(i) (bf16x8){vlo[(i)&3][0],vlo[(i)&3][1],vlo[(i)&3][2],vlo[(i)&3][3],vhi[(i)&3][0],vhi[(i)&3][1],vhi[(i)&3][2],vhi[(i)&3][3]}
  #define PIN(x) asm volatile("":"+v"(x))
  #define MX3(a,b,c) __builtin_fmaxf(__builtin_fmaxf((a),(b)),(c))
  #define GAPA(MF,A0,A1,A2,A3,W0,W1,PW) do{ MF; sacc+=A0; sacc+=A1; sacc+=A2; sacc+=A3; PIN(sacc); W0; W1; PIN(PW); SBAR(); }while(0)
  #define EX(v) __builtin_amdgcn_exp2f(v)
  #define GAPB(MF,X,B,Y) do{ MF; X[B]=EX(X[B]); X[B+1]=EX(X[B+1]); X[B+2]=EX(X[B+2]); X[B+3]=EX(X[B+3]); PIN(X); if(HASB){ Y[B]-=mhat; Y[B+1]-=mhat; Y[B+2]-=mhat; Y[B+3]-=mhat; PIN(Y); } SBAR(); }while(0)
  #define LOADB(Y0,Y1,t) do{ if(HASB){ const __attribute__((address_space(3))) char* kp_=kbl+(t)*256; \
      _Pragma("unroll") for(int g_=0;g_<4;++g_){ const f32x4 a_=*(lds_cf4*)(kp_+g_*32), b_=*(lds_cf4*)(kp_+128+g_*32); \
        _Pragma("unroll") for(int e_=0;e_<4;++e_){ Y0[4*g_+e_]=a_[e_]; Y1[4*g_+e_]=b_[e_]; } } } }while(0)
  #define VOFF(j) ((((j)>>3)*8192)+((((j)&7)&1)*4096)+((((j)&7)>>1)*1024))
  #define VRDJ(j) do{ vlo[(j)&3]=vtr(vp_+VOFF(j)); vhi[(j)&3]=vtr(vp_+VOFF(j)+512); SBAR(); }while(0)
  #define GAPC(MF,Y,B) do{ MF; SBAR(); }while(0)
  #define KRD(G,j) do{ if(G){ kload2(kf,kp0+sl_next,j); SBAR(); } }while(0)
  #define STEP(C0,C1,P0,P1,t,GK,GV,GL) do{ SBAR(); \
    const lds_cptr vp_=vp0+2*sl_prev; \
    VRDJ(0); float sacc=(P0[0]+P0[1]); \
    GAPA(C0=__builtin_amdgcn_mfma_f32_32x32x16_bf16(kf[0],qr[0],zero16,0,0,0), P0[2],P0[3],P0[4],P0[5],     pw0[0]=PKW(P0,0), pw0[1]=PKW(P0,2), pw0); \
    VRDJ(1); GAPA(C1=__builtin_amdgcn_mfma_f32_32x32x16_bf16(kf[1],qr[0],zero16,0,0,0), P0[6],P0[7],P0[8],P0[9],     pw0[2]=PKW(P0,4), pw0[3]=PKW(P0,6), pw0); \
    VRDJ(2); GAPA(C0=__builtin_amdgcn_mfma_f32_32x32x16_bf16(kf[2],qr[1],C0,0,0,0),   P0[10],P0[11],P0[12],P0[13], pw1[0]=PKW(P0,8), pw1[1]=PKW(P0,10), pw1); \
    VRDJ(3); GAPA(C1=__builtin_amdgcn_mfma_f32_32x32x16_bf16(kf[3],qr[1],C1,0,0,0),   P0[14],P0[15],P1[0],P1[1],   pw1[2]=PKW(P0,12),pw1[3]=PKW(P0,14), pw1); \
    GAPA(C0=__builtin_amdgcn_mfma_f32_32x32x16_bf16(kf[4],qr[2],C0,0,0,0),   P1[2],P1[3],P1[4],P1[5],     pw2[0]=PKW(P1,0), pw2[1]=PKW(P1,2), pw2); \
    GAPA(C1=__builtin_amdgcn_mfma_f32_32x32x16_bf16(kf[5],qr[2],C1,0,0,0),   P1[6],P1[7],P1[8],P1[9],     pw2[2]=PKW(P1,4), pw2[3]=PKW(P1,6), pw2); \
    GAPA(C0=__builtin_amdgcn_mfma_f32_32x32x16_bf16(kf[6],qr[3],C0,0,0,0),   P1[10],P1[11],P1[12],P1[13], pw3[0]=PKW(P1,8), pw3[1]=PKW(P1,10), pw3); \
    GAPA(C1=__builtin_amdgcn_mfma_f32_32x32x16_bf16(kf[7],qr[3],C1,0,0,0),   P1[14],P1[15],0.f,0.f,       pw3[2]=PKW(P1,12),pw3[3]=PKW(P1,14), pw3); \
    l_reg+=sacc; \
    if(!NODEC){ if(__builtin_expect(__any(mhat!=0.f),0)){ _Pragma("unroll") for(int r=0;r<16;++r){C0[r]-=mhat;C1[r]-=mhat;} } } \
    if(GK){DMA_K((t)+3,sl_cur);} if(GV){DMA_V((t)+1,sl_next);} \
    CMASK(C0,C1,t); \
    resc=false; if(!NODEC){ float a=MX3(C0[0],C0[1],C1[0]),b=MX3(C0[2],C0[3],C1[1]); a=MX3(a,C1[2],C1[3]); \
      _Pragma("unroll") for(int r=4;r<16;r+=4){a=MX3(a,C0[r],C0[r+1]);b=MX3(b,C0[r+2],C0[r+3]);a=MX3(a,C1[r],C1[r+1]);b=MX3(b,C1[r+2],C1[r+3]);} \
      float rm=__builtin_fmaxf(a,b); { auto rr=__builtin_amdgcn_permlane32_swap(__float_as_uint(rm),__float_as_uint(rm),false,false); rm=__builtin_fmaxf(__uint_as_float(rr[0]),__uint_as_float(rr[1])); } \
      resc=false; \
      if(__builtin_expect(__any(rm>(float)THRL),0)){ const float dl=__builtin_fmaxf(rm,0.f); mhat+=dl; \
        _Pragma("unroll") for(int r=0;r<16;++r){C0[r]-=dl;C1[r]-=dl;} \
        const float f=__builtin_amdgcn_exp2f(-dl); l_reg*=f; if(hi==0)wsf[r32]=f; resc=true; } } \
    SBAR(); \
    GAPB(o[0]=__builtin_amdgcn_mfma_f32_32x32x16_bf16(PAF(0),VFR(0),o[0],0,0,0), C0,0,P0); VRDJ(4); \
    GAPB(o[1]=__builtin_amdgcn_mfma_f32_32x32x16_bf16(PAF(0),VFR(1),o[1],0,0,0), C0,4,P0); VRDJ(5); \
    GAPB(o[0]=__builtin_amdgcn_mfma_f32_32x32x16_bf16(PAF(1),VFR(2),o[0],0,0,0), C0,8,P0); VRDJ(6); \
    GAPB(o[1]=__builtin_amdgcn_mfma_f32_32x32x16_bf16(PAF(1),VFR(3),o[1],0,0,0), C0,12,P0); VRDJ(7); \
    GAPB(o[0]=__builtin_amdgcn_mfma_f32_32x32x16_bf16(PAF(2),VFR(4),o[0],0,0,0), C1,0,P1); VRDJ(8); \
    GAPB(o[1]=__builtin_amdgcn_mfma_f32_32x32x16_bf16(PAF(2),VFR(5),o[1],0,0,0), C1,4,P1); VRDJ(9); \
    GAPB(o[0]=__builtin_amdgcn_mfma_f32_32x32x16_bf16(PAF(3),VFR(6),o[0],0,0,0), C1,8,P1); VRDJ(10); \
    GAPB(o[1]=__builtin_amdgcn_mfma_f32_32x32x16_bf16(PAF(3),VFR(7),o[1],0,0,0), C1,12,P1); VRDJ(11); \
    GAPC(o[2]=__builtin_amdgcn_mfma_f32_32x32x16_bf16(PAF(0),VFR(8),o[2],0,0,0), P0,0); VRDJ(12); \
    GAPC(o[3]=__builtin_amdgcn_mfma_f32_32x32x16_bf16(PAF(0),VFR(9),o[3],0,0,0), P0,4); VRDJ(13); \
    KRD(GL,0); GAPC(o[2]=__builtin_amdgcn_mfma_f32_32x32x16_bf16(PAF(1),VFR(10),o[2],0,0,0), P0,8); VRDJ(14); \
    KRD(GL,1); GAPC(o[3]=__builtin_amdgcn_mfma_f32_32x32x16_bf16(PAF(1),VFR(11),o[3],0,0,0), P0,12); VRDJ(15); \
    KRD(GL,2); GAPC(o[2]=__builtin_amdgcn_mfma_f32_32x32x16_bf16(PAF(2),VFR(12),o[2],0,0,0), P1,0); \
    KRD(GL,3); GAPC(o[3]=__builtin_amdgcn_mfma_f32_32x32x16_bf16(PAF(2),VFR(13),o[3],0,0,0), P1,4); \
    GAPC(o[2]=__builtin_amdgcn_mfma_f32_32x32x16_bf16(PAF(3),VFR(14),o[2],0,0,0), P1,8); \
    GAPC(o[3]=__builtin_amdgcn_mfma_f32_32x32x16_bf16(PAF(3),VFR(15),o[3],0,0,0), P1,12); \
    }while(0)
  const f32x16 zero16=f32x16{};
  int t=1;
  #undef CMASK
  #define CMASK(P0,P1,t) do{}while(0)
  for(;t+5<NT;t+=2){
    STEP(pB0,pB1,pA0,pA1,t,true,true,true);     WAIT_BAR(3); RESC(); ROT();
    STEP(pA0,pA1,pB0,pB1,t+1,true,true,true);   WAIT_BAR(3); RESC(); ROT();
  }
  #undef CMASK
  #define CMASK(P0,P1,t) do{int jb_=(t)-(NT-4); if(jb_>=0)cmask(P0,P1,jb_,qrel,hi);}while(0)
  #define ENDW(tt) do{ if((tt)+3<NT){WAIT_BAR(3);} else if((tt)+2<NT){WAIT_BAR(2);} else {WAIT_BAR(0);} }while(0)
  for(;t+1<NT;t+=2){
    STEP(pB0,pB1,pA0,pA1,t,(t+3<NT),(t+1<NT),(t+1<NT));       ENDW(t);   RESC(); ROT();
    STEP(pA0,pA1,pB0,pB1,t+1,(t+4<NT),(t+2<NT),(t+2<NT));     ENDW(t+1); RESC(); ROT();
  }
  STEP(pB0,pB1,pA0,pA1,NT-1,false,false,false); RESC();
  { float sacc=pB0[0]+pB0[1]; _Pragma("unroll") for(int r=2;r<16;++r)sacc+=pB0[r]; _Pragma("unroll") for(int r=0;r<16;++r)sacc+=pB1[r]; l_reg+=sacc;
    pw0=(u32x4){PKW(pB0,0),PKW(pB0,2),PKW(pB0,4),PKW(pB0,6)};pw1=(u32x4){PKW(pB0,8),PKW(pB0,10),PKW(pB0,12),PKW(pB0,14)};pw2=(u32x4){PKW(pB1,0),PKW(pB1,2),PKW(pB1,4),PKW(pB1,6)};pw3=(u32x4){PKW(pB1,8),PKW(pB1,10),PKW(pB1,12),PKW(pB1,14)};
    SBAR(); pv(o,vb0+2*sl_cur,PAF(0),PAF(1),PAF(2),PAF(3)); pv(o+2,vb0+2*sl_cur+8192,PAF(0),PAF(1),PAF(2),PAF(3)); }
  #undef PKW
  #undef PAF
  #undef VFR
  #undef PIN
  #undef MX3
  #undef GAPA
  #undef GAPB
  #undef LOADB
  #undef EX
  #undef VRDJ
  #undef VOFF
  #undef GAPC
  #undef KRD
  #undef STEP
  #undef ENDW
  {auto rr=__builtin_amdgcn_permlane32_swap(__float_as_uint(l_reg),__float_as_uint(l_reg),false,false);l_reg=__uint_as_float(rr[0])+__uint_as_float(rr[1]);}
  if(hi==0)wsf[32+r32]=l_reg;asm volatile("s_waitcnt lgkmcnt(0)":::"memory");
  float rli[16];
  #pragma unroll
  for(int r=0;r<16;++r)rli[r]=__builtin_amdgcn_rcpf(wsf[32+crow(r,hi)]);
  bf16*Ow=Oc+(rowbase+q0+wid*QBLK)*PO;
  { bf16*stg=(bf16*)(shm+LDS_OST128)+wid*2048;
    #pragma unroll
    for(int hf=0;hf<2;++hf){
      #pragma unroll
      for(int r=0;r<16;++r){const int orow=crow(r,hi);
        #pragma unroll
        for(int d0=0;d0<2;++d0)stg[orow*64+d0*32+r32]=__float2bfloat16(o[2*hf+d0][r]*rli[r]);}
      asm volatile("s_waitcnt lgkmcnt(0)":::"memory");
      #pragma unroll
      for(int i=0;i<4;++i){const int row=i*8+(lane>>3),ch=lane&7; const u32x4 v=*(const u32x4*)(stg+row*64+ch*8); ATTN_STORE16(Ow+(long)row*PO+hf*64+ch*8,v);}
      asm volatile("s_waitcnt lgkmcnt(0)":::"memory"); } }
  asm volatile("s_waitcnt lgkmcnt(0)\n\ts_barrier":::"memory");
  #undef CINIT
  #undef DMA_K
  #undef DMA_V
  #undef CMASK
  #undef START
  #undef RESC
  #undef ROT
}
constexpr int ATTN_LDS_BYTES=(LDS_BYTES>LDS_BYTES128)?LDS_BYTES:LDS_BYTES128;
#undef SBAR
#undef WAIT_BAR
}

namespace xattn {
using pg8::bf16_t; using pg8::bf16x8; using pg8::u32x4; using pg8::f32x4;
using f32x16 = __attribute__((ext_vector_type(16))) float;
#define XLAS __attribute__((address_space(3)))
constexpr int XB0 = 0, XB1 = 32768, X_WSF = 65536, X_OST = X_WSF + 2048, X_LDS_BYTES = X_OST + 8 * 4096;
__device__ __forceinline__ int crow(int r, int hi) { return (r & 3) + 8 * (r >> 2) + 4 * hi; }
__device__ __forceinline__ unsigned pk(float lo, float hi) { return pg8::cvt_pk_bf16(lo, hi); }
__device__ __forceinline__ void unit(int b, int h, int qblk, const bf16_t* __restrict__ CQ, const bf16_t* __restrict__ CK, const bf16_t* __restrict__ CVT, bf16_t* __restrict__ CO, XLAS unsigned char* lds, const int wv) {
    const int tid = wv * 64 + mk_lane(), lane = tid & 63, r32 = lane & 31, hi = lane >> 5; const int wid = __builtin_amdgcn_readfirstlane(tid >> 6);
    const size_t qrow0 = (size_t)b * 4096 + (size_t)qblk * 256 + wid * 32;
    const bf16_t* Qw = CQ + (qrow0 + r32) * 1024 + h * 256 + hi * 8;
    const bf16_t* Kg = CK + ((size_t)b * 256 + lane) * 1024 + h * 256 + wid * 8;
    const bf16_t* Vg = CVT + ((size_t)h * 256 + lane) * 2048 + (size_t)b * 256 + wid * 8;
    u32x4 st[4];
#define X_LOADK(dc) do { _Pragma("unroll") for (int i_ = 0; i_ < 4; ++i_) st[i_] = *(const u32x4*)(Kg + (dc) * 64 + (size_t)i_ * 64 * 1024); } while (0)
#define X_LOADV(c)  do { _Pragma("unroll") for (int i_ = 0; i_ < 4; ++i_) st[i_] = *(const u32x4*)(Vg + (size_t)(c) * 64 * 2048 + i_ * 64); } while (0)
#define X_STOREK(buf) do { _Pragma("unroll") for (int i_ = 0; i_ < 4; ++i_) *(XLAS u32x4*)(lds + (buf) + wid * 4096 + (64 * i_ + lane) * 16) = st[i_]; } while (0)
#define X_STOREV(buf) do { _Pragma("unroll") for (int i_ = 0; i_ < 4; ++i_) *(XLAS u32x4*)(lds + (buf) + (wid + 8 * i_) * 1024 + lane * 16) = st[i_]; } while (0)
    const int kswz = (r32 & ~12) | ((r32 & 4) << 1) | ((r32 & 8) >> 1);
    const int koff = hi * 4096 + kswz * 16;
    const int voff = hi * 1024 + r32 * 16;
    f32x16 s[8];
#pragma unroll
    for (int kt = 0; kt < 8; ++kt) s[kt] = f32x16{};
    X_LOADK(0);
    bf16x8 qfa[4][4];
#pragma unroll
    for (int dc = 0; dc < 4; ++dc)
#pragma unroll
        for (int ks = 0; ks < 4; ++ks) qfa[dc][ks] = *(const bf16x8*)(Qw + dc * 64 + ks * 16);
    X_STOREK(XB0);
    __syncthreads();
#pragma unroll
    for (int dc = 0; dc < 4; ++dc) {
        const int buf = (dc & 1) ? XB1 : XB0, nbuf = (dc & 1) ? XB0 : XB1;
        if (dc < 3) X_LOADK(dc + 1); else X_LOADV(0);
#pragma unroll
        for (int kt = 0; kt < 8; ++kt)
#pragma unroll
            for (int ks = 0; ks < 4; ++ks) {
                const bf16x8 kf = *(const XLAS bf16x8*)(lds + buf + koff + kt * 512 + ks * 8192);
                s[kt] = __builtin_amdgcn_mfma_f32_32x32x16_bf16(kf, qfa[dc][ks], s[kt], 0, 0, 0);
            }
        if (dc < 3) X_STOREK(nbuf); else X_STOREV(nbuf);
        __syncthreads();
    }
    float mx = s[0][0];
#pragma unroll
    for (int kt = 0; kt < 8; ++kt)
#pragma unroll
        for (int r = 0; r < 16; ++r) mx = fmaxf(mx, s[kt][r]);
    mx = fmaxf(mx, __shfl_xor(mx, 32));
    float l = 0.f;
#pragma unroll
    for (int kt = 0; kt < 8; ++kt)
#pragma unroll
        for (int r = 0; r < 16; ++r) { const float p = __builtin_amdgcn_exp2f(s[kt][r] - mx); s[kt][r] = p; l += p; }
    l += __shfl_xor(l, 32);
    u32x4 pw[16];
#pragma unroll
    for (int kt = 0; kt < 8; ++kt)
#pragma unroll
        for (int j2 = 0; j2 < 2; ++j2)
            pw[2 * kt + j2] = (u32x4){pk(s[kt][8 * j2 + 0], s[kt][8 * j2 + 1]), pk(s[kt][8 * j2 + 2], s[kt][8 * j2 + 3]), pk(s[kt][8 * j2 + 4], s[kt][8 * j2 + 5]), pk(s[kt][8 * j2 + 6], s[kt][8 * j2 + 7])};
    XLAS float* wsf = (XLAS float*)(lds + X_WSF) + wid * 64;
    if (hi == 0) wsf[r32] = l;
    asm volatile("s_waitcnt lgkmcnt(0)" ::: "memory");
    float rli[16];
#pragma unroll
    for (int r = 0; r < 16; ++r) rli[r] = __builtin_amdgcn_rcpf(wsf[crow(r, hi)]);
    XLAS bf16_t* stg = (XLAS bf16_t*)(lds + X_OST) + wid * 2048;
    bf16_t* Ow = CO + qrow0 * 1024 + h * 256;
#pragma unroll
    for (int c = 0; c < 4; ++c) {
        const int buf = (c & 1) ? XB1 : XB0, nbuf = (c & 1) ? XB0 : XB1;
        if (c < 3) X_LOADV(c + 1);
        f32x16 o[2]; o[0] = f32x16{}; o[1] = f32x16{};
#pragma unroll
        for (int j = 0; j < 16; ++j)
#pragma unroll
            for (int dt = 0; dt < 2; ++dt) {
                const bf16x8 vf = *(const XLAS bf16x8*)(lds + buf + voff + dt * 512 + j * 2048);
                o[dt] = __builtin_amdgcn_mfma_f32_32x32x16_bf16(__builtin_bit_cast(bf16x8, pw[j]), vf, o[dt], 0, 0, 0);
            }
#pragma unroll
        for (int r = 0; r < 16; ++r) { const int orow = crow(r, hi);
#pragma unroll
            for (int dt = 0; dt < 2; ++dt) { const unsigned w = pk(o[dt][r] * rli[r], 0.f); stg[orow * 64 + dt * 32 + r32] = (bf16_t)(w & 0xffffu); } }
        asm volatile("s_waitcnt lgkmcnt(0)" ::: "memory");
#pragma unroll
        for (int i = 0; i < 4; ++i) { const int row = i * 8 + (lane >> 3), ch = lane & 7; const u32x4 v = *(const XLAS u32x4*)(stg + row * 64 + ch * 8); *(u32x4*)(Ow + (size_t)row * 1024 + c * 64 + ch * 8) = v; }
        asm volatile("s_waitcnt lgkmcnt(0)" ::: "memory");
        if (c < 3) X_STOREV(nbuf);
        __syncthreads();
    }
#undef X_LOADK
#undef X_LOADV
#undef X_STOREK
#undef X_STOREV
}
}

#ifndef MK_PER_PHASE
#define MK_PER_PHASE 0
#endif
constexpr int NWAVES = 8;
constexpr int BATCH = 8, SEQ = 4096, D = 1024, M = BATCH * SEQ, FF = 4096, NMEM = 256, MM = BATCH * NMEM, INW = 3080, NPROJ = 3072, NATT = 1536;
constexpr float EPS = 1e-6f, SUBLN_EPS = 1e-5f;
constexpr int N_PHASES = 11;

constexpr size_t MiB = 1u << 20;
constexpr size_t WS_ROPE = 0;
constexpr size_t WS_LOGF = 1 * MiB;
constexpr size_t WS_KB   = 2 * MiB;
constexpr size_t WS_NRM  = 3 * MiB;
constexpr size_t WS_BAR  = 3 * MiB + 65536;
constexpr size_t WS_SS1  = 4 * MiB, WS_SS2 = 6 * MiB, WS_SS3 = 8 * MiB;
constexpr size_t WS_WIN = 10 * MiB, WS_WOUT = 16 * MiB, WS_WCQ = 18 * MiB, WS_WCKV = 20 * MiB, WS_WCO = 24 * MiB, WS_WUP = 26 * MiB, WS_WDN = 34 * MiB;
constexpr size_t WS_MEMN = 42 * MiB, WS_CK = 46 * MiB, WS_CVT = 50 * MiB;
constexpr size_t WS_SA = 56 * MiB;
constexpr size_t WS_SB = 120 * MiB;
constexpr size_t WS_PROJ = 184 * MiB;
constexpr size_t WS_ATT = 376 * MiB;
constexpr size_t WS_ZH = 184 * MiB;
constexpr size_t WS_END = 472 * MiB;
static_assert(WS_ZH + (size_t)M * FF * 2 <= WS_END && WS_ATT + (size_t)M * NATT * 2 <= WS_END && WS_PROJ + (size_t)M * NPROJ * 2 <= WS_ATT, "d_ws map");

constexpr int RING_BYTES = 131072, LDS_BYTES = 147456;
static_assert(attn_body::ATTN_LDS_BYTES <= RING_BYTES && xattn::X_LDS_BYTES <= RING_BYTES && pg8::STAGE_BYTES <= RING_BYTES, "LDS map");

#define LAS __attribute__((address_space(3)))
typedef unsigned short bf16;
typedef unsigned v4u __attribute__((ext_vector_type(4)));
typedef float f32x4 __attribute__((ext_vector_type(4)));
#define LDS_WAIT() asm volatile("s_waitcnt lgkmcnt(0)" ::: "memory")
__device__ __forceinline__ unsigned f2bf(float f) { unsigned u = __builtin_bit_cast(unsigned, f); return (u + 0x7fffu + ((u >> 16) & 1u)) >> 16; }
__device__ __forceinline__ unsigned pk2(float lo, float hi) { return f2bf(lo) | (f2bf(hi) << 16); }
__device__ __forceinline__ float bflo(unsigned w) { return __builtin_bit_cast(float, w << 16); }
__device__ __forceinline__ float bfhi(unsigned w) { return __builtin_bit_cast(float, w & 0xffff0000u); }
__device__ __forceinline__ float wave_sum(float v) {
#pragma unroll
    for (int o = 1; o < 64; o <<= 1) v += __shfl_xor(v, o);
    return v;
}

#define XB_TMO      128
#define XB_XCNT(j)  (256  + 64 * (j))
#define XB_XSUB(j)  (1280 + 64 * (j))
#define XB_XGEN(j)  (2304 + 64 * (j))
#define XB_TOP      3328
#define XB_TOPGEN   3392
#define XCD_BAR_WORDS 3456
#define XB_SPIN_CAP (1u << 18)

__device__ __forceinline__ unsigned xb_ld(unsigned* p)              { return __hip_atomic_load(p, __ATOMIC_RELAXED, __HIP_MEMORY_SCOPE_AGENT); }
__device__ __forceinline__ unsigned xb_add(unsigned* p, unsigned v) { return __hip_atomic_fetch_add(p, v, __ATOMIC_RELAXED, __HIP_MEMORY_SCOPE_AGENT); }
__device__ __forceinline__ unsigned xb_xcc_id() { return (unsigned)__builtin_amdgcn_s_getreg((3 << 11) | 20) & 0xFu; }
#define XB_SPIN(cond, bar) do { unsigned _sp = 0; while (cond) { __builtin_amdgcn_s_sleep(1); \
    if ((++_sp & 255u) == 0u) { if (xb_ld(&(bar)[XB_TMO])) break; if (_sp > XB_SPIN_CAP) { atomicAdd(&(bar)[XB_TMO], 1u); break; } } } } while (0)

struct XcdBarrier {
    unsigned* bar; unsigned x;
    volatile LAS unsigned* st;
};

__device__ __forceinline__ XcdBarrier xcd_barrier_post(unsigned* bar, volatile LAS unsigned* st, bool leader) {
    XcdBarrier b; b.bar = bar; b.x = xb_xcc_id(); b.st = st;
    if (leader) (void)xb_add(&bar[XB_XCNT(b.x)], 1u);
    return b;
}
__device__ __forceinline__ void xcd_barrier_complete(unsigned* bar, unsigned x, unsigned& nloc, unsigned& nx) {
    const unsigned G = gridDim.x * gridDim.y * gridDim.z;
    unsigned sum, cnt, mine, sp = 0u;
    for (;;) {
        sum = 0u; cnt = 0u; mine = 0u;
#pragma unroll
        for (unsigned j = 0; j < 16; ++j) { const unsigned c = xb_ld(&bar[XB_XCNT(j)]); sum += c; cnt += (c > 0u) ? 1u : 0u; mine = (j == x) ? c : mine; }
        if (sum == G) break;
        __builtin_amdgcn_s_sleep(1);
        if ((++sp & 255u) == 0u) { if (xb_ld(&bar[XB_TMO])) break; if (sp > XB_SPIN_CAP) { atomicAdd(&bar[XB_TMO], 1u); break; } }
    }
    nloc = mine > 0u ? mine : 1u; nx = cnt > 0u ? cnt : 1u;
}

__device__ __forceinline__ void xcd_barrier(const XcdBarrier& b, bool leader) {
    asm volatile("s_waitcnt vmcnt(0)" ::: "memory");
    __syncthreads();
    if (leader) {
        unsigned* bar = b.bar;
        __builtin_amdgcn_s_waitcnt(0);
        unsigned nloc = b.st[0], nx = b.st[1];
        if (nloc == 0u) { xcd_barrier_complete(bar, b.x, nloc, nx); b.st[0] = nloc; b.st[1] = nx; }
        const unsigned old = xb_add(&bar[XB_XSUB(b.x)], 1u);
        const unsigned gen = old / nloc;
        if (old + 1u == (gen + 1u) * nloc) {
            __builtin_amdgcn_fence(__ATOMIC_RELEASE, "agent");
            asm volatile("s_waitcnt vmcnt(0)" ::: "memory");
            const unsigned og = xb_add(&bar[XB_TOP], 1u);
            const unsigned tg = og / nx;
            if (og + 1u == (tg + 1u) * nx) xb_add(&bar[XB_TOPGEN], 1u);
            else XB_SPIN(xb_ld(&bar[XB_TOPGEN]) == tg, bar);
            __builtin_amdgcn_fence(__ATOMIC_ACQUIRE, "agent");
            xb_add(&bar[XB_XGEN(b.x)], 1u);
            asm volatile("s_waitcnt vmcnt(0)" ::: "memory");
        } else {
            XB_SPIN(xb_ld(&bar[XB_XGEN(b.x)]) == gen, bar);
            __builtin_amdgcn_fence(__ATOMIC_ACQUIRE, "agent");
            asm volatile("s_waitcnt vmcnt(0)" ::: "memory");
        }
    }
    __syncthreads();
}

struct Params { const float* in[21]; float* out; unsigned char* ws; int ph_lo, ph_hi; };
enum { I_X = 0, I_MEM, I_GMIX, I_WIN, I_BF, I_LQ1, I_LK1, I_LQ2, I_LK2, I_GSUB, I_GFOX, I_WOUT, I_GCROSS, I_GMEM, I_WCQ, I_WCKV, I_WCO, I_GMLP, I_WUP, I_WDN, I_GFIN };

__device__ __forceinline__ void p0_transpose_item(const float* W, int K, int ldw, int nblk, bf16* WT, LAS float* scr, int item, int lane, const float* gk = nullptr  ) {
    const int kb = item / nblk, nb = item % nblk, k0 = 64 * kb, n0 = 32 * nb;
    { f32x4 v[8]; float gg[8];
#pragma unroll
        for (int it = 0; it < 8; ++it) { const int kk = 8 * it + (lane >> 3); v[it] = __builtin_nontemporal_load((const f32x4*)(W + (size_t)(k0 + kk) * ldw + n0 + 4 * (lane & 7)));     gg[it] = gk ? gk[k0 + kk] : 1.f; }
#pragma unroll
        for (int it = 0; it < 8; ++it) { const int kk = 8 * it + (lane >> 3); LAS float* d = scr + kk * 33 + 4 * (lane & 7); d[0] = v[it].x * gg[it]; d[1] = v[it].y * gg[it]; d[2] = v[it].z * gg[it]; d[3] = v[it].w * gg[it]; } }
    LDS_WAIT(); asm volatile("" ::: "memory");
    const int c = lane & 7;
#pragma unroll
    for (int j = 0; j < 4; ++j) { const int n = (lane >> 3) + 8 * j; const LAS float* s = scr + (8 * c) * 33 + n;
        v4u o; o.x = pk2(s[0 * 33], s[1 * 33]); o.y = pk2(s[2 * 33], s[3 * 33]); o.z = pk2(s[4 * 33], s[5 * 33]); o.w = pk2(s[6 * 33], s[7 * 33]);
        *(v4u*)(WT + (size_t)(n0 + n) * K + k0 + 8 * c) = o; }
    LDS_WAIT(); asm volatile("" ::: "memory");
}

__device__ __forceinline__ void rms_row(const float* xrow, const f32x4 (&gq)[4], bf16* orow, int lane, f32x4 (&v)[4]) {
    const f32x4* xr = (const f32x4*)xrow + lane; float s = 0.f;
#pragma unroll
    for (int j = 0; j < 4; ++j) { v[j] = xr[64 * j]; s += (v[j].x * v[j].x + v[j].y * v[j].y) + (v[j].z * v[j].z + v[j].w * v[j].w); }
    const float rstd = 1.0f / sqrtf(wave_sum(s) * (1.f / 1024.f) + EPS);
    unsigned long long* o8 = (unsigned long long*)orow + lane;
#pragma unroll
    for (int j = 0; j < 4; ++j) { v[j] = v[j] * rstd * gq[j]; o8[64 * j] = (unsigned long long)pk2(v[j].x, v[j].y) | ((unsigned long long)pk2(v[j].z, v[j].w) << 32); }
}

template <class Sched> __device__ __forceinline__ void build_rstd_tables(LAS unsigned char* lds, const Sched& S, const float* sspart, float eps, int wave) {
    const int lane = mk_lane(), tid = wave * 64 + lane;
    LAS int* pml = (LAS int*)(lds + RING_BYTES + 1536); LAS float* tab = (LAS float*)(lds + RING_BYTES + 2048);
    if (tid == 0) { int n = 0; pg8::Unit u; for (int i = 0; S.next(i, u); ++i) { bool f = false; for (int j = 0; j < n; ++j) f |= (pml[j] == u.pm); if (!f && n < 8) pml[n++] = u.pm; } pml[8] = n; }
    __syncthreads();
    const int n = pml[8];
    for (int idx = tid; idx < n * 256; idx += NWAVES * 64) tab[idx] = pg8::row_rstd(sspart, pml[idx >> 8] * 256 + (idx & 255), eps);
    __syncthreads();
}
__global__ void __launch_bounds__(NWAVES * 64, 2) mk_fwd(Params P) {
    extern __shared__ __attribute__((aligned(16))) unsigned char lds_raw[];
    LAS unsigned char* lds = (LAS unsigned char*)lds_raw;
    const int wave = __builtin_amdgcn_readfirstlane((int)threadIdx.x >> 6);
#define LANE_TID const int lane = mk_lane(), tid = wave * 64 + lane
    const int G = gridDim.x; const int bx = blockIdx.x; const int vcu = (G % 8 == 0) ? (bx % 8) * (G / 8) + bx / 8 : bx;
    const int gw = vcu * NWAVES + wave, NGW = G * NWAVES;
    unsigned char* const ws = P.ws;
#define ROPE ((float*)(P.ws + WS_ROPE))
#define LOGF ((float*)(P.ws + WS_LOGF))
#define KBIAS ((float*)(P.ws + WS_KB))
#define NRM ((float*)(P.ws + WS_NRM))
#define SS1 ((float*)(P.ws + WS_SS1))
#define SS2 ((float*)(P.ws + WS_SS2))
#define SS3 ((float*)(P.ws + WS_SS3))
#define Win_t ((bf16*)(P.ws + WS_WIN))
#define Wout_t ((bf16*)(P.ws + WS_WOUT))
#define Wcq_t ((bf16*)(P.ws + WS_WCQ))
#define Wckv_t ((bf16*)(P.ws + WS_WCKV))
#define Wco_t ((bf16*)(P.ws + WS_WCO))
#define Wup_t ((bf16*)(P.ws + WS_WUP))
#define Wdn_t ((bf16*)(P.ws + WS_WDN))
#define MEMN ((bf16*)(P.ws + WS_MEMN))
#define CKb ((bf16*)(P.ws + WS_CK))
#define CVT ((bf16*)(P.ws + WS_CVT))
#define XN ((bf16*)(P.ws + WS_SB))
#define MIXA ((bf16*)(P.ws + WS_SA))
#define CQ ((bf16*)(P.ws + WS_SA))
#define H2B ((bf16*)(P.ws + WS_SA))
#define H1B ((bf16*)(P.ws + WS_SB))
#define CO ((bf16*)(P.ws + WS_PROJ))
#define PROJ ((bf16*)(P.ws + WS_PROJ))
#define ATT ((bf16*)(P.ws + WS_ATT))
#define ZH ((bf16*)(P.ws + WS_ZH))
    const int lo = P.ph_lo, hi_ph = P.ph_hi;
    volatile LAS unsigned* xst = (volatile LAS unsigned*)(lds + RING_BYTES + 1024);
    { const int l0 = mk_lane(); if (wave == 0 && l0 < 2) xst[l0] = 0u; }
    __syncthreads();
    XcdBarrier bar; bar.bar = (unsigned*)(ws + WS_BAR); bar.x = 0; bar.st = xst;
    if (hi_ph - lo > 1) bar = xcd_barrier_post((unsigned*)(ws + WS_BAR), xst, wave == 0 && mk_lane() == 0);
    if (lo < 0) cg::this_grid().sync();
#define IN(k) (lo <= (k) && (k) < hi_ph)
#ifndef MK_MASK
#define MK_MASK 0x7ff
#endif
#ifndef MK_ATT_MASK
#define MK_ATT_MASK 3
#endif
#ifndef MK_REP_MASK
#define MK_REP_MASK 0
#endif
#define PH(k) (IN(k) && ((MK_MASK >> (k)) & 1))
#define REPS(k) for (int rep_ = 0; rep_ < (((MK_REP_MASK) >> (k)) & 1) + 1; ++rep_)
#define SEAM(k) do { if (IN(k) && IN((k) + 1)) { xcd_barrier(bar, wave == 0 && mk_lane() == 0); } } while (0)

    if (PH(0)) REPS(0) {
        LANE_TID;
        {
            const float* win = P.in[I_WIN];
            for (int k = tid; k < 1024; k += NWAVES * 64) { const f32x4 a = *(const f32x4*)(win + (size_t)k * INW + 3072), b = *(const f32x4*)(win + (size_t)k * INW + 3076);
                const int slot = (((k >> 8) * 4 + (k & 3)) * 64 + ((k & 255) >> 2)); *(LAS f32x4*)(lds + slot * 32) = a; *(LAS f32x4*)(lds + slot * 32 + 16) = b; }
        }
        if (bx == 0 && tid < BATCH * 64) NRM[tid] = 0.f;
        __syncthreads();
        LAS float* scr = (LAS float*)(lds + 32768 + wave * 8704);
        {
            constexpr int I_IN = 16 * 96, I_SQ = 16 * 32, I_CKV = 16 * 64, I_UP = 16 * 128, I_DN = 64 * 32;
            constexpr int NITEMS = I_IN + 3 * I_SQ + I_CKV + I_UP + I_DN;
            for (int it = gw; it < NITEMS; it += NGW) {
                int r = it;
                if (r < I_IN) { p0_transpose_item(P.in[I_WIN], D, INW, 96, Win_t, scr, r, lane, P.in[I_GMIX]); continue; } r -= I_IN;
                if (r < I_SQ) { p0_transpose_item(P.in[I_WOUT], D, D, 32, Wout_t, scr, r, lane); continue; } r -= I_SQ;
                if (r < I_SQ) { p0_transpose_item(P.in[I_WCQ], D, D, 32, Wcq_t, scr, r, lane, P.in[I_GCROSS]); continue; } r -= I_SQ;
                if (r < I_SQ) { p0_transpose_item(P.in[I_WCO], D, D, 32, Wco_t, scr, r, lane); continue; } r -= I_SQ;
                if (r < I_CKV) { p0_transpose_item(P.in[I_WCKV], D, 2 * D, 64, Wckv_t, scr, r, lane); continue; } r -= I_CKV;
                if (r < I_UP) { p0_transpose_item(P.in[I_WUP], D, FF, 128, Wup_t, scr, r, lane, P.in[I_GMLP]); continue; } r -= I_UP;
                p0_transpose_item(P.in[I_WDN], FF, D, 32, Wdn_t, scr, r, lane);
            }
        }
        {
            for (int idx = gw * 64 + lane; idx < SEQ * 8; idx += NGW * 64) {
                const int pos = idx >> 3, j = idx & 7;
                const float f = j == 0 ? 1.0f : j == 1 ? 0.1939227432012558f : j == 2 ? 0.03760603070259094f : j == 3 ? 0.007292664609849453f : j == 4 ? 0.0014142135623842478f : j == 5 ? 0.00027424818836152554f : j == 6 ? 5.318296098266728e-05f : 1.0313386155758053e-05f;
                const float ang = (float)pos * f;
                double rev = (double)ang * 0.15915494309189535; rev -= __builtin_rint(rev);
                const float x = (float)(rev * 6.283185307179586);
                ROPE[pos * 16 + j] = cosf(x); ROPE[pos * 16 + 8 + j] = sinf(x);
            }
        }
        {
            f32x4 gq[4];
#pragma unroll
            for (int j = 0; j < 4; ++j) gq[j] = ((const f32x4*)P.in[I_GMIX])[64 * j + lane];
            const float bfv = P.in[I_BF][lane & 7];
            const bool b0 = lane & 1, b1 = lane & 2, b2 = lane & 4;
            const bool xal = (G == 256); const int mstart = xal ? (bx & 7) * SEQ + ((bx >> 3) * NWAVES + wave) * 4 : gw * 4, mstep = xal ? 1024 : NGW * 4, mend = xal ? (bx & 7) * SEQ + SEQ : M;
            for (int m0 = mstart; m0 < mend; m0 += mstep) {
                f32x4 v[4][4]; float s[4];
#pragma unroll
                for (int r = 0; r < 4; ++r)
#pragma unroll
                    for (int jj = 0; jj < 4; ++jj) v[r][jj] = __builtin_nontemporal_load((const f32x4*)(P.in[I_X] + (size_t)(m0 + r) * D) + 64 * jj + lane);
#pragma unroll
                for (int r = 0; r < 4; ++r) { s[r] = 0.f;
#pragma unroll
                    for (int jj = 0; jj < 4; ++jj) s[r] += (v[r][jj].x * v[r][jj].x + v[r][jj].y * v[r][jj].y) + (v[r][jj].z * v[r][jj].z + v[r][jj].w * v[r][jj].w); }
#pragma unroll
                for (int r = 0; r < 4; ++r) { const float ssum = wave_sum(s[r]); const float rstd = 1.0f / sqrtf(ssum * (1.f / 1024.f) + EPS);
                    unsigned long long* o8 = (unsigned long long*)(XN + (size_t)(m0 + r) * D) + lane;
                    if (lane < 4) ((f32x4*)(SS3 + (size_t)(m0 + r) * 16))[lane] = (f32x4){lane == 0 ? ssum : 0.f, 0.f, 0.f, 0.f};
#pragma unroll
                    for (int jj = 0; jj < 4; ++jj) { o8[64 * jj] = (unsigned long long)pk2(v[r][jj].x, v[r][jj].y) | ((unsigned long long)pk2(v[r][jj].z, v[r][jj].w) << 32);
                        v[r][jj] = v[r][jj] * rstd * gq[jj]; } }
                f32x4 a0[4], a1[4];
#pragma unroll
                for (int r = 0; r < 4; ++r) { a0[r] = (f32x4){0.f, 0.f, 0.f, 0.f}; a1[r] = a0[r]; }
#pragma unroll
                for (int jj = 0; jj < 4; ++jj)
#pragma unroll
                    for (int i = 0; i < 4; ++i) { const LAS f32x4* wp = (const LAS f32x4*)(lds + ((jj * 4 + i) * 64 + lane) * 32); const f32x4 w0 = wp[0], w1 = wp[1];
#pragma unroll
                        for (int r = 0; r < 4; ++r) { a0[r] += w0 * v[r][jj][i]; a1[r] += w1 * v[r][jj][i]; } }
#pragma unroll
                for (int r = 0; r < 4; ++r) {
                    float c0, c1, c2, c3, d0, d1, z;
                    { const float k0 = b0 ? a0[r][1] : a0[r][0], g0 = b0 ? a0[r][0] : a0[r][1]; c0 = k0 + __shfl_xor(g0, 1); }
                    { const float k0 = b0 ? a0[r][3] : a0[r][2], g0 = b0 ? a0[r][2] : a0[r][3]; c1 = k0 + __shfl_xor(g0, 1); }
                    { const float k0 = b0 ? a1[r][1] : a1[r][0], g0 = b0 ? a1[r][0] : a1[r][1]; c2 = k0 + __shfl_xor(g0, 1); }
                    { const float k0 = b0 ? a1[r][3] : a1[r][2], g0 = b0 ? a1[r][2] : a1[r][3]; c3 = k0 + __shfl_xor(g0, 1); }
                    { const float k0 = b1 ? c1 : c0, g0 = b1 ? c0 : c1; d0 = k0 + __shfl_xor(g0, 2); }
                    { const float k0 = b1 ? c3 : c2, g0 = b1 ? c2 : c3; d1 = k0 + __shfl_xor(g0, 2); }
                    { const float k0 = b2 ? d1 : d0, g0 = b2 ? d0 : d1; z = k0 + __shfl_xor(g0, 4); }
                    z += __shfl_xor(z, 8); z += __shfl_xor(z, 16); z += __shfl_xor(z, 32);
                    z += bfv;
                    const float ls = fminf(z, 0.f) - __logf(1.0f + __expf(-fabsf(z)));
                    const int m = m0 + r;
                    if (lane < 8) LOGF[((size_t)(m >> 12) * 8 + lane) * SEQ + (m & 4095)] = ls;
                }
            }
        }
        {
            f32x4 gq[4];
#pragma unroll
            for (int j = 0; j < 4; ++j) gq[j] = ((const f32x4*)P.in[I_GMEM])[64 * j + lane];
            for (int m = gw; m < MM; m += NGW) { f32x4 v[4]; rms_row(P.in[I_MEM] + (size_t)m * D, gq, MEMN + (size_t)m * D, lane, v); }
        }
        __syncthreads();
    }
    SEAM(0);

    if (PH(1)) REPS(1) {
        LANE_TID;
        if (bx < BATCH * 8) {
            const float* src = LOGF + (size_t)bx * SEQ + tid * 8; float* dst = KBIAS + (size_t)bx * SEQ + tid * 8;
            const f32x4 a = *(const f32x4*)src, b = *(const f32x4*)(src + 4);
            float p[8]; p[0] = a[0]; p[1] = p[0] + a[1]; p[2] = p[1] + a[2]; p[3] = p[2] + a[3]; p[4] = p[3] + b[0]; p[5] = p[4] + b[1]; p[6] = p[5] + b[2]; p[7] = p[6] + b[3];
            float inc = p[7];
#pragma unroll
            for (int o = 1; o < 64; o <<= 1) { const float t = __shfl_up(inc, o); if (lane >= o) inc += t; }
            LAS float* wt = (LAS float*)lds;
            if (lane == 63) wt[wave] = inc;
            __syncthreads();
            float pre = inc - p[7];
            for (int w = 0; w < wave; ++w) pre += wt[w];
            const float c = -1.4426950408889634f;
            *(f32x4*)dst = (f32x4){(pre + p[0]) * c, (pre + p[1]) * c, (pre + p[2]) * c, (pre + p[3]) * c};
            *(f32x4*)(dst + 4) = (f32x4){(pre + p[4]) * c, (pre + p[5]) * c, (pre + p[6]) * c, (pre + p[7]) * c};
            __syncthreads();
        }
        { pg8::Gemm g{XN, Win_t, M, NPROJ, D}; pg8::StaticOrder S; S.init(M, NPROJ, G, bx);
          build_rstd_tables(lds, S, SS3, EPS, wave);
          pg8::EpiProj E{PROJ, ROPE, NRM, SS3, (const LAS int*)(lds + RING_BYTES + 1536), (const LAS float*)(lds + RING_BYTES + 2048)};
          pg8::gemm_phase<pg8::EpiProj, pg8::StaticOrder, true, true>(lds, g, S, E, wave); }
    }
    SEAM(1);

    if (PH(2)) REPS(2) {
        for (int p = vcu; p < 1024; p += G) {
            const int pp = p & 511, bh = pp >> 3, s = pp & 7, b = bh >> 3, hm = bh & 7;
#ifdef MK_REP_ATT
            if (rep_ == 1 && !((MK_REP_ATT) & (p < 512 ? 1 : 2))) continue;
#endif
            for (int hh = 0; hh < 2; ++hh) {
                const int qb = hh ? s : 15 - s;
                if (p < 512) { if (!(MK_ATT_MASK & 1)) continue;
                    const float* nq = NRM + 256 + ((b * 2 + 0) * 8 + hm) * 2; const float* nk = NRM + 256 + ((b * 2 + 1) * 8 + hm) * 2;
                    const float bqd = sqrtf((nq[0] + nq[1]) * (nk[0] + nk[1])) * 1.02f;
                    if (bqd < 64.f)
                        attn_body::attn_unit128<16, true>(b, qb, (const attn_body::bf16*)PROJ + hm * 64, (const attn_body::bf16*)PROJ + 512 + hm * 64, (const attn_body::bf16*)PROJ + 1024 + (hm >> 1) * 128,
                                                          (attn_body::bf16*)ATT + (hm & 1) * 512 + (hm >> 1) * 128, (char*)lds_raw, wave);
                    else
                        attn_body::attn_unit128<16, false>(b, qb, (const attn_body::bf16*)PROJ + hm * 64, (const attn_body::bf16*)PROJ + 512 + hm * 64, (const attn_body::bf16*)PROJ + 1024 + (hm >> 1) * 128,
                                                           (attn_body::bf16*)ATT + (hm & 1) * 512 + (hm >> 1) * 128, (char*)lds_raw, wave);
                } else { if (!(MK_ATT_MASK & 2)) continue; const int h = hm;
                    const float* nq = NRM + ((b * 2 + 0) * 8 + h) * 2; const float* nk = NRM + ((b * 2 + 1) * 8 + h) * 2; const float* kbr = KBIAS + (size_t)(b * 8 + h) * SEQ;
                    const float bqk = sqrtf((nq[0] + nq[1]) * (nk[0] + nk[1])) * 1.02f;
                    const int NTf = 4 * qb + 4, tc = 2 * (mk_lane() & 31);
                    const bool skip_ok = (tc >= 2) && (tc <= NTf - 4) && (2.f * bqk + kbr[64 * tc - 1 + (tc ? 0 : 1)] - kbr[256 * qb] < -40.f);
                    const unsigned long long bm = __ballot(skip_ok);
                    const int t0 = bm ? 2 * ((63 - __builtin_clzll(bm)) & 31) : 0;
                    attn_body::attn_unit<8, true>(b, qb, (const attn_body::bf16*)PROJ + 1536 + h * 64, (const attn_body::bf16*)PROJ + 2048 + h * 64, (const attn_body::bf16*)PROJ + 2560 + h * 64,
                                                  (attn_body::bf16*)ATT + 1024 + h * 64, kbr, t0, (char*)lds_raw, wave);
                }
            }
        }
    }
    SEAM(2);

    if (PH(3)) REPS(3) {
        LANE_TID;
        if (bx < 64) {
        { pg8::Gemm g{MEMN, Wckv_t, MM, D, D}; pg8::StaticOrder S; S.init(MM, D, G, bx);
          pg8::EpiBf16<0> E{CKb, D, nullptr, 0, 0, 1.f};
          pg8::gemm_phase<pg8::EpiBf16<0>, pg8::StaticOrder, true, true>(lds, g, S, E, wave); }
        { pg8::Gemm g{Wckv_t + (size_t)D * D, MEMN, D, MM, D}; pg8::StaticOrder S; S.init(D, MM, G, (bx + G - 32) % G);
          pg8::EpiBf16<0> E{CVT, MM, nullptr, 0, 0, 1.f};
          pg8::gemm_phase<pg8::EpiBf16<0>, pg8::StaticOrder, true, true>(lds, g, S, E, wave); }
        }
        const float sa = wave_sum(P.in[I_LQ1][lane] * P.in[I_LK1][lane]), sb = wave_sum(P.in[I_LQ2][lane] * P.in[I_LK2][lane]);
        const float lam = __expf(sa) - __expf(sb) + 0.2f;
        const f32x4 gs0 = *(const f32x4*)(P.in[I_GSUB] + (8 * lane) % 128), gs1 = *(const f32x4*)(P.in[I_GSUB] + (8 * lane) % 128 + 4);
        const f32x4 gf0 = *(const f32x4*)(P.in[I_GFOX] + (8 * lane) % 64), gf1 = *(const f32x4*)(P.in[I_GFOX] + (8 * lane) % 64 + 4);
        const int gw3 = (G > 64) ? (bx - 64) * NWAVES + wave : gw, NGW3 = (G > 64) ? (G - 64) * NWAVES : NGW;
        const bool xal3 = (G == 256); const int m3start = xal3 ? (bx & 7) * SEQ + ((bx - 64) >> 3) * NWAVES + wave : gw3, m3step = xal3 ? 24 * NWAVES : NGW3, m3end = xal3 ? (bx & 7) * SEQ + SEQ : M;
        if (G <= 64 || bx >= 64)
        for (int m = m3start; m < m3end; m += m3step) {
            const bf16* a = ATT + (size_t)m * NATT + 8 * lane;
            const v4u o1 = *(const v4u*)a, o2 = *(const v4u*)(a + 512), of = *(const v4u*)(a + 1024);
            float d[8], f[8];
#pragma unroll
            for (int e = 0; e < 4; ++e) { d[2 * e] = bflo(o1[e]) - lam * bflo(o2[e]); d[2 * e + 1] = bfhi(o1[e]) - lam * bfhi(o2[e]); f[2 * e] = bflo(of[e]); f[2 * e + 1] = bfhi(of[e]); }
            float sd = 0.f, sf = 0.f;
#pragma unroll
            for (int e = 0; e < 8; ++e) { sd += d[e] * d[e]; sf += f[e] * f[e]; }
            sd += __shfl_xor(sd, 1); sd += __shfl_xor(sd, 2); sd += __shfl_xor(sd, 4); sd += __shfl_xor(sd, 8);
            sf += __shfl_xor(sf, 1); sf += __shfl_xor(sf, 2); sf += __shfl_xor(sf, 4);
            const float rd = 0.8f / sqrtf(sd * (1.f / 128.f) + SUBLN_EPS), rf = 1.0f / sqrtf(sf * (1.f / 64.f) + EPS);
            v4u wd, wf;
            wd.x = pk2(d[0] * rd * gs0[0], d[1] * rd * gs0[1]); wd.y = pk2(d[2] * rd * gs0[2], d[3] * rd * gs0[3]); wd.z = pk2(d[4] * rd * gs1[0], d[5] * rd * gs1[1]); wd.w = pk2(d[6] * rd * gs1[2], d[7] * rd * gs1[3]);
            wf.x = pk2(f[0] * rf * gf0[0], f[1] * rf * gf0[1]); wf.y = pk2(f[2] * rf * gf0[2], f[3] * rf * gf0[3]); wf.z = pk2(f[4] * rf * gf1[0], f[5] * rf * gf1[1]); wf.w = pk2(f[6] * rf * gf1[2], f[7] * rf * gf1[3]);
            bf16* o = MIXA + (size_t)m * D + 8 * lane;
            *(v4u*)o = wd; *(v4u*)(o + 512) = wf;
        }
    }
    SEAM(3);

    if (PH(4)) REPS(4) { pg8::Gemm g{MIXA, Wout_t, M, D, D}; pg8::StaticOrder S; S.init(M, D, G, bx);
        pg8::EpiRes2<true, true> E{XN, H1B, SS1};
        pg8::gemm_phase<pg8::EpiRes2<true, true>, pg8::StaticOrder, true, true>(lds, g, S, E, wave); }
    SEAM(4);

    if (PH(5)) REPS(5) { pg8::Gemm g{H1B, Wcq_t, M, D, D}; pg8::StaticOrder S; S.init(M, D, G, bx);
        build_rstd_tables(lds, S, SS1, EPS, wave);
        pg8::EpiRowScale<0> E{CQ, D, SS1, EPS, pg8::CROSS_C2, (const LAS int*)(lds + RING_BYTES + 1536), (const LAS float*)(lds + RING_BYTES + 2048)};
        pg8::gemm_phase<pg8::EpiRowScale<0>, pg8::StaticOrder, true, true>(lds, g, S, E, wave); }
    SEAM(5);

    if (PH(6)) REPS(6) {
        const int upc = (512 + G - 1) / G;
        for (int u = vcu * upc; u < (vcu + 1) * upc && u < 512; ++u) { const int bh = u >> 4, qblk = u & 15; xattn::unit(bh >> 2, bh & 3, qblk, CQ, CKb, CVT, CO, lds, wave); }
    }
    SEAM(6);

    if (PH(7)) REPS(7) { pg8::Gemm g{CO, Wco_t, M, D, D}; pg8::StaticOrder S; S.init(M, D, G, bx);
        pg8::EpiRes2<true, true> E{H1B, H2B, SS2};
        pg8::gemm_phase<pg8::EpiRes2<true, true>, pg8::StaticOrder, true, true>(lds, g, S, E, wave); }
    SEAM(7);

    if (PH(8)) REPS(8) { pg8::Gemm g{H2B, Wup_t, M, FF, D}; pg8::StaticOrder S; S.init(M, FF, G, bx);
        build_rstd_tables(lds, S, SS2, EPS, wave);
        pg8::EpiRowScale<1> E{ZH, FF, SS2, EPS, 1.f, (const LAS int*)(lds + RING_BYTES + 1536), (const LAS float*)(lds + RING_BYTES + 2048)};
        pg8::gemm_phase<pg8::EpiRowScale<1>, pg8::StaticOrder, true, true>(lds, g, S, E, wave); }
    SEAM(8);

    if (PH(9)) REPS(9) { pg8::Gemm g{ZH, Wdn_t, M, D, FF}; pg8::StaticOrder S; S.init(M, D, G, bx); S.rev = true;
        pg8::EpiRes2<true, true> E{H2B, H1B  , SS3};
        pg8::gemm_phase<pg8::EpiRes2<true, true>, pg8::StaticOrder, true, true>(lds, g, S, E, wave); }
    SEAM(9);

    if (PH(10)) REPS(10) {
        LANE_TID;
        f32x4 gq[4];
#pragma unroll
        for (int j = 0; j < 4; ++j) gq[j] = ((const f32x4*)P.in[I_GFIN])[64 * j + lane];
        const bool xal = (G == 256); const int mstart = xal ? (bx & 7) * SEQ + ((bx >> 3) * NWAVES + wave) * 4 : gw * 4, mstep = xal ? 1024 : NGW * 4, mend = xal ? (bx & 7) * SEQ + SEQ : M;
        for (int m0 = mstart; m0 < mend; m0 += mstep) {
            unsigned long long w[4][4]; float rr[4];
#pragma unroll
            for (int q = 0; q < 4; ++q) { const unsigned long long* hb = (const unsigned long long*)(H1B + (size_t)(m0 + q) * D) + lane;
#pragma unroll
                for (int j = 0; j < 4; ++j) w[q][j] = hb[64 * j];
                rr[q] = pg8::row_rstd(SS3, m0 + q, EPS); }
#pragma unroll
            for (int q = 0; q < 4; ++q) { f32x4* o = (f32x4*)(P.out + (size_t)(m0 + q) * D) + lane;
#pragma unroll
                for (int j = 0; j < 4; ++j) { const unsigned lo = (unsigned)w[q][j], hi2 = (unsigned)(w[q][j] >> 32);
                    const f32x4 v = {bflo(lo), bfhi(lo), bflo(hi2), bfhi(hi2)}; o[64 * j] = v * rr[q] * gq[j]; } }
        }
    }
#undef IN
#undef SEAM
#undef LANE_TID
#undef ROPE
#undef LOGF
#undef KBIAS
#undef NRM
#undef SS1
#undef SS2
#undef SS3
#undef Win_t
#undef Wout_t
#undef Wcq_t
#undef Wckv_t
#undef Wco_t
#undef Wup_t
#undef Wdn_t
#undef MEMN
#undef CKb
#undef CVT
#undef XN
#undef MIXA
#undef CQ
#undef H2B
#undef H1B
#undef CO
#undef PROJ
#undef ATT
#undef ZH
}

extern "C" void kernel_launch(void* const* d_in, const int* in_sizes, int n_in, void* d_out, int out_size, void* d_ws, size_t ws_size, hipStream_t stream) {
    static int grid = 0;
    if (grid == 0) {
        if (n_in != 21 || in_sizes[0] != M * D || out_size != M * D || ws_size < WS_END) { fprintf(stderr, "kernel_launch: unexpected shapes (n_in %d, in0 %d, out %d, ws %zu); nothing launched\n", n_in, n_in > 0 ? in_sizes[0] : -1, out_size, ws_size); grid = -1; return; }
        int dev = 0, cus = 0, per_cu = 0;
        if (hipGetDevice(&dev) != hipSuccess || hipDeviceGetAttribute(&cus, hipDeviceAttributeMultiprocessorCount, dev) != hipSuccess) { grid = -1; return; }
        if (hipFuncSetAttribute((const void*)mk_fwd, hipFuncAttributeMaxDynamicSharedMemorySize, LDS_BYTES) != hipSuccess) { fprintf(stderr, "kernel_launch: hipFuncSetAttribute failed\n"); grid = -1; return; }
        if (hipOccupancyMaxActiveBlocksPerMultiprocessor(&per_cu, (const void*)mk_fwd, NWAVES * 64, LDS_BYTES) != hipSuccess || per_cu < 1) { fprintf(stderr, "kernel_launch: occupancy query says %d blocks per CU\n", per_cu); per_cu = 1; }
        (void)hipGetLastError();
        grid = cus * per_cu;
    }
    if (grid < 0) return;
    if (hipMemsetAsync((char*)d_ws + WS_BAR, 0, XCD_BAR_WORDS * 4, stream) != hipSuccess) { fprintf(stderr, "kernel_launch: memset of the barrier words failed\n"); return; }
    Params p{};
    for (int i = 0; i < 21; ++i) p.in[i] = (const float*)d_in[i];
    p.out = (float*)d_out; p.ws = (unsigned char*)d_ws;
#if MK_PER_PHASE
    for (int ph = 0; ph < N_PHASES; ++ph) { p.ph_lo = ph; p.ph_hi = ph + 1; hipLaunchKernelGGL(mk_fwd, dim3(grid), dim3(NWAVES * 64), LDS_BYTES, stream, p); }
#else
    p.ph_lo = 0; p.ph_hi = N_PHASES;
    void* args[] = {&p};
    const hipError_t e = hipLaunchCooperativeKernel((const void*)mk_fwd, dim3(grid), dim3(NWAVES * 64), args, LDS_BYTES, stream);
    if (e != hipSuccess) fprintf(stderr, "kernel_launch: cooperative launch failed: %s (grid %d)\n", hipGetErrorString(e), grid);
#endif
}
```

```cpp
#include <hip/hip_runtime.h>
#include <hip/hip_cooperative_groups.h>
#include <hip/hip_bf16.h>
#include <cstdio>
#include <cstdint>
#include <cmath>
namespace cg = cooperative_groups;
__device__ __forceinline__ int mk_lane() { int l = (int)__builtin_amdgcn_mbcnt_hi(~0u, __builtin_amdgcn_mbcnt_lo(~0u, 0u)); asm volatile("" : "+v"(l)); return l; }
namespace pg8 {
#define PG8_LAS __attribute__((address_space(3)))
typedef unsigned short bf16_t;
typedef short bf16x8 __attribute__((ext_vector_type(8)));
typedef float f32x4 __attribute__((ext_vector_type(4)));
typedef unsigned u32x4 __attribute__((ext_vector_type(4)));
constexpr int BM = 256, BK = 64, HALF = 128, HTB = HALF * BK * 2  , STAGE_BYTES = 8 * HTB, NXCD = 8, WGM = 8;

__host__ __device__ __forceinline__ int lds_byte(int r, int c) { const int st = (r >> 4) * 2 + (c >> 5), rr = r & 15, cc = c & 31, ob = rr * 64 + cc * 2; return st * 1024 + (ob ^ (((ob >> 9) & 1) << 5)); }
__host__ __device__ __forceinline__ void stage_rc(int b, int& R, int& C) { const int st = b / 1024, sb = b % 1024, swz = sb ^ (((sb >> 9) & 1) << 5); R = (st >> 1) * 16 + swz / 64; C = (st & 1) * 32 + (swz % 64) / 2; }
__host__ __device__ __forceinline__ int perm32(int rho) { const int n = rho >> 4, i = rho & 15; return 8 * (i >> 2) + 4 * n + (i & 3); }

struct Unit { int pm, pn; };
struct Gemm { const bf16_t* A; const bf16_t* Bt; int M, N, K; };

struct StaticOrder {
    int nM, nN, nwg, G, c; bool rev = false;
    __host__ __device__ __forceinline__ void init(int M, int N, int G_, int c_) { nM = M / BM; nN = N / BM; nwg = nM * nN; G = G_; c = c_; }
    __host__ __device__ __forceinline__ bool next(int i, Unit& u) const {
        const long L = (long)i * G + c; if (L >= nwg) return false;
        int wgid = (int)L; { const int q = nwg / NXCD, r = nwg % NXCD, xcd = wgid % NXCD, off = wgid / NXCD; wgid = (xcd < r ? xcd * (q + 1) : r * (q + 1) + (xcd - r) * q) + off; }
        const int nig = WGM * nN, gid = wgid / nig, fm = gid * WGM, gsz = (nM - fm) < WGM ? (nM - fm) : WGM;
        u.pm = fm + ((wgid % nig) % gsz); u.pn = (wgid % nig) / gsz; if (rev) u.pm = nM - 1 - u.pm; return true;
    }
    __device__ __forceinline__ void a_ready(const Unit&) const {}
    __device__ __forceinline__ void done(const Unit&) const {}
};

__device__ __forceinline__ unsigned cvt_pk_bf16(float lo, float hi) { unsigned r; asm volatile("v_cvt_pk_bf16_f32 %0, %1, %2" : "=v"(r) : "v"(lo), "v"(hi)); return r; }
typedef float f32x2 __attribute__((ext_vector_type(2)));
__device__ __forceinline__ f32x2 gelu_pk(f32x2 v) {
    const f32x2 av = __builtin_elementwise_abs(v), d = av * 0.2316418882f + 1.0f;
    f32x2 t; t.x = __builtin_amdgcn_rcpf(d.x); t.y = __builtin_amdgcn_rcpf(d.y);
    f32x2 q = t * 0.5307027145f + (-0.7265760135f); q = q * t + 0.7107068705f; q = q * t + (-0.142248368f); q = q * t + 0.127414796f; q = q * t;
    const f32x2 s = (v * v) * (-0.72134752044f);
    f32x2 e; e.x = __builtin_amdgcn_exp2f(s.x); e.y = __builtin_amdgcn_exp2f(s.y);
    const f32x2 m = v * (q * e), r = v - m;
    f32x2 o; o.x = v.x < 0.f ? m.x : r.x; o.y = v.y < 0.f ? m.y : r.y; return o;
}

template <int ACT  > struct EpiBf16 {
    static constexpr bool PERM = true, AFTER_DRAIN = false; static_assert(ACT == 0 || ACT == 1, "EpiBf16: ACT is 0 (none) or 1 (gelu_pk)");
    bf16_t* O; int ldc; const float* bias; int split_cols; size_t split_stride; float scale0;
    __device__ __forceinline__ void operator()(const f32x4 (&acc)[2][2][4][2], const Unit& u, int wr, int wc, int fr, int fq) const {
        const int row0 = u.pm * BM + wr * 64 + fr; int colt = u.pn * BM; bf16_t* base = O;
        float sc = 1.f; if (split_cols) { const int t = colt / split_cols; base += (size_t)t * split_stride; colt -= t * split_cols; if (t == 0) sc = scale0; }
        const int col0 = colt + wc * 32 + 8 * fq, bcol0 = u.pn * BM + wc * 32 + 8 * fq;
        f32x4 bv[2][2];
#pragma unroll
        for (int bj = 0; bj < 2; ++bj)
#pragma unroll
            for (int n = 0; n < 2; ++n) bv[bj][n] = bias ? *(const f32x4*)(bias + bcol0 + bj * HALF + 4 * n) : (f32x4){0.f, 0.f, 0.f, 0.f};
#pragma unroll
        for (int ai = 0; ai < 2; ++ai)
#pragma unroll
            for (int m = 0; m < 4; ++m) { bf16_t* rowp = base + (size_t)(row0 + ai * HALF + m * 16) * ldc + col0;
#pragma unroll
                for (int bj = 0; bj < 2; ++bj) { f32x4 v0 = acc[ai][bj][m][0] + bv[bj][0], v1 = acc[ai][bj][m][1] + bv[bj][1];
                    if (ACT == 1) { f32x2 a = gelu_pk((f32x2){v0[0], v0[1]}), b = gelu_pk((f32x2){v0[2], v0[3]}), c = gelu_pk((f32x2){v1[0], v1[1]}), d = gelu_pk((f32x2){v1[2], v1[3]});
                        v0 = (f32x4){a.x, a.y, b.x, b.y}; v1 = (f32x4){c.x, c.y, d.x, d.y}; }
                    v0 = v0 * sc; v1 = v1 * sc; u32x4 w; w.x = cvt_pk_bf16(v0[0], v0[1]); w.y = cvt_pk_bf16(v0[2], v0[3]); w.z = cvt_pk_bf16(v1[0], v1[1]); w.w = cvt_pk_bf16(v1[2], v1[3]);
                    *(u32x4*)(rowp + bj * HALF) = w; } }
    }
};

constexpr float QK_C2 = 0.125f * 1.4426950408889634f;
constexpr float CROSS_C2 = 0.0625f * 1.4426950408889634f;
__device__ __forceinline__ float row_rstd(const float* part, int row, float eps) {
    const f32x4* p = (const f32x4*)(part + (size_t)row * 16);
    const f32x4 a = p[0], b = p[1], c = p[2], d = p[3];
    const float s = ((a[0] + a[1]) + (a[2] + a[3])) + ((b[0] + b[1]) + (b[2] + b[3])) + ((c[0] + c[1]) + (c[2] + c[3])) + ((d[0] + d[1]) + (d[2] + d[3]));
    return 1.0f / sqrtf(s * (1.0f / 1024.0f) + eps);
}
struct EpiProj {
    static constexpr bool PERM = true, AFTER_DRAIN = false;
    bf16_t* O; const float* rope; float* nrm; const float* ssp; const PG8_LAS int* pml; const PG8_LAS float* tab;
    __device__ __forceinline__ void operator()(const f32x4 (&acc)[2][2][4][2], const Unit& u, int wr, int wc, int fr, int fq) const {
        const int row0 = u.pm * BM + wr * 64 + fr, col0 = u.pn * BM + wc * 32 + 8 * fq;
        const int typ = u.pn >> 1;
        const float sc = (typ == 0 || typ == 3) ? QK_C2 : 1.f;
        int slot = -1;
        if (tab) { const int n = pml[8]; for (int j = 0; j < n; ++j) if (pml[j] == u.pm) slot = j; }
        const bool ropew = (typ < 2) && ((wc & 1) == 0);
        const bool nrmw = (typ == 0 || typ == 1 || typ == 3 || typ == 4); float mxn[2] = {0.f, 0.f};
#pragma unroll
        for (int ai = 0; ai < 2; ++ai) {
            f32x4 rc[4][4];
            if (ropew) {
#pragma unroll
                for (int m = 0; m < 4; ++m) { const f32x4* rp = (const f32x4*)(rope + (size_t)((row0 + ai * HALF + m * 16) & 4095) * 16); rc[m][0] = rp[0]; rc[m][1] = rp[1]; rc[m][2] = rp[2]; rc[m][3] = rp[3]; }
            }
#pragma unroll
            for (int m = 0; m < 4; ++m) {
                const int row = row0 + ai * HALF + m * 16;
                bf16_t* rowp = O + (size_t)row * 3072 + col0;
                const float scr = sc * (slot >= 0 ? tab[slot * 256 + (row - u.pm * BM)] : row_rstd(ssp, row, 1e-6f));
                f32x4 c0 = {1.f, 1.f, 1.f, 1.f}, c1 = c0, s0 = {0.f, 0.f, 0.f, 0.f}, s1 = s0;
                if (ropew) { c0 = rc[m][0]; c1 = rc[m][1]; s0 = rc[m][2]; s1 = rc[m][3]; if (fq == 0) { s0 = -s0; s1 = -s1; } if (fq >= 2) { c0 = (f32x4){1.f, 1.f, 1.f, 1.f}; c1 = c0; s0 = (f32x4){0.f, 0.f, 0.f, 0.f}; s1 = s0; } }
#pragma unroll
                for (int bj = 0; bj < 2; ++bj) {
                    f32x4 v0 = acc[ai][bj][m][0], v1 = acc[ai][bj][m][1];
                    if (ropew) {
                        f32x4 p0, p1;
#pragma unroll
                        for (int e = 0; e < 4; ++e) { p0[e] = __shfl_xor(v0[e], 16); p1[e] = __shfl_xor(v1[e], 16); }
                        v0 = v0 * c0 + p0 * s0; v1 = v1 * c1 + p1 * s1;
                    }
                    v0 = v0 * scr; v1 = v1 * scr;
                    if (nrmw) { float q = (v0[0] * v0[0] + v0[1] * v0[1]) + (v0[2] * v0[2] + v0[3] * v0[3]) + (v1[0] * v1[0] + v1[1] * v1[1]) + (v1[2] * v1[2] + v1[3] * v1[3]);
                        q += __shfl_xor(q, 16); q += __shfl_xor(q, 32); mxn[bj] = fmaxf(mxn[bj], q); }
                    u32x4 w; w.x = cvt_pk_bf16(v0[0], v0[1]); w.y = cvt_pk_bf16(v0[2], v0[3]); w.z = cvt_pk_bf16(v1[0], v1[1]); w.w = cvt_pk_bf16(v1[2], v1[3]);
                    *(u32x4*)(rowp + bj * HALF) = w;
                }
            }
        }
        if (nrmw) {
#pragma unroll
            for (int bj = 0; bj < 2; ++bj) { float q = mxn[bj];
                q = fmaxf(q, __shfl_xor(q, 1)); q = fmaxf(q, __shfl_xor(q, 2)); q = fmaxf(q, __shfl_xor(q, 4)); q = fmaxf(q, __shfl_xor(q, 8));
                const int rel = 256 * (u.pn & 1) + 128 * bj + 32 * wc, b = (u.pm * BM) >> 12;
                if (fr == 0 && fq == 0) atomicMax((unsigned*)nrm + (typ < 2 ? 256 : 0) + ((b * 2 + ((typ == 1 || typ == 4) ? 1 : 0)) * 8 + (rel >> 6)) * 2 + ((rel >> 5) & 1), __float_as_uint(q * 1.02f)); }
        }
    }
};
template <bool BASE_BF16, bool OUT_BF16> struct EpiRes2 {
    static constexpr bool PERM = true, AFTER_DRAIN = false;
    const void* base; void* out; float* sspart;
    __device__ __forceinline__ void operator()(const f32x4 (&acc)[2][2][4][2], const Unit& u, int wr, int wc, int fr, int fq) const {
        const int row0 = u.pm * BM + wr * 64 + fr, col0 = u.pn * BM + wc * 32 + 8 * fq;
#pragma unroll
        for (int ai = 0; ai < 2; ++ai) {
            u32x4 bw[4][2]; f32x4 bf[4][2][2];
#pragma unroll
            for (int m = 0; m < 4; ++m)
#pragma unroll
                for (int bj = 0; bj < 2; ++bj) { const size_t off = (size_t)(row0 + ai * HALF + m * 16) * 1024 + col0 + bj * HALF;
                    if (BASE_BF16) bw[m][bj] = *(const u32x4*)((const bf16_t*)base + off);
                    else { bf[m][bj][0] = *(const f32x4*)((const float*)base + off); bf[m][bj][1] = *(const f32x4*)((const float*)base + off + 4); } }
#pragma unroll
            for (int m = 0; m < 4; ++m) {
                const int row = row0 + ai * HALF + m * 16; const size_t off = (size_t)row * 1024 + col0;
                float ss = 0.f;
#pragma unroll
                for (int bj = 0; bj < 2; ++bj) {
                    f32x4 b0, b1;
                    if (BASE_BF16) { const u32x4 w = bw[m][bj];
                        b0 = (f32x4){__builtin_bit_cast(float, w.x << 16), __builtin_bit_cast(float, w.x & 0xffff0000u), __builtin_bit_cast(float, w.y << 16), __builtin_bit_cast(float, w.y & 0xffff0000u)};
                        b1 = (f32x4){__builtin_bit_cast(float, w.z << 16), __builtin_bit_cast(float, w.z & 0xffff0000u), __builtin_bit_cast(float, w.w << 16), __builtin_bit_cast(float, w.w & 0xffff0000u)}; }
                    else { b0 = bf[m][bj][0]; b1 = bf[m][bj][1]; }
                    const f32x4 v0 = acc[ai][bj][m][0] + b0, v1 = acc[ai][bj][m][1] + b1;
                    ss += (v0[0] * v0[0] + v0[1] * v0[1]) + (v0[2] * v0[2] + v0[3] * v0[3]) + (v1[0] * v1[0] + v1[1] * v1[1]) + (v1[2] * v1[2] + v1[3] * v1[3]);
                    if (OUT_BF16) { u32x4 w; w.x = cvt_pk_bf16(v0[0], v0[1]); w.y = cvt_pk_bf16(v0[2], v0[3]); w.z = cvt_pk_bf16(v1[0], v1[1]); w.w = cvt_pk_bf16(v1[2], v1[3]);
                        *(u32x4*)((bf16_t*)out + off + bj * HALF) = w; }
                    else { *(f32x4*)((float*)out + off + bj * HALF) = v0; *(f32x4*)((float*)out + off + bj * HALF + 4) = v1; }
                }
                ss += __shfl_xor(ss, 16); ss += __shfl_xor(ss, 32);
                if (fq == 0) sspart[(size_t)row * 16 + u.pn * 4 + wc] = ss;
            }
        }
    }
};
template <int ACT> struct EpiRowScale {
    static constexpr bool PERM = true, AFTER_DRAIN = false;
    bf16_t* O; int ldc; const float* sspart; float eps; float sc;
    const PG8_LAS int* pml; const PG8_LAS float* tab;
    __device__ __forceinline__ void operator()(const f32x4 (&acc)[2][2][4][2], const Unit& u, int wr, int wc, int fr, int fq) const {
        const int row0 = u.pm * BM + wr * 64 + fr, col0 = u.pn * BM + wc * 32 + 8 * fq;
        int slot = -1;
        if (tab) { const int n = pml[8]; for (int j = 0; j < n; ++j) if (pml[j] == u.pm) slot = j; }
#pragma unroll
        for (int ai = 0; ai < 2; ++ai)
#pragma unroll
            for (int m = 0; m < 4; ++m) {
                const int row = row0 + ai * HALF + m * 16; bf16_t* rowp = O + (size_t)row * ldc + col0;
                const float r = (slot >= 0 ? tab[slot * 256 + (row - u.pm * BM)] : row_rstd(sspart, row, eps)) * sc;
#pragma unroll
                for (int bj = 0; bj < 2; ++bj) {
                    f32x4 v0 = acc[ai][bj][m][0] * r, v1 = acc[ai][bj][m][1] * r;
                    if (ACT == 1) {
#pragma unroll
                        for (int e = 0; e < 4; ++e) { const float a = fmaxf(v0[e], 0.f), b = fmaxf(v1[e], 0.f); v0[e] = a * a; v1[e] = b * b; }
                    }
                    u32x4 w; w.x = cvt_pk_bf16(v0[0], v0[1]); w.y = cvt_pk_bf16(v0[2], v0[3]); w.z = cvt_pk_bf16(v1[0], v1[1]); w.w = cvt_pk_bf16(v1[2], v1[3]);
                    *(u32x4*)(rowp + bj * HALF) = w;
                }
            }
    }
};
template <class Epi, class Sched, bool ALIGN_EPI = false, bool SP2 = false>
__device__ __forceinline__ void gemm_phase(PG8_LAS unsigned char* lds, const Gemm g, const Sched& S, const Epi& E, const int wv  ) {
    int tid_ = wv * 64 + mk_lane();
    const int tid = tid_, wid = __builtin_amdgcn_readfirstlane(tid >> 6), lane = tid & 63, wr = wid >> 2, wc = wid & 3, fr = lane & 15, fq = lane >> 4;
    const int K = g.K, nt = K / BK;
    unsigned voffA[2], voffB[2];
#pragma unroll
    for (int i = 0; i < 2; ++i) { int R, C; stage_rc(tid * 16 + i * 8192, R, C); const int Rb = Epi::PERM ? ((R & ~31) + perm32(R & 31)) : R;
        voffA[i] = (unsigned)(R * K + C) * 2u; voffB[i] = (unsigned)(Rb * K + C) * 2u; }
    const size_t kstep = (size_t)(BK * 2);
    const size_t hstep = (size_t)HALF * K * 2;
    const size_t tstep = 2 * hstep;
    const unsigned ldsw = (unsigned)wid * 1024u;
    const int aoff = lds_byte(wr * 64 + fr, fq * 8), boff = lds_byte(wc * 32 + fr, fq * 8);
#define PG8_SA(b, h) (((b) * 2 + (h)) * HTB)
#define PG8_SB(b, h) ((4 + (b) * 2 + (h)) * HTB)
#define PG8_STAGE(bufoff, gbase, voff) do { _Pragma("unroll") for (int _i = 0; _i < 2; ++_i) \
        __builtin_amdgcn_global_load_lds((const unsigned*)((const char*)(gbase) + (voff)[_i]), (PG8_LAS unsigned*)(lds + (bufoff) + ldsw + _i * 8192), 16, 0, 0); } while (0)
#define PG8_LDA(dst, b, h) do { _Pragma("unroll") for (int m = 0; m < 4; ++m) _Pragma("unroll") for (int k = 0; k < 2; ++k) dst[m][k] = *(const PG8_LAS bf16x8*)(lds + PG8_SA(b, h) + aoff + m * 2048 + k * 1024); } while (0)
#define PG8_LDB(dst, b, h) do { _Pragma("unroll") for (int n = 0; n < 2; ++n) _Pragma("unroll") for (int k = 0; k < 2; ++k) dst[n][k] = *(const PG8_LAS bf16x8*)(lds + PG8_SB(b, h) + boff + n * 2048 + k * 1024); } while (0)
#define PG8_MMA(ai, bj, At, Bt) do { __builtin_amdgcn_s_setprio(1); _Pragma("unroll") for (int m = 0; m < 4; ++m) _Pragma("unroll") for (int n = 0; n < 2; ++n) _Pragma("unroll") for (int k = 0; k < 2; ++k) \
        acc[ai][bj][m][n] = __builtin_amdgcn_mfma_f32_16x16x32_bf16(Bt[n][k], At[m][k], acc[ai][bj][m][n], 0, 0, 0); __builtin_amdgcn_s_setprio(0); } while (0)
#define PG8_WAIT_V(n) asm volatile("s_waitcnt vmcnt(" #n ")" ::: "memory")
#define PG8_WAIT_L(n) asm volatile("s_waitcnt lgkmcnt(" #n ")" ::: "memory")
#define PG8_BAR __builtin_amdgcn_s_barrier()
#define PG8_SCHED __builtin_amdgcn_sched_barrier(0)
    Unit cur, nxt; int ui = 0;
    if (!S.next(0, cur)) return;
    f32x4 acc[2][2][4][2];
#pragma unroll
    for (int a = 0; a < 2; ++a)
#pragma unroll
        for (int b = 0; b < 2; ++b)
#pragma unroll
            for (int m = 0; m < 4; ++m)
#pragma unroll
                for (int n = 0; n < 2; ++n) acc[a][b][m][n] = (f32x4){0.f, 0.f, 0.f, 0.f};
    bf16x8 At[4][2], B0[2][2], B1[2][2];
    const char* cA = (const char*)g.A + (size_t)cur.pm * tstep; const char* cB = (const char*)g.Bt + (size_t)cur.pn * tstep;
    S.a_ready(cur);
    if constexpr (SP2) {
        PG8_STAGE(PG8_SB(0, 0), cB, voffB); PG8_STAGE(PG8_SB(0, 1), cB + hstep, voffB); PG8_STAGE(PG8_SA(0, 0), cA, voffA); PG8_STAGE(PG8_SA(0, 1), cA + hstep, voffA);
        if (wr == 1) PG8_BAR;
        PG8_WAIT_V(2); PG8_BAR;
        PG8_STAGE(PG8_SB(1, 0), cB + kstep, voffB); PG8_STAGE(PG8_SA(1, 0), cA + kstep, voffA); PG8_STAGE(PG8_SB(1, 1), cB + hstep + kstep, voffB);
        PG8_WAIT_V(6); PG8_BAR;
    } else {
        PG8_STAGE(PG8_SB(0, 0), cB, voffB); PG8_STAGE(PG8_SA(0, 0), cA, voffA); PG8_STAGE(PG8_SB(0, 1), cB + hstep, voffB); PG8_STAGE(PG8_SA(0, 1), cA + hstep, voffA);
        if (wr == 1) PG8_BAR;
        PG8_WAIT_V(4); PG8_BAR;
        PG8_STAGE(PG8_SB(1, 0), cB + kstep, voffB); PG8_STAGE(PG8_SA(1, 0), cA + kstep, voffA); PG8_STAGE(PG8_SB(1, 1), cB + hstep + kstep, voffB);
        PG8_WAIT_V(6); PG8_BAR;
    }
    for (;;) {
        const bool has_next = S.next(ui + 1, nxt);
        const char* nA = has_next ? (const char*)g.A + (size_t)nxt.pm * tstep : cA; const char* nB = has_next ? (const char*)g.Bt + (size_t)nxt.pn * tstep : cB;
        for (int t = 0; t < nt; t += 2) {
            const bool last = (t == nt - 2);
            const char* a1 = cA + (size_t)(t + 1) * kstep;
            const char* a2 = last ? nA : cA + (size_t)(t + 2) * kstep; const char* b2 = last ? nB : cB + (size_t)(t + 2) * kstep;
            const char* a3 = a2 + kstep; const char* b3 = b2 + kstep;
            if (last && has_next) S.a_ready(nxt);
            if constexpr (SP2) {
            PG8_LDB(B0, 0, 0); PG8_LDB(B1, 0, 1); PG8_SCHED; PG8_LDA(At, 0, 0); PG8_STAGE(PG8_SA(1, 1), a1 + hstep, voffA);
            PG8_WAIT_V(8); PG8_WAIT_L(0); PG8_BAR; PG8_MMA(0, 0, At, B0); PG8_MMA(0, 1, At, B1); PG8_BAR; PG8_SCHED;
            PG8_LDA(At, 0, 1); PG8_STAGE(PG8_SB(0, 0), b2, voffB); PG8_STAGE(PG8_SB(0, 1), b2 + hstep, voffB); PG8_STAGE(PG8_SA(0, 0), a2, voffA);
            PG8_WAIT_V(8); PG8_WAIT_L(0); PG8_BAR; PG8_MMA(1, 0, At, B0); PG8_MMA(1, 1, At, B1); PG8_BAR; PG8_SCHED;
            PG8_LDB(B0, 1, 0); PG8_LDB(B1, 1, 1); PG8_SCHED; PG8_LDA(At, 1, 0); PG8_STAGE(PG8_SA(0, 1), a2 + hstep, voffA);
            PG8_WAIT_V(8); PG8_WAIT_L(0); PG8_BAR; PG8_MMA(0, 0, At, B0); PG8_MMA(0, 1, At, B1); PG8_BAR; PG8_SCHED;
            PG8_LDA(At, 1, 1); PG8_STAGE(PG8_SB(1, 0), b3, voffB); PG8_STAGE(PG8_SB(1, 1), b3 + hstep, voffB); PG8_STAGE(PG8_SA(1, 0), a3, voffA);
            PG8_WAIT_V(8); PG8_WAIT_L(0); PG8_BAR; PG8_MMA(1, 0, At, B0); PG8_MMA(1, 1, At, B1); PG8_BAR; PG8_SCHED;
            } else {
            PG8_LDB(B0, 0, 0); PG8_SCHED; PG8_LDA(At, 0, 0); PG8_STAGE(PG8_SA(1, 1), a1 + hstep, voffA);
            PG8_WAIT_L(8); PG8_BAR; PG8_WAIT_L(0); PG8_MMA(0, 0, At, B0); PG8_BAR; PG8_SCHED;
            PG8_LDB(B1, 0, 1); PG8_STAGE(PG8_SB(0, 0), b2, voffB);
            PG8_BAR; PG8_WAIT_L(0); PG8_MMA(0, 1, At, B1); PG8_BAR;
            PG8_LDA(At, 0, 1); PG8_STAGE(PG8_SA(0, 0), a2, voffA);
            PG8_BAR; PG8_WAIT_L(0); PG8_MMA(1, 0, At, B0); PG8_BAR; PG8_SCHED;
            PG8_STAGE(PG8_SB(0, 1), b2 + hstep, voffB);
            PG8_WAIT_V(6); PG8_BAR; PG8_MMA(1, 1, At, B1); PG8_BAR;
            PG8_LDB(B0, 1, 0); PG8_SCHED; PG8_LDA(At, 1, 0); PG8_STAGE(PG8_SA(0, 1), a2 + hstep, voffA);
            PG8_WAIT_L(8); PG8_BAR; PG8_WAIT_L(0); PG8_MMA(0, 0, At, B0); PG8_BAR; PG8_SCHED;
            PG8_LDB(B1, 1, 1); PG8_STAGE(PG8_SB(1, 0), b3, voffB);
            PG8_BAR; PG8_WAIT_L(0); PG8_MMA(0, 1, At, B1); PG8_BAR;
            PG8_LDA(At, 1, 1); PG8_STAGE(PG8_SA(1, 0), a3, voffA);
            PG8_BAR; PG8_WAIT_L(0); PG8_MMA(1, 0, At, B0); PG8_BAR; PG8_SCHED;
            PG8_STAGE(PG8_SB(1, 1), b3 + hstep, voffB);
            PG8_WAIT_V(6); PG8_BAR; PG8_MMA(1, 1, At, B1); PG8_BAR;
            }
        }
        if constexpr (ALIGN_EPI) { if (wr == 0) PG8_BAR; }
        if constexpr (!Epi::AFTER_DRAIN) { E(acc, cur, wr, wc, fr, fq); S.done(cur); }
        if (!has_next) break;
#pragma unroll
        for (int a = 0; a < 2; ++a)
#pragma unroll
            for (int b = 0; b < 2; ++b)
#pragma unroll
                for (int m = 0; m < 4; ++m)
#pragma unroll
                    for (int n = 0; n < 2; ++n) acc[a][b][m][n] = (f32x4){0.f, 0.f, 0.f, 0.f};
        cur = nxt; cA = nA; cB = nB; ++ui;
        if constexpr (ALIGN_EPI) { if (wr == 1) PG8_BAR; }
    }
    PG8_WAIT_V(0);
    if constexpr (!ALIGN_EPI) { if (wr == 0) PG8_BAR; }
    PG8_BAR;
    if constexpr (Epi::AFTER_DRAIN) { E.fused(acc, cur, wr, wc, fr, fq, lds, wid, lane); S.done(cur); }
#undef PG8_SA
#undef PG8_SB
#undef PG8_STAGE
#undef PG8_LDA
#undef PG8_LDB
#undef PG8_MMA
#undef PG8_WAIT_V
#undef PG8_WAIT_L
#undef PG8_BAR
#undef PG8_SCHED
}
}

#ifndef PG8_SP2
#define PG8_SP2 true
#endif
#ifndef PG8_ALIGN
#define PG8_ALIGN true
#endif
namespace attn_body {
using bf16=__hip_bfloat16;
using bf16x8=__attribute__((ext_vector_type(8)))short;
using s16x4=__attribute__((ext_vector_type(4)))short;
using f32x16=__attribute__((ext_vector_type(16)))float;
using u32x4=__attribute__((ext_vector_type(4)))unsigned; using f32x4=__attribute__((ext_vector_type(4)))float;
constexpr int SEQ=4096,D=64,PQ=3072,PO=1536;
constexpr int NW=8,QBLK=32,QB=QBLK*NW,KVBLK=64,NQB=SEQ/QB;
constexpr int ATTN_UNIT_ROWS=QB;
__device__ __forceinline__ int crow(int r,int hi){return (r&3)+8*(r>>2)+4*hi;}
#define SBAR() __builtin_amdgcn_sched_barrier(0)
__device__ __forceinline__ void cmask(f32x16&p0,f32x16&p1,int jb,int qrel,int hi){
  const float NEG=-INFINITY; int kb=64*jb+4*hi;
  #pragma unroll
  for(int r=0;r<16;++r){int kv=kb+(r&3)+8*(r>>2); if(kv>qrel)p0[r]=NEG; if(kv+32>qrel)p1[r]=NEG;}
}

template<bool B> __device__ __forceinline__ const f32x16& csel(const f32x16&a,const f32x16&b){ if constexpr(B) return a; else return b; }
constexpr int NSLOT=3, SLOTB=8192;
constexpr int LDS_K=0, LDS_V=NSLOT*SLOTB, LDS_WS=2*NSLOT*SLOTB, LDS_OST=LDS_WS+NW*64*4, LDS_KBIAS=LDS_OST+NW*4096, LDS_BYTES=LDS_KBIAS+SEQ*4;
constexpr float C2=0.125f*1.4426950408889634f;
__device__ __forceinline__ void glds16(const void*gsrc,unsigned lds_dst){unsigned keep;
  asm volatile("s_mov_b32 %0, m0\n\ts_mov_b32 m0, %2\n\ts_nop 0\n\tglobal_load_lds_dwordx4 %1, off\n\ts_mov_b32 m0, %0":"=&s"(keep):"v"(gsrc),"s"(lds_dst):"memory");}
__device__ __forceinline__ float max3f(float a,float b,float c){float r;asm("v_max3_f32 %0, %1, %2, %3":"=v"(r):"v"(a),"v"(b),"v"(c));return r;}
__device__ __forceinline__ float max2f(float a,float b){float r;asm("v_max_f32_e32 %0, %1, %2":"=v"(r):"v"(a),"v"(b));return r;}
__device__ __forceinline__ float fadd_s(float a,float b){float r;asm("v_add_f32_e32 %0, %1, %2":"=v"(r):"v"(a),"v"(b));return r;}
__device__ __forceinline__ float fsub_s(float a,float b){float r;asm("v_sub_f32_e32 %0, %1, %2":"=v"(r):"v"(a),"v"(b));return r;}
typedef float f32x2_t __attribute__((ext_vector_type(2))); typedef __bf16 bf16x2_t __attribute__((ext_vector_type(2)));
__device__ __forceinline__ unsigned cvtpk_s(float lo,float hi){f32x2_t v={lo,hi};bf16x2_t b=__builtin_convertvector(v,bf16x2_t);return __builtin_bit_cast(unsigned,b);}
#define WAIT_BAR(N) asm volatile("s_waitcnt vmcnt(" #N ") lgkmcnt(0)\n\ts_barrier":::"memory")

__device__ __forceinline__ void qkt(f32x16&p0,f32x16&p1,const char*Kslot,const bf16x8*qr,const f32x16&ci0,const f32x16&ci1,int r32,int hi){
  const char*kb=Kslot+hi*1024+r32*16;
  #pragma unroll
  for(int d0=0;d0<4;++d0){
    const bf16x8 b0=*reinterpret_cast<const bf16x8*>(kb+d0*2048);
    const bf16x8 b1=*reinterpret_cast<const bf16x8*>(kb+d0*2048+512);
    if(d0==0){p0=__builtin_amdgcn_mfma_f32_32x32x16_bf16(b0,qr[0],ci0,0,0,0);p1=__builtin_amdgcn_mfma_f32_32x32x16_bf16(b1,qr[0],ci1,0,0,0);}
    else{p0=__builtin_amdgcn_mfma_f32_32x32x16_bf16(b0,qr[d0],p0,0,0,0);p1=__builtin_amdgcn_mfma_f32_32x32x16_bf16(b1,qr[d0],p1,0,0,0);}}
}
typedef __attribute__((address_space(3))) const char* lds_cptr;
typedef short v4i16_t __attribute__((ext_vector_type(4)));
__device__ __forceinline__ void kload8(bf16x8*kf,lds_cptr kp){
  kf[0]=*(const __attribute__((address_space(3))) bf16x8*)(kp);      kf[1]=*(const __attribute__((address_space(3))) bf16x8*)(kp+512);
  kf[2]=*(const __attribute__((address_space(3))) bf16x8*)(kp+2048); kf[3]=*(const __attribute__((address_space(3))) bf16x8*)(kp+2560);
  kf[4]=*(const __attribute__((address_space(3))) bf16x8*)(kp+4096); kf[5]=*(const __attribute__((address_space(3))) bf16x8*)(kp+4608);
  kf[6]=*(const __attribute__((address_space(3))) bf16x8*)(kp+6144); kf[7]=*(const __attribute__((address_space(3))) bf16x8*)(kp+6656);
}
__device__ __forceinline__ void kload2(bf16x8*kf,lds_cptr kp,int j){ kf[2*j]=*(const __attribute__((address_space(3))) bf16x8*)(kp+j*2048); kf[2*j+1]=*(const __attribute__((address_space(3))) bf16x8*)(kp+j*2048+512); }
__device__ __forceinline__ s16x4 vtr(lds_cptr p){ return __builtin_bit_cast(s16x4,__builtin_amdgcn_ds_read_tr16_b64_v4i16((__attribute__((address_space(3))) v4i16_t*)p)); }
__device__ __forceinline__ float rowmax(const f32x16&p0,const f32x16&p1){
  float a=max3f(p0[0],p0[1],p1[0]),b=max3f(p0[2],p0[3],p1[1]);a=max3f(a,p1[2],p1[3]);
  #pragma unroll
  for(int r=4;r<16;r+=4){a=max3f(a,p0[r],p0[r+1]);b=max3f(b,p0[r+2],p0[r+3]);a=max3f(a,p1[r],p1[r+1]);b=max3f(b,p1[r+2],p1[r+3]);}
  const float m=max2f(a,b);
  auto rr=__builtin_amdgcn_permlane32_swap(__float_as_uint(m),__float_as_uint(m),false,false);
  return max2f(__uint_as_float(rr[0]),__uint_as_float(rr[1]));
}
__device__ __forceinline__ void pv(f32x16*o,int vb,bf16x8 pa0,bf16x8 pa1,bf16x8 pa2,bf16x8 pa3){
  #pragma unroll
  for(int d0=0;d0<2;++d0){s16x4 lo[4],hi[4];
    #pragma unroll
    for(int ks=0;ks<4;++ks){
      asm volatile("ds_read_b64_tr_b16 %0,%1 offset:%c2":"=&v"(lo[ks]):"v"(vb),"i"(d0*4096+ks*1024):"memory");
      asm volatile("ds_read_b64_tr_b16 %0,%1 offset:%c2":"=&v"(hi[ks]):"v"(vb),"i"(d0*4096+ks*1024+512):"memory");}
    asm volatile("s_waitcnt lgkmcnt(0)":::"memory");SBAR();
    #define PK(k) (bf16x8){lo[k][0],lo[k][1],lo[k][2],lo[k][3],hi[k][0],hi[k][1],hi[k][2],hi[k][3]}
    o[d0]=__builtin_amdgcn_mfma_f32_32x32x16_bf16(pa0,PK(0),o[d0],0,0,0);
    o[d0]=__builtin_amdgcn_mfma_f32_32x32x16_bf16(pa1,PK(1),o[d0],0,0,0);
    o[d0]=__builtin_amdgcn_mfma_f32_32x32x16_bf16(pa2,PK(2),o[d0],0,0,0);
    o[d0]=__builtin_amdgcn_mfma_f32_32x32x16_bf16(pa3,PK(3),o[d0],0,0,0);
    #undef PK
  }
}

#ifndef ATTN_STORE16
#define ATTN_STORE16(p,v) (*(u32x4*)(p)=(v))
#endif
template<int THRL,bool HASB> __device__ __forceinline__ void attn_unit(int b,int qb,const bf16*Qc,const bf16*__restrict__ Kc,const bf16*__restrict__ Vc,bf16*Oc,const float*__restrict__ kbg,int t0,char*shm,const int wv){
  int tid_=wv*64+mk_lane();
  const int tid=tid_,lane=tid&63,r32=lane&31,hi=lane>>5; const int wid=__builtin_amdgcn_readfirstlane(tid>>6);
  const long rowbase=(long)b*SEQ; const int q0=qb*QB;
  const bf16*Qw=Qc+(rowbase+q0+wid*QBLK)*PQ;
  const bf16*Kh=Kc+(rowbase+(long)t0*KVBLK)*PQ,*Vh=Vc+(rowbase+(long)t0*KVBLK)*PQ;
  const unsigned lds0=(unsigned)(uintptr_t)shm;
  float*wsf=(float*)(shm+LDS_WS)+wid*64;
  const bf16*ksrc=Kh+(long)lane*PQ+wid*8;
  const bf16*vsrc=Vh+(long)(16*(wid&3)+(lane>>2))*PQ+(wid>>2)*32+(lane&3)*8;
  const unsigned kdst=lds0+LDS_K+wid*1024, vdst=lds0+LDS_V+wid*1024;
  #define DMA_K(t,slot) glds16(ksrc+(long)(t)*KVBLK*PQ,(unsigned)__builtin_amdgcn_readfirstlane(kdst+(slot)))
  #define DMA_V(t,slot) glds16(vsrc+(long)(t)*KVBLK*PQ,(unsigned)__builtin_amdgcn_readfirstlane(vdst+(slot)))
  const int vb0=(int)(lds0+LDS_V)+((lane>>4)&1)*32+(lane&3)*8+(4*hi+((lane&15)>>2))*64;
  const char*Kbase=shm+LDS_K; bf16x8 kf[8];
  const lds_cptr shm3=(lds_cptr)shm; const lds_cptr kp0=shm3+LDS_K+hi*1024+r32*16; const lds_cptr vp0=shm3+LDS_V+((lane>>4)&1)*32+(lane&3)*8+(4*hi+((lane&15)>>2))*64;
  const int NT=(q0+QB)/KVBLK-t0;
  typedef __attribute__((address_space(3))) const f32x4 lds_cf4; typedef __attribute__((address_space(3))) f32x4 lds_f4;
  const __attribute__((address_space(3))) char* kbl=(const __attribute__((address_space(3))) char*)shm+LDS_KBIAS+hi*16;
  DMA_K(0,0);DMA_V(0,0);DMA_K(1,SLOTB);
  bf16x8 qr[4];
  #pragma unroll
  for(int d0=0;d0<4;++d0)qr[d0]=*reinterpret_cast<const bf16x8*>(&Qw[(long)r32*PQ+d0*16+hi*8]);
  float mhat=0.f,l_reg=0.f;f32x16 o[2];o[0]=f32x16{};o[1]=f32x16{};f32x16 negm=f32x16{};asm volatile("":"+v"(negm));
  const int qrel=wid*QBLK+r32;
  float mref=0.f;
  #define CINIT(C0,C1,t) do{ if(HASB){ const __attribute__((address_space(3))) char* kp_=kbl+(t)*256; \
      _Pragma("unroll") for(int g_=0;g_<4;++g_){ const f32x4 a_=*(lds_cf4*)(kp_+g_*32), b_=*(lds_cf4*)(kp_+128+g_*32); \
        _Pragma("unroll") for(int e_=0;e_<4;++e_){ C0[4*g_+e_]=a_[e_]-mhat; C1[4*g_+e_]=b_[e_]-mhat; } } } \
    }while(0)
  #define CMASK(P0,P1,t) do{int jb_=(t)-(NT-4); if(jb_>=0)cmask(P0,P1,jb_,qrel,hi);}while(0)
  bool resc=false;
  #define START(P0,P1) do{ const float rm=rowmax(P0,P1); resc=false; \
    { const float dl=HASB?__builtin_fmaxf(rm,0.f):rm; mhat=fadd_s(mhat,dl); \
      _Pragma("unroll") for(int r=0;r<16;++r){P0[r]=fsub_s(P0[r],dl);P1[r]=fsub_s(P1[r],dl);} \
      if(!HASB){ _Pragma("unroll") for(int r=0;r<16;++r)negm[r]=-mhat; asm volatile("":"+v"(negm)); } } \
    _Pragma("unroll") for(int r=0;r<16;++r)P0[r]=__builtin_amdgcn_exp2f(P0[r]); }while(0)
  #define RESC() do{ if(resc){ asm volatile("s_waitcnt lgkmcnt(0)":::"memory"); \
      _Pragma("unroll") for(int d_=0;d_<2;++d_) _Pragma("unroll") for(int r=0;r<16;++r)o[d_][r]*=wsf[crow(r,hi)]; } }while(0)
  f32x16 pA0,pA1,pB0,pB1;
  int sl_prev=0,sl_cur=0,sl_next=SLOTB;
  #define ROT() do{sl_prev=sl_cur;sl_cur=sl_next;sl_next=(sl_next==(NSLOT-1)*SLOTB)?0:sl_next+SLOTB;}while(0)
  DMA_K(2,2*SLOTB);
  if(HASB){ const int n4=(q0+QB-t0*KVBLK)/4; for(int i=tid;i<n4;i+=NW*64){ const f32x4 v=*(const f32x4*)(kbg+t0*KVBLK+4*i); *((lds_f4*)((__attribute__((address_space(3))) char*)shm+LDS_KBIAS)+i)=v; } }
  WAIT_BAR(3);
  if(HASB){ mref=*(const __attribute__((address_space(3))) float*)((const __attribute__((address_space(3))) char*)shm+LDS_KBIAS+(q0-t0*KVBLK+qrel)*4); mhat=mref; }
  { f32x16 ci0=f32x16{},ci1=f32x16{}; CINIT(ci0,ci1,0); qkt(pA0,pA1,Kbase,qr,csel<HASB>(ci0,negm),csel<HASB>(ci1,negm),r32,hi); } asm volatile("s_nop 15\n\ts_nop 7":"+v"(pA0),"+v"(pA1));CMASK(pA0,pA1,0);
  START(pA0,pA1);
  _Pragma("unroll") for(int r=0;r<16;++r)pA1[r]=__builtin_amdgcn_exp2f(pA1[r]);
  WAIT_BAR(0);
  DMA_K(3,0);DMA_V(1,SLOTB);
  ROT();
  kload8(kf,kp0+sl_cur);
  WAIT_BAR(2);
  s16x4 vlo[8],vhi[8]; u32x4 pw0,pw1,pw2,pw3;
  #define PKW(P,B) cvtpk_s(P[B],P[B+1])
  #define PAF(k) __builtin_bit_cast(bf16x8,pw##k)
  #define VFR(i) (bf16x8){vlo[i][0],vlo[i][1],vlo[i][2],vlo[i][3],vhi[i][0],vhi[i][1],vhi[i][2],vhi[i][3]}
  #define PIN(x) asm volatile("":"+v"(x))
  #define MX3(a,b,c) __builtin_fmaxf(__builtin_fmaxf((a),(b)),(c))
  #define GAPA(MF,A0,A1,A2,A3,W0,W1,PW) do{ MF; sacc+=A0; sacc+=A1; sacc+=A2; sacc+=A3; PIN(sacc); W0; W1; PIN(PW); SBAR(); }while(0)
  #define EX(v) __builtin_amdgcn_exp2f(v)
  #define GAPB(MF,X,B,Y) do{ MF; X[B]=EX(X[B]); X[B+1]=EX(X[B+1]); X[B+2]=EX(X[B+2]); X[B+3]=EX(X[B+3]); PIN(X); if(HASB){ Y[B]-=mhat; Y[B+1]-=mhat; Y[B+2]-=mhat; Y[B+3]-=mhat; PIN(Y); } SBAR(); }while(0)
  #define LOADB(Y0,Y1,t) do{ if(HASB){ const __attribute__((address_space(3))) char* kp_=kbl+(t)*256; \
      _Pragma("unroll") for(int g_=0;g_<4;++g_){ const f32x4 a_=*(lds_cf4*)(kp_+g_*32), b_=*(lds_cf4*)(kp_+128+g_*32); \
        _Pragma("unroll") for(int e_=0;e_<4;++e_){ Y0[4*g_+e_]=a_[e_]; Y1[4*g_+e_]=b_[e_]; } } } }while(0)
  #define VRD(i) do{ vlo[i]=vtr(vp_+(((i)>>2)*4096+((i)&3)*1024)); vhi[i]=vtr(vp_+(((i)>>2)*4096+((i)&3)*1024+512)); }while(0)
  #define KRD(G,j) do{ if(G){ kload2(kf,kp0+sl_next,j); SBAR(); } }while(0)
  #define STEP(C0,C1,P0,P1,t,GK,GV,GL) do{ SBAR(); \
    const lds_cptr vp_=vp0+sl_prev; \
    VRD(0); SBAR(); float sacc=(P0[0]+P0[1]); \
    GAPA(C0=__builtin_amdgcn_mfma_f32_32x32x16_bf16(kf[0],qr[0],csel<HASB>(C0,negm),0,0,0), P0[2],P0[3],P0[4],P0[5],     pw0[0]=PKW(P0,0), pw0[1]=PKW(P0,2), pw0); \
    VRD(4); SBAR(); GAPA(C1=__builtin_amdgcn_mfma_f32_32x32x16_bf16(kf[1],qr[0],csel<HASB>(C1,negm),0,0,0), P0[6],P0[7],P0[8],P0[9],     pw0[2]=PKW(P0,4), pw0[3]=PKW(P0,6), pw0); \
    VRD(1); SBAR(); GAPA(C0=__builtin_amdgcn_mfma_f32_32x32x16_bf16(kf[2],qr[1],C0,0,0,0),   P0[10],P0[11],P0[12],P0[13], pw1[0]=PKW(P0,8), pw1[1]=PKW(P0,10), pw1); \
    VRD(5); SBAR(); GAPA(C1=__builtin_amdgcn_mfma_f32_32x32x16_bf16(kf[3],qr[1],C1,0,0,0),   P0[14],P0[15],P1[0],P1[1],   pw1[2]=PKW(P0,12),pw1[3]=PKW(P0,14), pw1); \
    VRD(2); SBAR(); GAPA(C0=__builtin_amdgcn_mfma_f32_32x32x16_bf16(kf[4],qr[2],C0,0,0,0),   P1[2],P1[3],P1[4],P1[5],     pw2[0]=PKW(P1,0), pw2[1]=PKW(P1,2), pw2); \
    VRD(6); SBAR(); GAPA(C1=__builtin_amdgcn_mfma_f32_32x32x16_bf16(kf[5],qr[2],C1,0,0,0),   P1[6],P1[7],P1[8],P1[9],     pw2[2]=PKW(P1,4), pw2[3]=PKW(P1,6), pw2); \
    VRD(3); SBAR(); GAPA(C0=__builtin_amdgcn_mfma_f32_32x32x16_bf16(kf[6],qr[3],C0,0,0,0),   P1[10],P1[11],P1[12],P1[13], pw3[0]=PKW(P1,8), pw3[1]=PKW(P1,10), pw3); \
    VRD(7); SBAR(); GAPA(C1=__builtin_amdgcn_mfma_f32_32x32x16_bf16(kf[7],qr[3],C1,0,0,0),   P1[14],P1[15],0.f,0.f,       pw3[2]=PKW(P1,12),pw3[3]=PKW(P1,14), pw3); \
    l_reg+=sacc; \
    LOADB(P0,P1,(t)+1); \
    if(GK){DMA_K((t)+3,sl_cur);} if(GV){DMA_V((t)+1,sl_next);} \
    CMASK(C0,C1,t); \
    { float a=MX3(C0[0],C0[1],C1[0]),b=MX3(C0[2],C0[3],C1[1]); a=MX3(a,C1[2],C1[3]); \
      _Pragma("unroll") for(int r=4;r<16;r+=4){a=MX3(a,C0[r],C0[r+1]);b=MX3(b,C0[r+2],C0[r+3]);a=MX3(a,C1[r],C1[r+1]);b=MX3(b,C1[r+2],C1[r+3]);} \
      float rm=__builtin_fmaxf(a,b); { auto rr=__builtin_amdgcn_permlane32_swap(__float_as_uint(rm),__float_as_uint(rm),false,false); rm=__builtin_fmaxf(__uint_as_float(rr[0]),__uint_as_float(rr[1])); } \
      resc=false; \
      if(__builtin_expect(__any(rm>(float)THRL),0)){ const float dl=__builtin_fmaxf(rm,0.f); mhat+=dl; \
        _Pragma("unroll") for(int r=0;r<16;++r){C0[r]-=dl;C1[r]-=dl;} \
        if(!HASB){ _Pragma("unroll") for(int r=0;r<16;++r)negm[r]=-mhat; asm volatile("":"+v"(negm)); } \
        const float f=__builtin_amdgcn_exp2f(-dl); l_reg*=f; if(hi==0)wsf[r32]=f; resc=true; } } \
    SBAR(); \
    GAPB(o[0]=__builtin_amdgcn_mfma_f32_32x32x16_bf16(PAF(0),VFR(0),o[0],0,0,0), C0,0,P0); \
    GAPB(o[1]=__builtin_amdgcn_mfma_f32_32x32x16_bf16(PAF(0),VFR(4),o[1],0,0,0), C0,4,P0); \
    KRD(GL,0); GAPB(o[0]=__builtin_amdgcn_mfma_f32_32x32x16_bf16(PAF(1),VFR(1),o[0],0,0,0), C0,8,P0); \
    KRD(GL,1); GAPB(o[1]=__builtin_amdgcn_mfma_f32_32x32x16_bf16(PAF(1),VFR(5),o[1],0,0,0), C0,12,P0); \
    KRD(GL,2); GAPB(o[0]=__builtin_amdgcn_mfma_f32_32x32x16_bf16(PAF(2),VFR(2),o[0],0,0,0), C1,0,P1); \
    KRD(GL,3); GAPB(o[1]=__builtin_amdgcn_mfma_f32_32x32x16_bf16(PAF(2),VFR(6),o[1],0,0,0), C1,4,P1); \
    GAPB(o[0]=__builtin_amdgcn_mfma_f32_32x32x16_bf16(PAF(3),VFR(3),o[0],0,0,0), C1,8,P1); \
    GAPB(o[1]=__builtin_amdgcn_mfma_f32_32x32x16_bf16(PAF(3),VFR(7),o[1],0,0,0), C1,12,P1); \
    }while(0)
  CINIT(pB0,pB1,1);
  int t=1;
  #undef CMASK
  #define CMASK(P0,P1,t) do{}while(0)
  for(;t+5<NT;t+=2){
    STEP(pB0,pB1,pA0,pA1,t,true,true,true);     WAIT_BAR(2); RESC(); ROT();
    STEP(pA0,pA1,pB0,pB1,t+1,true,true,true);   WAIT_BAR(2); RESC(); ROT();
  }
  #undef CMASK
  #define CMASK(P0,P1,t) do{int jb_=(t)-(NT-4); if(jb_>=0)cmask(P0,P1,jb_,qrel,hi);}while(0)
  #define ENDW(tt) do{ if((tt)+3<NT){WAIT_BAR(2);} else if((tt)+2<NT){WAIT_BAR(1);} else {WAIT_BAR(0);} }while(0)
  for(;t+1<NT;t+=2){
    STEP(pB0,pB1,pA0,pA1,t,(t+3<NT),(t+1<NT),(t+1<NT));       ENDW(t);   RESC(); ROT();
    STEP(pA0,pA1,pB0,pB1,t+1,(t+4<NT),(t+2<NT),(t+2<NT));     ENDW(t+1); RESC(); ROT();
  }
  STEP(pB0,pB1,pA0,pA1,NT-1,false,false,false); RESC();
  { float sacc=pB0[0]+pB0[1]; _Pragma("unroll") for(int r=2;r<16;++r)sacc+=pB0[r]; _Pragma("unroll") for(int r=0;r<16;++r)sacc+=pB1[r]; l_reg+=sacc;
    pw0=(u32x4){PKW(pB0,0),PKW(pB0,2),PKW(pB0,4),PKW(pB0,6)};pw1=(u32x4){PKW(pB0,8),PKW(pB0,10),PKW(pB0,12),PKW(pB0,14)};pw2=(u32x4){PKW(pB1,0),PKW(pB1,2),PKW(pB1,4),PKW(pB1,6)};pw3=(u32x4){PKW(pB1,8),PKW(pB1,10),PKW(pB1,12),PKW(pB1,14)};
    SBAR(); pv(o,vb0+sl_cur,PAF(0),PAF(1),PAF(2),PAF(3)); }
  #undef PKW
  #undef PAF
  #undef VFR
  #undef PIN
  #undef MX3
  #undef GAPA
  #undef GAPB
  #undef LOADB
  #undef EX
  #undef VRD
  #undef KRD
  #undef STEP
  #undef ENDW
  {auto rr=__builtin_amdgcn_permlane32_swap(__float_as_uint(l_reg),__float_as_uint(l_reg),false,false);l_reg=__uint_as_float(rr[0])+__uint_as_float(rr[1]);}
  if(hi==0)wsf[32+r32]=l_reg;asm volatile("s_waitcnt lgkmcnt(0)":::"memory");
  float rli[16];
  #pragma unroll
  for(int r=0;r<16;++r)rli[r]=__builtin_amdgcn_rcpf(wsf[32+crow(r,hi)]);
  bf16*Ow=Oc+(rowbase+q0+wid*QBLK)*PO;
  { bf16*stg=(bf16*)(shm+LDS_OST)+wid*2048;
    #pragma unroll
    for(int r=0;r<16;++r){const int orow=crow(r,hi);
      #pragma unroll
      for(int d0=0;d0<2;++d0)stg[orow*64+d0*32+r32]=__float2bfloat16(o[d0][r]*rli[r]);}
    asm volatile("s_waitcnt lgkmcnt(0)":::"memory");
    #pragma unroll
    for(int i=0;i<4;++i){const int row=i*8+(lane>>3),ch=lane&7; const u32x4 v=*(const u32x4*)(stg+row*64+ch*8); ATTN_STORE16(Ow+(long)row*PO+ch*8,v);} }
  asm volatile("s_waitcnt lgkmcnt(0)\n\ts_barrier":::"memory");
  #undef CINIT
  #undef DMA_K
  #undef DMA_V
  #undef CMASK
  #undef START
  #undef RESC
  #undef ROT
}
constexpr int LDS_WS128=LDS_V+NSLOT*2*SLOTB, LDS_OST128=LDS_WS128+NW*64*4, LDS_BYTES128=LDS_OST128+NW*4096;
template<int THRL,bool NODEC> __device__ __forceinline__ void attn_unit128(int b,int qb,const bf16*Qc,const bf16*__restrict__ Kc,const bf16*__restrict__ Vc,bf16*Oc,char*shm,const int wv){ constexpr bool HASB=false; constexpr int t0=0; const float* kbg=nullptr;
  int tid_=wv*64+mk_lane();
  const int tid=tid_,lane=tid&63,r32=lane&31,hi=lane>>5; const int wid=__builtin_amdgcn_readfirstlane(tid>>6);
  const long rowbase=(long)b*SEQ; const int q0=qb*QB;
  const bf16*Qw=Qc+(rowbase+q0+wid*QBLK)*PQ;
  const bf16*Kh=Kc+(rowbase+(long)t0*KVBLK)*PQ,*Vh=Vc+(rowbase+(long)t0*KVBLK)*PQ;
  const unsigned lds0=(unsigned)(uintptr_t)shm;
  float*wsf=(float*)(shm+LDS_WS128)+wid*64;
  const bf16*ksrc=Kh+(long)lane*PQ+wid*8;
  const bf16*vsrc=Vh+(long)(16*(wid&3)+(lane>>2))*PQ+(wid>>2)*32+(lane&3)*8;
  const unsigned kdst=lds0+LDS_K+wid*1024, vdst=lds0+LDS_V+(wid>>2)*4096+(wid&3)*1024;
  #define DMA_K(t,slot) glds16(ksrc+(long)(t)*KVBLK*PQ,(unsigned)__builtin_amdgcn_readfirstlane(kdst+(slot)))
  #define DMA_V(t,slot) do{ glds16(vsrc+(long)(t)*KVBLK*PQ,(unsigned)__builtin_amdgcn_readfirstlane(vdst+2*(slot))); glds16(vsrc+64+(long)(t)*KVBLK*PQ,(unsigned)__builtin_amdgcn_readfirstlane(vdst+8192+2*(slot))); }while(0)
  const int vb0=(int)(lds0+LDS_V)+((lane>>4)&1)*32+(lane&3)*8+(4*hi+((lane&15)>>2))*64;
  const char*Kbase=shm+LDS_K; bf16x8 kf[8];
  const lds_cptr shm3=(lds_cptr)shm; const lds_cptr kp0=shm3+LDS_K+hi*1024+r32*16; const lds_cptr vp0=shm3+LDS_V+((lane>>4)&1)*32+(lane&3)*8+(4*hi+((lane&15)>>2))*64;
  const int NT=(q0+QB)/KVBLK-t0;
  typedef __attribute__((address_space(3))) const f32x4 lds_cf4; typedef __attribute__((address_space(3))) f32x4 lds_f4;
  const __attribute__((address_space(3))) char* kbl=(const __attribute__((address_space(3))) char*)shm+LDS_KBIAS+hi*16;
  if(HASB){ const int n4=(q0+QB-t0*KVBLK)/4; for(int i=tid;i<n4;i+=NW*64){ const f32x4 v=*(const f32x4*)(kbg+t0*KVBLK+4*i); *((lds_f4*)((__attribute__((address_space(3))) char*)shm+LDS_KBIAS)+i)=v; } }
  DMA_K(0,0);DMA_V(0,0);DMA_K(1,SLOTB);
  bf16x8 qr[4];
  #pragma unroll
  for(int d0=0;d0<4;++d0)qr[d0]=*reinterpret_cast<const bf16x8*>(&Qw[(long)r32*PQ+d0*16+hi*8]);
  float mhat=0.f,l_reg=0.f;f32x16 o[4];o[0]=f32x16{};o[1]=f32x16{};o[2]=f32x16{};o[3]=f32x16{};
  const int qrel=wid*QBLK+r32;
  float mref=0.f;
  #define CINIT(C0,C1,t) do{ if(HASB){ const __attribute__((address_space(3))) char* kp_=kbl+(t)*256; \
      _Pragma("unroll") for(int g_=0;g_<4;++g_){ const f32x4 a_=*(lds_cf4*)(kp_+g_*32), b_=*(lds_cf4*)(kp_+128+g_*32); \
        _Pragma("unroll") for(int e_=0;e_<4;++e_){ C0[4*g_+e_]=a_[e_]-mhat; C1[4*g_+e_]=b_[e_]-mhat; } } } \
    }while(0)
  #define CMASK(P0,P1,t) do{int jb_=(t)-(NT-4); if(jb_>=0)cmask(P0,P1,jb_,qrel,hi);}while(0)
  bool resc=false;
  #define START(P0,P1) do{ resc=false; \
    if(!NODEC){ const float rm=rowmax(P0,P1); const float dl=__any(rm>(float)THRL)?__builtin_fmaxf(rm,0.f):0.f; mhat=fadd_s(mhat,dl); \
      _Pragma("unroll") for(int r=0;r<16;++r){P0[r]=fsub_s(P0[r],dl);P1[r]=fsub_s(P1[r],dl);} \
      } \
    _Pragma("unroll") for(int r=0;r<16;++r)P0[r]=__builtin_amdgcn_exp2f(P0[r]); }while(0)
  #define RESC() do{ if(resc){ asm volatile("s_waitcnt lgkmcnt(0)":::"memory"); \
      _Pragma("unroll") for(int d_=0;d_<4;++d_) _Pragma("unroll") for(int r=0;r<16;++r)o[d_][r]*=wsf[crow(r,hi)]; } }while(0)
  f32x16 pA0,pA1,pB0,pB1;
  int sl_prev=0,sl_cur=0,sl_next=SLOTB;
  #define ROT() do{sl_prev=sl_cur;sl_cur=sl_next;sl_next=(sl_next==(NSLOT-1)*SLOTB)?0:sl_next+SLOTB;}while(0)
  DMA_K(2,2*SLOTB);
  WAIT_BAR(4);
  { f32x16 ci0=f32x16{}; asm volatile("":"+v"(ci0)); qkt(pA0,pA1,Kbase,qr,ci0,ci0,r32,hi); } asm volatile("s_nop 15\n\ts_nop 7":"+v"(pA0),"+v"(pA1));CMASK(pA0,pA1,0);
  START(pA0,pA1);
  _Pragma("unroll") for(int r=0;r<16;++r)pA1[r]=__builtin_amdgcn_exp2f(pA1[r]);
  WAIT_BAR(0);
  DMA_K(3,0);DMA_V(1,SLOTB);
  ROT();
  kload8(kf,kp0+sl_cur);
  WAIT_BAR(3);
  s16x4 vlo[4],vhi[4]; u32x4 pw0,pw1,pw2,pw3;
  #define PKW(P,B) cvtpk_s(P[B],P[B+1])
  #define PAF(k) __builtin_bit_cast(bf16x8,pw##k)
  #define VFR(i) (bf16x8){vlo[(i)&3][0],vlo[(i)&3][1],vlo[(i)&3][2],vlo[(i)&3][3],vhi[(i)&3][0],vhi[(i)&3][1],vhi[(i)&3][2],vhi[(i)&3][3]}
  #define PIN(x) asm volatile("":"+v"(x))
  #define MX3(a,b,c) __builtin_fmaxf(__builtin_fmaxf((a),(b)),(c))
  #define GAPA(MF,A0,A1,A2,A3,W0,W1,PW) do{ MF; sacc+=A0; sacc+=A1; sacc+=A2; sacc+=A3; PIN(sacc); W0; W1; PIN(PW); SBAR(); }while(0)
  #define EX(v) __builtin_amdgcn_exp2f(v)
  #define GAPB(MF,X,B,Y) do{ MF; X[B]=EX(X[B]); X[B+1]=EX(X[B+1]); X[B+2]=EX(X[B+2]); X[B+3]=EX(X[B+3]); PIN(X); if(HASB){ Y[B]-=mhat; Y[B+1]-=mhat; Y[B+2]-=mhat; Y[B+3]-=mhat; PIN(Y); } SBAR(); }while(0)
  #define LOADB(Y0,Y1,t) do{ if(HASB){ const __attribute__((address_space(3))) char* kp_=kbl+(t)*256; \
      _Pragma("unroll") for(int g_=0;g_<4;++g_){ const f32x4 a_=*(lds_cf4*)(kp_+g_*32), b_=*(lds_cf4*)(kp_+128+g_*32); \
        _Pragma("unroll") for(int e_=0;e_<4;++e_){ Y0[4*g_+e_]=a_[e_]; Y1[4*g_+e_]=b_[e_]; } } } }while(0)
  #define VOFF(j) ((((j)>>3)*8192)+((((j)&7)&1)*4096)+((((j)&7)>>1)*1024))
  #define VRDJ(j) do{ vlo[(j)&3]=vtr(vp_+VOFF(j)); vhi[(j)&3]=vtr(vp_+VOFF(j)+512); SBAR(); }while(0)
  #define GAPC(MF,Y,B) do{ MF; SBAR(); }while(0)
  #define KRD(G,j) do{ if(G){ kload2(kf,kp0+sl_next,j); SBAR(); } }while(0)
  #define STEP(C0,C1,P0,P1,t,GK,GV,GL) do{ SBAR(); \
    const lds_cptr vp_=vp0+2*sl_prev; \
    VRDJ(0); float sacc=(P0[0]+P0[1]); \
    GAPA(C0=__builtin_amdgcn_mfma_f32_32x32x16_bf16(kf[0],qr[0],zero16,0,0,0), P0[2],P0[3],P0[4],P0[5],     pw0[0]=PKW(P0,0), pw0[1]=PKW(P0,2), pw0); \
    VRDJ(1); GAPA(C1=__builtin_amdgcn_mfma_f32_32x32x16_bf16(kf[1],qr[0],zero16,0,0,0), P0[6],P0[7],P0[8],P0[9],     pw0[2]=PKW(P0,4), pw0[3]=PKW(P0,6), pw0); \
    VRDJ(2); GAPA(C0=__builtin_amdgcn_mfma_f32_32x32x16_bf16(kf[2],qr[1],C0,0,0,0),   P0[10],P0[11],P0[12],P0[13], pw1[0]=PKW(P0,8), pw1[1]=PKW(P0,10), pw1); \
    VRDJ(3); GAPA(C1=__builtin_amdgcn_mfma_f32_32x32x16_bf16(kf[3],qr[1],C1,0,0,0),   P0[14],P0[15],P1[0],P1[1],   pw1[2]=PKW(P0,12),pw1[3]=PKW(P0,14), pw1); \
    GAPA(C0=__builtin_amdgcn_mfma_f32_32x32x16_bf16(kf[4],qr[2],C0,0,0,0),   P1[2],P1[3],P1[4],P1[5],     pw2[0]=PKW(P1,0), pw2[1]=PKW(P1,2), pw2); \
    GAPA(C1=__builtin_amdgcn_mfma_f32_32x32x16_bf16(kf[5],qr[2],C1,0,0,0),   P1[6],P1[7],P1[8],P1[9],     pw2[2]=PKW(P1,4), pw2[3]=PKW(P1,6), pw2); \
    GAPA(C0=__builtin_amdgcn_mfma_f32_32x32x16_bf16(kf[6],qr[3],C0,0,0,0),   P1[10],P1[11],P1[12],P1[13], pw3[0]=PKW(P1,8), pw3[1]=PKW(P1,10), pw3); \
    GAPA(C1=__builtin_amdgcn_mfma_f32_32x32x16_bf16(kf[7],qr[3],C1,0,0,0),   P1[14],P1[15],0.f,0.f,       pw3[2]=PKW(P1,12),pw3[3]=PKW(P1,14), pw3); \
    l_reg+=sacc; \
    if(!NODEC){ if(__builtin_expect(__any(mhat!=0.f),0)){ _Pragma("unroll") for(int r=0;r<16;++r){C0[r]-=mhat;C1[r]-=mhat;} } } \
    if(GK){DMA_K((t)+3,sl_cur);} if(GV){DMA_V((t)+1,sl_next);} \
    CMASK(C0,C1,t); \
    resc=false; if(!NODEC){ float a=MX3(C0[0],C0[1],C1[0]),b=MX3(C0[2],C0[3],C1[1]); a=MX3(a,C1[2],C1[3]); \
      _Pragma("unroll") for(int r=4;r<16;r+=4){a=MX3(a,C0[r],C0[r+1]);b=MX3(b,C0[r+2],C0[r+3]);a=MX3(a,C1[r],C1[r+1]);b=MX3(b,C1[r+2],C1[r+3]);} \
      float rm=__builtin_fmaxf(a,b); { auto rr=__builtin_amdgcn_permlane32_swap(__float_as_uint(rm),__float_as_uint(rm),false,false); rm=__builtin_fmaxf(__uint_as_float(rr[0]),__uint_as_float(rr[1])); } \
      resc=false; \
      if(__builtin_expect(__any(rm>(float)THRL),0)){ const float dl=__builtin_fmaxf(rm,0.f); mhat+=dl; \
        _Pragma("unroll") for(int r=0;r<16;++r){C0[r]-=dl;C1[r]-=dl;} \
        const float f=__builtin_amdgcn_exp2f(-dl); l_reg*=f; if(hi==0)wsf[r32]=f; resc=true; } } \
    SBAR(); \
    GAPB(o[0]=__builtin_amdgcn_mfma_f32_32x32x16_bf16(PAF(0),VFR(0),o[0],0,0,0), C0,0,P0); VRDJ(4); \
    GAPB(o[1]=__builtin_amdgcn_mfma_f32_32x32x16_bf16(PAF(0),VFR(1),o[1],0,0,0), C0,4,P0); VRDJ(5); \
    GAPB(o[0]=__builtin_amdgcn_mfma_f32_32x32x16_bf16(PAF(1),VFR(2),o[0],0,0,0), C0,8,P0); VRDJ(6); \
    GAPB(o[1]=__builtin_amdgcn_mfma_f32_32x32x16_bf16(PAF(1),VFR(3),o[1],0,0,0), C0,12,P0); VRDJ(7); \
    GAPB(o[0]=__builtin_amdgcn_mfma_f32_32x32x16_bf16(PAF(2),VFR(4),o[0],0,0,0), C1,0,P1); VRDJ(8); \
    GAPB(o[1]=__builtin_amdgcn_mfma_f32_32x32x16_bf16(PAF(2),VFR(5),o[1],0,0,0), C1,4,P1); VRDJ(9); \
    GAPB(o[0]=__builtin_amdgcn_mfma_f32_32x32x16_bf16(PAF(3),VFR(6),o[0],0,0,0), C1,8,P1); VRDJ(10); \
    GAPB(o[1]=__builtin_amdgcn_mfma_f32_32x32x16_bf16(PAF(3),VFR(7),o[1],0,0,0), C1,12,P1); VRDJ(11); \
    GAPC(o[2]=__builtin_amdgcn_mfma_f32_32x32x16_bf16(PAF(0),VFR(8),o[2],0,0,0), P0,0); VRDJ(12); \
    GAPC(o[3]=__builtin_amdgcn_mfma_f32_32x32x16_bf16(PAF(0),VFR(9),o[3],0,0,0), P0,4); VRDJ(13); \
    KRD(GL,0); GAPC(o[2]=__builtin_amdgcn_mfma_f32_32x32x16_bf16(PAF(1),VFR(10),o[2],0,0,0), P0,8); VRDJ(14); \
    KRD(GL,1); GAPC(o[3]=__builtin_amdgcn_mfma_f32_32x32x16_bf16(PAF(1),VFR(11),o[3],0,0,0), P0,12); VRDJ(15); \
    KRD(GL,2); GAPC(o[2]=__builtin_amdgcn_mfma_f32_32x32x16_bf16(PAF(2),VFR(12),o[2],0,0,0), P1,0); \
    KRD(GL,3); GAPC(o[3]=__builtin_amdgcn_mfma_f32_32x32x16_bf16(PAF(2),VFR(13),o[3],0,0,0), P1,4); \
    GAPC(o[2]=__builtin_amdgcn_mfma_f32_32x32x16_bf16(PAF(3),VFR(14),o[2],0,0,0), P1,8); \
    GAPC(o[3]=__builtin_amdgcn_mfma_f32_32x32x16_bf16(PAF(3),VFR(15),o[3],0,0,0), P1,12); \
    }while(0)
  const f32x16 zero16=f32x16{};
  int t=1;
  #undef CMASK
  #define CMASK(P0,P1,t) do{}while(0)
  for(;t+5<NT;t+=2){
    STEP(pB0,pB1,pA0,pA1,t,true,true,true);     WAIT_BAR(3); RESC(); ROT();
    STEP(pA0,pA1,pB0,pB1,t+1,true,true,true);   WAIT_BAR(3); RESC(); ROT();
  }
  #undef CMASK
  #define CMASK(P0,P1,t) do{int jb_=(t)-(NT-4); if(jb_>=0)cmask(P0,P1,jb_,qrel,hi);}while(0)
  #define ENDW(tt) do{ if((tt)+3<NT){WAIT_BAR(3);} else if((tt)+2<NT){WAIT_BAR(2);} else {WAIT_BAR(0);} }while(0)
  for(;t+1<NT;t+=2){
    STEP(pB0,pB1,pA0,pA1,t,(t+3<NT),(t+1<NT),(t+1<NT));       ENDW(t);   RESC(); ROT();
    STEP(pA0,pA1,pB0,pB1,t+1,(t+4<NT),(t+2<NT),(t+2<NT));     ENDW(t+1); RESC(); ROT();
  }
  STEP(pB0,pB1,pA0,pA1,NT-1,false,false,false); RESC();
  { float sacc=pB0[0]+pB0[1]; _Pragma("unroll") for(int r=2;r<16;++r)sacc+=pB0[r]; _Pragma("unroll") for(int r=0;r<16;++r)sacc+=pB1[r]; l_reg+=sacc;
    pw0=(u32x4){PKW(pB0,0),PKW(pB0,2),PKW(pB0,4),PKW(pB0,6)};pw1=(u32x4){PKW(pB0,8),PKW(pB0,10),PKW(pB0,12),PKW(pB0,14)};pw2=(u32x4){PKW(pB1,0),PKW(pB1,2),PKW(pB1,4),PKW(pB1,6)};pw3=(u32x4){PKW(pB1,8),PKW(pB1,10),PKW(pB1,12),PKW(pB1,14)};
    SBAR(); pv(o,vb0+2*sl_cur,PAF(0),PAF(1),PAF(2),PAF(3)); pv(o+2,vb0+2*sl_cur+8192,PAF(0),PAF(1),PAF(2),PAF(3)); }
  #undef PKW
  #undef PAF
  #undef VFR
  #undef PIN
  #undef MX3
  #undef GAPA
  #undef GAPB
  #undef LOADB
  #undef EX
  #undef VRDJ
  #undef VOFF
  #undef GAPC
  #undef KRD
  #undef STEP
  #undef ENDW
  {auto rr=__builtin_amdgcn_permlane32_swap(__float_as_uint(l_reg),__float_as_uint(l_reg),false,false);l_reg=__uint_as_float(rr[0])+__uint_as_float(rr[1]);}
  if(hi==0)wsf[32+r32]=l_reg;asm volatile("s_waitcnt lgkmcnt(0)":::"memory");
  float rli[16];
  #pragma unroll
  for(int r=0;r<16;++r)rli[r]=__builtin_amdgcn_rcpf(wsf[32+crow(r,hi)]);
  bf16*Ow=Oc+(rowbase+q0+wid*QBLK)*PO;
  { bf16*stg=(bf16*)(shm+LDS_OST128)+wid*2048;
    #pragma unroll
    for(int hf=0;hf<2;++hf){
      #pragma unroll
      for(int r=0;r<16;++r){const int orow=crow(r,hi);
        #pragma unroll
        for(int d0=0;d0<2;++d0)stg[orow*64+d0*32+r32]=__float2bfloat16(o[2*hf+d0][r]*rli[r]);}
      asm volatile("s_waitcnt lgkmcnt(0)":::"memory");
      #pragma unroll
      for(int i=0;i<4;++i){const int row=i*8+(lane>>3),ch=lane&7; const u32x4 v=*(const u32x4*)(stg+row*64+ch*8); ATTN_STORE16(Ow+(long)row*PO+hf*64+ch*8,v);}
      asm volatile("s_waitcnt lgkmcnt(0)":::"memory"); } }
  asm volatile("s_waitcnt lgkmcnt(0)\n\ts_barrier":::"memory");
  #undef CINIT
  #undef DMA_K
  #undef DMA_V
  #undef CMASK
  #undef START
  #undef RESC
  #undef ROT
}
constexpr int ATTN_LDS_BYTES=(LDS_BYTES>LDS_BYTES128)?LDS_BYTES:LDS_BYTES128;
#undef SBAR
#undef WAIT_BAR
}

namespace xattn {
using pg8::bf16_t; using pg8::bf16x8; using pg8::u32x4; using pg8::f32x4;
using f32x16 = __attribute__((ext_vector_type(16))) float;
#define XLAS __attribute__((address_space(3)))
constexpr int XB0 = 0, XB1 = 32768, X_WSF = 65536, X_OST = X_WSF + 2048, X_LDS_BYTES = X_OST + 8 * 4096;
__device__ __forceinline__ int crow(int r, int hi) { return (r & 3) + 8 * (r >> 2) + 4 * hi; }
__device__ __forceinline__ unsigned pk(float lo, float hi) { return pg8::cvt_pk_bf16(lo, hi); }
__device__ __forceinline__ void unit(int b, int h, int qblk, const bf16_t* __restrict__ CQ, const bf16_t* __restrict__ CK, const bf16_t* __restrict__ CVT, bf16_t* __restrict__ CO, XLAS unsigned char* lds, const int wv) {
    const int tid = wv * 64 + mk_lane(), lane = tid & 63, r32 = lane & 31, hi = lane >> 5; const int wid = __builtin_amdgcn_readfirstlane(tid >> 6);
    const size_t qrow0 = (size_t)b * 4096 + (size_t)qblk * 256 + wid * 32;
    const bf16_t* Qw = CQ + (qrow0 + r32) * 1024 + h * 256 + hi * 8;
    const bf16_t* Kg = CK + ((size_t)b * 256 + lane) * 1024 + h * 256 + wid * 8;
    const bf16_t* Vg = CVT + ((size_t)h * 256 + lane) * 2048 + (size_t)b * 256 + wid * 8;
    u32x4 st[4];
#define X_LOADK(dc) do { _Pragma("unroll") for (int i_ = 0; i_ < 4; ++i_) st[i_] = *(const u32x4*)(Kg + (dc) * 64 + (size_t)i_ * 64 * 1024); } while (0)
#define X_LOADV(c)  do { _Pragma("unroll") for (int i_ = 0; i_ < 4; ++i_) st[i_] = *(const u32x4*)(Vg + (size_t)(c) * 64 * 2048 + i_ * 64); } while (0)
#define X_STOREK(buf) do { _Pragma("unroll") for (int i_ = 0; i_ < 4; ++i_) *(XLAS u32x4*)(lds + (buf) + wid * 4096 + (64 * i_ + lane) * 16) = st[i_]; } while (0)
#define X_STOREV(buf) do { _Pragma("unroll") for (int i_ = 0; i_ < 4; ++i_) *(XLAS u32x4*)(lds + (buf) + (wid + 8 * i_) * 1024 + lane * 16) = st[i_]; } while (0)
    const int kswz = (r32 & ~12) | ((r32 & 4) << 1) | ((r32 & 8) >> 1);
    const int koff = hi * 4096 + kswz * 16;
    const int voff = hi * 1024 + r32 * 16;
    f32x16 s[8];
#pragma unroll
    for (int kt = 0; kt < 8; ++kt) s[kt] = f32x16{};
    X_LOADK(0);
    bf16x8 qfa[4][4];
#pragma unroll
    for (int dc = 0; dc < 4; ++dc)
#pragma unroll
        for (int ks = 0; ks < 4; ++ks) qfa[dc][ks] = *(const bf16x8*)(Qw + dc * 64 + ks * 16);
    X_STOREK(XB0);
    __syncthreads();
#pragma unroll
    for (int dc = 0; dc < 4; ++dc) {
        const int buf = (dc & 1) ? XB1 : XB0, nbuf = (dc & 1) ? XB0 : XB1;
        if (dc < 3) X_LOADK(dc + 1); else X_LOADV(0);
#pragma unroll
        for (int kt = 0; kt < 8; ++kt)
#pragma unroll
            for (int ks = 0; ks < 4; ++ks) {
                const bf16x8 kf = *(const XLAS bf16x8*)(lds + buf + koff + kt * 512 + ks * 8192);
                s[kt] = __builtin_amdgcn_mfma_f32_32x32x16_bf16(kf, qfa[dc][ks], s[kt], 0, 0, 0);
            }
        if (dc < 3) X_STOREK(nbuf); else X_STOREV(nbuf);
        __syncthreads();
    }
    float mx = s[0][0];
#pragma unroll
    for (int kt = 0; kt < 8; ++kt)
#pragma unroll
        for (int r = 0; r < 16; ++r) mx = fmaxf(mx, s[kt][r]);
    mx = fmaxf(mx, __shfl_xor(mx, 32));
    float l = 0.f;
#pragma unroll
    for (int kt = 0; kt < 8; ++kt)
#pragma unroll
        for (int r = 0; r < 16; ++r) { const float p = __builtin_amdgcn_exp2f(s[kt][r] - mx); s[kt][r] = p; l += p; }
    l += __shfl_xor(l, 32);
    u32x4 pw[16];
#pragma unroll
    for (int kt = 0; kt < 8; ++kt)
#pragma unroll
        for (int j2 = 0; j2 < 2; ++j2)
            pw[2 * kt + j2] = (u32x4){pk(s[kt][8 * j2 + 0], s[kt][8 * j2 + 1]), pk(s[kt][8 * j2 + 2], s[kt][8 * j2 + 3]), pk(s[kt][8 * j2 + 4], s[kt][8 * j2 + 5]), pk(s[kt][8 * j2 + 6], s[kt][8 * j2 + 7])};
    XLAS float* wsf = (XLAS float*)(lds + X_WSF) + wid * 64;
    if (hi == 0) wsf[r32] = l;
    asm volatile("s_waitcnt lgkmcnt(0)" ::: "memory");
    float rli[16];
#pragma unroll
    for (int r = 0; r < 16; ++r) rli[r] = __builtin_amdgcn_rcpf(wsf[crow(r, hi)]);
    XLAS bf16_t* stg = (XLAS bf16_t*)(lds + X_OST) + wid * 2048;
    bf16_t* Ow = CO + qrow0 * 1024 + h * 256;
#pragma unroll
    for (int c = 0; c < 4; ++c) {
        const int buf = (c & 1) ? XB1 : XB0, nbuf = (c & 1) ? XB0 : XB1;
        if (c < 3) X_LOADV(c + 1);
        f32x16 o[2]; o[0] = f32x16{}; o[1] = f32x16{};
#pragma unroll
        for (int j = 0; j < 16; ++j)
#pragma unroll
            for (int dt = 0; dt < 2; ++dt) {
                const bf16x8 vf = *(const XLAS bf16x8*)(lds + buf + voff + dt * 512 + j * 2048);
                o[dt] = __builtin_amdgcn_mfma_f32_32x32x16_bf16(__builtin_bit_cast(bf16x8, pw[j]), vf, o[dt], 0, 0, 0);
            }
#pragma unroll
        for (int r = 0; r < 16; ++r) { const int orow = crow(r, hi);
#pragma unroll
            for (int dt = 0; dt < 2; ++dt) { const unsigned w = pk(o[dt][r] * rli[r], 0.f); stg[orow * 64 + dt * 32 + r32] = (bf16_t)(w & 0xffffu); } }
        asm volatile("s_waitcnt lgkmcnt(0)" ::: "memory");
#pragma unroll
        for (int i = 0; i < 4; ++i) { const int row = i * 8 + (lane >> 3), ch = lane & 7; const u32x4 v = *(const XLAS u32x4*)(stg + row * 64 + ch * 8); *(u32x4*)(Ow + (size_t)row * 1024 + c * 64 + ch * 8) = v; }
        asm volatile("s_waitcnt lgkmcnt(0)" ::: "memory");
        if (c < 3) X_STOREV(nbuf);
        __syncthreads();
    }
#undef X_LOADK
#undef X_LOADV
#undef X_STOREK
#undef X_STOREV
}
}

#ifndef MK_PER_PHASE
#define MK_PER_PHASE 0
#endif
constexpr int NWAVES = 8;
constexpr int BATCH = 8, SEQ = 4096, D = 1024, M = BATCH * SEQ, FF = 4096, NMEM = 256, MM = BATCH * NMEM, INW = 3080, NPROJ = 3072, NATT = 1536;
constexpr float EPS = 1e-6f, SUBLN_EPS = 1e-5f;
constexpr int N_PHASES = 11;

constexpr size_t MiB = 1u << 20;
constexpr size_t WS_ROPE = 0;
constexpr size_t WS_LOGF = 1 * MiB;
constexpr size_t WS_KB   = 2 * MiB;
constexpr size_t WS_NRM  = 3 * MiB;
constexpr size_t WS_BAR  = 3 * MiB + 65536;
constexpr size_t WS_SS1  = 4 * MiB, WS_SS2 = 6 * MiB, WS_SS3 = 8 * MiB;
constexpr size_t WS_WIN = 10 * MiB, WS_WOUT = 16 * MiB, WS_WCQ = 18 * MiB, WS_WCKV = 20 * MiB, WS_WCO = 24 * MiB, WS_WUP = 26 * MiB, WS_WDN = 34 * MiB;
constexpr size_t WS_MEMN = 42 * MiB, WS_CK = 46 * MiB, WS_CVT = 50 * MiB;
constexpr size_t WS_SA = 56 * MiB;
constexpr size_t WS_SB = 448 * MiB;
constexpr size_t WS_PROJ = 216 * MiB;
constexpr size_t WS_ATT = 120 * MiB;
constexpr size_t WS_ZH = 120 * MiB;
constexpr size_t WS_END = 512 * MiB;
static_assert(WS_SA + 64 * MiB <= WS_ATT && WS_ATT + (size_t)M * NATT * 2 <= WS_PROJ && WS_PROJ + (size_t)M * NPROJ * 2 <= WS_SB && WS_ZH + (size_t)M * FF * 2 <= WS_SB && WS_ZH >= WS_SA + 64 * MiB && WS_SB + 64 * MiB <= WS_END, "d_ws map: slot A | ATT | PROJ | (gap) | slot B; ZH overlays ATT + PROJ only");

constexpr int RING_BYTES = 131072, LDS_BYTES = 147456;
static_assert(attn_body::ATTN_LDS_BYTES <= RING_BYTES && xattn::X_LDS_BYTES <= RING_BYTES && pg8::STAGE_BYTES <= RING_BYTES, "LDS map");

#define LAS __attribute__((address_space(3)))
typedef unsigned short bf16;
typedef unsigned v4u __attribute__((ext_vector_type(4)));
typedef float f32x4 __attribute__((ext_vector_type(4)));
#define LDS_WAIT() asm volatile("s_waitcnt lgkmcnt(0)" ::: "memory")
__device__ __forceinline__ unsigned f2bf(float f) { unsigned u = __builtin_bit_cast(unsigned, f); return (u + 0x7fffu + ((u >> 16) & 1u)) >> 16; }
__device__ __forceinline__ unsigned pk2(float lo, float hi) { return f2bf(lo) | (f2bf(hi) << 16); }
__device__ __forceinline__ float bflo(unsigned w) { return __builtin_bit_cast(float, w << 16); }
__device__ __forceinline__ float bfhi(unsigned w) { return __builtin_bit_cast(float, w & 0xffff0000u); }
__device__ __forceinline__ float wave_sum(float v) {
#pragma unroll
    for (int o = 1; o < 64; o <<= 1) v += __shfl_xor(v, o);
    return v;
}

#define XB_TMO      128
#define XB_XCNT(j)  (256  + 64 * (j))
#define XB_XSUB(j)  (1280 + 64 * (j))
#define XB_XGEN(j)  (2304 + 64 * (j))
#define XB_TOP      3328
#define XB_TOPGEN   3392
#define XCD_BAR_WORDS 3456
#define XB_SPIN_CAP (1u << 18)

__device__ __forceinline__ unsigned xb_ld(unsigned* p)              { return __hip_atomic_load(p, __ATOMIC_RELAXED, __HIP_MEMORY_SCOPE_AGENT); }
__device__ __forceinline__ unsigned xb_add(unsigned* p, unsigned v) { return __hip_atomic_fetch_add(p, v, __ATOMIC_RELAXED, __HIP_MEMORY_SCOPE_AGENT); }
__device__ __forceinline__ unsigned xb_xcc_id() { return (unsigned)__builtin_amdgcn_s_getreg((3 << 11) | 20) & 0xFu; }
#define XB_SPIN(cond, bar) do { unsigned _sp = 0; while (cond) { __builtin_amdgcn_s_sleep(1); \
    if ((++_sp & 255u) == 0u) { if (xb_ld(&(bar)[XB_TMO])) break; if (_sp > XB_SPIN_CAP) { atomicAdd(&(bar)[XB_TMO], 1u); break; } } } } while (0)

struct XcdBarrier {
    unsigned* bar; unsigned x;
    volatile LAS unsigned* st;
};

__device__ __forceinline__ XcdBarrier xcd_barrier_post(unsigned* bar, volatile LAS unsigned* st, bool leader) {
    XcdBarrier b; b.bar = bar; b.x = xb_xcc_id(); b.st = st;
    if (leader) (void)xb_add(&bar[XB_XCNT(b.x)], 1u);
    return b;
}
__device__ __forceinline__ void xcd_barrier_complete(unsigned* bar, unsigned x, unsigned& nloc, unsigned& nx) {
    const unsigned G = gridDim.x * gridDim.y * gridDim.z;
    unsigned sum, cnt, mine, sp = 0u;
    for (;;) {
        sum = 0u; cnt = 0u; mine = 0u;
#pragma unroll
        for (unsigned j = 0; j < 16; ++j) { const unsigned c = xb_ld(&bar[XB_XCNT(j)]); sum += c; cnt += (c > 0u) ? 1u : 0u; mine = (j == x) ? c : mine; }
        if (sum == G) break;
        __builtin_amdgcn_s_sleep(1);
        if ((++sp & 255u) == 0u) { if (xb_ld(&bar[XB_TMO])) break; if (sp > XB_SPIN_CAP) { atomicAdd(&bar[XB_TMO], 1u); break; } }
    }
    nloc = mine > 0u ? mine : 1u; nx = cnt > 0u ? cnt : 1u;
}

__device__ __forceinline__ void xcd_barrier(const XcdBarrier& b, bool leader) {
    asm volatile("s_waitcnt vmcnt(0)" ::: "memory");
    __syncthreads();
    if (leader) {
        unsigned* bar = b.bar;
        __builtin_amdgcn_s_waitcnt(0);
        unsigned nloc = b.st[0], nx = b.st[1];
        if (nloc == 0u) { xcd_barrier_complete(bar, b.x, nloc, nx); b.st[0] = nloc; b.st[1] = nx; }
        const unsigned old = xb_add(&bar[XB_XSUB(b.x)], 1u);
        const unsigned gen = old / nloc;
        if (old + 1u == (gen + 1u) * nloc) {
            __builtin_amdgcn_fence(__ATOMIC_RELEASE, "agent");
            asm volatile("s_waitcnt vmcnt(0)" ::: "memory");
            const unsigned og = xb_add(&bar[XB_TOP], 1u);
            const unsigned tg = og / nx;
            if (og + 1u == (tg + 1u) * nx) xb_add(&bar[XB_TOPGEN], 1u);
            else XB_SPIN(xb_ld(&bar[XB_TOPGEN]) == tg, bar);
            __builtin_amdgcn_fence(__ATOMIC_ACQUIRE, "agent");
            xb_add(&bar[XB_XGEN(b.x)], 1u);
            asm volatile("s_waitcnt vmcnt(0)" ::: "memory");
        } else {
            XB_SPIN(xb_ld(&bar[XB_XGEN(b.x)]) == gen, bar);
            __builtin_amdgcn_fence(__ATOMIC_ACQUIRE, "agent");
            asm volatile("s_waitcnt vmcnt(0)" ::: "memory");
        }
    }
    __syncthreads();
}

struct Params { const float* in[21]; float* out; unsigned char* ws; int ph_lo, ph_hi; };
enum { I_X = 0, I_MEM, I_GMIX, I_WIN, I_BF, I_LQ1, I_LK1, I_LQ2, I_LK2, I_GSUB, I_GFOX, I_WOUT, I_GCROSS, I_GMEM, I_WCQ, I_WCKV, I_WCO, I_GMLP, I_WUP, I_WDN, I_GFIN };

__device__ __forceinline__ void p0_transpose_item(const float* W, int K, int ldw, int nblk, bf16* WT, LAS float* scr, int item, int lane, const float* gk = nullptr  ) {
    const int kb = item / nblk, nb = item % nblk, k0 = 64 * kb, n0 = 32 * nb;
    { f32x4 v[8]; float gg[8];
#pragma unroll
        for (int it = 0; it < 8; ++it) { const int kk = 8 * it + (lane >> 3); v[it] = __builtin_nontemporal_load((const f32x4*)(W + (size_t)(k0 + kk) * ldw + n0 + 4 * (lane & 7)));     gg[it] = gk ? gk[k0 + kk] : 1.f; }
#pragma unroll
        for (int it = 0; it < 8; ++it) { const int kk = 8 * it + (lane >> 3); LAS float* d = scr + kk * 33 + 4 * (lane & 7); d[0] = v[it].x * gg[it]; d[1] = v[it].y * gg[it]; d[2] = v[it].z * gg[it]; d[3] = v[it].w * gg[it]; } }
    LDS_WAIT(); asm volatile("" ::: "memory");
    const int c = lane & 7;
#pragma unroll
    for (int j = 0; j < 4; ++j) { const int n = (lane >> 3) + 8 * j; const LAS float* s = scr + (8 * c) * 33 + n;
        v4u o; o.x = pk2(s[0 * 33], s[1 * 33]); o.y = pk2(s[2 * 33], s[3 * 33]); o.z = pk2(s[4 * 33], s[5 * 33]); o.w = pk2(s[6 * 33], s[7 * 33]);
        *(v4u*)(WT + (size_t)(n0 + n) * K + k0 + 8 * c) = o; }
    LDS_WAIT(); asm volatile("" ::: "memory");
}

__device__ __forceinline__ void rms_row(const float* xrow, const f32x4 (&gq)[4], bf16* orow, int lane, f32x4 (&v)[4]) {
    const f32x4* xr = (const f32x4*)xrow + lane; float s = 0.f;
#pragma unroll
    for (int j = 0; j < 4; ++j) { v[j] = xr[64 * j]; s += (v[j].x * v[j].x + v[j].y * v[j].y) + (v[j].z * v[j].z + v[j].w * v[j].w); }
    const float rstd = 1.0f / sqrtf(wave_sum(s) * (1.f / 1024.f) + EPS);
    unsigned long long* o8 = (unsigned long long*)orow + lane;
#pragma unroll
    for (int j = 0; j < 4; ++j) { v[j] = v[j] * rstd * gq[j]; o8[64 * j] = (unsigned long long)pk2(v[j].x, v[j].y) | ((unsigned long long)pk2(v[j].z, v[j].w) << 32); }
}

template <class Sched> __device__ __forceinline__ void build_rstd_tables(LAS unsigned char* lds, const Sched& S, const float* sspart, float eps, int wave) {
    const int lane = mk_lane(), tid = wave * 64 + lane;
    LAS int* pml = (LAS int*)(lds + RING_BYTES + 1536); LAS float* tab = (LAS float*)(lds + RING_BYTES + 2048);
    if (tid == 0) { int n = 0; pg8::Unit u; for (int i = 0; S.next(i, u); ++i) { bool f = false; for (int j = 0; j < n; ++j) f |= (pml[j] == u.pm); if (!f && n < 8) pml[n++] = u.pm; } pml[8] = n; }
    __syncthreads();
    const int n = pml[8];
    for (int idx = tid; idx < n * 256; idx += NWAVES * 64) tab[idx] = pg8::row_rstd(sspart, pml[idx >> 8] * 256 + (idx & 255), eps);
    __syncthreads();
}
__global__ void __launch_bounds__(NWAVES * 64, 2) mk_fwd(Params P) {
    extern __shared__ __attribute__((aligned(16))) unsigned char lds_raw[];
    LAS unsigned char* lds = (LAS unsigned char*)lds_raw;
    const int wave = __builtin_amdgcn_readfirstlane((int)threadIdx.x >> 6);
#define LANE_TID const int lane = mk_lane(), tid = wave * 64 + lane
    const int G = gridDim.x; const int bx = blockIdx.x; const int vcu = (G % 8 == 0) ? (bx % 8) * (G / 8) + bx / 8 : bx;
    const int gw = vcu * NWAVES + wave, NGW = G * NWAVES;
    unsigned char* const ws = P.ws;
#define ROPE ((float*)(P.ws + WS_ROPE))
#define LOGF ((float*)(P.ws + WS_LOGF))
#define KBIAS ((float*)(P.ws + WS_KB))
#define NRM ((float*)(P.ws + WS_NRM))
#define SS1 ((float*)(P.ws + WS_SS1))
#define SS2 ((float*)(P.ws + WS_SS2))
#define SS3 ((float*)(P.ws + WS_SS3))
#define Win_t ((bf16*)(P.ws + WS_WIN))
#define Wout_t ((bf16*)(P.ws + WS_WOUT))
#define Wcq_t ((bf16*)(P.ws + WS_WCQ))
#define Wckv_t ((bf16*)(P.ws + WS_WCKV))
#define Wco_t ((bf16*)(P.ws + WS_WCO))
#define Wup_t ((bf16*)(P.ws + WS_WUP))
#define Wdn_t ((bf16*)(P.ws + WS_WDN))
#define MEMN ((bf16*)(P.ws + WS_MEMN))
#define CKb ((bf16*)(P.ws + WS_CK))
#define CVT ((bf16*)(P.ws + WS_CVT))
#define XN ((bf16*)(P.ws + WS_SB))
#define MIXA ((bf16*)(P.ws + WS_SA))
#define CQ ((bf16*)(P.ws + WS_SA))
#define H2B ((bf16*)(P.ws + WS_SA))
#define H1B ((bf16*)(P.ws + WS_SB))
#define CO ((bf16*)(P.ws + WS_PROJ))
#define PROJ ((bf16*)(P.ws + WS_PROJ))
#define ATT ((bf16*)(P.ws + WS_ATT))
#define ZH ((bf16*)(P.ws + WS_ZH))
    const int lo = P.ph_lo, hi_ph = P.ph_hi;
    volatile LAS unsigned* xst = (volatile LAS unsigned*)(lds + RING_BYTES + 1024);
    { const int l0 = mk_lane(); if (wave == 0 && l0 < 2) xst[l0] = 0u; }
    __syncthreads();
    XcdBarrier bar; bar.bar = (unsigned*)(ws + WS_BAR); bar.x = 0; bar.st = xst;
    if (hi_ph - lo > 1) bar = xcd_barrier_post((unsigned*)(ws + WS_BAR), xst, wave == 0 && mk_lane() == 0);
    if (lo < 0) cg::this_grid().sync();
#define IN(k) (lo <= (k) && (k) < hi_ph)
#ifndef MK_MASK
#define MK_MASK 0x7ff
#endif
#ifndef MK_ATT_MASK
#define MK_ATT_MASK 3
#endif
#ifndef MK_REP_MASK
#define MK_REP_MASK 0
#endif
#define PH(k) (IN(k) && ((MK_MASK >> (k)) & 1))
#define REPS(k) for (int rep_ = 0; rep_ < (((MK_REP_MASK) >> (k)) & 1) + 1; ++rep_)
#define SEAM(k) do { if (IN(k) && IN((k) + 1)) { xcd_barrier(bar, wave == 0 && mk_lane() == 0); } } while (0)

    if (PH(0)) REPS(0) {
        LANE_TID;
        {
            const float* win = P.in[I_WIN];
            for (int k = tid; k < 1024; k += NWAVES * 64) { const f32x4 a = *(const f32x4*)(win + (size_t)k * INW + 3072), b = *(const f32x4*)(win + (size_t)k * INW + 3076);
                const int slot = (((k >> 8) * 4 + (k & 3)) * 64 + ((k & 255) >> 2)); *(LAS f32x4*)(lds + slot * 32) = a; *(LAS f32x4*)(lds + slot * 32 + 16) = b; }
        }
        if (bx == 0 && tid < BATCH * 64) NRM[tid] = 0.f;
        __syncthreads();
        LAS float* scr = (LAS float*)(lds + 32768 + wave * 8704);
        {
            constexpr int I_IN = 16 * 96, I_SQ = 16 * 32, I_CKV = 16 * 64, I_UP = 16 * 128, I_DN = 64 * 32;
            constexpr int NITEMS = I_IN + 3 * I_SQ + I_CKV + I_UP + I_DN;
            for (int it = gw; it < NITEMS; it += NGW) {
                int r = it;
                if (r < I_IN) { p0_transpose_item(P.in[I_WIN], D, INW, 96, Win_t, scr, r, lane, P.in[I_GMIX]); continue; } r -= I_IN;
                if (r < I_SQ) { p0_transpose_item(P.in[I_WOUT], D, D, 32, Wout_t, scr, r, lane); continue; } r -= I_SQ;
                if (r < I_SQ) { p0_transpose_item(P.in[I_WCQ], D, D, 32, Wcq_t, scr, r, lane, P.in[I_GCROSS]); continue; } r -= I_SQ;
                if (r < I_SQ) { p0_transpose_item(P.in[I_WCO], D, D, 32, Wco_t, scr, r, lane); continue; } r -= I_SQ;
                if (r < I_CKV) { p0_transpose_item(P.in[I_WCKV], D, 2 * D, 64, Wckv_t, scr, r, lane); continue; } r -= I_CKV;
                if (r < I_UP) { p0_transpose_item(P.in[I_WUP], D, FF, 128, Wup_t, scr, r, lane, P.in[I_GMLP]); continue; } r -= I_UP;
                p0_transpose_item(P.in[I_WDN], FF, D, 32, Wdn_t, scr, r, lane);
            }
        }
        {
            for (int idx = gw * 64 + lane; idx < SEQ * 8; idx += NGW * 64) {
                const int pos = idx >> 3, j = idx & 7;
                const float f = j == 0 ? 1.0f : j == 1 ? 0.1939227432012558f : j == 2 ? 0.03760603070259094f : j == 3 ? 0.007292664609849453f : j == 4 ? 0.0014142135623842478f : j == 5 ? 0.00027424818836152554f : j == 6 ? 5.318296098266728e-05f : 1.0313386155758053e-05f;
                const float ang = (float)pos * f;
                double rev = (double)ang * 0.15915494309189535; rev -= __builtin_rint(rev);
                const float x = (float)(rev * 6.283185307179586);
                ROPE[pos * 16 + j] = cosf(x); ROPE[pos * 16 + 8 + j] = sinf(x);
            }
        }
        {
            f32x4 gq[4];
#pragma unroll
            for (int j = 0; j < 4; ++j) gq[j] = ((const f32x4*)P.in[I_GMIX])[64 * j + lane];
            const float bfv = P.in[I_BF][lane & 7];
            const bool b0 = lane & 1, b1 = lane & 2, b2 = lane & 4;
            const bool xal = (G == 256); const int mstart = xal ? (bx & 7) * SEQ + ((bx >> 3) * NWAVES + wave) * 4 : gw * 4, mstep = xal ? 1024 : NGW * 4, mend = xal ? (bx & 7) * SEQ + SEQ : M;
            for (int m0 = mstart; m0 < mend; m0 += mstep) {
                f32x4 v[4][4]; float s[4];
#pragma unroll
                for (int r = 0; r < 4; ++r)
#pragma unroll
                    for (int jj = 0; jj < 4; ++jj) v[r][jj] = __builtin_nontemporal_load((const f32x4*)(P.in[I_X] + (size_t)(m0 + r) * D) + 64 * jj + lane);
#pragma unroll
                for (int r = 0; r < 4; ++r) { s[r] = 0.f;
#pragma unroll
                    for (int jj = 0; jj < 4; ++jj) s[r] += (v[r][jj].x * v[r][jj].x + v[r][jj].y * v[r][jj].y) + (v[r][jj].z * v[r][jj].z + v[r][jj].w * v[r][jj].w); }
#pragma unroll
                for (int r = 0; r < 4; ++r) { const float ssum = wave_sum(s[r]); const float rstd = 1.0f / sqrtf(ssum * (1.f / 1024.f) + EPS);
                    unsigned long long* o8 = (unsigned long long*)(XN + (size_t)(m0 + r) * D) + lane;
                    if (lane < 4) ((f32x4*)(SS3 + (size_t)(m0 + r) * 16))[lane] = (f32x4){lane == 0 ? ssum : 0.f, 0.f, 0.f, 0.f};
#pragma unroll
                    for (int jj = 0; jj < 4; ++jj) { o8[64 * jj] = (unsigned long long)pk2(v[r][jj].x, v[r][jj].y) | ((unsigned long long)pk2(v[r][jj].z, v[r][jj].w) << 32);
                        v[r][jj] = v[r][jj] * rstd * gq[jj]; } }
                f32x4 a0[4], a1[4];
#pragma unroll
                for (int r = 0; r < 4; ++r) { a0[r] = (f32x4){0.f, 0.f, 0.f, 0.f}; a1[r] = a0[r]; }
#pragma unroll
                for (int jj = 0; jj < 4; ++jj)
#pragma unroll
                    for (int i = 0; i < 4; ++i) { const LAS f32x4* wp = (const LAS f32x4*)(lds + ((jj * 4 + i) * 64 + lane) * 32); const f32x4 w0 = wp[0], w1 = wp[1];
#pragma unroll
                        for (int r = 0; r < 4; ++r) { a0[r] += w0 * v[r][jj][i]; a1[r] += w1 * v[r][jj][i]; } }
#pragma unroll
                for (int r = 0; r < 4; ++r) {
                    float c0, c1, c2, c3, d0, d1, z;
                    { const float k0 = b0 ? a0[r][1] : a0[r][0], g0 = b0 ? a0[r][0] : a0[r][1]; c0 = k0 + __shfl_xor(g0, 1); }
                    { const float k0 = b0 ? a0[r][3] : a0[r][2], g0 = b0 ? a0[r][2] : a0[r][3]; c1 = k0 + __shfl_xor(g0, 1); }
                    { const float k0 = b0 ? a1[r][1] : a1[r][0], g0 = b0 ? a1[r][0] : a1[r][1]; c2 = k0 + __shfl_xor(g0, 1); }
                    { const float k0 = b0 ? a1[r][3] : a1[r][2], g0 = b0 ? a1[r][2] : a1[r][3]; c3 = k0 + __shfl_xor(g0, 1); }
                    { const float k0 = b1 ? c1 : c0, g0 = b1 ? c0 : c1; d0 = k0 + __shfl_xor(g0, 2); }
                    { const float k0 = b1 ? c3 : c2, g0 = b1 ? c2 : c3; d1 = k0 + __shfl_xor(g0, 2); }
                    { const float k0 = b2 ? d1 : d0, g0 = b2 ? d0 : d1; z = k0 + __shfl_xor(g0, 4); }
                    z += __shfl_xor(z, 8); z += __shfl_xor(z, 16); z += __shfl_xor(z, 32);
                    z += bfv;
                    const float ls = fminf(z, 0.f) - __logf(1.0f + __expf(-fabsf(z)));
                    const int m = m0 + r;
                    if (lane < 8) LOGF[((size_t)(m >> 12) * 8 + lane) * SEQ + (m & 4095)] = ls;
                }
            }
        }
        {
            f32x4 gq[4];
#pragma unroll
            for (int j = 0; j < 4; ++j) gq[j] = ((const f32x4*)P.in[I_GMEM])[64 * j + lane];
            for (int m = gw; m < MM; m += NGW) { f32x4 v[4]; rms_row(P.in[I_MEM] + (size_t)m * D, gq, MEMN + (size_t)m * D, lane, v); }
        }
        __syncthreads();
    }
    SEAM(0);

    if (PH(1)) REPS(1) {
        LANE_TID;
        if (bx < BATCH * 8) {
            const float* src = LOGF + (size_t)bx * SEQ + tid * 8; float* dst = KBIAS + (size_t)bx * SEQ + tid * 8;
            const f32x4 a = *(const f32x4*)src, b = *(const f32x4*)(src + 4);
            float p[8]; p[0] = a[0]; p[1] = p[0] + a[1]; p[2] = p[1] + a[2]; p[3] = p[2] + a[3]; p[4] = p[3] + b[0]; p[5] = p[4] + b[1]; p[6] = p[5] + b[2]; p[7] = p[6] + b[3];
            float inc = p[7];
#pragma unroll
            for (int o = 1; o < 64; o <<= 1) { const float t = __shfl_up(inc, o); if (lane >= o) inc += t; }
            LAS float* wt = (LAS float*)lds;
            if (lane == 63) wt[wave] = inc;
            __syncthreads();
            float pre = inc - p[7];
            for (int w = 0; w < wave; ++w) pre += wt[w];
            const float c = -1.4426950408889634f;
            *(f32x4*)dst = (f32x4){(pre + p[0]) * c, (pre + p[1]) * c, (pre + p[2]) * c, (pre + p[3]) * c};
            *(f32x4*)(dst + 4) = (f32x4){(pre + p[4]) * c, (pre + p[5]) * c, (pre + p[6]) * c, (pre + p[7]) * c};
            __syncthreads();
        }
        { pg8::Gemm g{XN, Win_t, M, NPROJ, D}; pg8::StaticOrder S; S.init(M, NPROJ, G, bx);
          build_rstd_tables(lds, S, SS3, EPS, wave);
          pg8::EpiProj E{PROJ, ROPE, NRM, SS3, (const LAS int*)(lds + RING_BYTES + 1536), (const LAS float*)(lds + RING_BYTES + 2048)};
          pg8::gemm_phase<pg8::EpiProj, pg8::StaticOrder, true, true>(lds, g, S, E, wave); }
    }
    SEAM(1);

    if (PH(2)) REPS(2) {
        for (int p = vcu; p < 1024; p += G) {
            const int pp = p & 511, bh = pp >> 3, s = pp & 7, b = bh >> 3, hm = bh & 7;
#ifdef MK_REP_ATT
            if (rep_ == 1 && !((MK_REP_ATT) & (p < 512 ? 1 : 2))) continue;
#endif
            for (int hh = 0; hh < 2; ++hh) {
                const int qb = hh ? s : 15 - s;
                if (p < 512) { if (!(MK_ATT_MASK & 1)) continue;
                    const float* nq = NRM + 256 + ((b * 2 + 0) * 8 + hm) * 2; const float* nk = NRM + 256 + ((b * 2 + 1) * 8 + hm) * 2;
                    const float bqd = sqrtf((nq[0] + nq[1]) * (nk[0] + nk[1])) * 1.02f;
                    if (bqd < 64.f)
                        attn_body::attn_unit128<16, true>(b, qb, (const attn_body::bf16*)PROJ + hm * 64, (const attn_body::bf16*)PROJ + 512 + hm * 64, (const attn_body::bf16*)PROJ + 1024 + (hm >> 1) * 128,
                                                          (attn_body::bf16*)ATT + (hm & 1) * 512 + (hm >> 1) * 128, (char*)lds_raw, wave);
                    else
                        attn_body::attn_unit128<16, false>(b, qb, (const attn_body::bf16*)PROJ + hm * 64, (const attn_body::bf16*)PROJ + 512 + hm * 64, (const attn_body::bf16*)PROJ + 1024 + (hm >> 1) * 128,
                                                           (attn_body::bf16*)ATT + (hm & 1) * 512 + (hm >> 1) * 128, (char*)lds_raw, wave);
                } else { if (!(MK_ATT_MASK & 2)) continue; const int h = hm;
                    const float* nq = NRM + ((b * 2 + 0) * 8 + h) * 2; const float* nk = NRM + ((b * 2 + 1) * 8 + h) * 2; const float* kbr = KBIAS + (size_t)(b * 8 + h) * SEQ;
                    const float bqk = sqrtf((nq[0] + nq[1]) * (nk[0] + nk[1])) * 1.02f;
                    const int NTf = 4 * qb + 4, tc = 2 * (mk_lane() & 31);
                    const bool skip_ok = (tc >= 2) && (tc <= NTf - 4) && (2.f * bqk + kbr[64 * tc - 1 + (tc ? 0 : 1)] - kbr[256 * qb] < -40.f);
                    const unsigned long long bm = __ballot(skip_ok);
                    const int t0 = bm ? 2 * ((63 - __builtin_clzll(bm)) & 31) : 0;
                    attn_body::attn_unit<8, true>(b, qb, (const attn_body::bf16*)PROJ + 1536 + h * 64, (const attn_body::bf16*)PROJ + 2048 + h * 64, (const attn_body::bf16*)PROJ + 2560 + h * 64,
                                                  (attn_body::bf16*)ATT + 1024 + h * 64, kbr, t0, (char*)lds_raw, wave);
                }
            }
        }
    }
    SEAM(2);

    if (PH(3)) REPS(3) {
        LANE_TID;
        if (bx < 64) {
        { pg8::Gemm g{MEMN, Wckv_t, MM, D, D}; pg8::StaticOrder S; S.init(MM, D, G, bx);
          pg8::EpiBf16<0> E{CKb, D, nullptr, 0, 0, 1.f};
          pg8::gemm_phase<pg8::EpiBf16<0>, pg8::StaticOrder, true, true>(lds, g, S, E, wave); }
        { pg8::Gemm g{Wckv_t + (size_t)D * D, MEMN, D, MM, D}; pg8::StaticOrder S; S.init(D, MM, G, (bx + G - 32) % G);
          pg8::EpiBf16<0> E{CVT, MM, nullptr, 0, 0, 1.f};
          pg8::gemm_phase<pg8::EpiBf16<0>, pg8::StaticOrder, true, true>(lds, g, S, E, wave); }
        }
        const float sa = wave_sum(P.in[I_LQ1][lane] * P.in[I_LK1][lane]), sb = wave_sum(P.in[I_LQ2][lane] * P.in[I_LK2][lane]);
        const float lam = __expf(sa) - __expf(sb) + 0.2f;
        const f32x4 gs0 = *(const f32x4*)(P.in[I_GSUB] + (8 * lane) % 128), gs1 = *(const f32x4*)(P.in[I_GSUB] + (8 * lane) % 128 + 4);
        const f32x4 gf0 = *(const f32x4*)(P.in[I_GFOX] + (8 * lane) % 64), gf1 = *(const f32x4*)(P.in[I_GFOX] + (8 * lane) % 64 + 4);
        const int gw3 = (G > 64) ? (bx - 64) * NWAVES + wave : gw, NGW3 = (G > 64) ? (G - 64) * NWAVES : NGW;
        const bool xal3 = (G == 256); const int m3start = xal3 ? (bx & 7) * SEQ + ((bx - 64) >> 3) * NWAVES + wave : gw3, m3step = xal3 ? 24 * NWAVES : NGW3, m3end = xal3 ? (bx & 7) * SEQ + SEQ : M;
        if (G <= 64 || bx >= 64)
        for (int m = m3start; m < m3end; m += m3step) {
            const bf16* a = ATT + (size_t)m * NATT + 8 * lane;
            const v4u o1 = *(const v4u*)a, o2 = *(const v4u*)(a + 512), of = *(const v4u*)(a + 1024);
            float d[8], f[8];
#pragma unroll
            for (int e = 0; e < 4; ++e) { d[2 * e] = bflo(o1[e]) - lam * bflo(o2[e]); d[2 * e + 1] = bfhi(o1[e]) - lam * bfhi(o2[e]); f[2 * e] = bflo(of[e]); f[2 * e + 1] = bfhi(of[e]); }
            float sd = 0.f, sf = 0.f;
#pragma unroll
            for (int e = 0; e < 8; ++e) { sd += d[e] * d[e]; sf += f[e] * f[e]; }
            sd += __shfl_xor(sd, 1); sd += __shfl_xor(sd, 2); sd += __shfl_xor(sd, 4); sd += __shfl_xor(sd, 8);
            sf += __shfl_xor(sf, 1); sf += __shfl_xor(sf, 2); sf += __shfl_xor(sf, 4);
            const float rd = 0.8f / sqrtf(sd * (1.f / 128.f) + SUBLN_EPS), rf = 1.0f / sqrtf(sf * (1.f / 64.f) + EPS);
            v4u wd, wf;
            wd.x = pk2(d[0] * rd * gs0[0], d[1] * rd * gs0[1]); wd.y = pk2(d[2] * rd * gs0[2], d[3] * rd * gs0[3]); wd.z = pk2(d[4] * rd * gs1[0], d[5] * rd * gs1[1]); wd.w = pk2(d[6] * rd * gs1[2], d[7] * rd * gs1[3]);
            wf.x = pk2(f[0] * rf * gf0[0], f[1] * rf * gf0[1]); wf.y = pk2(f[2] * rf * gf0[2], f[3] * rf * gf0[3]); wf.z = pk2(f[4] * rf * gf1[0], f[5] * rf * gf1[1]); wf.w = pk2(f[6] * rf * gf1[2], f[7] * rf * gf1[3]);
            bf16* o = MIXA + (size_t)m * D + 8 * lane;
            *(v4u*)o = wd; *(v4u*)(o + 512) = wf;
        }
    }
    SEAM(3);

    if (PH(4)) REPS(4) { pg8::Gemm g{MIXA, Wout_t, M, D, D}; pg8::StaticOrder S; S.init(M, D, G, bx);
        pg8::EpiRes2<true, true> E{XN, H1B, SS1};
        pg8::gemm_phase<pg8::EpiRes2<true, true>, pg8::StaticOrder, true, true>(lds, g, S, E, wave); }
    SEAM(4);

    if (PH(5)) REPS(5) { pg8::Gemm g{H1B, Wcq_t, M, D, D}; pg8::StaticOrder S; S.init(M, D, G, bx);
        build_rstd_tables(lds, S, SS1, EPS, wave);
        pg8::EpiRowScale<0> E{CQ, D, SS1, EPS, pg8::CROSS_C2, (const LAS int*)(lds + RING_BYTES + 1536), (const LAS float*)(lds + RING_BYTES + 2048)};
        pg8::gemm_phase<pg8::EpiRowScale<0>, pg8::StaticOrder, true, true>(lds, g, S, E, wave); }
    SEAM(5);

    if (PH(6)) REPS(6) {
        const int upc = (512 + G - 1) / G;
        for (int u = vcu * upc; u < (vcu + 1) * upc && u < 512; ++u) { const int bh = u >> 4, qblk = u & 15; xattn::unit(bh >> 2, bh & 3, qblk, CQ, CKb, CVT, CO, lds, wave); }
    }
    SEAM(6);

    if (PH(7)) REPS(7) { pg8::Gemm g{CO, Wco_t, M, D, D}; pg8::StaticOrder S; S.init(M, D, G, bx);
        pg8::EpiRes2<true, true> E{H1B, H2B, SS2};
        pg8::gemm_phase<pg8::EpiRes2<true, true>, pg8::StaticOrder, true, true>(lds, g, S, E, wave); }
    SEAM(7);

    if (PH(8)) REPS(8) { pg8::Gemm g{H2B, Wup_t, M, FF, D}; pg8::StaticOrder S; S.init(M, FF, G, bx);
        build_rstd_tables(lds, S, SS2, EPS, wave);
        pg8::EpiRowScale<1> E{ZH, FF, SS2, EPS, 1.f, (const LAS int*)(lds + RING_BYTES + 1536), (const LAS float*)(lds + RING_BYTES + 2048)};
        pg8::gemm_phase<pg8::EpiRowScale<1>, pg8::StaticOrder, true, true>(lds, g, S, E, wave); }
    SEAM(8);

    if (PH(9)) REPS(9) { pg8::Gemm g{ZH, Wdn_t, M, D, FF}; pg8::StaticOrder S; S.init(M, D, G, bx); S.rev = true;
        pg8::EpiRes2<true, true> E{H2B, H1B  , SS3};
        pg8::gemm_phase<pg8::EpiRes2<true, true>, pg8::StaticOrder, true, true>(lds, g, S, E, wave); }
    SEAM(9);

    if (PH(10)) REPS(10) {
        LANE_TID;
        f32x4 gq[4];
#pragma unroll
        for (int j = 0; j < 4; ++j) gq[j] = ((const f32x4*)P.in[I_GFIN])[64 * j + lane];
        const bool xal = (G == 256); const int mstart = xal ? (bx & 7) * SEQ + ((bx >> 3) * NWAVES + wave) * 4 : gw * 4, mstep = xal ? 1024 : NGW * 4, mend = xal ? (bx & 7) * SEQ + SEQ : M;
        for (int m0 = mstart; m0 < mend; m0 += mstep) {
            unsigned long long w[4][4]; float rr[4];
#pragma unroll
            for (int q = 0; q < 4; ++q) { const unsigned long long* hb = (const unsigned long long*)(H1B + (size_t)(m0 + q) * D) + lane;
#pragma unroll
                for (int j = 0; j < 4; ++j) w[q][j] = hb[64 * j];
                rr[q] = pg8::row_rstd(SS3, m0 + q, EPS); }
#pragma unroll
            for (int q = 0; q < 4; ++q) { f32x4* o = (f32x4*)(P.out + (size_t)(m0 + q) * D) + lane;
#pragma unroll
                for (int j = 0; j < 4; ++j) { const unsigned lo = (unsigned)w[q][j], hi2 = (unsigned)(w[q][j] >> 32);
                    const f32x4 v = {bflo(lo), bfhi(lo), bflo(hi2), bfhi(hi2)}; o[64 * j] = v * rr[q] * gq[j]; } }
        }
    }
#undef IN
#undef SEAM
#undef LANE_TID
#undef ROPE
#undef LOGF
#undef KBIAS
#undef NRM
#undef SS1
#undef SS2
#undef SS3
#undef Win_t
#undef Wout_t
#undef Wcq_t
#undef Wckv_t
#undef Wco_t
#undef Wup_t
#undef Wdn_t
#undef MEMN
#undef CKb
#undef CVT
#undef XN
#undef MIXA
#undef CQ
#undef H2B
#undef H1B
#undef CO
#undef PROJ
#undef ATT
#undef ZH
}

extern "C" void kernel_launch(void* const* d_in, const int* in_sizes, int n_in, void* d_out, int out_size, void* d_ws, size_t ws_size, hipStream_t stream) {
    static int grid = 0;
    if (grid == 0) {
        if (n_in != 21 || in_sizes[0] != M * D || out_size != M * D || ws_size < WS_END) { fprintf(stderr, "kernel_launch: unexpected shapes (n_in %d, in0 %d, out %d, ws %zu); nothing launched\n", n_in, n_in > 0 ? in_sizes[0] : -1, out_size, ws_size); grid = -1; return; }
        int dev = 0, cus = 0, per_cu = 0;
        if (hipGetDevice(&dev) != hipSuccess || hipDeviceGetAttribute(&cus, hipDeviceAttributeMultiprocessorCount, dev) != hipSuccess) { grid = -1; return; }
        if (hipFuncSetAttribute((const void*)mk_fwd, hipFuncAttributeMaxDynamicSharedMemorySize, LDS_BYTES) != hipSuccess) { fprintf(stderr, "kernel_launch: hipFuncSetAttribute failed\n"); grid = -1; return; }
        if (hipOccupancyMaxActiveBlocksPerMultiprocessor(&per_cu, (const void*)mk_fwd, NWAVES * 64, LDS_BYTES) != hipSuccess || per_cu < 1) { fprintf(stderr, "kernel_launch: occupancy query says %d blocks per CU\n", per_cu); per_cu = 1; }
        (void)hipGetLastError();
        grid = cus * per_cu;
    }
    if (grid < 0) return;
    if (hipMemsetAsync((char*)d_ws + WS_BAR, 0, XCD_BAR_WORDS * 4, stream) != hipSuccess) { fprintf(stderr, "kernel_launch: memset of the barrier words failed\n"); return; }
    Params p{};
    for (int i = 0; i < 21; ++i) p.in[i] = (const float*)d_in[i];
    p.out = (float*)d_out; p.ws = (unsigned char*)d_ws;
#if MK_PER_PHASE
    for (int ph = 0; ph < N_PHASES; ++ph) { p.ph_lo = ph; p.ph_hi = ph + 1; hipLaunchKernelGGL(mk_fwd, dim3(grid), dim3(NWAVES * 64), LDS_BYTES, stream, p); }
#else
    p.ph_lo = 0; p.ph_hi = N_PHASES;
    void* args[] = {&p};
    const hipError_t e = hipLaunchCooperativeKernel((const void*)mk_fwd, dim3(grid), dim3(NWAVES * 64), args, LDS_BYTES, stream);
    if (e != hipSuccess) fprintf(stderr, "kernel_launch: cooperative launch failed: %s (grid %d)\n", hipGetErrorString(e), grid);
#endif
}
```

```cpp
#include <hip/hip_runtime.h>
#include <hip/hip_cooperative_groups.h>
#include <hip/hip_bf16.h>
#include <cstdio>
#include <cstdint>
#include <cmath>
namespace cg = cooperative_groups;
__device__ __forceinline__ int mk_lane() { int l = (int)__builtin_amdgcn_mbcnt_hi(~0u, __builtin_amdgcn_mbcnt_lo(~0u, 0u)); asm volatile("" : "+v"(l)); return l; }
namespace pg8 {
#define PG8_LAS __attribute__((address_space(3)))
typedef unsigned short bf16_t;
typedef short bf16x8 __attribute__((ext_vector_type(8)));
typedef float f32x4 __attribute__((ext_vector_type(4)));
typedef unsigned u32x4 __attribute__((ext_vector_type(4)));
constexpr int BM = 256, BK = 64, HALF = 128, HTB = HALF * BK * 2  , STAGE_BYTES = 8 * HTB, NXCD = 8, WGM = 8;

__host__ __device__ __forceinline__ int lds_byte(int r, int c) { const int st = (r >> 4) * 2 + (c >> 5), rr = r & 15, cc = c & 31, ob = rr * 64 + cc * 2; return st * 1024 + (ob ^ (((ob >> 9) & 1) << 5)); }
__host__ __device__ __forceinline__ void stage_rc(int b, int& R, int& C) { const int st = b / 1024, sb = b % 1024, swz = sb ^ (((sb >> 9) & 1) << 5); R = (st >> 1) * 16 + swz / 64; C = (st & 1) * 32 + (swz % 64) / 2; }
__host__ __device__ __forceinline__ int perm32(int rho) { const int n = rho >> 4, i = rho & 15; return 8 * (i >> 2) + 4 * n + (i & 3); }

struct Unit { int pm, pn; };
struct Gemm { const bf16_t* A; const bf16_t* Bt; int M, N, K; };

struct StaticOrder {
    int nM, nN, nwg, G, c; bool rev = false;
    __host__ __device__ __forceinline__ void init(int M, int N, int G_, int c_) { nM = M / BM; nN = N / BM; nwg = nM * nN; G = G_; c = c_; }
    __host__ __device__ __forceinline__ bool next(int i, Unit& u) const {
        const long L = (long)i * G + c; if (L >= nwg) return false;
        int wgid = (int)L; { const int q = nwg / NXCD, r = nwg % NXCD, xcd = wgid % NXCD, off = wgid / NXCD; wgid = (xcd < r ? xcd * (q + 1) : r * (q + 1) + (xcd - r) * q) + off; }
        const int nig = WGM * nN, gid = wgid / nig, fm = gid * WGM, gsz = (nM - fm) < WGM ? (nM - fm) : WGM;
        u.pm = fm + ((wgid % nig) % gsz); u.pn = (wgid % nig) / gsz; if (rev) u.pm = nM - 1 - u.pm; return true;
    }
    __device__ __forceinline__ void a_ready(const Unit&) const {}
    __device__ __forceinline__ void done(const Unit&) const {}
};

__device__ __forceinline__ unsigned cvt_pk_bf16(float lo, float hi) { unsigned r; asm volatile("v_cvt_pk_bf16_f32 %0, %1, %2" : "=v"(r) : "v"(lo), "v"(hi)); return r; }
typedef float f32x2 __attribute__((ext_vector_type(2)));
__device__ __forceinline__ f32x2 gelu_pk(f32x2 v) {
    const f32x2 av = __builtin_elementwise_abs(v), d = av * 0.2316418882f + 1.0f;
    f32x2 t; t.x = __builtin_amdgcn_rcpf(d.x); t.y = __builtin_amdgcn_rcpf(d.y);
    f32x2 q = t * 0.5307027145f + (-0.7265760135f); q = q * t + 0.7107068705f; q = q * t + (-0.142248368f); q = q * t + 0.127414796f; q = q * t;
    const f32x2 s = (v * v) * (-0.72134752044f);
    f32x2 e; e.x = __builtin_amdgcn_exp2f(s.x); e.y = __builtin_amdgcn_exp2f(s.y);
    const f32x2 m = v * (q * e), r = v - m;
    f32x2 o; o.x = v.x < 0.f ? m.x : r.x; o.y = v.y < 0.f ? m.y : r.y; return o;
}

template <int ACT  > struct EpiBf16 {
    static constexpr bool PERM = true, AFTER_DRAIN = false; static_assert(ACT == 0 || ACT == 1, "EpiBf16: ACT is 0 (none) or 1 (gelu_pk)");
    bf16_t* O; int ldc; const float* bias; int split_cols; size_t split_stride; float scale0;
    __device__ __forceinline__ void operator()(const f32x4 (&acc)[2][2][4][2], const Unit& u, int wr, int wc, int fr, int fq) const {
        const int row0 = u.pm * BM + wr * 64 + fr; int colt = u.pn * BM; bf16_t* base = O;
        float sc = 1.f; if (split_cols) { const int t = colt / split_cols; base += (size_t)t * split_stride; colt -= t * split_cols; if (t == 0) sc = scale0; }
        const int col0 = colt + wc * 32 + 8 * fq, bcol0 = u.pn * BM + wc * 32 + 8 * fq;
        f32x4 bv[2][2];
#pragma unroll
        for (int bj = 0; bj < 2; ++bj)
#pragma unroll
            for (int n = 0; n < 2; ++n) bv[bj][n] = bias ? *(const f32x4*)(bias + bcol0 + bj * HALF + 4 * n) : (f32x4){0.f, 0.f, 0.f, 0.f};
#pragma unroll
        for (int ai = 0; ai < 2; ++ai)
#pragma unroll
            for (int m = 0; m < 4; ++m) { bf16_t* rowp = base + (size_t)(row0 + ai * HALF + m * 16) * ldc + col0;
#pragma unroll
                for (int bj = 0; bj < 2; ++bj) { f32x4 v0 = acc[ai][bj][m][0] + bv[bj][0], v1 = acc[ai][bj][m][1] + bv[bj][1];
                    if (ACT == 1) { f32x2 a = gelu_pk((f32x2){v0[0], v0[1]}), b = gelu_pk((f32x2){v0[2], v0[3]}), c = gelu_pk((f32x2){v1[0], v1[1]}), d = gelu_pk((f32x2){v1[2], v1[3]});
                        v0 = (f32x4){a.x, a.y, b.x, b.y}; v1 = (f32x4){c.x, c.y, d.x, d.y}; }
                    v0 = v0 * sc; v1 = v1 * sc; u32x4 w; w.x = cvt_pk_bf16(v0[0], v0[1]); w.y = cvt_pk_bf16(v0[2], v0[3]); w.z = cvt_pk_bf16(v1[0], v1[1]); w.w = cvt_pk_bf16(v1[2], v1[3]);
                    *(u32x4*)(rowp + bj * HALF) = w; } }
    }
};

constexpr float QK_C2 = 0.125f * 1.4426950408889634f;
constexpr float CROSS_C2 = 0.0625f * 1.4426950408889634f;
__device__ __forceinline__ float row_rstd(const float* part, int row, float eps) {
    const f32x4* p = (const f32x4*)(part + (size_t)row * 16);
    const f32x4 a = p[0], b = p[1], c = p[2], d = p[3];
    const float s = ((a[0] + a[1]) + (a[2] + a[3])) + ((b[0] + b[1]) + (b[2] + b[3])) + ((c[0] + c[1]) + (c[2] + c[3])) + ((d[0] + d[1]) + (d[2] + d[3]));
    return 1.0f / sqrtf(s * (1.0f / 1024.0f) + eps);
}
struct EpiProj {
    static constexpr bool PERM = true, AFTER_DRAIN = false;
    bf16_t* O; const float* rope; float* nrm; const float* ssp; const PG8_LAS int* pml; const PG8_LAS float* tab;
    __device__ __forceinline__ void operator()(const f32x4 (&acc)[2][2][4][2], const Unit& u, int wr, int wc, int fr, int fq) const {
        const int row0 = u.pm * BM + wr * 64 + fr, col0 = u.pn * BM + wc * 32 + 8 * fq;
        const int typ = u.pn >> 1;
        const float sc = (typ == 0 || typ == 3) ? QK_C2 : 1.f;
        int slot = -1;
        if (tab) { const int n = pml[8]; for (int j = 0; j < n; ++j) if (pml[j] == u.pm) slot = j; }
        const bool ropew = (typ < 2) && ((wc & 1) == 0);
        const bool nrmw = (typ == 0 || typ == 1 || typ == 3 || typ == 4); float mxn[2] = {0.f, 0.f};
#pragma unroll
        for (int ai = 0; ai < 2; ++ai) {
            f32x4 rc[4][4];
            if (ropew) {
#pragma unroll
                for (int m = 0; m < 4; ++m) { const f32x4* rp = (const f32x4*)(rope + (size_t)((row0 + ai * HALF + m * 16) & 4095) * 16); rc[m][0] = rp[0]; rc[m][1] = rp[1]; rc[m][2] = rp[2]; rc[m][3] = rp[3]; }
            }
#pragma unroll
            for (int m = 0; m < 4; ++m) {
                const int row = row0 + ai * HALF + m * 16;
                bf16_t* rowp = O + (size_t)row * 3072 + col0;
                const float scr = sc * (slot >= 0 ? tab[slot * 256 + (row - u.pm * BM)] : row_rstd(ssp, row, 1e-6f));
                f32x4 c0 = {1.f, 1.f, 1.f, 1.f}, c1 = c0, s0 = {0.f, 0.f, 0.f, 0.f}, s1 = s0;
                if (ropew) { c0 = rc[m][0]; c1 = rc[m][1]; s0 = rc[m][2]; s1 = rc[m][3]; if (fq == 0) { s0 = -s0; s1 = -s1; } if (fq >= 2) { c0 = (f32x4){1.f, 1.f, 1.f, 1.f}; c1 = c0; s0 = (f32x4){0.f, 0.f, 0.f, 0.f}; s1 = s0; } }
#pragma unroll
                for (int bj = 0; bj < 2; ++bj) {
                    f32x4 v0 = acc[ai][bj][m][0], v1 = acc[ai][bj][m][1];
                    if (ropew) {
                        f32x4 p0, p1;
#pragma unroll
                        for (int e = 0; e < 4; ++e) { p0[e] = __shfl_xor(v0[e], 16); p1[e] = __shfl_xor(v1[e], 16); }
                        v0 = v0 * c0 + p0 * s0; v1 = v1 * c1 + p1 * s1;
                    }
                    v0 = v0 * scr; v1 = v1 * scr;
                    if (nrmw) { float q = (v0[0] * v0[0] + v0[1] * v0[1]) + (v0[2] * v0[2] + v0[3] * v0[3]) + (v1[0] * v1[0] + v1[1] * v1[1]) + (v1[2] * v1[2] + v1[3] * v1[3]);
                        q += __shfl_xor(q, 16); q += __shfl_xor(q, 32); mxn[bj] = fmaxf(mxn[bj], q); }
                    u32x4 w; w.x = cvt_pk_bf16(v0[0], v0[1]); w.y = cvt_pk_bf16(v0[2], v0[3]); w.z = cvt_pk_bf16(v1[0], v1[1]); w.w = cvt_pk_bf16(v1[2], v1[3]);
                    *(u32x4*)(rowp + bj * HALF) = w;
                }
            }
        }
        if (nrmw) {
#pragma unroll
            for (int bj = 0; bj < 2; ++bj) { float q = mxn[bj];
                q = fmaxf(q, __shfl_xor(q, 1)); q = fmaxf(q, __shfl_xor(q, 2)); q = fmaxf(q, __shfl_xor(q, 4)); q = fmaxf(q, __shfl_xor(q, 8));
                const int rel = 256 * (u.pn & 1) + 128 * bj + 32 * wc, b = (u.pm * BM) >> 12;
                if (fr == 0 && fq == 0) atomicMax((unsigned*)nrm + (typ < 2 ? 256 : 0) + ((b * 2 + ((typ == 1 || typ == 4) ? 1 : 0)) * 8 + (rel >> 6)) * 2 + ((rel >> 5) & 1), __float_as_uint(q * 1.02f)); }
        }
    }
};
template <bool BASE_BF16, bool OUT_BF16> struct EpiRes2 {
    static constexpr bool PERM = true, AFTER_DRAIN = false;
    const void* base; void* out; float* sspart;
    __device__ __forceinline__ void operator()(const f32x4 (&acc)[2][2][4][2], const Unit& u, int wr, int wc, int fr, int fq) const {
        const int row0 = u.pm * BM + wr * 64 + fr, col0 = u.pn * BM + wc * 32 + 8 * fq;
#pragma unroll
        for (int ai = 0; ai < 2; ++ai) {
            u32x4 bw[4][2]; f32x4 bf[4][2][2];
#pragma unroll
            for (int m = 0; m < 4; ++m)
#pragma unroll
                for (int bj = 0; bj < 2; ++bj) { const size_t off = (size_t)(row0 + ai * HALF + m * 16) * 1024 + col0 + bj * HALF;
                    if (BASE_BF16) bw[m][bj] = *(const u32x4*)((const bf16_t*)base + off);
                    else { bf[m][bj][0] = *(const f32x4*)((const float*)base + off); bf[m][bj][1] = *(const f32x4*)((const float*)base + off + 4); } }
#pragma unroll
            for (int m = 0; m < 4; ++m) {
                const int row = row0 + ai * HALF + m * 16; const size_t off = (size_t)row * 1024 + col0;
                float ss = 0.f;
#pragma unroll
                for (int bj = 0; bj < 2; ++bj) {
                    f32x4 b0, b1;
                    if (BASE_BF16) { const u32x4 w = bw[m][bj];
                        b0 = (f32x4){__builtin_bit_cast(float, w.x << 16), __builtin_bit_cast(float, w.x & 0xffff0000u), __builtin_bit_cast(float, w.y << 16), __builtin_bit_cast(float, w.y & 0xffff0000u)};
                        b1 = (f32x4){__builtin_bit_cast(float, w.z << 16), __builtin_bit_cast(float, w.z & 0xffff0000u), __builtin_bit_cast(float, w.w << 16), __builtin_bit_cast(float, w.w & 0xffff0000u)}; }
                    else { b0 = bf[m][bj][0]; b1 = bf[m][bj][1]; }
                    const f32x4 v0 = acc[ai][bj][m][0] + b0, v1 = acc[ai][bj][m][1] + b1;
                    ss += (v0[0] * v0[0] + v0[1] * v0[1]) + (v0[2] * v0[2] + v0[3] * v0[3]) + (v1[0] * v1[0] + v1[1] * v1[1]) + (v1[2] * v1[2] + v1[3] * v1[3]);
                    if (OUT_BF16) { u32x4 w; w.x = cvt_pk_bf16(v0[0], v0[1]); w.y = cvt_pk_bf16(v0[2], v0[3]); w.z = cvt_pk_bf16(v1[0], v1[1]); w.w = cvt_pk_bf16(v1[2], v1[3]);
                        *(u32x4*)((bf16_t*)out + off + bj * HALF) = w; }
                    else { *(f32x4*)((float*)out + off + bj * HALF) = v0; *(f32x4*)((float*)out + off + bj * HALF + 4) = v1; }
                }
                ss += __shfl_xor(ss, 16); ss += __shfl_xor(ss, 32);
                if (fq == 0) sspart[(size_t)row * 16 + u.pn * 4 + wc] = ss;
            }
        }
    }
};
template <int ACT> struct EpiRowScale {
    static constexpr bool PERM = true, AFTER_DRAIN = false;
    bf16_t* O; int ldc; const float* sspart; float eps; float sc;
    const PG8_LAS int* pml; const PG8_LAS float* tab;
    __device__ __forceinline__ void operator()(const f32x4 (&acc)[2][2][4][2], const Unit& u, int wr, int wc, int fr, int fq) const {
        const int row0 = u.pm * BM + wr * 64 + fr, col0 = u.pn * BM + wc * 32 + 8 * fq;
        int slot = -1;
        if (tab) { const int n = pml[8]; for (int j = 0; j < n; ++j) if (pml[j] == u.pm) slot = j; }
#pragma unroll
        for (int ai = 0; ai < 2; ++ai)
#pragma unroll
            for (int m = 0; m < 4; ++m) {
                const int row = row0 + ai * HALF + m * 16; bf16_t* rowp = O + (size_t)row * ldc + col0;
                const float r = (slot >= 0 ? tab[slot * 256 + (row - u.pm * BM)] : row_rstd(sspart, row, eps)) * sc;
#pragma unroll
                for (int bj = 0; bj < 2; ++bj) {
                    f32x4 v0 = acc[ai][bj][m][0] * r, v1 = acc[ai][bj][m][1] * r;
                    if (ACT == 1) {
#pragma unroll
                        for (int e = 0; e < 4; ++e) { const float a = fmaxf(v0[e], 0.f), b = fmaxf(v1[e], 0.f); v0[e] = a * a; v1[e] = b * b; }
                    }
                    u32x4 w; w.x = cvt_pk_bf16(v0[0], v0[1]); w.y = cvt_pk_bf16(v0[2], v0[3]); w.z = cvt_pk_bf16(v1[0], v1[1]); w.w = cvt_pk_bf16(v1[2], v1[3]);
                    *(u32x4*)(rowp + bj * HALF) = w;
                }
            }
    }
};
template <class Epi, class Sched, bool ALIGN_EPI = false, bool SP2 = false>
__device__ __forceinline__ void gemm_phase(PG8_LAS unsigned char* lds, const Gemm g, const Sched& S, const Epi& E, const int wv  ) {
    int tid_ = wv * 64 + mk_lane();
    const int tid = tid_, wid = __builtin_amdgcn_readfirstlane(tid >> 6), lane = tid & 63, wr = wid >> 2, wc = wid & 3, fr = lane & 15, fq = lane >> 4;
    const int K = g.K, nt = K / BK;
    unsigned voffA[2], voffB[2];
#pragma unroll
    for (int i = 0; i < 2; ++i) { int R, C; stage_rc(tid * 16 + i * 8192, R, C); const int Rb = Epi::PERM ? ((R & ~31) + perm32(R & 31)) : R;
        voffA[i] = (unsigned)(R * K + C) * 2u; voffB[i] = (unsigned)(Rb * K + C) * 2u; }
    const size_t kstep = (size_t)(BK * 2);
    const size_t hstep = (size_t)HALF * K * 2;
    const size_t tstep = 2 * hstep;
    const unsigned ldsw = (unsigned)wid * 1024u;
    const int aoff = lds_byte(wr * 64 + fr, fq * 8), boff = lds_byte(wc * 32 + fr, fq * 8);
#define PG8_SA(b, h) (((b) * 2 + (h)) * HTB)
#define PG8_SB(b, h) ((4 + (b) * 2 + (h)) * HTB)
#define PG8_STAGE(bufoff, gbase, voff) do { _Pragma("unroll") for (int _i = 0; _i < 2; ++_i) \
        __builtin_amdgcn_global_load_lds((const unsigned*)((const char*)(gbase) + (voff)[_i]), (PG8_LAS unsigned*)(lds + (bufoff) + ldsw + _i * 8192), 16, 0, 0); } while (0)
#define PG8_LDA(dst, b, h) do { _Pragma("unroll") for (int m = 0; m < 4; ++m) _Pragma("unroll") for (int k = 0; k < 2; ++k) dst[m][k] = *(const PG8_LAS bf16x8*)(lds + PG8_SA(b, h) + aoff + m * 2048 + k * 1024); } while (0)
#define PG8_LDB(dst, b, h) do { _Pragma("unroll") for (int n = 0; n < 2; ++n) _Pragma("unroll") for (int k = 0; k < 2; ++k) dst[n][k] = *(const PG8_LAS bf16x8*)(lds + PG8_SB(b, h) + boff + n * 2048 + k * 1024); } while (0)
#define PG8_MMA(ai, bj, At, Bt) do { __builtin_amdgcn_s_setprio(1); _Pragma("unroll") for (int m = 0; m < 4; ++m) _Pragma("unroll") for (int n = 0; n < 2; ++n) _Pragma("unroll") for (int k = 0; k < 2; ++k) \
        acc[ai][bj][m][n] = __builtin_amdgcn_mfma_f32_16x16x32_bf16(Bt[n][k], At[m][k], acc[ai][bj][m][n], 0, 0, 0); __builtin_amdgcn_s_setprio(0); } while (0)
#define PG8_WAIT_V(n) asm volatile("s_waitcnt vmcnt(" #n ")" ::: "memory")
#define PG8_WAIT_L(n) asm volatile("s_waitcnt lgkmcnt(" #n ")" ::: "memory")
#define PG8_BAR __builtin_amdgcn_s_barrier()
#define PG8_SCHED __builtin_amdgcn_sched_barrier(0)
    Unit cur, nxt; int ui = 0;
    if (!S.next(0, cur)) return;
    f32x4 acc[2][2][4][2];
#pragma unroll
    for (int a = 0; a < 2; ++a)
#pragma unroll
        for (int b = 0; b < 2; ++b)
#pragma unroll
            for (int m = 0; m < 4; ++m)
#pragma unroll
                for (int n = 0; n < 2; ++n) acc[a][b][m][n] = (f32x4){0.f, 0.f, 0.f, 0.f};
    bf16x8 At[4][2], B0[2][2], B1[2][2];
    const char* cA = (const char*)g.A + (size_t)cur.pm * tstep; const char* cB = (const char*)g.Bt + (size_t)cur.pn * tstep;
    S.a_ready(cur);
    if constexpr (SP2) {
        PG8_STAGE(PG8_SB(0, 0), cB, voffB); PG8_STAGE(PG8_SB(0, 1), cB + hstep, voffB); PG8_STAGE(PG8_SA(0, 0), cA, voffA); PG8_STAGE(PG8_SA(0, 1), cA + hstep, voffA);
        if (wr == 1) PG8_BAR;
        PG8_WAIT_V(2); PG8_BAR;
        PG8_STAGE(PG8_SB(1, 0), cB + kstep, voffB); PG8_STAGE(PG8_SA(1, 0), cA + kstep, voffA); PG8_STAGE(PG8_SB(1, 1), cB + hstep + kstep, voffB);
        PG8_WAIT_V(6); PG8_BAR;
    } else {
        PG8_STAGE(PG8_SB(0, 0), cB, voffB); PG8_STAGE(PG8_SA(0, 0), cA, voffA); PG8_STAGE(PG8_SB(0, 1), cB + hstep, voffB); PG8_STAGE(PG8_SA(0, 1), cA + hstep, voffA);
        if (wr == 1) PG8_BAR;
        PG8_WAIT_V(4); PG8_BAR;
        PG8_STAGE(PG8_SB(1, 0), cB + kstep, voffB); PG8_STAGE(PG8_SA(1, 0), cA + kstep, voffA); PG8_STAGE(PG8_SB(1, 1), cB + hstep + kstep, voffB);
        PG8_WAIT_V(6); PG8_BAR;
    }
    for (;;) {
        const bool has_next = S.next(ui + 1, nxt);
        const char* nA = has_next ? (const char*)g.A + (size_t)nxt.pm * tstep : cA; const char* nB = has_next ? (const char*)g.Bt + (size_t)nxt.pn * tstep : cB;
        for (int t = 0; t < nt; t += 2) {
            const bool last = (t == nt - 2);
            const char* a1 = cA + (size_t)(t + 1) * kstep;
            const char* a2 = last ? nA : cA + (size_t)(t + 2) * kstep; const char* b2 = last ? nB : cB + (size_t)(t + 2) * kstep;
            const char* a3 = a2 + kstep; const char* b3 = b2 + kstep;
            if (last && has_next) S.a_ready(nxt);
            if constexpr (SP2) {
            PG8_LDB(B0, 0, 0); PG8_LDB(B1, 0, 1); PG8_SCHED; PG8_LDA(At, 0, 0); PG8_STAGE(PG8_SA(1, 1), a1 + hstep, voffA);
            PG8_WAIT_V(8); PG8_WAIT_L(0); PG8_BAR; PG8_MMA(0, 0, At, B0); PG8_MMA(0, 1, At, B1); PG8_BAR; PG8_SCHED;
            PG8_LDA(At, 0, 1); PG8_STAGE(PG8_SB(0, 0), b2, voffB); PG8_STAGE(PG8_SB(0, 1), b2 + hstep, voffB); PG8_STAGE(PG8_SA(0, 0), a2, voffA);
            PG8_WAIT_V(8); PG8_WAIT_L(0); PG8_BAR; PG8_MMA(1, 0, At, B0); PG8_MMA(1, 1, At, B1); PG8_BAR; PG8_SCHED;
            PG8_LDB(B0, 1, 0); PG8_LDB(B1, 1, 1); PG8_SCHED; PG8_LDA(At, 1, 0); PG8_STAGE(PG8_SA(0, 1), a2 + hstep, voffA);
            PG8_WAIT_V(8); PG8_WAIT_L(0); PG8_BAR; PG8_MMA(0, 0, At, B0); PG8_MMA(0, 1, At, B1); PG8_BAR; PG8_SCHED;
            PG8_LDA(At, 1, 1); PG8_STAGE(PG8_SB(1, 0), b3, voffB); PG8_STAGE(PG8_SB(1, 1), b3 + hstep, voffB); PG8_STAGE(PG8_SA(1, 0), a3, voffA);
            PG8_WAIT_V(8); PG8_WAIT_L(0); PG8_BAR; PG8_MMA(1, 0, At, B0); PG8_MMA(1, 1, At, B1); PG8_BAR; PG8_SCHED;
            } else {
            PG8_LDB(B0, 0, 0); PG8_SCHED; PG8_LDA(At, 0, 0); PG8_STAGE(PG8_SA(1, 1), a1 + hstep, voffA);
            PG8_WAIT_L(8); PG8_BAR; PG8_WAIT_L(0); PG8_MMA(0, 0, At, B0); PG8_BAR; PG8_SCHED;
            PG8_LDB(B1, 0, 1); PG8_STAGE(PG8_SB(0, 0), b2, voffB);
            PG8_BAR; PG8_WAIT_L(0); PG8_MMA(0, 1, At, B1); PG8_BAR;
            PG8_LDA(At, 0, 1); PG8_STAGE(PG8_SA(0, 0), a2, voffA);
            PG8_BAR; PG8_WAIT_L(0); PG8_MMA(1, 0, At, B0); PG8_BAR; PG8_SCHED;
            PG8_STAGE(PG8_SB(0, 1), b2 + hstep, voffB);
            PG8_WAIT_V(6); PG8_BAR; PG8_MMA(1, 1, At, B1); PG8_BAR;
            PG8_LDB(B0, 1, 0); PG8_SCHED; PG8_LDA(At, 1, 0); PG8_STAGE(PG8_SA(0, 1), a2 + hstep, voffA);
            PG8_WAIT_L(8); PG8_BAR; PG8_WAIT_L(0); PG8_MMA(0, 0, At, B0); PG8_BAR; PG8_SCHED;
            PG8_LDB(B1, 1, 1); PG8_STAGE(PG8_SB(1, 0), b3, voffB);
            PG8_BAR; PG8_WAIT_L(0); PG8_MMA(0, 1, At, B1); PG8_BAR;
            PG8_LDA(At, 1, 1); PG8_STAGE(PG8_SA(1, 0), a3, voffA);
            PG8_BAR; PG8_WAIT_L(0); PG8_MMA(1, 0, At, B0); PG8_BAR; PG8_SCHED;
            PG8_STAGE(PG8_SB(1, 1), b3 + hstep, voffB);
            PG8_WAIT_V(6); PG8_BAR; PG8_MMA(1, 1, At, B1); PG8_BAR;
            }
        }
        if constexpr (ALIGN_EPI) { if (wr == 0) PG8_BAR; }
        if constexpr (!Epi::AFTER_DRAIN) { E(acc, cur, wr, wc, fr, fq); S.done(cur); }
        if (!has_next) break;
#pragma unroll
        for (int a = 0; a < 2; ++a)
#pragma unroll
            for (int b = 0; b < 2; ++b)
#pragma unroll
                for (int m = 0; m < 4; ++m)
#pragma unroll
                    for (int n = 0; n < 2; ++n) acc[a][b][m][n] = (f32x4){0.f, 0.f, 0.f, 0.f};
        cur = nxt; cA = nA; cB = nB; ++ui;
        if constexpr (ALIGN_EPI) { if (wr == 1) PG8_BAR; }
    }
    PG8_WAIT_V(0);
    if constexpr (!ALIGN_EPI) { if (wr == 0) PG8_BAR; }
    PG8_BAR;
    if constexpr (Epi::AFTER_DRAIN) { E.fused(acc, cur, wr, wc, fr, fq, lds, wid, lane); S.done(cur); }
#undef PG8_SA
#undef PG8_SB
#undef PG8_STAGE
#undef PG8_LDA
#undef PG8_LDB
#undef PG8_MMA
#undef PG8_WAIT_V
#undef PG8_WAIT_L
#undef PG8_BAR
#undef PG8_SCHED
}
}

#ifndef PG8_SP2
#define PG8_SP2 true
#endif
#ifndef PG8_ALIGN
#define PG8_ALIGN true
#endif
namespace attn_body {
using bf16=__hip_bfloat16;
using bf16x8=__attribute__((ext_vector_type(8)))short;
using s16x4=__attribute__((ext_vector_type(4)))short;
using f32x16=__attribute__((ext_vector_type(16)))float;
using u32x4=__attribute__((ext_vector_type(4)))unsigned; using f32x4=__attribute__((ext_vector_type(4)))float;
constexpr int SEQ=4096,D=64,PQ=3072,PO=1536;
constexpr int NW=8,QBLK=32,QB=QBLK*NW,KVBLK=64,NQB=SEQ/QB;
constexpr int ATTN_UNIT_ROWS=QB;
__device__ __forceinline__ int crow(int r,int hi){return (r&3)+8*(r>>2)+4*hi;}
#define SBAR() __builtin_amdgcn_sched_barrier(0)
__device__ __forceinline__ void cmask(f32x16&p0,f32x16&p1,int jb,int qrel,int hi){
  const float NEG=-INFINITY; int kb=64*jb+4*hi;
  #pragma unroll
  for(int r=0;r<16;++r){int kv=kb+(r&3)+8*(r>>2); if(kv>qrel)p0[r]=NEG; if(kv+32>qrel)p1[r]=NEG;}
}

template<bool B> __device__ __forceinline__ const f32x16& csel(const f32x16&a,const f32x16&b){ if constexpr(B) return a; else return b; }
constexpr int NSLOT=3, SLOTB=8192;
constexpr int LDS_K=0, LDS_V=NSLOT*SLOTB, LDS_WS=2*NSLOT*SLOTB, LDS_OST=LDS_WS+NW*64*4, LDS_KBIAS=LDS_OST+NW*4096, LDS_BYTES=LDS_KBIAS+SEQ*4;
constexpr float C2=0.125f*1.4426950408889634f;
__device__ __forceinline__ void glds16(const void*gsrc,unsigned lds_dst){unsigned keep;
  asm volatile("s_mov_b32 %0, m0\n\ts_mov_b32 m0, %2\n\ts_nop 0\n\tglobal_load_lds_dwordx4 %1, off\n\ts_mov_b32 m0, %0":"=&s"(keep):"v"(gsrc),"s"(lds_dst):"memory");}
__device__ __forceinline__ float max3f(float a,float b,float c){float r;asm("v_max3_f32 %0, %1, %2, %3":"=v"(r):"v"(a),"v"(b),"v"(c));return r;}
__device__ __forceinline__ float max2f(float a,float b){float r;asm("v_max_f32_e32 %0, %1, %2":"=v"(r):"v"(a),"v"(b));return r;}
__device__ __forceinline__ float fadd_s(float a,float b){float r;asm("v_add_f32_e32 %0, %1, %2":"=v"(r):"v"(a),"v"(b));return r;}
__device__ __forceinline__ float fsub_s(float a,float b){float r;asm("v_sub_f32_e32 %0, %1, %2":"=v"(r):"v"(a),"v"(b));return r;}
typedef float f32x2_t __attribute__((ext_vector_type(2))); typedef __bf16 bf16x2_t __attribute__((ext_vector_type(2)));
__device__ __forceinline__ unsigned cvtpk_s(float lo,float hi){f32x2_t v={lo,hi};bf16x2_t b=__builtin_convertvector(v,bf16x2_t);return __builtin_bit_cast(unsigned,b);}
#define WAIT_BAR(N) asm volatile("s_waitcnt vmcnt(" #N ") lgkmcnt(0)\n\ts_barrier":::"memory")

__device__ __forceinline__ void qkt(f32x16&p0,f32x16&p1,const char*Kslot,const bf16x8*qr,const f32x16&ci0,const f32x16&ci1,int r32,int hi){
  const char*kb=Kslot+hi*1024+r32*16;
  #pragma unroll
  for(int d0=0;d0<4;++d0){
    const bf16x8 b0=*reinterpret_cast<const bf16x8*>(kb+d0*2048);
    const bf16x8 b1=*reinterpret_cast<const bf16x8*>(kb+d0*2048+512);
    if(d0==0){p0=__builtin_amdgcn_mfma_f32_32x32x16_bf16(b0,qr[0],ci0,0,0,0);p1=__builtin_amdgcn_mfma_f32_32x32x16_bf16(b1,qr[0],ci1,0,0,0);}
    else{p0=__builtin_amdgcn_mfma_f32_32x32x16_bf16(b0,qr[d0],p0,0,0,0);p1=__builtin_amdgcn_mfma_f32_32x32x16_bf16(b1,qr[d0],p1,0,0,0);}}
}
typedef __attribute__((address_space(3))) const char* lds_cptr;
typedef short v4i16_t __attribute__((ext_vector_type(4)));
__device__ __forceinline__ void kload8(bf16x8*kf,lds_cptr kp){
  kf[0]=*(const __attribute__((address_space(3))) bf16x8*)(kp);      kf[1]=*(const __attribute__((address_space(3))) bf16x8*)(kp+512);
  kf[2]=*(const __attribute__((address_space(3))) bf16x8*)(kp+2048); kf[3]=*(const __attribute__((address_space(3))) bf16x8*)(kp+2560);
  kf[4]=*(const __attribute__((address_space(3))) bf16x8*)(kp+4096); kf[5]=*(const __attribute__((address_space(3))) bf16x8*)(kp+4608);
  kf[6]=*(const __attribute__((address_space(3))) bf16x8*)(kp+6144); kf[7]=*(const __attribute__((address_space(3))) bf16x8*)(kp+6656);
}
__device__ __forceinline__ void kload2(bf16x8*kf,lds_cptr kp,int j){ kf[2*j]=*(const __attribute__((address_space(3))) bf16x8*)(kp+j*2048); kf[2*j+1]=*(const __attribute__((address_space(3))) bf16x8*)(kp+j*2048+512); }
__device__ __forceinline__ s16x4 vtr(lds_cptr p){ return __builtin_bit_cast(s16x4,__builtin_amdgcn_ds_read_tr16_b64_v4i16((__attribute__((address_space(3))) v4i16_t*)p)); }
__device__ __forceinline__ float rowmax(const f32x16&p0,const f32x16&p1){
  float a=max3f(p0[0],p0[1],p1[0]),b=max3f(p0[2],p0[3],p1[1]);a=max3f(a,p1[2],p1[3]);
  #pragma unroll
  for(int r=4;r<16;r+=4){a=max3f(a,p0[r],p0[r+1]);b=max3f(b,p0[r+2],p0[r+3]);a=max3f(a,p1[r],p1[r+1]);b=max3f(b,p1[r+2],p1[r+3]);}
  const float m=max2f(a,b);
  auto rr=__builtin_amdgcn_permlane32_swap(__float_as_uint(m),__float_as_uint(m),false,false);
  return max2f(__uint_as_float(rr[0]),__uint_as_float(rr[1]));
}
__device__ __forceinline__ void pv(f32x16*o,int vb,bf16x8 pa0,bf16x8 pa1,bf16x8 pa2,bf16x8 pa3){
  #pragma unroll
  for(int d0=0;d0<2;++d0){s16x4 lo[4],hi[4];
    #pragma unroll
    for(int ks=0;ks<4;++ks){
      asm volatile("ds_read_b64_tr_b16 %0,%1 offset:%c2":"=&v"(lo[ks]):"v"(vb),"i"(d0*4096+ks*1024):"memory");
      asm volatile("ds_read_b64_tr_b16 %0,%1 offset:%c2":"=&v"(hi[ks]):"v"(vb),"i"(d0*4096+ks*1024+512):"memory");}
    asm volatile("s_waitcnt lgkmcnt(0)":::"memory");SBAR();
    #define PK(k) (bf16x8){lo[k][0],lo[k][1],lo[k][2],lo[k][3],hi[k][0],hi[k][1],hi[k][2],hi[k][3]}
    o[d0]=__builtin_amdgcn_mfma_f32_32x32x16_bf16(pa0,PK(0),o[d0],0,0,0);
    o[d0]=__builtin_amdgcn_mfma_f32_32x32x16_bf16(pa1,PK(1),o[d0],0,0,0);
    o[d0]=__builtin_amdgcn_mfma_f32_32x32x16_bf16(pa2,PK(2),o[d0],0,0,0);
    o[d0]=__builtin_amdgcn_mfma_f32_32x32x16_bf16(pa3,PK(3),o[d0],0,0,0);
    #undef PK
  }
}

#ifndef ATTN_STORE16
#define ATTN_STORE16(p,v) (*(u32x4*)(p)=(v))
#endif
template<int THRL,bool HASB> __device__ __forceinline__ void attn_unit(int b,int qb,const bf16*Qc,const bf16*__restrict__ Kc,const bf16*__restrict__ Vc,bf16*Oc,const float*__restrict__ kbg,int t0,char*shm,const int wv){
  int tid_=wv*64+mk_lane();
  const int tid=tid_,lane=tid&63,r32=lane&31,hi=lane>>5; const int wid=__builtin_amdgcn_readfirstlane(tid>>6);
  const long rowbase=(long)b*SEQ; const int q0=qb*QB;
  const bf16*Qw=Qc+(rowbase+q0+wid*QBLK)*PQ;
  const bf16*Kh=Kc+(rowbase+(long)t0*KVBLK)*PQ,*Vh=Vc+(rowbase+(long)t0*KVBLK)*PQ;
  const unsigned lds0=(unsigned)(uintptr_t)shm;
  float*wsf=(float*)(shm+LDS_WS)+wid*64;
  const bf16*ksrc=Kh+(long)lane*PQ+wid*8;
  const bf16*vsrc=Vh+(long)(16*(wid&3)+(lane>>2))*PQ+(wid>>2)*32+(lane&3)*8;
  const unsigned kdst=lds0+LDS_K+wid*1024, vdst=lds0+LDS_V+wid*1024;
  #define DMA_K(t,slot) glds16(ksrc+(long)(t)*KVBLK*PQ,(unsigned)__builtin_amdgcn_readfirstlane(kdst+(slot)))
  #define DMA_V(t,slot) glds16(vsrc+(long)(t)*KVBLK*PQ,(unsigned)__builtin_amdgcn_readfirstlane(vdst+(slot)))
  const int vb0=(int)(lds0+LDS_V)+((lane>>4)&1)*32+(lane&3)*8+(4*hi+((lane&15)>>2))*64;
  const char*Kbase=shm+LDS_K; bf16x8 kf[8];
  const lds_cptr shm3=(lds_cptr)shm; const lds_cptr kp0=shm3+LDS_K+hi*1024+r32*16; const lds_cptr vp0=shm3+LDS_V+((lane>>4)&1)*32+(lane&3)*8+(4*hi+((lane&15)>>2))*64;
  const int NT=(q0+QB)/KVBLK-t0;
  typedef __attribute__((address_space(3))) const f32x4 lds_cf4; typedef __attribute__((address_space(3))) f32x4 lds_f4;
  const __attribute__((address_space(3))) char* kbl=(const __attribute__((address_space(3))) char*)shm+LDS_KBIAS+hi*16;
  DMA_K(0,0);DMA_V(0,0);DMA_K(1,SLOTB);
  bf16x8 qr[4];
  #pragma unroll
  for(int d0=0;d0<4;++d0)qr[d0]=*reinterpret_cast<const bf16x8*>(&Qw[(long)r32*PQ+d0*16+hi*8]);
  float mhat=0.f,l_reg=0.f;f32x16 o[2];o[0]=f32x16{};o[1]=f32x16{};f32x16 negm=f32x16{};asm volatile("":"+v"(negm));
  const int qrel=wid*QBLK+r32;
  float mref=0.f;
  #define CINIT(C0,C1,t) do{ if(HASB){ const __attribute__((address_space(3))) char* kp_=kbl+(t)*256; \
      _Pragma("unroll") for(int g_=0;g_<4;++g_){ const f32x4 a_=*(lds_cf4*)(kp_+g_*32), b_=*(lds_cf4*)(kp_+128+g_*32); \
        _Pragma("unroll") for(int e_=0;e_<4;++e_){ C0[4*g_+e_]=a_[e_]-mhat; C1[4*g_+e_]=b_[e_]-mhat; } } } \
    }while(0)
  #define CMASK(P0,P1,t) do{int jb_=(t)-(NT-4); if(jb_>=0)cmask(P0,P1,jb_,qrel,hi);}while(0)
  bool resc=false;
  #define START(P0,P1) do{ const float rm=rowmax(P0,P1); resc=false; \
    { const float dl=HASB?__builtin_fmaxf(rm,0.f):rm; mhat=fadd_s(mhat,dl); \
      _Pragma("unroll") for(int r=0;r<16;++r){P0[r]=fsub_s(P0[r],dl);P1[r]=fsub_s(P1[r],dl);} \
      if(!HASB){ _Pragma("unroll") for(int r=0;r<16;++r)negm[r]=-mhat; asm volatile("":"+v"(negm)); } } \
    _Pragma("unroll") for(int r=0;r<16;++r)P0[r]=__builtin_amdgcn_exp2f(P0[r]); }while(0)
  #define RESC() do{ if(resc){ asm volatile("s_waitcnt lgkmcnt(0)":::"memory"); \
      _Pragma("unroll") for(int d_=0;d_<2;++d_) _Pragma("unroll") for(int r=0;r<16;++r)o[d_][r]*=wsf[crow(r,hi)]; } }while(0)
  f32x16 pA0,pA1,pB0,pB1;
  int sl_prev=0,sl_cur=0,sl_next=SLOTB;
  #define ROT() do{sl_prev=sl_cur;sl_cur=sl_next;sl_next=(sl_next==(NSLOT-1)*SLOTB)?0:sl_next+SLOTB;}while(0)
  DMA_K(2,2*SLOTB);
  if(HASB){ const int n4=(q0+QB-t0*KVBLK)/4; for(int i=tid;i<n4;i+=NW*64){ const f32x4 v=*(const f32x4*)(kbg+t0*KVBLK+4*i); *((lds_f4*)((__attribute__((address_space(3))) char*)shm+LDS_KBIAS)+i)=v; } }
  WAIT_BAR(3);
  if(HASB){ mref=*(const __attribute__((address_space(3))) float*)((const __attribute__((address_space(3))) char*)shm+LDS_KBIAS+(q0-t0*KVBLK+qrel)*4); mhat=mref; }
  { f32x16 ci0=f32x16{},ci1=f32x16{}; CINIT(ci0,ci1,0); qkt(pA0,pA1,Kbase,qr,csel<HASB>(ci0,negm),csel<HASB>(ci1,negm),r32,hi); } asm volatile("s_nop 15\n\ts_nop 7":"+v"(pA0),"+v"(pA1));CMASK(pA0,pA1,0);
  START(pA0,pA1);
  _Pragma("unroll") for(int r=0;r<16;++r)pA1[r]=__builtin_amdgcn_exp2f(pA1[r]);
  WAIT_BAR(0);
  DMA_K(3,0);DMA_V(1,SLOTB);
  ROT();
  kload8(kf,kp0+sl_cur);
  WAIT_BAR(2);
  s16x4 vlo[8],vhi[8]; u32x4 pw0,pw1,pw2,pw3;
  #define PKW(P,B) cvtpk_s(P[B],P[B+1])
  #define PAF(k) __builtin_bit_cast(bf16x8,pw##k)
  #define VFR(i) (bf16x8){vlo[i][0],vlo[i][1],vlo[i][2],vlo[i][3],vhi[i][0],vhi[i][1],vhi[i][2],vhi[i][3]}
  #define PIN(x) asm volatile("":"+v"(x))
  #define MX3(a,b,c) __builtin_fmaxf(__builtin_fmaxf((a),(b)),(c))
  #define GAPA(MF,A0,A1,A2,A3,W0,W1,PW) do{ MF; sacc+=A0; sacc+=A1; sacc+=A2; sacc+=A3; PIN(sacc); W0; W1; PIN(PW); SBAR(); }while(0)
  #define EX(v) __builtin_amdgcn_exp2f(v)
  #define GAPB(MF,X,B,Y) do{ MF; X[B]=EX(X[B]); X[B+1]=EX(X[B+1]); X[B+2]=EX(X[B+2]); X[B+3]=EX(X[B+3]); PIN(X); if(HASB){ Y[B]-=mhat; Y[B+1]-=mhat; Y[B+2]-=mhat; Y[B+3]-=mhat; PIN(Y); } SBAR(); }while(0)
  #define LOADB(Y0,Y1,t) do{ if(HASB){ const __attribute__((address_space(3))) char* kp_=kbl+(t)*256; \
      _Pragma("unroll") for(int g_=0;g_<4;++g_){ const f32x4 a_=*(lds_cf4*)(kp_+g_*32), b_=*(lds_cf4*)(kp_+128+g_*32); \
        _Pragma("unroll") for(int e_=0;e_<4;++e_){ Y0[4*g_+e_]=a_[e_]; Y1[4*g_+e_]=b_[e_]; } } } }while(0)
  #define VRD(i) do{ vlo[i]=vtr(vp_+(((i)>>2)*4096+((i)&3)*1024)); vhi[i]=vtr(vp_+(((i)>>2)*4096+((i)&3)*1024+512)); }while(0)
  #define KRD(G,j) do{ if(G){ kload2(kf,kp0+sl_next,j); SBAR(); } }while(0)
  #define STEP(C0,C1,P0,P1,t,GK,GV,GL) do{ SBAR(); \
    const lds_cptr vp_=vp0+sl_prev; \
    VRD(0); SBAR(); float sacc=(P0[0]+P0[1]); \
    GAPA(C0=__builtin_amdgcn_mfma_f32_32x32x16_bf16(kf[0],qr[0],csel<HASB>(C0,negm),0,0,0), P0[2],P0[3],P0[4],P0[5],     pw0[0]=PKW(P0,0), pw0[1]=PKW(P0,2), pw0); \
    VRD(4); SBAR(); GAPA(C1=__builtin_amdgcn_mfma_f32_32x32x16_bf16(kf[1],qr[0],csel<HASB>(C1,negm),0,0,0), P0[6],P0[7],P0[8],P0[9],     pw0[2]=PKW(P0,4), pw0[3]=PKW(P0,6), pw0); \
    VRD(1); SBAR(); GAPA(C0=__builtin_amdgcn_mfma_f32_32x32x16_bf16(kf[2],qr[1],C0,0,0,0),   P0[10],P0[11],P0[12],P0[13], pw1[0]=PKW(P0,8), pw1[1]=PKW(P0,10), pw1); \
    VRD(5); SBAR(); GAPA(C1=__builtin_amdgcn_mfma_f32_32x32x16_bf16(kf[3],qr[1],C1,0,0,0),   P0[14],P0[15],P1[0],P1[1],   pw1[2]=PKW(P0,12),pw1[3]=PKW(P0,14), pw1); \
    VRD(2); SBAR(); GAPA(C0=__builtin_amdgcn_mfma_f32_32x32x16_bf16(kf[4],qr[2],C0,0,0,0),   P1[2],P1[3],P1[4],P1[5],     pw2[0]=PKW(P1,0), pw2[1]=PKW(P1,2), pw2); \
    VRD(6); SBAR(); GAPA(C1=__builtin_amdgcn_mfma_f32_32x32x16_bf16(kf[5],qr[2],C1,0,0,0),   P1[6],P1[7],P1[8],P1[9],     pw2[2]=PKW(P1,4), pw2[3]=PKW(P1,6), pw2); \
    VRD(3); SBAR(); GAPA(C0=__builtin_amdgcn_mfma_f32_32x32x16_bf16(kf[6],qr[3],C0,0,0,0),   P1[10],P1[11],P1[12],P1[13], pw3[0]=PKW(P1,8), pw3[1]=PKW(P1,10), pw3); \
    VRD(7); SBAR(); GAPA(C1=__builtin_amdgcn_mfma_f32_32x32x16_bf16(kf[7],qr[3],C1,0,0,0),   P1[14],P1[15],0.f,0.f,       pw3[2]=PKW(P1,12),pw3[3]=PKW(P1,14), pw3); \
    l_reg+=sacc; \
    LOADB(P0,P1,(t)+1); \
    if(GK){DMA_K((t)+3,sl_cur);} if(GV){DMA_V((t)+1,sl_next);} \
    CMASK(C0,C1,t); \
    { float a=MX3(C0[0],C0[1],C1[0]),b=MX3(C0[2],C0[3],C1[1]); a=MX3(a,C1[2],C1[3]); \
      _Pragma("unroll") for(int r=4;r<16;r+=4){a=MX3(a,C0[r],C0[r+1]);b=MX3(b,C0[r+2],C0[r+3]);a=MX3(a,C1[r],C1[r+1]);b=MX3(b,C1[r+2],C1[r+3]);} \
      float rm=__builtin_fmaxf(a,b); { auto rr=__builtin_amdgcn_permlane32_swap(__float_as_uint(rm),__float_as_uint(rm),false,false); rm=__builtin_fmaxf(__uint_as_float(rr[0]),__uint_as_float(rr[1])); } \
      resc=false; \
      if(__builtin_expect(__any(rm>(float)THRL),0)){ const float dl=__builtin_fmaxf(rm,0.f); mhat+=dl; \
        _Pragma("unroll") for(int r=0;r<16;++r){C0[r]-=dl;C1[r]-=dl;} \
        if(!HASB){ _Pragma("unroll") for(int r=0;r<16;++r)negm[r]=-mhat; asm volatile("":"+v"(negm)); } \
        const float f=__builtin_amdgcn_exp2f(-dl); l_reg*=f; if(hi==0)wsf[r32]=f; resc=true; } } \
    SBAR(); \
    GAPB(o[0]=__builtin_amdgcn_mfma_f32_32x32x16_bf16(PAF(0),VFR(0),o[0],0,0,0), C0,0,P0); \
    GAPB(o[1]=__builtin_amdgcn_mfma_f32_32x32x16_bf16(PAF(0),VFR(4),o[1],0,0,0), C0,4,P0); \
    KRD(GL,0); GAPB(o[0]=__builtin_amdgcn_mfma_f32_32x32x16_bf16(PAF(1),VFR(1),o[0],0,0,0), C0,8,P0); \
    KRD(GL,1); GAPB(o[1]=__builtin_amdgcn_mfma_f32_32x32x16_bf16(PAF(1),VFR(5),o[1],0,0,0), C0,12,P0); \
    KRD(GL,2); GAPB(o[0]=__builtin_amdgcn_mfma_f32_32x32x16_bf16(PAF(2),VFR(2),o[0],0,0,0), C1,0,P1); \
    KRD(GL,3); GAPB(o[1]=__builtin_amdgcn_mfma_f32_32x32x16_bf16(PAF(2),VFR(6),o[1],0,0,0), C1,4,P1); \
    GAPB(o[0]=__builtin_amdgcn_mfma_f32_32x32x16_bf16(PAF(3),VFR(3),o[0],0,0,0), C1,8,P1); \
    GAPB(o[1]=__builtin_amdgcn_mfma_f32_32x32x16_bf16(PAF(3),VFR(7),o[1],0,0,0), C1,12,P1); \
    }while(0)
  CINIT(pB0,pB1,1);
  int t=1;
  #undef CMASK
  #define CMASK(P0,P1,t) do{}while(0)
  for(;t+5<NT;t+=2){
    STEP(pB0,pB1,pA0,pA1,t,true,true,true);     WAIT_BAR(2); RESC(); ROT();
    STEP(pA0,pA1,pB0,pB1,t+1,true,true,true);   WAIT_BAR(2); RESC(); ROT();
  }
  #undef CMASK
  #define CMASK(P0,P1,t) do{int jb_=(t)-(NT-4); if(jb_>=0)cmask(P0,P1,jb_,qrel,hi);}while(0)
  #define ENDW(tt) do{ if((tt)+3<NT){WAIT_BAR(2);} else if((tt)+2<NT){WAIT_BAR(1);} else {WAIT_BAR(0);} }while(0)
  for(;t+1<NT;t+=2){
    STEP(pB0,pB1,pA0,pA1,t,(t+3<NT),(t+1<NT),(t+1<NT));       ENDW(t);   RESC(); ROT();
    STEP(pA0,pA1,pB0,pB1,t+1,(t+4<NT),(t+2<NT),(t+2<NT));     ENDW(t+1); RESC(); ROT();
  }
  STEP(pB0,pB1,pA0,pA1,NT-1,false,false,false); RESC();
  { float sacc=pB0[0]+pB0[1]; _Pragma("unroll") for(int r=2;r<16;++r)sacc+=pB0[r]; _Pragma("unroll") for(int r=0;r<16;++r)sacc+=pB1[r]; l_reg+=sacc;
    pw0=(u32x4){PKW(pB0,0),PKW(pB0,2),PKW(pB0,4),PKW(pB0,6)};pw1=(u32x4){PKW(pB0,8),PKW(pB0,10),PKW(pB0,12),PKW(pB0,14)};pw2=(u32x4){PKW(pB1,0),PKW(pB1,2),PKW(pB1,4),PKW(pB1,6)};pw3=(u32x4){PKW(pB1,8),PKW(pB1,10),PKW(pB1,12),PKW(pB1,14)};
    SBAR(); pv(o,vb0+sl_cur,PAF(0),PAF(1),PAF(2),PAF(3)); }
  #undef PKW
  #undef PAF
  #undef VFR
  #undef PIN
  #undef MX3
  #undef GAPA
  #undef GAPB
  #undef LOADB
  #undef EX
  #undef VRD
  #undef KRD
  #undef STEP
  #undef ENDW
  {auto rr=__builtin_amdgcn_permlane32_swap(__float_as_uint(l_reg),__float_as_uint(l_reg),false,false);l_reg=__uint_as_float(rr[0])+__uint_as_float(rr[1]);}
  if(hi==0)wsf[32+r32]=l_reg;asm volatile("s_waitcnt lgkmcnt(0)":::"memory");
  float rli[16];
  #pragma unroll
  for(int r=0;r<16;++r)rli[r]=__builtin_amdgcn_rcpf(wsf[32+crow(r,hi)]);
  bf16*Ow=Oc+(rowbase+q0+wid*QBLK)*PO;
  { bf16*stg=(bf16*)(shm+LDS_OST)+wid*2048;
    #pragma unroll
    for(int r=0;r<16;++r){const int orow=crow(r,hi);
      #pragma unroll
      for(int d0=0;d0<2;++d0)stg[orow*64+d0*32+r32]=__float2bfloat16(o[d0][r]*rli[r]);}
    asm volatile("s_waitcnt lgkmcnt(0)":::"memory");
    #pragma unroll
    for(int i=0;i<4;++i){const int row=i*8+(lane>>3),ch=lane&7; const u32x4 v=*(const u32x4*)(stg+row*64+ch*8); ATTN_STORE16(Ow+(long)row*PO+ch*8,v);} }
  asm volatile("s_waitcnt lgkmcnt(0)\n\ts_barrier":::"memory");
  #undef CINIT
  #undef DMA_K
  #undef DMA_V
  #undef CMASK
  #undef START
  #undef RESC
  #undef ROT
}
constexpr int LDS_WS128=LDS_V+NSLOT*2*SLOTB, LDS_OST128=LDS_WS128+NW*64*4, LDS_BYTES128=LDS_OST128+NW*4096;
template<int THRL,bool NODEC> __device__ __forceinline__ void attn_unit128(int b,int qb,const bf16*Qc,const bf16*__restrict__ Kc,const bf16*__restrict__ Vc,bf16*Oc,char*shm,const int wv){ constexpr bool HASB=false; constexpr int t0=0; const float* kbg=nullptr;
  int tid_=wv*64+mk_lane();
  const int tid=tid_,lane=tid&63,r32=lane&31,hi=lane>>5; const int wid=__builtin_amdgcn_readfirstlane(tid>>6);
  const long rowbase=(long)b*SEQ; const int q0=qb*QB;
  const bf16*Qw=Qc+(rowbase+q0+wid*QBLK)*PQ;
  const bf16*Kh=Kc+(rowbase+(long)t0*KVBLK)*PQ,*Vh=Vc+(rowbase+(long)t0*KVBLK)*PQ;
  const unsigned lds0=(unsigned)(uintptr_t)shm;
  float*wsf=(float*)(shm+LDS_WS128)+wid*64;
  const bf16*ksrc=Kh+(long)lane*PQ+wid*8;
  const bf16*vsrc=Vh+(long)(16*(wid&3)+(lane>>2))*PQ+(wid>>2)*32+(lane&3)*8;
  const unsigned kdst=lds0+LDS_K+wid*1024, vdst=lds0+LDS_V+(wid>>2)*4096+(wid&3)*1024;
  #define DMA_K(t,slot) glds16(ksrc+(long)(t)*KVBLK*PQ,(unsigned)__builtin_amdgcn_readfirstlane(kdst+(slot)))
  #define DMA_V(t,slot) do{ glds16(vsrc+(long)(t)*KVBLK*PQ,(unsigned)__builtin_amdgcn_readfirstlane(vdst+2*(slot))); glds16(vsrc+64+(long)(t)*KVBLK*PQ,(unsigned)__builtin_amdgcn_readfirstlane(vdst+8192+2*(slot))); }while(0)
  const int vb0=(int)(lds0+LDS_V)+((lane>>4)&1)*32+(lane&3)*8+(4*hi+((lane&15)>>2))*64;
  const char*Kbase=shm+LDS_K; bf16x8 kf[8];
  const lds_cptr shm3=(lds_cptr)shm; const lds_cptr kp0=shm3+LDS_K+hi*1024+r32*16; const lds_cptr vp0=shm3+LDS_V+((lane>>4)&1)*32+(lane&3)*8+(4*hi+((lane&15)>>2))*64;
  const int NT=(q0+QB)/KVBLK-t0;
  typedef __attribute__((address_space(3))) const f32x4 lds_cf4; typedef __attribute__((address_space(3))) f32x4 lds_f4;
  const __attribute__((address_space(3))) char* kbl=(const __attribute__((address_space(3))) char*)shm+LDS_KBIAS+hi*16;
  if(HASB){ const int n4=(q0+QB-t0*KVBLK)/4; for(int i=tid;i<n4;i+=NW*64){ const f32x4 v=*(const f32x4*)(kbg+t0*KVBLK+4*i); *((lds_f4*)((__attribute__((address_space(3))) char*)shm+LDS_KBIAS)+i)=v; } }
  DMA_K(0,0);DMA_V(0,0);DMA_K(1,SLOTB);
  bf16x8 qr[4];
  #pragma unroll
  for(int d0=0;d0<4;++d0)qr[d0]=*reinterpret_cast<const bf16x8*>(&Qw[(long)r32*PQ+d0*16+hi*8]);
  float mhat=0.f,l_reg=0.f;f32x16 o[4];o[0]=f32x16{};o[1]=f32x16{};o[2]=f32x16{};o[3]=f32x16{};
  const int qrel=wid*QBLK+r32;
  float mref=0.f;
  #define CINIT(C0,C1,t) do{ if(HASB){ const __attribute__((address_space(3))) char* kp_=kbl+(t)*256; \
      _Pragma("unroll") for(int g_=0;g_<4;++g_){ const f32x4 a_=*(lds_cf4*)(kp_+g_*32), b_=*(lds_cf4*)(kp_+128+g_*32); \
        _Pragma("unroll") for(int e_=0;e_<4;++e_){ C0[4*g_+e_]=a_[e_]-mhat; C1[4*g_+e_]=b_[e_]-mhat; } } } \
    }while(0)
  #define CMASK(P0,P1,t) do{int jb_=(t)-(NT-4); if(jb_>=0)cmask(P0,P1,jb_,qrel,hi);}while(0)
  bool resc=false;
  #define START(P0,P1) do{ resc=false; \
    if(!NODEC){ const float rm=rowmax(P0,P1); const float dl=__any(rm>(float)THRL)?__builtin_fmaxf(rm,0.f):0.f; mhat=fadd_s(mhat,dl); \
      _Pragma("unroll") for(int r=0;r<16;++r){P0[r]=fsub_s(P0[r],dl);P1[r]=fsub_s(P1[r],dl);} \
      } \
    _Pragma("unroll") for(int r=0;r<16;++r)P0[r]=__builtin_amdgcn_exp2f(P0[r]); }while(0)
  #define RESC() do{ if(resc){ asm volatile("s_waitcnt lgkmcnt(0)":::"memory"); \
      _Pragma("unroll") for(int d_=0;d_<4;++d_) _Pragma("unroll") for(int r=0;r<16;++r)o[d_][r]*=wsf[crow(r,hi)]; } }while(0)
  f32x16 pA0,pA1,pB0,pB1;
  int sl_prev=0,sl_cur=0,sl_next=SLOTB;
  #define ROT() do{sl_prev=sl_cur;sl_cur=sl_next;sl_next=(sl_next==(NSLOT-1)*SLOTB)?0:sl_next+SLOTB;}while(0)
  DMA_K(2,2*SLOTB);
  WAIT_BAR(4);
  { f32x16 ci0=f32x16{}; asm volatile("":"+v"(ci0)); qkt(pA0,pA1,Kbase,qr,ci0,ci0,r32,hi); } asm volatile("s_nop 15\n\ts_nop 7":"+v"(pA0),"+v"(pA1));CMASK(pA0,pA1,0);
  START(pA0,pA1);
  _Pragma("unroll") for(int r=0;r<16;++r)pA1[r]=__builtin_amdgcn_exp2f(pA1[r]);
  WAIT_BAR(0);
  DMA_K(3,0);DMA_V(1,SLOTB);
  ROT();
  kload8(kf,kp0+sl_cur);
  WAIT_BAR(3);
  s16x4 vlo[4],vhi[4]; u32x4 pw0,pw1,pw2,pw3;
  #define PKW(P,B) cvtpk_s(P[B],P[B+1])
  #define PAF(k) __builtin_bit_cast(bf16x8,pw##k)
  #define VFR(i) (bf16x8){vlo[(i)&3][0],vlo[(i)&3][1],vlo[(i)&3][2],vlo[(i)&3][3],vhi[(i)&3][0],vhi[(i)&3][1],vhi[(i)&3][2],vhi[(i)&3][3]}
  #define PIN(x) asm volatile("":"+v"(x))
  #define MX3(a,b,c) __builtin_fmaxf(__builtin_fmaxf((a),(b)),(c))
  #define GAPA(MF,A0,A1,A2,A3,W0,W1,PW) do{ MF; sacc+=A0; sacc+=A1; sacc+=A2; sacc+=A3; PIN(sacc); W0; W1; PIN(PW); SBAR(); }while(0)
  #define EX(v) __builtin_amdgcn_exp2f(v)
  #define GAPB(MF,X,B,Y) do{ MF; X[B]=EX(X[B]); X[B+1]=EX(X[B+1]); X[B+2]=EX(X[B+2]); X[B+3]=EX(X[B+3]); PIN(X); if(HASB){ Y[B]-=mhat; Y[B+1]-=mhat; Y[B+2]-=mhat; Y[B+3]-=mhat; PIN(Y); } SBAR(); }while(0)
  #define LOADB(Y0,Y1,t) do{ if(HASB){ const __attribute__((address_space(3))) char* kp_=kbl+(t)*256; \
      _Pragma("unroll") for(int g_=0;g_<4;++g_){ const f32x4 a_=*(lds_cf4*)(kp_+g_*32), b_=*(lds_cf4*)(kp_+128+g_*32); \
        _Pragma("unroll") for(int e_=0;e_<4;++e_){ Y0[4*g_+e_]=a_[e_]; Y1[4*g_+e_]=b_[e_]; } } } }while(0)
  #define VOFF(j) ((((j)>>3)*8192)+((((j)&7)&1)*4096)+((((j)&7)>>1)*1024))
  #define VRDJ(j) do{ vlo[(j)&3]=vtr(vp_+VOFF(j)); vhi[(j)&3]=vtr(vp_+VOFF(j)+512); SBAR(); }while(0)
  #define GAPC(MF,Y,B) do{ MF; SBAR(); }while(0)
  #define KRD(G,j) do{ if(G){ kload2(kf,kp0+sl_next,j); SBAR(); } }while(0)
  #define STEP(C0,C1,P0,P1,t,GK,GV,GL) do{ SBAR(); \
    const lds_cptr vp_=vp0+2*sl_prev; \
    VRDJ(0); float sacc=(P0[0]+P0[1]); \
    GAPA(C0=__builtin_amdgcn_mfma_f32_32x32x16_bf16(kf[0],qr[0],zero16,0,0,0), P0[2],P0[3],P0[4],P0[5],     pw0[0]=PKW(P0,0), pw0[1]=PKW(P0,2), pw0); \
    VRDJ(1); GAPA(C1=__builtin_amdgcn_mfma_f32_32x32x16_bf16(kf[1],qr[0],zero16,0,0,0), P0[6],P0[7],P0[8],P0[9],     pw0[2]=PKW(P0,4), pw0[3]=PKW(P0,6), pw0); \
    VRDJ(2); GAPA(C0=__builtin_amdgcn_mfma_f32_32x32x16_bf16(kf[2],qr[1],C0,0,0,0),   P0[10],P0[11],P0[12],P0[13], pw1[0]=PKW(P0,8), pw1[1]=PKW(P0,10), pw1); \
    VRDJ(3); GAPA(C1=__builtin_amdgcn_mfma_f32_32x32x16_bf16(kf[3],qr[1],C1,0,0,0),   P0[14],P0[15],P1[0],P1[1],   pw1[2]=PKW(P0,12),pw1[3]=PKW(P0,14), pw1); \
    GAPA(C0=__builtin_amdgcn_mfma_f32_32x32x16_bf16(kf[4],qr[2],C0,0,0,0),   P1[2],P1[3],P1[4],P1[5],     pw2[0]=PKW(P1,0), pw2[1]=PKW(P1,2), pw2); \
    GAPA(C1=__builtin_amdgcn_mfma_f32_32x32x16_bf16(kf[5],qr[2],C1,0,0,0),   P1[6],P1[7],P1[8],P1[9],     pw2[2]=PKW(P1,4), pw2[3]=PKW(P1,6), pw2); \
    GAPA(C0=__builtin_amdgcn_mfma_f32_32x32x16_bf16(kf[6],qr[3],C0,0,0,0),   P1[10],P1[11],P1[12],P1[13], pw3[0]=PKW(P1,8), pw3[1]=PKW(P1,10), pw3); \
    GAPA(C1=__builtin_amdgcn_mfma_f32_32x32x16_bf16(kf[7],qr[3],C1,0,0,0),   P1[14],P1[15],0.f,0.f,       pw3[2]=PKW(P1,12),pw3[3]=PKW(P1,14), pw3); \
    l_reg+=sacc; \
    if(!NODEC){ if(__builtin_expect(__any(mhat!=0.f),0)){ _Pragma("unroll") for(int r=0;r<16;++r){C0[r]-=mhat;C1[r]-=mhat;} } } \
    if(GK){DMA_K((t)+3,sl_cur);} if(GV){DMA_V((t)+1,sl_next);} \
    CMASK(C0,C1,t); \
    resc=false; if(!NODEC){ float a=MX3(C0[0],C0[1],C1[0]),b=MX3(C0[2],C0[3],C1[1]); a=MX3(a,C1[2],C1[3]); \
      _Pragma("unroll") for(int r=4;r<16;r+=4){a=MX3(a,C0[r],C0[r+1]);b=MX3(b,C0[r+2],C0[r+3]);a=MX3(a,C1[r],C1[r+1]);b=MX3(b,C1[r+2],C1[r+3]);} \
      float rm=__builtin_fmaxf(a,b); { auto rr=__builtin_amdgcn_permlane32_swap(__float_as_uint(rm),__float_as_uint(rm),false,false); rm=__builtin_fmaxf(__uint_as_float(rr[0]),__uint_as_float(rr[1])); } \
      resc=false; \
      if(__builtin_expect(__any(rm>(float)THRL),0)){ const float dl=__builtin_fmaxf(rm,0.f); mhat+=dl; \
        _Pragma("unroll") for(int r=0;r<16;++r){C0[r]-=dl;C1[r]-=dl;} \
        const float f=__builtin_amdgcn_exp2f(-dl); l_reg*=f; if(hi==0)wsf[r32]=f; resc=true; } } \
    SBAR(); \
    GAPB(o[0]=__builtin_amdgcn_mfma_f32_32x32x16_bf16(PAF(0),VFR(0),o[0],0,0,0), C0,0,P0); VRDJ(4); \
    GAPB(o[1]=__builtin_amdgcn_mfma_f32_32x32x16_bf16(PAF(0),VFR(1),o[1],0,0,0), C0,4,P0); VRDJ(5); \
    GAPB(o[0]=__builtin_amdgcn_mfma_f32_32x32x16_bf16(PAF(1),VFR(2),o[0],0,0,0), C0,8,P0); VRDJ(6); \
    GAPB(o[1]=__builtin_amdgcn_mfma_f32_32x32x16_bf16(PAF(1),VFR(3),o[1],0,0,0), C0,12,P0); VRDJ(7); \
    GAPB(o[0]=__builtin_amdgcn_mfma_f32_32x32x16_bf16(PAF(2),VFR(4),o[0],0,0,0), C1,0,P1); VRDJ(8); \
    GAPB(o[1]=__builtin_amdgcn_mfma_f32_32x32x16_bf16(PAF(2),VFR(5),o[1],0,0,0), C1,4,P1); VRDJ(9); \
    GAPB(o[0]=__builtin_amdgcn_mfma_f32_32x32x16_bf16(PAF(3),VFR(6),o[0],0,0,0), C1,8,P1); VRDJ(10); \
    GAPB(o[1]=__builtin_amdgcn_mfma_f32_32x32x16_bf16(PAF(3),VFR(7),o[1],0,0,0), C1,12,P1); VRDJ(11); \
    GAPC(o[2]=__builtin_amdgcn_mfma_f32_32x32x16_bf16(PAF(0),VFR(8),o[2],0,0,0), P0,0); VRDJ(12); \
    GAPC(o[3]=__builtin_amdgcn_mfma_f32_32x32x16_bf16(PAF(0),VFR(9),o[3],0,0,0), P0,4); VRDJ(13); \
    KRD(GL,0); GAPC(o[2]=__builtin_amdgcn_mfma_f32_32x32x16_bf16(PAF(1),VFR(10),o[2],0,0,0), P0,8); VRDJ(14); \
    KRD(GL,1); GAPC(o[3]=__builtin_amdgcn_mfma_f32_32x32x16_bf16(PAF(1),VFR(11),o[3],0,0,0), P0,12); VRDJ(15); \
    KRD(GL,2); GAPC(o[2]=__builtin_amdgcn_mfma_f32_32x32x16_bf16(PAF(2),VFR(12),o[2],0,0,0), P1,0); \
    KRD(GL,3); GAPC(o[3]=__builtin_amdgcn_mfma_f32_32x32x16_bf16(PAF(2),VFR(13),o[3],0,0,0), P1,4); \
    GAPC(o[2]=__builtin_amdgcn_mfma_f32_32x32x16_bf16(PAF(3),VFR(14),o[2],0,0,0), P1,8); \
    GAPC(o[3]=__builtin_amdgcn_mfma_f32_32x32x16_bf16(PAF(3),VFR(15),o[3],0,0,0), P1,12); \
    }while(0)
  const f32x16 zero16=f32x16{};
  int t=1;
  #undef CMASK
  #define CMASK(P0,P1,t) do{}while(0)
  for(;t+5<NT;t+=2){
    STEP(pB0,pB1,pA0,pA1,t,true,true,true);     WAIT_BAR(3); RESC(); ROT();
    STEP(pA0,pA1,pB0,pB1,t+1,true,true,true);   WAIT_BAR(3); RESC(); ROT();
  }
  #undef CMASK
  #define CMASK(P0,P1,t) do{int jb_=(t)-(NT-4); if(jb_>=0)cmask(P0,P1,jb_,qrel,hi);}while(0)
  #define ENDW(tt) do{ if((tt)+3<NT){WAIT_BAR(3);} else if((tt)+2<NT){WAIT_BAR(2);} else {WAIT_BAR(0);} }while(0)
  for(;t+1<NT;t+=2){
    STEP(pB0,pB1,pA0,pA1,t,(t+3<NT),(t+1<NT),(t+1<NT));       ENDW(t);   RESC(); ROT();
    STEP(pA0,pA1,pB0,pB1,t+1,(t+4<NT),(t+2<NT),(t+2<NT));     ENDW(t+1); RESC(); ROT();
  }
  STEP(pB0,pB1,pA0,pA1,NT-1,false,false,false); RESC();
  { float sacc=pB0[0]+pB0[1]; _Pragma("unroll") for(int r=2;r<16;++r)sacc+=pB0[r]; _Pragma("unroll") for(int r=0;r<16;++r)sacc+=pB1[r]; l_reg+=sacc;
    pw0=(u32x4){PKW(pB0,0),PKW(pB0,2),PKW(pB0,4),PKW(pB0,6)};pw1=(u32x4){PKW(pB0,8),PKW(pB0,10),PKW(pB0,12),PKW(pB0,14)};pw2=(u32x4){PKW(pB1,0),PKW(pB1,2),PKW(pB1,4),PKW(pB1,6)};pw3=(u32x4){PKW(pB1,8),PKW(pB1,10),PKW(pB1,12),PKW(pB1,14)};
    SBAR(); pv(o,vb0+2*sl_cur,PAF(0),PAF(1),PAF(2),PAF(3)); pv(o+2,vb0+2*sl_cur+8192,PAF(0),PAF(1),PAF(2),PAF(3)); }
  #undef PKW
  #undef PAF
  #undef VFR
  #undef PIN
  #undef MX3
  #undef GAPA
  #undef GAPB
  #undef LOADB
  #undef EX
  #undef VRDJ
  #undef VOFF
  #undef GAPC
  #undef KRD
  #undef STEP
  #undef ENDW
  {auto rr=__builtin_amdgcn_permlane32_swap(__float_as_uint(l_reg),__float_as_uint(l_reg),false,false);l_reg=__uint_as_float(rr[0])+__uint_as_float(rr[1]);}
  if(hi==0)wsf[32+r32]=l_reg;asm volatile("s_waitcnt lgkmcnt(0)":::"memory");
  float rli[16];
  #pragma unroll
  for(int r=0;r<16;++r)rli[r]=__builtin_amdgcn_rcpf(wsf[32+crow(r,hi)]);
  bf16*Ow=Oc+(rowbase+q0+wid*QBLK)*PO;
  { bf16*stg=(bf16*)(shm+LDS_OST128)+wid*2048;
    #pragma unroll
    for(int hf=0;hf<2;++hf){
      #pragma unroll
      for(int r=0;r<16;++r){const int orow=crow(r,hi);
        #pragma unroll
        for(int d0=0;d0<2;++d0)stg[orow*64+d0*32+r32]=__float2bfloat16(o[2*hf+d0][r]*rli[r]);}
      asm volatile("s_waitcnt lgkmcnt(0)":::"memory");
      #pragma unroll
      for(int i=0;i<4;++i){const int row=i*8+(lane>>3),ch=lane&7; const u32x4 v=*(const u32x4*)(stg+row*64+ch*8); ATTN_STORE16(Ow+(long)row*PO+hf*64+ch*8,v);}
      asm volatile("s_waitcnt lgkmcnt(0)":::"memory"); } }
  asm volatile("s_waitcnt lgkmcnt(0)\n\ts_barrier":::"memory");
  #undef CINIT
  #undef DMA_K
  #undef DMA_V
  #undef CMASK
  #undef START
  #undef RESC
  #undef ROT
}
constexpr int ATTN_LDS_BYTES=(LDS_BYTES>LDS_BYTES128)?LDS_BYTES:LDS_BYTES128;
#undef SBAR
#undef WAIT_BAR
}

namespace xattn {
using pg8::bf16_t; using pg8::bf16x8; using pg8::u32x4; using pg8::f32x4;
using f32x16 = __attribute__((ext_vector_type(16))) float;
#define XLAS __attribute__((address_space(3)))
constexpr int XB0 = 0, XB1 = 32768, X_WSF = 65536, X_OST = X_WSF + 2048, X_LDS_BYTES = X_OST + 8 * 4096;
__device__ __forceinline__ int crow(int r, int hi) { return (r & 3) + 8 * (r >> 2) + 4 * hi; }
__device__ __forceinline__ unsigned pk(float lo, float hi) { return pg8::cvt_pk_bf16(lo, hi); }
__device__ __forceinline__ void unit(int b, int h, int qblk, const bf16_t* __restrict__ CQ, const bf16_t* __restrict__ CK, const bf16_t* __restrict__ CVT, bf16_t* __restrict__ CO, XLAS unsigned char* lds, const int wv) {
    const int tid = wv * 64 + mk_lane(), lane = tid & 63, r32 = lane & 31, hi = lane >> 5; const int wid = __builtin_amdgcn_readfirstlane(tid >> 6);
    const size_t qrow0 = (size_t)b * 4096 + (size_t)qblk * 256 + wid * 32;
    const bf16_t* Qw = CQ + (qrow0 + r32) * 1024 + h * 256 + hi * 8;
    const bf16_t* Kg = CK + ((size_t)b * 256 + lane) * 1024 + h * 256 + wid * 8;
    const bf16_t* Vg = CVT + ((size_t)h * 256 + lane) * 2048 + (size_t)b * 256 + wid * 8;
    u32x4 st[4];
#define X_LOADK(dc) do { _Pragma("unroll") for (int i_ = 0; i_ < 4; ++i_) st[i_] = *(const u32x4*)(Kg + (dc) * 64 + (size_t)i_ * 64 * 1024); } while (0)
#define X_LOADV(c)  do { _Pragma("unroll") for (int i_ = 0; i_ < 4; ++i_) st[i_] = *(const u32x4*)(Vg + (size_t)(c) * 64 * 2048 + i_ * 64); } while (0)
#define X_STOREK(buf) do { _Pragma("unroll") for (int i_ = 0; i_ < 4; ++i_) *(XLAS u32x4*)(lds + (buf) + wid * 4096 + (64 * i_ + lane) * 16) = st[i_]; } while (0)
#define X_STOREV(buf) do { _Pragma("unroll") for (int i_ = 0; i_ < 4; ++i_) *(XLAS u32x4*)(lds + (buf) + (wid + 8 * i_) * 1024 + lane * 16) = st[i_]; } while (0)
    const int kswz = (r32 & ~12) | ((r32 & 4) << 1) | ((r32 & 8) >> 1);
    const int koff = hi * 4096 + kswz * 16;
    const int voff = hi * 1024 + r32 * 16;
    f32x16 s[8];
#pragma unroll
    for (int kt = 0; kt < 8; ++kt) s[kt] = f32x16{};
    X_LOADK(0);
    bf16x8 qfa[4][4];
#pragma unroll
    for (int dc = 0; dc < 4; ++dc)
#pragma unroll
        for (int ks = 0; ks < 4; ++ks) qfa[dc][ks] = *(const bf16x8*)(Qw + dc * 64 + ks * 16);
    X_STOREK(XB0);
    __syncthreads();
#pragma unroll
    for (int dc = 0; dc < 4; ++dc) {
        const int buf = (dc & 1) ? XB1 : XB0, nbuf = (dc & 1) ? XB0 : XB1;
        if (dc < 3) X_LOADK(dc + 1); else X_LOADV(0);
#pragma unroll
        for (int kt = 0; kt < 8; ++kt)
#pragma unroll
            for (int ks = 0; ks < 4; ++ks) {
                const bf16x8 kf = *(const XLAS bf16x8*)(lds + buf + koff + kt * 512 + ks * 8192);
                s[kt] = __builtin_amdgcn_mfma_f32_32x32x16_bf16(kf, qfa[dc][ks], s[kt], 0, 0, 0);
            }
        if (dc < 3) X_STOREK(nbuf); else X_STOREV(nbuf);
        __syncthreads();
    }
    float mx = s[0][0];
#pragma unroll
    for (int kt = 0; kt < 8; ++kt)
#pragma unroll
        for (int r = 0; r < 16; ++r) mx = fmaxf(mx, s[kt][r]);
    mx = fmaxf(mx, __shfl_xor(mx, 32));
    float l = 0.f;
#pragma unroll
    for (int kt = 0; kt < 8; ++kt)
#pragma unroll
        for (int r = 0; r < 16; ++r) { const float p = __builtin_amdgcn_exp2f(s[kt][r] - mx); s[kt][r] = p; l += p; }
    l += __shfl_xor(l, 32);
    u32x4 pw[16];
#pragma unroll
    for (int kt = 0; kt < 8; ++kt)
#pragma unroll
        for (int j2 = 0; j2 < 2; ++j2)
            pw[2 * kt + j2] = (u32x4){pk(s[kt][8 * j2 + 0], s[kt][8 * j2 + 1]), pk(s[kt][8 * j2 + 2], s[kt][8 * j2 + 3]), pk(s[kt][8 * j2 + 4], s[kt][8 * j2 + 5]), pk(s[kt][8 * j2 + 6], s[kt][8 * j2 + 7])};
    XLAS float* wsf = (XLAS float*)(lds + X_WSF) + wid * 64;
    if (hi == 0) wsf[r32] = l;
    asm volatile("s_waitcnt lgkmcnt(0)" ::: "memory");
    float rli[16];
#pragma unroll
    for (int r = 0; r < 16; ++r) rli[r] = __builtin_amdgcn_rcpf(wsf[crow(r, hi)]);
    XLAS bf16_t* stg = (XLAS bf16_t*)(lds + X_OST) + wid * 2048;
    bf16_t* Ow = CO + qrow0 * 1024 + h * 256;
#pragma unroll
    for (int c = 0; c < 4; ++c) {
        const int buf = (c & 1) ? XB1 : XB0, nbuf = (c & 1) ? XB0 : XB1;
        if (c < 3) X_LOADV(c + 1);
        f32x16 o[2]; o[0] = f32x16{}; o[1] = f32x16{};
#pragma unroll
        for (int j = 0; j < 16; ++j)
#pragma unroll
            for (int dt = 0; dt < 2; ++dt) {
                const bf16x8 vf = *(const XLAS bf16x8*)(lds + buf + voff + dt * 512 + j * 2048);
                o[dt] = __builtin_amdgcn_mfma_f32_32x32x16_bf16(__builtin_bit_cast(bf16x8, pw[j]), vf, o[dt], 0, 0, 0);
            }
#pragma unroll
        for (int r = 0; r < 16; ++r) { const int orow = crow(r, hi);
#pragma unroll
            for (int dt = 0; dt < 2; ++dt) { const unsigned w = pk(o[dt][r] * rli[r], 0.f); stg[orow * 64 + dt * 32 + r32] = (bf16_t)(w & 0xffffu); } }
        asm volatile("s_waitcnt lgkmcnt(0)" ::: "memory");
#pragma unroll
        for (int i = 0; i < 4; ++i) { const int row = i * 8 + (lane >> 3), ch = lane & 7; const u32x4 v = *(const XLAS u32x4*)(stg + row * 64 + ch * 8); *(u32x4*)(Ow + (size_t)row * 1024 + c * 64 + ch * 8) = v; }
        asm volatile("s_waitcnt lgkmcnt(0)" ::: "memory");
        if (c < 3) X_STOREV(nbuf);
        __syncthreads();
    }
#undef X_LOADK
#undef X_LOADV
#undef X_STOREK
#undef X_STOREV
}
}

#ifndef MK_PER_PHASE
#define MK_PER_PHASE 0
#endif
constexpr int NWAVES = 8;
constexpr int BATCH = 8, SEQ = 4096, D = 1024, M = BATCH * SEQ, FF = 4096, NMEM = 256, MM = BATCH * NMEM, INW = 3080, NPROJ = 3072, NATT = 1536;
constexpr float EPS = 1e-6f, SUBLN_EPS = 1e-5f;
constexpr int N_PHASES = 11;

constexpr size_t MiB = 1u << 20;
constexpr size_t WS_ROPE = 0;
constexpr size_t WS_LOGF = 1 * MiB;
constexpr size_t WS_KB   = 2 * MiB;
constexpr size_t WS_NRM  = 3 * MiB;
constexpr size_t WS_BAR  = 3 * MiB + 65536;
constexpr size_t WS_SS1  = 4 * MiB, WS_SS2 = 6 * MiB, WS_SS3 = 8 * MiB;
constexpr size_t WS_WIN = 408 * MiB, WS_WOUT = 414 * MiB, WS_WCQ = 416 * MiB, WS_WCKV = 418 * MiB, WS_WCO = 422 * MiB, WS_WUP = 424 * MiB, WS_WDN = 432 * MiB;
constexpr size_t WS_MEMN = 42 * MiB, WS_CK = 46 * MiB, WS_CVT = 50 * MiB;
constexpr size_t WS_SA = 56 * MiB;
constexpr size_t WS_SB = 448 * MiB;
constexpr size_t WS_PROJ = 216 * MiB;
constexpr size_t WS_ATT = 120 * MiB;
constexpr size_t WS_ZH = 120 * MiB;
constexpr size_t WS_END = 512 * MiB;
static_assert(WS_WIN >= WS_PROJ + (size_t)M * NPROJ * 2 && WS_WDN + 8 * MiB <= WS_SB && WS_MEMN >= 10 * MiB, "weight copies sit in the gap");
static_assert(WS_SA + 64 * MiB <= WS_ATT && WS_ATT + (size_t)M * NATT * 2 <= WS_PROJ && WS_PROJ + (size_t)M * NPROJ * 2 <= WS_SB && WS_ZH + (size_t)M * FF * 2 <= WS_SB && WS_ZH >= WS_SA + 64 * MiB && WS_SB + 64 * MiB <= WS_END, "d_ws map: slot A | ATT | PROJ | (gap) | slot B; ZH overlays ATT + PROJ only");

constexpr int RING_BYTES = 131072, LDS_BYTES = 147456;
static_assert(attn_body::ATTN_LDS_BYTES <= RING_BYTES && xattn::X_LDS_BYTES <= RING_BYTES && pg8::STAGE_BYTES <= RING_BYTES, "LDS map");

#define LAS __attribute__((address_space(3)))
typedef unsigned short bf16;
typedef unsigned v4u __attribute__((ext_vector_type(4)));
typedef float f32x4 __attribute__((ext_vector_type(4)));
#define LDS_WAIT() asm volatile("s_waitcnt lgkmcnt(0)" ::: "memory")
__device__ __forceinline__ unsigned f2bf(float f) { unsigned u = __builtin_bit_cast(unsigned, f); return (u + 0x7fffu + ((u >> 16) & 1u)) >> 16; }
__device__ __forceinline__ unsigned pk2(float lo, float hi) { return f2bf(lo) | (f2bf(hi) << 16); }
__device__ __forceinline__ float bflo(unsigned w) { return __builtin_bit_cast(float, w << 16); }
__device__ __forceinline__ float bfhi(unsigned w) { return __builtin_bit_cast(float, w & 0xffff0000u); }
__device__ __forceinline__ float wave_sum(float v) {
#pragma unroll
    for (int o = 1; o < 64; o <<= 1) v += __shfl_xor(v, o);
    return v;
}

#define XB_TMO      128
#define XB_XCNT(j)  (256  + 64 * (j))
#define XB_XSUB(j)  (1280 + 64 * (j))
#define XB_XGEN(j)  (2304 + 64 * (j))
#define XB_TOP      3328
#define XB_TOPGEN   3392
#define XCD_BAR_WORDS 3456
#define XB_SPIN_CAP (1u << 18)

__device__ __forceinline__ unsigned xb_ld(unsigned* p)              { return __hip_atomic_load(p, __ATOMIC_RELAXED, __HIP_MEMORY_SCOPE_AGENT); }
__device__ __forceinline__ unsigned xb_add(unsigned* p, unsigned v) { return __hip_atomic_fetch_add(p, v, __ATOMIC_RELAXED, __HIP_MEMORY_SCOPE_AGENT); }
__device__ __forceinline__ unsigned xb_xcc_id() { return (unsigned)__builtin_amdgcn_s_getreg((3 << 11) | 20) & 0xFu; }
#define XB_SPIN(cond, bar) do { unsigned _sp = 0; while (cond) { __builtin_amdgcn_s_sleep(1); \
    if ((++_sp & 255u) == 0u) { if (xb_ld(&(bar)[XB_TMO])) break; if (_sp > XB_SPIN_CAP) { atomicAdd(&(bar)[XB_TMO], 1u); break; } } } } while (0)

struct XcdBarrier {
    unsigned* bar; unsigned x;
    volatile LAS unsigned* st;
};

__device__ __forceinline__ XcdBarrier xcd_barrier_post(unsigned* bar, volatile LAS unsigned* st, bool leader) {
    XcdBarrier b; b.bar = bar; b.x = xb_xcc_id(); b.st = st;
    if (leader) (void)xb_add(&bar[XB_XCNT(b.x)], 1u);
    return b;
}
__device__ __forceinline__ void xcd_barrier_complete(unsigned* bar, unsigned x, unsigned& nloc, unsigned& nx) {
    const unsigned G = gridDim.x * gridDim.y * gridDim.z;
    unsigned sum, cnt, mine, sp = 0u;
    for (;;) {
        sum = 0u; cnt = 0u; mine = 0u;
#pragma unroll
        for (unsigned j = 0; j < 16; ++j) { const unsigned c = xb_ld(&bar[XB_XCNT(j)]); sum += c; cnt += (c > 0u) ? 1u : 0u; mine = (j == x) ? c : mine; }
        if (sum == G) break;
        __builtin_amdgcn_s_sleep(1);
        if ((++sp & 255u) == 0u) { if (xb_ld(&bar[XB_TMO])) break; if (sp > XB_SPIN_CAP) { atomicAdd(&bar[XB_TMO], 1u); break; } }
    }
    nloc = mine > 0u ? mine : 1u; nx = cnt > 0u ? cnt : 1u;
}

__device__ __forceinline__ void xcd_barrier(const XcdBarrier& b, bool leader) {
    asm volatile("s_waitcnt vmcnt(0)" ::: "memory");
    __syncthreads();
    if (leader) {
        unsigned* bar = b.bar;
        __builtin_amdgcn_s_waitcnt(0);
        unsigned nloc = b.st[0], nx = b.st[1];
        if (nloc == 0u) { xcd_barrier_complete(bar, b.x, nloc, nx); b.st[0] = nloc; b.st[1] = nx; }
        const unsigned old = xb_add(&bar[XB_XSUB(b.x)], 1u);
        const unsigned gen = old / nloc;
        if (old + 1u == (gen + 1u) * nloc) {
            __builtin_amdgcn_fence(__ATOMIC_RELEASE, "agent");
            asm volatile("s_waitcnt vmcnt(0)" ::: "memory");
            const unsigned og = xb_add(&bar[XB_TOP], 1u);
            const unsigned tg = og / nx;
            if (og + 1u == (tg + 1u) * nx) xb_add(&bar[XB_TOPGEN], 1u);
            else XB_SPIN(xb_ld(&bar[XB_TOPGEN]) == tg, bar);
            __builtin_amdgcn_fence(__ATOMIC_ACQUIRE, "agent");
            xb_add(&bar[XB_XGEN(b.x)], 1u);
            asm volatile("s_waitcnt vmcnt(0)" ::: "memory");
        } else {
            XB_SPIN(xb_ld(&bar[XB_XGEN(b.x)]) == gen, bar);
            __builtin_amdgcn_fence(__ATOMIC_ACQUIRE, "agent");
            asm volatile("s_waitcnt vmcnt(0)" ::: "memory");
        }
    }
    __syncthreads();
}

struct Params { const float* in[21]; float* out; unsigned char* ws; int ph_lo, ph_hi; };
enum { I_X = 0, I_MEM, I_GMIX, I_WIN, I_BF, I_LQ1, I_LK1, I_LQ2, I_LK2, I_GSUB, I_GFOX, I_WOUT, I_GCROSS, I_GMEM, I_WCQ, I_WCKV, I_WCO, I_GMLP, I_WUP, I_WDN, I_GFIN };

__device__ __forceinline__ void p0_transpose_item(const float* W, int K, int ldw, int nblk, bf16* WT, LAS float* scr, int item, int lane, const float* gk = nullptr  ) {
    const int kb = item / nblk, nb = item % nblk, k0 = 64 * kb, n0 = 32 * nb;
    { f32x4 v[8]; float gg[8];
#pragma unroll
        for (int it = 0; it < 8; ++it) { const int kk = 8 * it + (lane >> 3); v[it] = __builtin_nontemporal_load((const f32x4*)(W + (size_t)(k0 + kk) * ldw + n0 + 4 * (lane & 7)));     gg[it] = gk ? gk[k0 + kk] : 1.f; }
#pragma unroll
        for (int it = 0; it < 8; ++it) { const int kk = 8 * it + (lane >> 3); LAS float* d = scr + kk * 33 + 4 * (lane & 7); d[0] = v[it].x * gg[it]; d[1] = v[it].y * gg[it]; d[2] = v[it].z * gg[it]; d[3] = v[it].w * gg[it]; } }
    LDS_WAIT(); asm volatile("" ::: "memory");
    const int c = lane & 7;
#pragma unroll
    for (int j = 0; j < 4; ++j) { const int n = (lane >> 3) + 8 * j; const LAS float* s = scr + (8 * c) * 33 + n;
        v4u o; o.x = pk2(s[0 * 33], s[1 * 33]); o.y = pk2(s[2 * 33], s[3 * 33]); o.z = pk2(s[4 * 33], s[5 * 33]); o.w = pk2(s[6 * 33], s[7 * 33]);
        *(v4u*)(WT + (size_t)(n0 + n) * K + k0 + 8 * c) = o; }
    LDS_WAIT(); asm volatile("" ::: "memory");
}

__device__ __forceinline__ void rms_row(const float* xrow, const f32x4 (&gq)[4], bf16* orow, int lane, f32x4 (&v)[4]) {
    const f32x4* xr = (const f32x4*)xrow + lane; float s = 0.f;
#pragma unroll
    for (int j = 0; j < 4; ++j) { v[j] = xr[64 * j]; s += (v[j].x * v[j].x + v[j].y * v[j].y) + (v[j].z * v[j].z + v[j].w * v[j].w); }
    const float rstd = 1.0f / sqrtf(wave_sum(s) * (1.f / 1024.f) + EPS);
    unsigned long long* o8 = (unsigned long long*)orow + lane;
#pragma unroll
    for (int j = 0; j < 4; ++j) { v[j] = v[j] * rstd * gq[j]; o8[64 * j] = (unsigned long long)pk2(v[j].x, v[j].y) | ((unsigned long long)pk2(v[j].z, v[j].w) << 32); }
}

template <class Sched> __device__ __forceinline__ void build_rstd_tables(LAS unsigned char* lds, const Sched& S, const float* sspart, float eps, int wave) {
    const int lane = mk_lane(), tid = wave * 64 + lane;
    LAS int* pml = (LAS int*)(lds + RING_BYTES + 1536); LAS float* tab = (LAS float*)(lds + RING_BYTES + 2048);
    if (tid == 0) { int n = 0; pg8::Unit u; for (int i = 0; S.next(i, u); ++i) { bool f = false; for (int j = 0; j < n; ++j) f |= (pml[j] == u.pm); if (!f && n < 8) pml[n++] = u.pm; } pml[8] = n; }
    __syncthreads();
    const int n = pml[8];
    for (int idx = tid; idx < n * 256; idx += NWAVES * 64) tab[idx] = pg8::row_rstd(sspart, pml[idx >> 8] * 256 + (idx & 255), eps);
    __syncthreads();
}
__global__ void __launch_bounds__(NWAVES * 64, 2) mk_fwd(Params P) {
    extern __shared__ __attribute__((aligned(16))) unsigned char lds_raw[];
    LAS unsigned char* lds = (LAS unsigned char*)lds_raw;
    const int wave = __builtin_amdgcn_readfirstlane((int)threadIdx.x >> 6);
#define LANE_TID const int lane = mk_lane(), tid = wave * 64 + lane
    const int G = gridDim.x; const int bx = blockIdx.x; const int vcu = (G % 8 == 0) ? (bx % 8) * (G / 8) + bx / 8 : bx;
    const int gw = vcu * NWAVES + wave, NGW = G * NWAVES;
    unsigned char* const ws = P.ws;
#define ROPE ((float*)(P.ws + WS_ROPE))
#define LOGF ((float*)(P.ws + WS_LOGF))
#define KBIAS ((float*)(P.ws + WS_KB))
#define NRM ((float*)(P.ws + WS_NRM))
#define SS1 ((float*)(P.ws + WS_SS1))
#define SS2 ((float*)(P.ws + WS_SS2))
#define SS3 ((float*)(P.ws + WS_SS3))
#define Win_t ((bf16*)(P.ws + WS_WIN))
#define Wout_t ((bf16*)(P.ws + WS_WOUT))
#define Wcq_t ((bf16*)(P.ws + WS_WCQ))
#define Wckv_t ((bf16*)(P.ws + WS_WCKV))
#define Wco_t ((bf16*)(P.ws + WS_WCO))
#define Wup_t ((bf16*)(P.ws + WS_WUP))
#define Wdn_t ((bf16*)(P.ws + WS_WDN))
#define MEMN ((bf16*)(P.ws + WS_MEMN))
#define CKb ((bf16*)(P.ws + WS_CK))
#define CVT ((bf16*)(P.ws + WS_CVT))
#define XN ((bf16*)(P.ws + WS_SB))
#define MIXA ((bf16*)(P.ws + WS_SA))
#define CQ ((bf16*)(P.ws + WS_SA))
#define H2B ((bf16*)(P.ws + WS_SA))
#define H1B ((bf16*)(P.ws + WS_SB))
#define CO ((bf16*)(P.ws + WS_PROJ))
#define PROJ ((bf16*)(P.ws + WS_PROJ))
#define ATT ((bf16*)(P.ws + WS_ATT))
#define ZH ((bf16*)(P.ws + WS_ZH))
    const int lo = P.ph_lo, hi_ph = P.ph_hi;
    volatile LAS unsigned* xst = (volatile LAS unsigned*)(lds + RING_BYTES + 1024);
    { const int l0 = mk_lane(); if (wave == 0 && l0 < 2) xst[l0] = 0u; }
    __syncthreads();
    XcdBarrier bar; bar.bar = (unsigned*)(ws + WS_BAR); bar.x = 0; bar.st = xst;
    if (hi_ph - lo > 1) bar = xcd_barrier_post((unsigned*)(ws + WS_BAR), xst, wave == 0 && mk_lane() == 0);
    if (lo < 0) cg::this_grid().sync();
#define IN(k) (lo <= (k) && (k) < hi_ph)
#ifndef MK_MASK
#define MK_MASK 0x7ff
#endif
#ifndef MK_ATT_MASK
#define MK_ATT_MASK 3
#endif
#ifndef MK_REP_MASK
#define MK_REP_MASK 0
#endif
#define PH(k) (IN(k) && ((MK_MASK >> (k)) & 1))
#define REPS(k) for (int rep_ = 0; rep_ < (((MK_REP_MASK) >> (k)) & 1) + 1; ++rep_)
#define SEAM(k) do { if (IN(k) && IN((k) + 1)) { xcd_barrier(bar, wave == 0 && mk_lane() == 0); } } while (0)

    if (PH(0)) REPS(0) {
        LANE_TID;
        {
            const float* win = P.in[I_WIN];
            for (int k = tid; k < 1024; k += NWAVES * 64) { const f32x4 a = *(const f32x4*)(win + (size_t)k * INW + 3072), b = *(const f32x4*)(win + (size_t)k * INW + 3076);
                const int slot = (((k >> 8) * 4 + (k & 3)) * 64 + ((k & 255) >> 2)); *(LAS f32x4*)(lds + slot * 32) = a; *(LAS f32x4*)(lds + slot * 32 + 16) = b; }
        }
        if (bx == 0 && tid < BATCH * 64) NRM[tid] = 0.f;
        __syncthreads();
        LAS float* scr = (LAS float*)(lds + 32768 + wave * 8704);
        {
            constexpr int I_IN = 16 * 96, I_SQ = 16 * 32, I_CKV = 16 * 64, I_UP = 16 * 128, I_DN = 64 * 32;
            constexpr int NITEMS = I_IN + 3 * I_SQ + I_CKV + I_UP + I_DN;
            for (int it = gw; it < NITEMS; it += NGW) {
                int r = it;
                if (r < I_IN) { p0_transpose_item(P.in[I_WIN], D, INW, 96, Win_t, scr, r, lane, P.in[I_GMIX]); continue; } r -= I_IN;
                if (r < I_SQ) { p0_transpose_item(P.in[I_WOUT], D, D, 32, Wout_t, scr, r, lane); continue; } r -= I_SQ;
                if (r < I_SQ) { p0_transpose_item(P.in[I_WCQ], D, D, 32, Wcq_t, scr, r, lane, P.in[I_GCROSS]); continue; } r -= I_SQ;
                if (r < I_SQ) { p0_transpose_item(P.in[I_WCO], D, D, 32, Wco_t, scr, r, lane); continue; } r -= I_SQ;
                if (r < I_CKV) { p0_transpose_item(P.in[I_WCKV], D, 2 * D, 64, Wckv_t, scr, r, lane); continue; } r -= I_CKV;
                if (r < I_UP) { p0_transpose_item(P.in[I_WUP], D, FF, 128, Wup_t, scr, r, lane, P.in[I_GMLP]); continue; } r -= I_UP;
                p0_transpose_item(P.in[I_WDN], FF, D, 32, Wdn_t, scr, r, lane);
            }
        }
        {
            for (int idx = gw * 64 + lane; idx < SEQ * 8; idx += NGW * 64) {
                const int pos = idx >> 3, j = idx & 7;
                const float f = j == 0 ? 1.0f : j == 1 ? 0.1939227432012558f : j == 2 ? 0.03760603070259094f : j == 3 ? 0.007292664609849453f : j == 4 ? 0.0014142135623842478f : j == 5 ? 0.00027424818836152554f : j == 6 ? 5.318296098266728e-05f : 1.0313386155758053e-05f;
                const float ang = (float)pos * f;
                double rev = (double)ang * 0.15915494309189535; rev -= __builtin_rint(rev);
                const float x = (float)(rev * 6.283185307179586);
                ROPE[pos * 16 + j] = cosf(x); ROPE[pos * 16 + 8 + j] = sinf(x);
            }
        }
        {
            f32x4 gq[4];
#pragma unroll
            for (int j = 0; j < 4; ++j) gq[j] = ((const f32x4*)P.in[I_GMIX])[64 * j + lane];
            const float bfv = P.in[I_BF][lane & 7];
            const bool b0 = lane & 1, b1 = lane & 2, b2 = lane & 4;
            const bool xal = (G == 256); const int mstart = xal ? (bx & 7) * SEQ + ((bx >> 3) * NWAVES + wave) * 4 : gw * 4, mstep = xal ? 1024 : NGW * 4, mend = xal ? (bx & 7) * SEQ + SEQ : M;
            for (int m0 = mstart; m0 < mend; m0 += mstep) {
                f32x4 v[4][4]; float s[4];
#pragma unroll
                for (int r = 0; r < 4; ++r)
#pragma unroll
                    for (int jj = 0; jj < 4; ++jj) v[r][jj] = __builtin_nontemporal_load((const f32x4*)(P.in[I_X] + (size_t)(m0 + r) * D) + 64 * jj + lane);
#pragma unroll
                for (int r = 0; r < 4; ++r) { s[r] = 0.f;
#pragma unroll
                    for (int jj = 0; jj < 4; ++jj) s[r] += (v[r][jj].x * v[r][jj].x + v[r][jj].y * v[r][jj].y) + (v[r][jj].z * v[r][jj].z + v[r][jj].w * v[r][jj].w); }
#pragma unroll
                for (int r = 0; r < 4; ++r) { const float ssum = wave_sum(s[r]); const float rstd = 1.0f / sqrtf(ssum * (1.f / 1024.f) + EPS);
                    unsigned long long* o8 = (unsigned long long*)(XN + (size_t)(m0 + r) * D) + lane;
                    if (lane < 4) ((f32x4*)(SS3 + (size_t)(m0 + r) * 16))[lane] = (f32x4){lane == 0 ? ssum : 0.f, 0.f, 0.f, 0.f};
#pragma unroll
                    for (int jj = 0; jj < 4; ++jj) { o8[64 * jj] = (unsigned long long)pk2(v[r][jj].x, v[r][jj].y) | ((unsigned long long)pk2(v[r][jj].z, v[r][jj].w) << 32);
                        v[r][jj] = v[r][jj] * rstd * gq[jj]; } }
                f32x4 a0[4], a1[4];
#pragma unroll
                for (int r = 0; r < 4; ++r) { a0[r] = (f32x4){0.f, 0.f, 0.f, 0.f}; a1[r] = a0[r]; }
#pragma unroll
                for (int jj = 0; jj < 4; ++jj)
#pragma unroll
                    for (int i = 0; i < 4; ++i) { const LAS f32x4* wp = (const LAS f32x4*)(lds + ((jj * 4 + i) * 64 + lane) * 32); const f32x4 w0 = wp[0], w1 = wp[1];
#pragma unroll
                        for (int r = 0; r < 4; ++r) { a0[r] += w0 * v[r][jj][i]; a1[r] += w1 * v[r][jj][i]; } }
#pragma unroll
                for (int r = 0; r < 4; ++r) {
                    float c0, c1, c2, c3, d0, d1, z;
                    { const float k0 = b0 ? a0[r][1] : a0[r][0], g0 = b0 ? a0[r][0] : a0[r][1]; c0 = k0 + __shfl_xor(g0, 1); }
                    { const float k0 = b0 ? a0[r][3] : a0[r][2], g0 = b0 ? a0[r][2] : a0[r][3]; c1 = k0 + __shfl_xor(g0, 1); }
                    { const float k0 = b0 ? a1[r][1] : a1[r][0], g0 = b0 ? a1[r][0] : a1[r][1]; c2 = k0 + __shfl_xor(g0, 1); }
                    { const float k0 = b0 ? a1[r][3] : a1[r][2], g0 = b0 ? a1[r][2] : a1[r][3]; c3 = k0 + __shfl_xor(g0, 1); }
                    { const float k0 = b1 ? c1 : c0, g0 = b1 ? c0 : c1; d0 = k0 + __shfl_xor(g0, 2); }
                    { const float k0 = b1 ? c3 : c2, g0 = b1 ? c2 : c3; d1 = k0 + __shfl_xor(g0, 2); }
                    { const float k0 = b2 ? d1 : d0, g0 = b2 ? d0 : d1; z = k0 + __shfl_xor(g0, 4); }
                    z += __shfl_xor(z, 8); z += __shfl_xor(z, 16); z += __shfl_xor(z, 32);
                    z += bfv;
                    const float ls = fminf(z, 0.f) - __logf(1.0f + __expf(-fabsf(z)));
                    const int m = m0 + r;
                    if (lane < 8) LOGF[((size_t)(m >> 12) * 8 + lane) * SEQ + (m & 4095)] = ls;
                }
            }
        }
        {
            f32x4 gq[4];
#pragma unroll
            for (int j = 0; j < 4; ++j) gq[j] = ((const f32x4*)P.in[I_GMEM])[64 * j + lane];
            for (int m = gw; m < MM; m += NGW) { f32x4 v[4]; rms_row(P.in[I_MEM] + (size_t)m * D, gq, MEMN + (size_t)m * D, lane, v); }
        }
        __syncthreads();
    }
    SEAM(0);

    if (PH(1)) REPS(1) {
        LANE_TID;
        if (bx < BATCH * 8) {
            const float* src = LOGF + (size_t)bx * SEQ + tid * 8; float* dst = KBIAS + (size_t)bx * SEQ + tid * 8;
            const f32x4 a = *(const f32x4*)src, b = *(const f32x4*)(src + 4);
            float p[8]; p[0] = a[0]; p[1] = p[0] + a[1]; p[2] = p[1] + a[2]; p[3] = p[2] + a[3]; p[4] = p[3] + b[0]; p[5] = p[4] + b[1]; p[6] = p[5] + b[2]; p[7] = p[6] + b[3];
            float inc = p[7];
#pragma unroll
            for (int o = 1; o < 64; o <<= 1) { const float t = __shfl_up(inc, o); if (lane >= o) inc += t; }
            LAS float* wt = (LAS float*)lds;
            if (lane == 63) wt[wave] = inc;
            __syncthreads();
            float pre = inc - p[7];
            for (int w = 0; w < wave; ++w) pre += wt[w];
            const float c = -1.4426950408889634f;
            *(f32x4*)dst = (f32x4){(pre + p[0]) * c, (pre + p[1]) * c, (pre + p[2]) * c, (pre + p[3]) * c};
            *(f32x4*)(dst + 4) = (f32x4){(pre + p[4]) * c, (pre + p[5]) * c, (pre + p[6]) * c, (pre + p[7]) * c};
            __syncthreads();
        }
        { pg8::Gemm g{XN, Win_t, M, NPROJ, D}; pg8::StaticOrder S; S.init(M, NPROJ, G, bx);
          build_rstd_tables(lds, S, SS3, EPS, wave);
          pg8::EpiProj E{PROJ, ROPE, NRM, SS3, (const LAS int*)(lds + RING_BYTES + 1536), (const LAS float*)(lds + RING_BYTES + 2048)};
          pg8::gemm_phase<pg8::EpiProj, pg8::StaticOrder, true, true>(lds, g, S, E, wave); }
    }
    SEAM(1);

    if (PH(2)) REPS(2) {
        for (int p = vcu; p < 1024; p += G) {
            const int pp = p & 511, bh = pp >> 3, s = pp & 7, b = bh >> 3, hm = bh & 7;
#ifdef MK_REP_ATT
            if (rep_ == 1 && !((MK_REP_ATT) & (p < 512 ? 1 : 2))) continue;
#endif
            for (int hh = 0; hh < 2; ++hh) {
                const int qb = hh ? s : 15 - s;
                if (p < 512) { if (!(MK_ATT_MASK & 1)) continue;
                    const float* nq = NRM + 256 + ((b * 2 + 0) * 8 + hm) * 2; const float* nk = NRM + 256 + ((b * 2 + 1) * 8 + hm) * 2;
                    const float bqd = sqrtf((nq[0] + nq[1]) * (nk[0] + nk[1])) * 1.02f;
                    if (bqd < 64.f)
                        attn_body::attn_unit128<16, true>(b, qb, (const attn_body::bf16*)PROJ + hm * 64, (const attn_body::bf16*)PROJ + 512 + hm * 64, (const attn_body::bf16*)PROJ + 1024 + (hm >> 1) * 128,
                                                          (attn_body::bf16*)ATT + (hm & 1) * 512 + (hm >> 1) * 128, (char*)lds_raw, wave);
                    else
                        attn_body::attn_unit128<16, false>(b, qb, (const attn_body::bf16*)PROJ + hm * 64, (const attn_body::bf16*)PROJ + 512 + hm * 64, (const attn_body::bf16*)PROJ + 1024 + (hm >> 1) * 128,
                                                           (attn_body::bf16*)ATT + (hm & 1) * 512 + (hm >> 1) * 128, (char*)lds_raw, wave);
                } else { if (!(MK_ATT_MASK & 2)) continue; const int h = hm;
                    const float* nq = NRM + ((b * 2 + 0) * 8 + h) * 2; const float* nk = NRM + ((b * 2 + 1) * 8 + h) * 2; const float* kbr = KBIAS + (size_t)(b * 8 + h) * SEQ;
                    const float bqk = sqrtf((nq[0] + nq[1]) * (nk[0] + nk[1])) * 1.02f;
                    const int NTf = 4 * qb + 4, tc = 2 * (mk_lane() & 31);
                    const bool skip_ok = (tc >= 2) && (tc <= NTf - 4) && (2.f * bqk + kbr[64 * tc - 1 + (tc ? 0 : 1)] - kbr[256 * qb] < -40.f);
                    const unsigned long long bm = __ballot(skip_ok);
                    const int t0 = bm ? 2 * ((63 - __builtin_clzll(bm)) & 31) : 0;
                    attn_body::attn_unit<8, true>(b, qb, (const attn_body::bf16*)PROJ + 1536 + h * 64, (const attn_body::bf16*)PROJ + 2048 + h * 64, (const attn_body::bf16*)PROJ + 2560 + h * 64,
                                                  (attn_body::bf16*)ATT + 1024 + h * 64, kbr, t0, (char*)lds_raw, wave);
                }
            }
        }
    }
    SEAM(2);

    if (PH(3)) REPS(3) {
        LANE_TID;
        if (bx < 64) {
        { pg8::Gemm g{MEMN, Wckv_t, MM, D, D}; pg8::StaticOrder S; S.init(MM, D, G, bx);
          pg8::EpiBf16<0> E{CKb, D, nullptr, 0, 0, 1.f};
          pg8::gemm_phase<pg8::EpiBf16<0>, pg8::StaticOrder, true, true>(lds, g, S, E, wave); }
        { pg8::Gemm g{Wckv_t + (size_t)D * D, MEMN, D, MM, D}; pg8::StaticOrder S; S.init(D, MM, G, (bx + G - 32) % G);
          pg8::EpiBf16<0> E{CVT, MM, nullptr, 0, 0, 1.f};
          pg8::gemm_phase<pg8::EpiBf16<0>, pg8::StaticOrder, true, true>(lds, g, S, E, wave); }
        }
        const float sa = wave_sum(P.in[I_LQ1][lane] * P.in[I_LK1][lane]), sb = wave_sum(P.in[I_LQ2][lane] * P.in[I_LK2][lane]);
        const float lam = __expf(sa) - __expf(sb) + 0.2f;
        const f32x4 gs0 = *(const f32x4*)(P.in[I_GSUB] + (8 * lane) % 128), gs1 = *(const f32x4*)(P.in[I_GSUB] + (8 * lane) % 128 + 4);
        const f32x4 gf0 = *(const f32x4*)(P.in[I_GFOX] + (8 * lane) % 64), gf1 = *(const f32x4*)(P.in[I_GFOX] + (8 * lane) % 64 + 4);
        const int gw3 = (G > 64) ? (bx - 64) * NWAVES + wave : gw, NGW3 = (G > 64) ? (G - 64) * NWAVES : NGW;
        const bool xal3 = (G == 256); const int m3start = xal3 ? (bx & 7) * SEQ + ((bx - 64) >> 3) * NWAVES + wave : gw3, m3step = xal3 ? 24 * NWAVES : NGW3, m3end = xal3 ? (bx & 7) * SEQ + SEQ : M;
        if (G <= 64 || bx >= 64)
        for (int m = m3start; m < m3end; m += m3step) {
            const bf16* a = ATT + (size_t)m * NATT + 8 * lane;
            const v4u o1 = *(const v4u*)a, o2 = *(const v4u*)(a + 512), of = *(const v4u*)(a + 1024);
            float d[8], f[8];
#pragma unroll
            for (int e = 0; e < 4; ++e) { d[2 * e] = bflo(o1[e]) - lam * bflo(o2[e]); d[2 * e + 1] = bfhi(o1[e]) - lam * bfhi(o2[e]); f[2 * e] = bflo(of[e]); f[2 * e + 1] = bfhi(of[e]); }
            float sd = 0.f, sf = 0.f;
#pragma unroll
            for (int e = 0; e < 8; ++e) { sd += d[e] * d[e]; sf += f[e] * f[e]; }
            sd += __shfl_xor(sd, 1); sd += __shfl_xor(sd, 2); sd += __shfl_xor(sd, 4); sd += __shfl_xor(sd, 8);
            sf += __shfl_xor(sf, 1); sf += __shfl_xor(sf, 2); sf += __shfl_xor(sf, 4);
            const float rd = 0.8f / sqrtf(sd * (1.f / 128.f) + SUBLN_EPS), rf = 1.0f / sqrtf(sf * (1.f / 64.f) + EPS);
            v4u wd, wf;
            wd.x = pk2(d[0] * rd * gs0[0], d[1] * rd * gs0[1]); wd.y = pk2(d[2] * rd * gs0[2], d[3] * rd * gs0[3]); wd.z = pk2(d[4] * rd * gs1[0], d[5] * rd * gs1[1]); wd.w = pk2(d[6] * rd * gs1[2], d[7] * rd * gs1[3]);
            wf.x = pk2(f[0] * rf * gf0[0], f[1] * rf * gf0[1]); wf.y = pk2(f[2] * rf * gf0[2], f[3] * rf * gf0[3]); wf.z = pk2(f[4] * rf * gf1[0], f[5] * rf * gf1[1]); wf.w = pk2(f[6] * rf * gf1[2], f[7] * rf * gf1[3]);
            bf16* o = MIXA + (size_t)m * D + 8 * lane;
            *(v4u*)o = wd; *(v4u*)(o + 512) = wf;
        }
    }
    SEAM(3);

    if (PH(4)) REPS(4) { pg8::Gemm g{MIXA, Wout_t, M, D, D}; pg8::StaticOrder S; S.init(M, D, G, bx);
        pg8::EpiRes2<true, true> E{XN, H1B, SS1};
        pg8::gemm_phase<pg8::EpiRes2<true, true>, pg8::StaticOrder, true, true>(lds, g, S, E, wave); }
    SEAM(4);

    if (PH(5)) REPS(5) { pg8::Gemm g{H1B, Wcq_t, M, D, D}; pg8::StaticOrder S; S.init(M, D, G, bx);
        build_rstd_tables(lds, S, SS1, EPS, wave);
        pg8::EpiRowScale<0> E{CQ, D, SS1, EPS, pg8::CROSS_C2, (const LAS int*)(lds + RING_BYTES + 1536), (const LAS float*)(lds + RING_BYTES + 2048)};
        pg8::gemm_phase<pg8::EpiRowScale<0>, pg8::StaticOrder, true, true>(lds, g, S, E, wave); }
    SEAM(5);

    if (PH(6)) REPS(6) {
        const int upc = (512 + G - 1) / G;
        for (int u = vcu * upc; u < (vcu + 1) * upc && u < 512; ++u) { const int bh = u >> 4, qblk = u & 15; xattn::unit(bh >> 2, bh & 3, qblk, CQ, CKb, CVT, CO, lds, wave); }
    }
    SEAM(6);

    if (PH(7)) REPS(7) { pg8::Gemm g{CO, Wco_t, M, D, D}; pg8::StaticOrder S; S.init(M, D, G, bx);
        pg8::EpiRes2<true, true> E{H1B, H2B, SS2};
        pg8::gemm_phase<pg8::EpiRes2<true, true>, pg8::StaticOrder, true, true>(lds, g, S, E, wave); }
    SEAM(7);

    if (PH(8)) REPS(8) { pg8::Gemm g{H2B, Wup_t, M, FF, D}; pg8::StaticOrder S; S.init(M, FF, G, bx);
        build_rstd_tables(lds, S, SS2, EPS, wave);
        pg8::EpiRowScale<1> E{ZH, FF, SS2, EPS, 1.f, (const LAS int*)(lds + RING_BYTES + 1536), (const LAS float*)(lds + RING_BYTES + 2048)};
        pg8::gemm_phase<pg8::EpiRowScale<1>, pg8::StaticOrder, true, true>(lds, g, S, E, wave); }
    SEAM(8);

    if (PH(9)) REPS(9) { pg8::Gemm g{ZH, Wdn_t, M, D, FF}; pg8::StaticOrder S; S.init(M, D, G, bx); S.rev = true;
        pg8::EpiRes2<true, true> E{H2B, H1B  , SS3};
        pg8::gemm_phase<pg8::EpiRes2<true, true>, pg8::StaticOrder, true, true>(lds, g, S, E, wave); }
    SEAM(9);

    if (PH(10)) REPS(10) {
        LANE_TID;
        f32x4 gq[4];
#pragma unroll
        for (int j = 0; j < 4; ++j) gq[j] = ((const f32x4*)P.in[I_GFIN])[64 * j + lane];
        const bool xal = (G == 256); const int mstart = xal ? (bx & 7) * SEQ + ((bx >> 3) * NWAVES + wave) * 4 : gw * 4, mstep = xal ? 1024 : NGW * 4, mend = xal ? (bx & 7) * SEQ + SEQ : M;
        for (int m0 = mstart; m0 < mend; m0 += mstep) {
            unsigned long long w[4][4]; float rr[4];
#pragma unroll
            for (int q = 0; q < 4; ++q) { const unsigned long long* hb = (const unsigned long long*)(H1B + (size_t)(m0 + q) * D) + lane;
#pragma unroll
                for (int j = 0; j < 4; ++j) w[q][j] = hb[64 * j];
                rr[q] = pg8::row_rstd(SS3, m0 + q, EPS); }
#pragma unroll
            for (int q = 0; q < 4; ++q) { f32x4* o = (f32x4*)(P.out + (size_t)(m0 + q) * D) + lane;
#pragma unroll
                for (int j = 0; j < 4; ++j) { const unsigned lo = (unsigned)w[q][j], hi2 = (unsigned)(w[q][j] >> 32);
                    const f32x4 v = {bflo(lo), bfhi(lo), bflo(hi2), bfhi(hi2)}; o[64 * j] = v * rr[q] * gq[j]; } }
        }
    }
#undef IN
#undef SEAM
#undef LANE_TID
#undef ROPE
#undef LOGF
#undef KBIAS
#undef NRM
#undef SS1
#undef SS2
#undef SS3
#undef Win_t
#undef Wout_t
#undef Wcq_t
#undef Wckv_t
#undef Wco_t
#undef Wup_t
#undef Wdn_t
#undef MEMN
#undef CKb
#undef CVT
#undef XN
#undef MIXA
#undef CQ
#undef H2B
#undef H1B
#undef CO
#undef PROJ
#undef ATT
#undef ZH
}

extern "C" void kernel_launch(void* const* d_in, const int* in_sizes, int n_in, void* d_out, int out_size, void* d_ws, size_t ws_size, hipStream_t stream) {
    static int grid = 0;
    if (grid == 0) {
        if (n_in != 21 || in_sizes[0] != M * D || out_size != M * D || ws_size < WS_END) { fprintf(stderr, "kernel_launch: unexpected shapes (n_in %d, in0 %d, out %d, ws %zu); nothing launched\n", n_in, n_in > 0 ? in_sizes[0] : -1, out_size, ws_size); grid = -1; return; }
        int dev = 0, cus = 0, per_cu = 0;
        if (hipGetDevice(&dev) != hipSuccess || hipDeviceGetAttribute(&cus, hipDeviceAttributeMultiprocessorCount, dev) != hipSuccess) { grid = -1; return; }
        if (hipFuncSetAttribute((const void*)mk_fwd, hipFuncAttributeMaxDynamicSharedMemorySize, LDS_BYTES) != hipSuccess) { fprintf(stderr, "kernel_launch: hipFuncSetAttribute failed\n"); grid = -1; return; }
        if (hipOccupancyMaxActiveBlocksPerMultiprocessor(&per_cu, (const void*)mk_fwd, NWAVES * 64, LDS_BYTES) != hipSuccess || per_cu < 1) { fprintf(stderr, "kernel_launch: occupancy query says %d blocks per CU\n", per_cu); per_cu = 1; }
        (void)hipGetLastError();
        grid = cus * per_cu;
    }
    if (grid < 0) return;
    if (hipMemsetAsync((char*)d_ws + WS_BAR, 0, XCD_BAR_WORDS * 4, stream) != hipSuccess) { fprintf(stderr, "kernel_launch: memset of the barrier words failed\n"); return; }
    Params p{};
    for (int i = 0; i < 21; ++i) p.in[i] = (const float*)d_in[i];
    p.out = (float*)d_out; p.ws = (unsigned char*)d_ws;
#if MK_PER_PHASE
    for (int ph = 0; ph < N_PHASES; ++ph) { p.ph_lo = ph; p.ph_hi = ph + 1; hipLaunchKernelGGL(mk_fwd, dim3(grid), dim3(NWAVES * 64), LDS_BYTES, stream, p); }
#else
    p.ph_lo = 0; p.ph_hi = N_PHASES;
    void* args[] = {&p};
    const hipError_t e = hipLaunchCooperativeKernel((const void*)mk_fwd, dim3(grid), dim3(NWAVES * 64), args, LDS_BYTES, stream);
    if (e != hipSuccess) fprintf(stderr, "kernel_launch: cooperative launch failed: %s (grid %d)\n", hipGetErrorString(e), grid);
#endif
}
```

```cpp
#include <hip/hip_runtime.h>
#include <hip/hip_cooperative_groups.h>
#include <hip/hip_bf16.h>
#include <cstdio>
#include <cstdint>
#include <cmath>
namespace cg = cooperative_groups;
__device__ __forceinline__ int mk_lane() { int l = (int)__builtin_amdgcn_mbcnt_hi(~0u, __builtin_amdgcn_mbcnt_lo(~0u, 0u)); asm volatile("" : "+v"(l)); return l; }
namespace pg8 {
#define PG8_LAS __attribute__((address_space(3)))
typedef unsigned short bf16_t;
typedef short bf16x8 __attribute__((ext_vector_type(8)));
typedef float f32x4 __attribute__((ext_vector_type(4)));
typedef unsigned u32x4 __attribute__((ext_vector_type(4)));
constexpr int BM = 256, BK = 64, HALF = 128, HTB = HALF * BK * 2  , STAGE_BYTES = 8 * HTB, NXCD = 8, WGM = 8;

__host__ __device__ __forceinline__ int lds_byte(int r, int c) { const int st = (r >> 4) * 2 + (c >> 5), rr = r & 15, cc = c & 31, ob = rr * 64 + cc * 2; return st * 1024 + (ob ^ (((ob >> 9) & 1) << 5)); }
__host__ __device__ __forceinline__ void stage_rc(int b, int& R, int& C) { const int st = b / 1024, sb = b % 1024, swz = sb ^ (((sb >> 9) & 1) << 5); R = (st >> 1) * 16 + swz / 64; C = (st & 1) * 32 + (swz % 64) / 2; }
__host__ __device__ __forceinline__ int perm32(int rho) { const int n = rho >> 4, i = rho & 15; return 8 * (i >> 2) + 4 * n + (i & 3); }

struct Unit { int pm, pn; };
struct Gemm { const bf16_t* A; const bf16_t* Bt; int M, N, K; };

struct StaticOrder {
    int nM, nN, nwg, G, c; bool rev = false;
    __host__ __device__ __forceinline__ void init(int M, int N, int G_, int c_) { nM = M / BM; nN = N / BM; nwg = nM * nN; G = G_; c = c_; }
    __host__ __device__ __forceinline__ bool next(int i, Unit& u) const {
        const long L = (long)i * G + c; if (L >= nwg) return false;
        int wgid = (int)L; { const int q = nwg / NXCD, r = nwg % NXCD, xcd = wgid % NXCD, off = wgid / NXCD; wgid = (xcd < r ? xcd * (q + 1) : r * (q + 1) + (xcd - r) * q) + off; }
        const int nig = WGM * nN, gid = wgid / nig, fm = gid * WGM, gsz = (nM - fm) < WGM ? (nM - fm) : WGM;
        u.pm = fm + ((wgid % nig) % gsz); u.pn = (wgid % nig) / gsz; if (rev) u.pm = nM - 1 - u.pm; return true;
    }
    __device__ __forceinline__ void a_ready(const Unit&) const {}
    __device__ __forceinline__ void done(const Unit&) const {}
};

__device__ __forceinline__ unsigned cvt_pk_bf16(float lo, float hi) { unsigned r; asm volatile("v_cvt_pk_bf16_f32 %0, %1, %2" : "=v"(r) : "v"(lo), "v"(hi)); return r; }
typedef float f32x2 __attribute__((ext_vector_type(2)));
__device__ __forceinline__ f32x2 gelu_pk(f32x2 v) {
    const f32x2 av = __builtin_elementwise_abs(v), d = av * 0.2316418882f + 1.0f;
    f32x2 t; t.x = __builtin_amdgcn_rcpf(d.x); t.y = __builtin_amdgcn_rcpf(d.y);
    f32x2 q = t * 0.5307027145f + (-0.7265760135f); q = q * t + 0.7107068705f; q = q * t + (-0.142248368f); q = q * t + 0.127414796f; q = q * t;
    const f32x2 s = (v * v) * (-0.72134752044f);
    f32x2 e; e.x = __builtin_amdgcn_exp2f(s.x); e.y = __builtin_amdgcn_exp2f(s.y);
    const f32x2 m = v * (q * e), r = v - m;
    f32x2 o; o.x = v.x < 0.f ? m.x : r.x; o.y = v.y < 0.f ? m.y : r.y; return o;
}

template <int ACT  > struct EpiBf16 {
    static constexpr bool PERM = true, AFTER_DRAIN = false; static_assert(ACT == 0 || ACT == 1, "EpiBf16: ACT is 0 (none) or 1 (gelu_pk)");
    bf16_t* O; int ldc; const float* bias; int split_cols; size_t split_stride; float scale0;
    __device__ __forceinline__ void operator()(const f32x4 (&acc)[2][2][4][2], const Unit& u, int wr, int wc, int fr, int fq) const {
        const int row0 = u.pm * BM + wr * 64 + fr; int colt = u.pn * BM; bf16_t* base = O;
        float sc = 1.f; if (split_cols) { const int t = colt / split_cols; base += (size_t)t * split_stride; colt -= t * split_cols; if (t == 0) sc = scale0; }
        const int col0 = colt + wc * 32 + 8 * fq, bcol0 = u.pn * BM + wc * 32 + 8 * fq;
        f32x4 bv[2][2];
#pragma unroll
        for (int bj = 0; bj < 2; ++bj)
#pragma unroll
            for (int n = 0; n < 2; ++n) bv[bj][n] = bias ? *(const f32x4*)(bias + bcol0 + bj * HALF + 4 * n) : (f32x4){0.f, 0.f, 0.f, 0.f};
#pragma unroll
        for (int ai = 0; ai < 2; ++ai)
#pragma unroll
            for (int m = 0; m < 4; ++m) { bf16_t* rowp = base + (size_t)(row0 + ai * HALF + m * 16) * ldc + col0;
#pragma unroll
                for (int bj = 0; bj < 2; ++bj) { f32x4 v0 = acc[ai][bj][m][0] + bv[bj][0], v1 = acc[ai][bj][m][1] + bv[bj][1];
                    if (ACT == 1) { f32x2 a = gelu_pk((f32x2){v0[0], v0[1]}), b = gelu_pk((f32x2){v0[2], v0[3]}), c = gelu_pk((f32x2){v1[0], v1[1]}), d = gelu_pk((f32x2){v1[2], v1[3]});
                        v0 = (f32x4){a.x, a.y, b.x, b.y}; v1 = (f32x4){c.x, c.y, d.x, d.y}; }
                    v0 = v0 * sc; v1 = v1 * sc; u32x4 w; w.x = cvt_pk_bf16(v0[0], v0[1]); w.y = cvt_pk_bf16(v0[2], v0[3]); w.z = cvt_pk_bf16(v1[0], v1[1]); w.w = cvt_pk_bf16(v1[2], v1[3]);
                    *(u32x4*)(rowp + bj * HALF) = w; } }
    }
};

constexpr float QK_C2 = 0.125f * 1.4426950408889634f;
constexpr float CROSS_C2 = 0.0625f * 1.4426950408889634f;
__device__ __forceinline__ float row_rstd(const float* part, int row, float eps) {
    const f32x4* p = (const f32x4*)(part + (size_t)row * 16);
    const f32x4 a = p[0], b = p[1], c = p[2], d = p[3];
    const float s = ((a[0] + a[1]) + (a[2] + a[3])) + ((b[0] + b[1]) + (b[2] + b[3])) + ((c[0] + c[1]) + (c[2] + c[3])) + ((d[0] + d[1]) + (d[2] + d[3]));
    return 1.0f / sqrtf(s * (1.0f / 1024.0f) + eps);
}
struct EpiProj {
    static constexpr bool PERM = true, AFTER_DRAIN = false;
    bf16_t* O; const float* rope; float* nrm; const float* ssp; const PG8_LAS int* pml; const PG8_LAS float* tab;
    __device__ __forceinline__ void operator()(const f32x4 (&acc)[2][2][4][2], const Unit& u, int wr, int wc, int fr, int fq) const {
        const int row0 = u.pm * BM + wr * 64 + fr, col0 = u.pn * BM + wc * 32 + 8 * fq;
        const int typ = u.pn >> 1;
        const float sc = (typ == 0 || typ == 3) ? QK_C2 : 1.f;
        int slot = -1;
        if (tab) { const int n = pml[8]; for (int j = 0; j < n; ++j) if (pml[j] == u.pm) slot = j; }
        const bool ropew = (typ < 2) && ((wc & 1) == 0);
        const bool nrmw = (typ == 0 || typ == 1 || typ == 3 || typ == 4); float mxn[2] = {0.f, 0.f};
#pragma unroll
        for (int ai = 0; ai < 2; ++ai) {
            f32x4 rc[4][4];
            if (ropew) {
#pragma unroll
                for (int m = 0; m < 4; ++m) { const f32x4* rp = (const f32x4*)(rope + (size_t)((row0 + ai * HALF + m * 16) & 4095) * 16); rc[m][0] = rp[0]; rc[m][1] = rp[1]; rc[m][2] = rp[2]; rc[m][3] = rp[3]; }
            }
#pragma unroll
            for (int m = 0; m < 4; ++m) {
                const int row = row0 + ai * HALF + m * 16;
                bf16_t* rowp = O + (size_t)row * 3072 + col0;
                const float scr = sc * (slot >= 0 ? tab[slot * 256 + (row - u.pm * BM)] : row_rstd(ssp, row, 1e-6f));
                f32x4 c0 = {1.f, 1.f, 1.f, 1.f}, c1 = c0, s0 = {0.f, 0.f, 0.f, 0.f}, s1 = s0;
                if (ropew) { c0 = rc[m][0]; c1 = rc[m][1]; s0 = rc[m][2]; s1 = rc[m][3]; if (fq == 0) { s0 = -s0; s1 = -s1; } if (fq >= 2) { c0 = (f32x4){1.f, 1.f, 1.f, 1.f}; c1 = c0; s0 = (f32x4){0.f, 0.f, 0.f, 0.f}; s1 = s0; } }
#pragma unroll
                for (int bj = 0; bj < 2; ++bj) {
                    f32x4 v0 = acc[ai][bj][m][0], v1 = acc[ai][bj][m][1];
                    if (ropew) {
                        f32x4 p0, p1;
#pragma unroll
                        for (int e = 0; e < 4; ++e) { p0[e] = __shfl_xor(v0[e], 16); p1[e] = __shfl_xor(v1[e], 16); }
                        v0 = v0 * c0 + p0 * s0; v1 = v1 * c1 + p1 * s1;
                    }
                    v0 = v0 * scr; v1 = v1 * scr;
                    if (nrmw) { float q = (v0[0] * v0[0] + v0[1] * v0[1]) + (v0[2] * v0[2] + v0[3] * v0[3]) + (v1[0] * v1[0] + v1[1] * v1[1]) + (v1[2] * v1[2] + v1[3] * v1[3]);
                        q += __shfl_xor(q, 16); q += __shfl_xor(q, 32); mxn[bj] = fmaxf(mxn[bj], q); }
                    u32x4 w; w.x = cvt_pk_bf16(v0[0], v0[1]); w.y = cvt_pk_bf16(v0[2], v0[3]); w.z = cvt_pk_bf16(v1[0], v1[1]); w.w = cvt_pk_bf16(v1[2], v1[3]);
                    *(u32x4*)(rowp + bj * HALF) = w;
                }
            }
        }
        if (nrmw) {
#pragma unroll
            for (int bj = 0; bj < 2; ++bj) { float q = mxn[bj];
                q = fmaxf(q, __shfl_xor(q, 1)); q = fmaxf(q, __shfl_xor(q, 2)); q = fmaxf(q, __shfl_xor(q, 4)); q = fmaxf(q, __shfl_xor(q, 8));
                const int rel = 256 * (u.pn & 1) + 128 * bj + 32 * wc, b = (u.pm * BM) >> 12;
                if (fr == 0 && fq == 0) atomicMax((unsigned*)nrm + (typ < 2 ? 256 : 0) + ((b * 2 + ((typ == 1 || typ == 4) ? 1 : 0)) * 8 + (rel >> 6)) * 2 + ((rel >> 5) & 1), __float_as_uint(q * 1.02f)); }
        }
    }
};
template <bool BASE_BF16, bool OUT_BF16> struct EpiRes2 {
    static constexpr bool PERM = true, AFTER_DRAIN = false;
    const void* base; void* out; float* sspart;
    __device__ __forceinline__ void operator()(const f32x4 (&acc)[2][2][4][2], const Unit& u, int wr, int wc, int fr, int fq) const {
        const int row0 = u.pm * BM + wr * 64 + fr, col0 = u.pn * BM + wc * 32 + 8 * fq;
#pragma unroll
        for (int ai = 0; ai < 2; ++ai) {
            u32x4 bw[4][2]; f32x4 bf[4][2][2];
#pragma unroll
            for (int m = 0; m < 4; ++m)
#pragma unroll
                for (int bj = 0; bj < 2; ++bj) { const size_t off = (size_t)(row0 + ai * HALF + m * 16) * 1024 + col0 + bj * HALF;
                    if (BASE_BF16) bw[m][bj] = *(const u32x4*)((const bf16_t*)base + off);
                    else { bf[m][bj][0] = *(const f32x4*)((const float*)base + off); bf[m][bj][1] = *(const f32x4*)((const float*)base + off + 4); } }
#pragma unroll
            for (int m = 0; m < 4; ++m) {
                const int row = row0 + ai * HALF + m * 16; const size_t off = (size_t)row * 1024 + col0;
                float ss = 0.f;
#pragma unroll
                for (int bj = 0; bj < 2; ++bj) {
                    f32x4 b0, b1;
                    if (BASE_BF16) { const u32x4 w = bw[m][bj];
                        b0 = (f32x4){__builtin_bit_cast(float, w.x << 16), __builtin_bit_cast(float, w.x & 0xffff0000u), __builtin_bit_cast(float, w.y << 16), __builtin_bit_cast(float, w.y & 0xffff0000u)};
                        b1 = (f32x4){__builtin_bit_cast(float, w.z << 16), __builtin_bit_cast(float, w.z & 0xffff0000u), __builtin_bit_cast(float, w.w << 16), __builtin_bit_cast(float, w.w & 0xffff0000u)}; }
                    else { b0 = bf[m][bj][0]; b1 = bf[m][bj][1]; }
                    const f32x4 v0 = acc[ai][bj][m][0] + b0, v1 = acc[ai][bj][m][1] + b1;
                    ss += (v0[0] * v0[0] + v0[1] * v0[1]) + (v0[2] * v0[2] + v0[3] * v0[3]) + (v1[0] * v1[0] + v1[1] * v1[1]) + (v1[2] * v1[2] + v1[3] * v1[3]);
                    if (OUT_BF16) { u32x4 w; w.x = cvt_pk_bf16(v0[0], v0[1]); w.y = cvt_pk_bf16(v0[2], v0[3]); w.z = cvt_pk_bf16(v1[0], v1[1]); w.w = cvt_pk_bf16(v1[2], v1[3]);
                        *(u32x4*)((bf16_t*)out + off + bj * HALF) = w; }
                    else { *(f32x4*)((float*)out + off + bj * HALF) = v0; *(f32x4*)((float*)out + off + bj * HALF + 4) = v1; }
                }
                ss += __shfl_xor(ss, 16); ss += __shfl_xor(ss, 32);
                if (fq == 0) sspart[(size_t)row * 16 + u.pn * 4 + wc] = ss;
            }
        }
    }
};
template <int ACT> struct EpiRowScale {
    static constexpr bool PERM = true, AFTER_DRAIN = false;
    bf16_t* O; int ldc; const float* sspart; float eps; float sc;
    const PG8_LAS int* pml; const PG8_LAS float* tab;
    __device__ __forceinline__ void operator()(const f32x4 (&acc)[2][2][4][2], const Unit& u, int wr, int wc, int fr, int fq) const {
        const int row0 = u.pm * BM + wr * 64 + fr, col0 = u.pn * BM + wc * 32 + 8 * fq;
        int slot = -1;
        if (tab) { const int n = pml[8]; for (int j = 0; j < n; ++j) if (pml[j] == u.pm) slot = j; }
#pragma unroll
        for (int ai = 0; ai < 2; ++ai)
#pragma unroll
            for (int m = 0; m < 4; ++m) {
                const int row = row0 + ai * HALF + m * 16; bf16_t* rowp = O + (size_t)row * ldc + col0;
                const float r = (slot >= 0 ? tab[slot * 256 + (row - u.pm * BM)] : row_rstd(sspart, row, eps)) * sc;
#pragma unroll
                for (int bj = 0; bj < 2; ++bj) {
                    f32x4 v0 = acc[ai][bj][m][0] * r, v1 = acc[ai][bj][m][1] * r;
                    if (ACT == 1) {
#pragma unroll
                        for (int e = 0; e < 4; ++e) { const float a = fmaxf(v0[e], 0.f), b = fmaxf(v1[e], 0.f); v0[e] = a * a; v1[e] = b * b; }
                    }
                    u32x4 w; w.x = cvt_pk_bf16(v0[0], v0[1]); w.y = cvt_pk_bf16(v0[2], v0[3]); w.z = cvt_pk_bf16(v1[0], v1[1]); w.w = cvt_pk_bf16(v1[2], v1[3]);
                    *(u32x4*)(rowp + bj * HALF) = w;
                }
            }
    }
};
template <class Epi, class Sched, bool ALIGN_EPI = false, bool SP2 = false>
__device__ __forceinline__ void gemm_phase(PG8_LAS unsigned char* lds, const Gemm g, const Sched& S, const Epi& E, const int wv  ) {
    int tid_ = wv * 64 + mk_lane();
    const int tid = tid_, wid = __builtin_amdgcn_readfirstlane(tid >> 6), lane = tid & 63, wr = wid >> 2, wc = wid & 3, fr = lane & 15, fq = lane >> 4;
    const int K = g.K, nt = K / BK;
    unsigned voffA[2], voffB[2];
#pragma unroll
    for (int i = 0; i < 2; ++i) { int R, C; stage_rc(tid * 16 + i * 8192, R, C); const int Rb = Epi::PERM ? ((R & ~31) + perm32(R & 31)) : R;
        voffA[i] = (unsigned)(R * K + C) * 2u; voffB[i] = (unsigned)(Rb * K + C) * 2u; }
    const size_t kstep = (size_t)(BK * 2);
    const size_t hstep = (size_t)HALF * K * 2;
    const size_t tstep = 2 * hstep;
    const unsigned ldsw = (unsigned)wid * 1024u;
    const int aoff = lds_byte(wr * 64 + fr, fq * 8), boff = lds_byte(wc * 32 + fr, fq * 8);
#define PG8_SA(b, h) (((b) * 2 + (h)) * HTB)
#define PG8_SB(b, h) ((4 + (b) * 2 + (h)) * HTB)
#define PG8_STAGE(bufoff, gbase, voff) do { _Pragma("unroll") for (int _i = 0; _i < 2; ++_i) \
        __builtin_amdgcn_global_load_lds((const unsigned*)((const char*)(gbase) + (voff)[_i]), (PG8_LAS unsigned*)(lds + (bufoff) + ldsw + _i * 8192), 16, 0, 0); } while (0)
#define PG8_LDA(dst, b, h) do { _Pragma("unroll") for (int m = 0; m < 4; ++m) _Pragma("unroll") for (int k = 0; k < 2; ++k) dst[m][k] = *(const PG8_LAS bf16x8*)(lds + PG8_SA(b, h) + aoff + m * 2048 + k * 1024); } while (0)
#define PG8_LDB(dst, b, h) do { _Pragma("unroll") for (int n = 0; n < 2; ++n) _Pragma("unroll") for (int k = 0; k < 2; ++k) dst[n][k] = *(const PG8_LAS bf16x8*)(lds + PG8_SB(b, h) + boff + n * 2048 + k * 1024); } while (0)
#define PG8_MMA(ai, bj, At, Bt) do { __builtin_amdgcn_s_setprio(1); _Pragma("unroll") for (int m = 0; m < 4; ++m) _Pragma("unroll") for (int n = 0; n < 2; ++n) _Pragma("unroll") for (int k = 0; k < 2; ++k) \
        acc[ai][bj][m][n] = __builtin_amdgcn_mfma_f32_16x16x32_bf16(Bt[n][k], At[m][k], acc[ai][bj][m][n], 0, 0, 0); __builtin_amdgcn_s_setprio(0); } while (0)
#define PG8_WAIT_V(n) asm volatile("s_waitcnt vmcnt(" #n ")" ::: "memory")
#define PG8_WAIT_L(n) asm volatile("s_waitcnt lgkmcnt(" #n ")" ::: "memory")
#define PG8_BAR __builtin_amdgcn_s_barrier()
#define PG8_SCHED __builtin_amdgcn_sched_barrier(0)
    Unit cur, nxt; int ui = 0;
    if (!S.next(0, cur)) return;
    f32x4 acc[2][2][4][2];
#pragma unroll
    for (int a = 0; a < 2; ++a)
#pragma unroll
        for (int b = 0; b < 2; ++b)
#pragma unroll
            for (int m = 0; m < 4; ++m)
#pragma unroll
                for (int n = 0; n < 2; ++n) acc[a][b][m][n] = (f32x4){0.f, 0.f, 0.f, 0.f};
    bf16x8 At[4][2], B0[2][2], B1[2][2];
    const char* cA = (const char*)g.A + (size_t)cur.pm * tstep; const char* cB = (const char*)g.Bt + (size_t)cur.pn * tstep;
    S.a_ready(cur);
    if constexpr (SP2) {
        PG8_STAGE(PG8_SB(0, 0), cB, voffB); PG8_STAGE(PG8_SB(0, 1), cB + hstep, voffB); PG8_STAGE(PG8_SA(0, 0), cA, voffA); PG8_STAGE(PG8_SA(0, 1), cA + hstep, voffA);
        if (wr == 1) PG8_BAR;
        PG8_WAIT_V(2); PG8_BAR;
        PG8_STAGE(PG8_SB(1, 0), cB + kstep, voffB); PG8_STAGE(PG8_SA(1, 0), cA + kstep, voffA); PG8_STAGE(PG8_SB(1, 1), cB + hstep + kstep, voffB);
        PG8_WAIT_V(6); PG8_BAR;
    } else {
        PG8_STAGE(PG8_SB(0, 0), cB, voffB); PG8_STAGE(PG8_SA(0, 0), cA, voffA); PG8_STAGE(PG8_SB(0, 1), cB + hstep, voffB); PG8_STAGE(PG8_SA(0, 1), cA + hstep, voffA);
        if (wr == 1) PG8_BAR;
        PG8_WAIT_V(4); PG8_BAR;
        PG8_STAGE(PG8_SB(1, 0), cB + kstep, voffB); PG8_STAGE(PG8_SA(1, 0), cA + kstep, voffA); PG8_STAGE(PG8_SB(1, 1), cB + hstep + kstep, voffB);
        PG8_WAIT_V(6); PG8_BAR;
    }
    for (;;) {
        const bool has_next = S.next(ui + 1, nxt);
        const char* nA = has_next ? (const char*)g.A + (size_t)nxt.pm * tstep : cA; const char* nB = has_next ? (const char*)g.Bt + (size_t)nxt.pn * tstep : cB;
        for (int t = 0; t < nt; t += 2) {
            const bool last = (t == nt - 2);
            const char* a1 = cA + (size_t)(t + 1) * kstep;
            const char* a2 = last ? nA : cA + (size_t)(t + 2) * kstep; const char* b2 = last ? nB : cB + (size_t)(t + 2) * kstep;
            const char* a3 = a2 + kstep; const char* b3 = b2 + kstep;
            if (last && has_next) S.a_ready(nxt);
            if constexpr (SP2) {
            PG8_LDB(B0, 0, 0); PG8_LDB(B1, 0, 1); PG8_SCHED; PG8_LDA(At, 0, 0); PG8_STAGE(PG8_SA(1, 1), a1 + hstep, voffA);
            PG8_WAIT_V(8); PG8_WAIT_L(0); PG8_BAR; PG8_MMA(0, 0, At, B0); PG8_MMA(0, 1, At, B1); PG8_BAR; PG8_SCHED;
            PG8_LDA(At, 0, 1); PG8_STAGE(PG8_SB(0, 0), b2, voffB); PG8_STAGE(PG8_SB(0, 1), b2 + hstep, voffB); PG8_STAGE(PG8_SA(0, 0), a2, voffA);
            PG8_WAIT_V(8); PG8_WAIT_L(0); PG8_BAR; PG8_MMA(1, 0, At, B0); PG8_MMA(1, 1, At, B1); PG8_BAR; PG8_SCHED;
            PG8_LDB(B0, 1, 0); PG8_LDB(B1, 1, 1); PG8_SCHED; PG8_LDA(At, 1, 0); PG8_STAGE(PG8_SA(0, 1), a2 + hstep, voffA);
            PG8_WAIT_V(8); PG8_WAIT_L(0); PG8_BAR; PG8_MMA(0, 0, At, B0); PG8_MMA(0, 1, At, B1); PG8_BAR; PG8_SCHED;
            PG8_LDA(At, 1, 1); PG8_STAGE(PG8_SB(1, 0), b3, voffB); PG8_STAGE(PG8_SB(1, 1), b3 + hstep, voffB); PG8_STAGE(PG8_SA(1, 0), a3, voffA);
            PG8_WAIT_V(8); PG8_WAIT_L(0); PG8_BAR; PG8_MMA(1, 0, At, B0); PG8_MMA(1, 1, At, B1); PG8_BAR; PG8_SCHED;
            } else {
            PG8_LDB(B0, 0, 0); PG8_SCHED; PG8_LDA(At, 0, 0); PG8_STAGE(PG8_SA(1, 1), a1 + hstep, voffA);
            PG8_WAIT_L(8); PG8_BAR; PG8_WAIT_L(0); PG8_MMA(0, 0, At, B0); PG8_BAR; PG8_SCHED;
            PG8_LDB(B1, 0, 1); PG8_STAGE(PG8_SB(0, 0), b2, voffB);
            PG8_BAR; PG8_WAIT_L(0); PG8_MMA(0, 1, At, B1); PG8_BAR;
            PG8_LDA(At, 0, 1); PG8_STAGE(PG8_SA(0, 0), a2, voffA);
            PG8_BAR; PG8_WAIT_L(0); PG8_MMA(1, 0, At, B0); PG8_BAR; PG8_SCHED;
            PG8_STAGE(PG8_SB(0, 1), b2 + hstep, voffB);
            PG8_WAIT_V(6); PG8_BAR; PG8_MMA(1, 1, At, B1); PG8_BAR;
            PG8_LDB(B0, 1, 0); PG8_SCHED; PG8_LDA(At, 1, 0); PG8_STAGE(PG8_SA(0, 1), a2 + hstep, voffA);
            PG8_WAIT_L(8); PG8_BAR; PG8_WAIT_L(0); PG8_MMA(0, 0, At, B0); PG8_BAR; PG8_SCHED;
            PG8_LDB(B1, 1, 1); PG8_STAGE(PG8_SB(1, 0), b3, voffB);
            PG8_BAR; PG8_WAIT_L(0); PG8_MMA(0, 1, At, B1); PG8_BAR;
            PG8_LDA(At, 1, 1); PG8_STAGE(PG8_SA(1, 0), a3, voffA);
            PG8_BAR; PG8_WAIT_L(0); PG8_MMA(1, 0, At, B0); PG8_BAR; PG8_SCHED;
            PG8_STAGE(PG8_SB(1, 1), b3 + hstep, voffB);
            PG8_WAIT_V(6); PG8_BAR; PG8_MMA(1, 1, At, B1); PG8_BAR;
            }
        }
        if constexpr (ALIGN_EPI) { if (wr == 0) PG8_BAR; }
        if constexpr (!Epi::AFTER_DRAIN) { E(acc, cur, wr, wc, fr, fq); S.done(cur); }
        if (!has_next) break;
#pragma unroll
        for (int a = 0; a < 2; ++a)
#pragma unroll
            for (int b = 0; b < 2; ++b)
#pragma unroll
                for (int m = 0; m < 4; ++m)
#pragma unroll
                    for (int n = 0; n < 2; ++n) acc[a][b][m][n] = (f32x4){0.f, 0.f, 0.f, 0.f};
        cur = nxt; cA = nA; cB = nB; ++ui;
        if constexpr (ALIGN_EPI) { if (wr == 1) PG8_BAR; }
    }
    PG8_WAIT_V(0);
    if constexpr (!ALIGN_EPI) { if (wr == 0) PG8_BAR; }
    PG8_BAR;
    if constexpr (Epi::AFTER_DRAIN) { E.fused(acc, cur, wr, wc, fr, fq, lds, wid, lane); S.done(cur); }
#undef PG8_SA
#undef PG8_SB
#undef PG8_STAGE
#undef PG8_LDA
#undef PG8_LDB
#undef PG8_MMA
#undef PG8_WAIT_V
#undef PG8_WAIT_L
#undef PG8_BAR
#undef PG8_SCHED
}
}

#ifndef PG8_SP2
#define PG8_SP2 true
#endif
#ifndef PG8_ALIGN
#define PG8_ALIGN true
#endif
namespace attn_body {
using bf16=__hip_bfloat16;
using bf16x8=__attribute__((ext_vector_type(8)))short;
using s16x4=__attribute__((ext_vector_type(4)))short;
using f32x16=__attribute__((ext_vector_type(16)))float;
using u32x4=__attribute__((ext_vector_type(4)))unsigned; using f32x4=__attribute__((ext_vector_type(4)))float;
constexpr int SEQ=4096,D=64,PQ=3072,PO=1536;
constexpr int NW=8,QBLK=32,QB=QBLK*NW,KVBLK=64,NQB=SEQ/QB;
constexpr int ATTN_UNIT_ROWS=QB;
__device__ __forceinline__ int crow(int r,int hi){return (r&3)+8*(r>>2)+4*hi;}
#define SBAR() __builtin_amdgcn_sched_barrier(0)
__device__ __forceinline__ void cmask(f32x16&p0,f32x16&p1,int jb,int qrel,int hi){
  const float NEG=-INFINITY; int kb=64*jb+4*hi;
  #pragma unroll
  for(int r=0;r<16;++r){int kv=kb+(r&3)+8*(r>>2); if(kv>qrel)p0[r]=NEG; if(kv+32>qrel)p1[r]=NEG;}
}

template<bool B> __device__ __forceinline__ const f32x16& csel(const f32x16&a,const f32x16&b){ if constexpr(B) return a; else return b; }
constexpr int NSLOT=3, SLOTB=8192;
constexpr int LDS_K=0, LDS_V=NSLOT*SLOTB, LDS_WS=2*NSLOT*SLOTB, LDS_OST=LDS_WS+NW*64*4, LDS_KBIAS=LDS_OST+NW*4096, LDS_BYTES=LDS_KBIAS+SEQ*4;
constexpr float C2=0.125f*1.4426950408889634f;
__device__ __forceinline__ void glds16(const void*gsrc,unsigned lds_dst){unsigned keep;
  asm volatile("s_mov_b32 %0, m0\n\ts_mov_b32 m0, %2\n\ts_nop 0\n\tglobal_load_lds_dwordx4 %1, off\n\ts_mov_b32 m0, %0":"=&s"(keep):"v"(gsrc),"s"(lds_dst):"memory");}
__device__ __forceinline__ float max3f(float a,float b,float c){float r;asm("v_max3_f32 %0, %1, %2, %3":"=v"(r):"v"(a),"v"(b),"v"(c));return r;}
__device__ __forceinline__ float max2f(float a,float b){float r;asm("v_max_f32_e32 %0, %1, %2":"=v"(r):"v"(a),"v"(b));return r;}
__device__ __forceinline__ float fadd_s(float a,float b){float r;asm("v_add_f32_e32 %0, %1, %2":"=v"(r):"v"(a),"v"(b));return r;}
__device__ __forceinline__ float fsub_s(float a,float b){float r;asm("v_sub_f32_e32 %0, %1, %2":"=v"(r):"v"(a),"v"(b));return r;}
typedef float f32x2_t __attribute__((ext_vector_type(2))); typedef __bf16 bf16x2_t __attribute__((ext_vector_type(2)));
__device__ __forceinline__ unsigned cvtpk_s(float lo,float hi){f32x2_t v={lo,hi};bf16x2_t b=__builtin_convertvector(v,bf16x2_t);return __builtin_bit_cast(unsigned,b);}
#define WAIT_BAR(N) asm volatile("s_waitcnt vmcnt(" #N ") lgkmcnt(0)\n\ts_barrier":::"memory")

__device__ __forceinline__ void qkt(f32x16&p0,f32x16&p1,const char*Kslot,const bf16x8*qr,const f32x16&ci0,const f32x16&ci1,int r32,int hi){
  const char*kb=Kslot+hi*1024+r32*16;
  #pragma unroll
  for(int d0=0;d0<4;++d0){
    const bf16x8 b0=*reinterpret_cast<const bf16x8*>(kb+d0*2048);
    const bf16x8 b1=*reinterpret_cast<const bf16x8*>(kb+d0*2048+512);
    if(d0==0){p0=__builtin_amdgcn_mfma_f32_32x32x16_bf16(b0,qr[0],ci0,0,0,0);p1=__builtin_amdgcn_mfma_f32_32x32x16_bf16(b1,qr[0],ci1,0,0,0);}
    else{p0=__builtin_amdgcn_mfma_f32_32x32x16_bf16(b0,qr[d0],p0,0,0,0);p1=__builtin_amdgcn_mfma_f32_32x32x16_bf16(b1,qr[d0],p1,0,0,0);}}
}
typedef __attribute__((address_space(3))) const char* lds_cptr;
typedef short v4i16_t __attribute__((ext_vector_type(4)));
__device__ __forceinline__ void kload8(bf16x8*kf,lds_cptr kp){
  kf[0]=*(const __attribute__((address_space(3))) bf16x8*)(kp);      kf[1]=*(const __attribute__((address_space(3))) bf16x8*)(kp+512);
  kf[2]=*(const __attribute__((address_space(3))) bf16x8*)(kp+2048); kf[3]=*(const __attribute__((address_space(3))) bf16x8*)(kp+2560);
  kf[4]=*(const __attribute__((address_space(3))) bf16x8*)(kp+4096); kf[5]=*(const __attribute__((address_space(3))) bf16x8*)(kp+4608);
  kf[6]=*(const __attribute__((address_space(3))) bf16x8*)(kp+6144); kf[7]=*(const __attribute__((address_space(3))) bf16x8*)(kp+6656);
}
__device__ __forceinline__ void kload2(bf16x8*kf,lds_cptr kp,int j){ kf[2*j]=*(const __attribute__((address_space(3))) bf16x8*)(kp+j*2048); kf[2*j+1]=*(const __attribute__((address_space(3))) bf16x8*)(kp+j*2048+512); }
__device__ __forceinline__ s16x4 vtr(lds_cptr p){ return __builtin_bit_cast(s16x4,__builtin_amdgcn_ds_read_tr16_b64_v4i16((__attribute__((address_space(3))) v4i16_t*)p)); }
__device__ __forceinline__ float rowmax(const f32x16&p0,const f32x16&p1){
  float a=max3f(p0[0],p0[1],p1[0]),b=max3f(p0[2],p0[3],p1[1]);a=max3f(a,p1[2],p1[3]);
  #pragma unroll
  for(int r=4;r<16;r+=4){a=max3f(a,p0[r],p0[r+1]);b=max3f(b,p0[r+2],p0[r+3]);a=max3f(a,p1[r],p1[r+1]);b=max3f(b,p1[r+2],p1[r+3]);}
  const float m=max2f(a,b);
  auto rr=__builtin_amdgcn_permlane32_swap(__float_as_uint(m),__float_as_uint(m),false,false);
  return max2f(__uint_as_float(rr[0]),__uint_as_float(rr[1]));
}
__device__ __forceinline__ void pv(f32x16*o,int vb,bf16x8 pa0,bf16x8 pa1,bf16x8 pa2,bf16x8 pa3){
  #pragma unroll
  for(int d0=0;d0<2;++d0){s16x4 lo[4],hi[4];
    #pragma unroll
    for(int ks=0;ks<4;++ks){
      asm volatile("ds_read_b64_tr_b16 %0,%1 offset:%c2":"=&v"(lo[ks]):"v"(vb),"i"(d0*4096+ks*1024):"memory");
      asm volatile("ds_read_b64_tr_b16 %0,%1 offset:%c2":"=&v"(hi[ks]):"v"(vb),"i"(d0*4096+ks*1024+512):"memory");}
    asm volatile("s_waitcnt lgkmcnt(0)":::"memory");SBAR();
    #define PK(k) (bf16x8){lo[k][0],lo[k][1],lo[k][2],lo[k][3],hi[k][0],hi[k][1],hi[k][2],hi[k][3]}
    o[d0]=__builtin_amdgcn_mfma_f32_32x32x16_bf16(pa0,PK(0),o[d0],0,0,0);
    o[d0]=__builtin_amdgcn_mfma_f32_32x32x16_bf16(pa1,PK(1),o[d0],0,0,0);
    o[d0]=__builtin_amdgcn_mfma_f32_32x32x16_bf16(pa2,PK(2),o[d0],0,0,0);
    o[d0]=__builtin_amdgcn_mfma_f32_32x32x16_bf16(pa3,PK(3),o[d0],0,0,0);
    #undef PK
  }
}

#ifndef ATTN_STORE16
#define ATTN_STORE16(p,v) (*(u32x4*)(p)=(v))
#endif
template<int THRL,bool HASB> __device__ __forceinline__ void attn_unit(int b,int qb,const bf16*Qc,const bf16*__restrict__ Kc,const bf16*__restrict__ Vc,bf16*Oc,const float*__restrict__ kbg,int t0,char*shm,const int wv){
  int tid_=wv*64+mk_lane();
  const int tid=tid_,lane=tid&63,r32=lane&31,hi=lane>>5; const int wid=__builtin_amdgcn_readfirstlane(tid>>6);
  const long rowbase=(long)b*SEQ; const int q0=qb*QB;
  const bf16*Qw=Qc+(rowbase+q0+wid*QBLK)*PQ;
  const bf16*Kh=Kc+(rowbase+(long)t0*KVBLK)*PQ,*Vh=Vc+(rowbase+(long)t0*KVBLK)*PQ;
  const unsigned lds0=(unsigned)(uintptr_t)shm;
  float*wsf=(float*)(shm+LDS_WS)+wid*64;
  const bf16*ksrc=Kh+(long)lane*PQ+wid*8;
  const bf16*vsrc=Vh+(long)(16*(wid&3)+(lane>>2))*PQ+(wid>>2)*32+(lane&3)*8;
  const unsigned kdst=lds0+LDS_K+wid*1024, vdst=lds0+LDS_V+wid*1024;
  #define DMA_K(t,slot) glds16(ksrc+(long)(t)*KVBLK*PQ,(unsigned)__builtin_amdgcn_readfirstlane(kdst+(slot)))
  #define DMA_V(t,slot) glds16(vsrc+(long)(t)*KVBLK*PQ,(unsigned)__builtin_amdgcn_readfirstlane(vdst+(slot)))
  const int vb0=(int)(lds0+LDS_V)+((lane>>4)&1)*32+(lane&3)*8+(4*hi+((lane&15)>>2))*64;
  const char*Kbase=shm+LDS_K; bf16x8 kf[8];
  const lds_cptr shm3=(lds_cptr)shm; const lds_cptr kp0=shm3+LDS_K+hi*1024+r32*16; const lds_cptr vp0=shm3+LDS_V+((lane>>4)&1)*32+(lane&3)*8+(4*hi+((lane&15)>>2))*64;
  const int NT=(q0+QB)/KVBLK-t0;
  typedef __attribute__((address_space(3))) const f32x4 lds_cf4; typedef __attribute__((address_space(3))) f32x4 lds_f4;
  const __attribute__((address_space(3))) char* kbl=(const __attribute__((address_space(3))) char*)shm+LDS_KBIAS+hi*16;
  DMA_K(0,0);DMA_V(0,0);DMA_K(1,SLOTB);
  bf16x8 qr[4];
  #pragma unroll
  for(int d0=0;d0<4;++d0)qr[d0]=*reinterpret_cast<const bf16x8*>(&Qw[(long)r32*PQ+d0*16+hi*8]);
  float mhat=0.f,l_reg=0.f;f32x16 o[2];o[0]=f32x16{};o[1]=f32x16{};f32x16 negm=f32x16{};asm volatile("":"+v"(negm));
  const int qrel=wid*QBLK+r32;
  float mref=0.f;
  #define CINIT(C0,C1,t) do{ if(HASB){ const __attribute__((address_space(3))) char* kp_=kbl+(t)*256; \
      _Pragma("unroll") for(int g_=0;g_<4;++g_){ const f32x4 a_=*(lds_cf4*)(kp_+g_*32), b_=*(lds_cf4*)(kp_+128+g_*32); \
        _Pragma("unroll") for(int e_=0;e_<4;++e_){ C0[4*g_+e_]=a_[e_]-mhat; C1[4*g_+e_]=b_[e_]-mhat; } } } \
    }while(0)
  #define CMASK(P0,P1,t) do{int jb_=(t)-(NT-4); if(jb_>=0)cmask(P0,P1,jb_,qrel,hi);}while(0)
  bool resc=false;
  #define START(P0,P1) do{ const float rm=rowmax(P0,P1); resc=false; \
    { const float dl=HASB?__builtin_fmaxf(rm,0.f):rm; mhat=fadd_s(mhat,dl); \
      _Pragma("unroll") for(int r=0;r<16;++r){P0[r]=fsub_s(P0[r],dl);P1[r]=fsub_s(P1[r],dl);} \
      if(!HASB){ _Pragma("unroll") for(int r=0;r<16;++r)negm[r]=-mhat; asm volatile("":"+v"(negm)); } } \
    _Pragma("unroll") for(int r=0;r<16;++r)P0[r]=__builtin_amdgcn_exp2f(P0[r]); }while(0)
  #define RESC() do{ if(resc){ asm volatile("s_waitcnt lgkmcnt(0)":::"memory"); \
      _Pragma("unroll") for(int d_=0;d_<2;++d_) _Pragma("unroll") for(int r=0;r<16;++r)o[d_][r]*=wsf[crow(r,hi)]; } }while(0)
  f32x16 pA0,pA1,pB0,pB1;
  int sl_prev=0,sl_cur=0,sl_next=SLOTB;
  #define ROT() do{sl_prev=sl_cur;sl_cur=sl_next;sl_next=(sl_next==(NSLOT-1)*SLOTB)?0:sl_next+SLOTB;}while(0)
  DMA_K(2,2*SLOTB);
  if(HASB){ const int n4=(q0+QB-t0*KVBLK)/4; for(int i=tid;i<n4;i+=NW*64){ const f32x4 v=*(const f32x4*)(kbg+t0*KVBLK+4*i); *((lds_f4*)((__attribute__((address_space(3))) char*)shm+LDS_KBIAS)+i)=v; } }
  WAIT_BAR(3);
  if(HASB){ mref=*(const __attribute__((address_space(3))) float*)((const __attribute__((address_space(3))) char*)shm+LDS_KBIAS+(q0-t0*KVBLK+qrel)*4); mhat=mref; }
  { f32x16 ci0=f32x16{},ci1=f32x16{}; CINIT(ci0,ci1,0); qkt(pA0,pA1,Kbase,qr,csel<HASB>(ci0,negm),csel<HASB>(ci1,negm),r32,hi); } asm volatile("s_nop 15\n\ts_nop 7":"+v"(pA0),"+v"(pA1));CMASK(pA0,pA1,0);
  START(pA0,pA1);
  _Pragma("unroll") for(int r=0;r<16;++r)pA1[r]=__builtin_amdgcn_exp2f(pA1[r]);
  WAIT_BAR(0);
  DMA_K(3,0);DMA_V(1,SLOTB);
  ROT();
  kload8(kf,kp0+sl_cur);
  WAIT_BAR(2);
  s16x4 vlo[8],vhi[8]; u32x4 pw0,pw1,pw2,pw3;
  #define PKW(P,B) cvtpk_s(P[B],P[B+1])
  #define PAF(k) __builtin_bit_cast(bf16x8,pw##k)
  #define VFR(i) (bf16x8){vlo[i][0],vlo[i][1],vlo[i][2],vlo[i][3],vhi[i][0],vhi[i][1],vhi[i][2],vhi[i][3]}
  #define PIN(x) asm volatile("":"+v"(x))
  #define MX3(a,b,c) __builtin_fmaxf(__builtin_fmaxf((a),(b)),(c))
  #define GAPA(MF,A0,A1,A2,A3,W0,W1,PW) do{ MF; sacc+=A0; sacc+=A1; sacc+=A2; sacc+=A3; PIN(sacc); W0; W1; PIN(PW); SBAR(); }while(0)
  #define EX(v) __builtin_amdgcn_exp2f(v)
  #define GAPB(MF,X,B,Y) do{ MF; X[B]=EX(X[B]); X[B+1]=EX(X[B+1]); X[B+2]=EX(X[B+2]); X[B+3]=EX(X[B+3]); PIN(X); if(HASB){ Y[B]-=mhat; Y[B+1]-=mhat; Y[B+2]-=mhat; Y[B+3]-=mhat; PIN(Y); } SBAR(); }while(0)
  #define LOADB(Y0,Y1,t) do{ if(HASB){ const __attribute__((address_space(3))) char* kp_=kbl+(t)*256; \
      _Pragma("unroll") for(int g_=0;g_<4;++g_){ const f32x4 a_=*(lds_cf4*)(kp_+g_*32), b_=*(lds_cf4*)(kp_+128+g_*32); \
        _Pragma("unroll") for(int e_=0;e_<4;++e_){ Y0[4*g_+e_]=a_[e_]; Y1[4*g_+e_]=b_[e_]; } } } }while(0)
  #define VRD(i) do{ vlo[i]=vtr(vp_+(((i)>>2)*4096+((i)&3)*1024)); vhi[i]=vtr(vp_+(((i)>>2)*4096+((i)&3)*1024+512)); }while(0)
  #define KRD(G,j) do{ if(G){ kload2(kf,kp0+sl_next,j); SBAR(); } }while(0)
  #define STEP(C0,C1,P0,P1,t,GK,GV,GL) do{ SBAR(); \
    const lds_cptr vp_=vp0+sl_prev; \
    VRD(0); SBAR(); float sacc=(P0[0]+P0[1]); \
    GAPA(C0=__builtin_amdgcn_mfma_f32_32x32x16_bf16(kf[0],qr[0],csel<HASB>(C0,negm),0,0,0), P0[2],P0[3],P0[4],P0[5],     pw0[0]=PKW(P0,0), pw0[1]=PKW(P0,2), pw0); \
    VRD(4); SBAR(); GAPA(C1=__builtin_amdgcn_mfma_f32_32x32x16_bf16(kf[1],qr[0],csel<HASB>(C1,negm),0,0,0), P0[6],P0[7],P0[8],P0[9],     pw0[2]=PKW(P0,4), pw0[3]=PKW(P0,6), pw0); \
    VRD(1); SBAR(); GAPA(C0=__builtin_amdgcn_mfma_f32_32x32x16_bf16(kf[2],qr[1],C0,0,0,0),   P0[10],P0[11],P0[12],P0[13], pw1[0]=PKW(P0,8), pw1[1]=PKW(P0,10), pw1); \
    VRD(5); SBAR(); GAPA(C1=__builtin_amdgcn_mfma_f32_32x32x16_bf16(kf[3],qr[1],C1,0,0,0),   P0[14],P0[15],P1[0],P1[1],   pw1[2]=PKW(P0,12),pw1[3]=PKW(P0,14), pw1); \
    VRD(2); SBAR(); GAPA(C0=__builtin_amdgcn_mfma_f32_32x32x16_bf16(kf[4],qr[2],C0,0,0,0),   P1[2],P1[3],P1[4],P1[5],     pw2[0]=PKW(P1,0), pw2[1]=PKW(P1,2), pw2); \
    VRD(6); SBAR(); GAPA(C1=__builtin_amdgcn_mfma_f32_32x32x16_bf16(kf[5],qr[2],C1,0,0,0),   P1[6],P1[7],P1[8],P1[9],     pw2[2]=PKW(P1,4), pw2[3]=PKW(P1,6), pw2); \
    VRD(3); SBAR(); GAPA(C0=__builtin_amdgcn_mfma_f32_32x32x16_bf16(kf[6],qr[3],C0,0,0,0),   P1[10],P1[11],P1[12],P1[13], pw3[0]=PKW(P1,8), pw3[1]=PKW(P1,10), pw3); \
    VRD(7); SBAR(); GAPA(C1=__builtin_amdgcn_mfma_f32_32x32x16_bf16(kf[7],qr[3],C1,0,0,0),   P1[14],P1[15],0.f,0.f,       pw3[2]=PKW(P1,12),pw3[3]=PKW(P1,14), pw3); \
    l_reg+=sacc; \
    LOADB(P0,P1,(t)+1); \
    if(GK){DMA_K((t)+3,sl_cur);} if(GV){DMA_V((t)+1,sl_next);} \
    CMASK(C0,C1,t); \
    { float a=MX3(C0[0],C0[1],C1[0]),b=MX3(C0[2],C0[3],C1[1]); a=MX3(a,C1[2],C1[3]); \
      _Pragma("unroll") for(int r=4;r<16;r+=4){a=MX3(a,C0[r],C0[r+1]);b=MX3(b,C0[r+2],C0[r+3]);a=MX3(a,C1[r],C1[r+1]);b=MX3(b,C1[r+2],C1[r+3]);} \
      float rm=__builtin_fmaxf(a,b); { auto rr=__builtin_amdgcn_permlane32_swap(__float_as_uint(rm),__float_as_uint(rm),false,false); rm=__builtin_fmaxf(__uint_as_float(rr[0]),__uint_as_float(rr[1])); } \
      resc=false; \
      if(__builtin_expect(__any(rm>(float)THRL),0)){ const float dl=__builtin_fmaxf(rm,0.f); mhat+=dl; \
        _Pragma("unroll") for(int r=0;r<16;++r){C0[r]-=dl;C1[r]-=dl;} \
        if(!HASB){ _Pragma("unroll") for(int r=0;r<16;++r)negm[r]=-mhat; asm volatile("":"+v"(negm)); } \
        const float f=__builtin_amdgcn_exp2f(-dl); l_reg*=f; if(hi==0)wsf[r32]=f; resc=true; } } \
    SBAR(); \
    GAPB(o[0]=__builtin_amdgcn_mfma_f32_32x32x16_bf16(PAF(0),VFR(0),o[0],0,0,0), C0,0,P0); \
    GAPB(o[1]=__builtin_amdgcn_mfma_f32_32x32x16_bf16(PAF(0),VFR(4),o[1],0,0,0), C0,4,P0); \
    KRD(GL,0); GAPB(o[0]=__builtin_amdgcn_mfma_f32_32x32x16_bf16(PAF(1),VFR(1),o[0],0,0,0), C0,8,P0); \
    KRD(GL,1); GAPB(o[1]=__builtin_amdgcn_mfma_f32_32x32x16_bf16(PAF(1),VFR(5),o[1],0,0,0), C0,12,P0); \
    KRD(GL,2); GAPB(o[0]=__builtin_amdgcn_mfma_f32_32x32x16_bf16(PAF(2),VFR(2),o[0],0,0,0), C1,0,P1); \
    KRD(GL,3); GAPB(o[1]=__builtin_amdgcn_mfma_f32_32x32x16_bf16(PAF(2),VFR(6),o[1],0,0,0), C1,4,P1); \
    GAPB(o[0]=__builtin_amdgcn_mfma_f32_32x32x16_bf16(PAF(3),VFR(3),o[0],0,0,0), C1,8,P1); \
    GAPB(o[1]=__builtin_amdgcn_mfma_f32_32x32x16_bf16(PAF(3),VFR(7),o[1],0,0,0), C1,12,P1); \
    }while(0)
  CINIT(pB0,pB1,1);
  int t=1;
  #undef CMASK
  #define CMASK(P0,P1,t) do{}while(0)
  for(;t+5<NT;t+=2){
    STEP(pB0,pB1,pA0,pA1,t,true,true,true);     WAIT_BAR(2); RESC(); ROT();
    STEP(pA0,pA1,pB0,pB1,t+1,true,true,true);   WAIT_BAR(2); RESC(); ROT();
  }
  #undef CMASK
  #define CMASK(P0,P1,t) do{int jb_=(t)-(NT-4); if(jb_>=0)cmask(P0,P1,jb_,qrel,hi);}while(0)
  #define ENDW(tt) do{ if((tt)+3<NT){WAIT_BAR(2);} else if((tt)+2<NT){WAIT_BAR(1);} else {WAIT_BAR(0);} }while(0)
  for(;t+1<NT;t+=2){
    STEP(pB0,pB1,pA0,pA1,t,(t+3<NT),(t+1<NT),(t+1<NT));       ENDW(t);   RESC(); ROT();
    STEP(pA0,pA1,pB0,pB1,t+1,(t+4<NT),(t+2<NT),(t+2<NT));     ENDW(t+1); RESC(); ROT();
  }
  STEP(pB0,pB1,pA0,pA1,NT-1,false,false,false); RESC();
  { float sacc=pB0[0]+pB0[1]; _Pragma("unroll") for(int r=2;r<16;++r)sacc+=pB0[r]; _Pragma("unroll") for(int r=0;r<16;++r)sacc+=pB1[r]; l_reg+=sacc;
    pw0=(u32x4){PKW(pB0,0),PKW(pB0,2),PKW(pB0,4),PKW(pB0,6)};pw1=(u32x4){PKW(pB0,8),PKW(pB0,10),PKW(pB0,12),PKW(pB0,14)};pw2=(u32x4){PKW(pB1,0),PKW(pB1,2),PKW(pB1,4),PKW(pB1,6)};pw3=(u32x4){PKW(pB1,8),PKW(pB1,10),PKW(pB1,12),PKW(pB1,14)};
    SBAR(); pv(o,vb0+sl_cur,PAF(0),PAF(1),PAF(2),PAF(3)); }
  #undef PKW
  #undef PAF
  #undef VFR
  #undef PIN
  #undef MX3
  #undef GAPA
  #undef GAPB
  #undef LOADB
  #undef EX
  #undef VRD
  #undef KRD
  #undef STEP
  #undef ENDW
  {auto rr=__builtin_amdgcn_permlane32_swap(__float_as_uint(l_reg),__float_as_uint(l_reg),false,false);l_reg=__uint_as_float(rr[0])+__uint_as_float(rr[1]);}
  if(hi==0)wsf[32+r32]=l_reg;asm volatile("s_waitcnt lgkmcnt(0)":::"memory");
  float rli[16];
  #pragma unroll
  for(int r=0;r<16;++r)rli[r]=__builtin_amdgcn_rcpf(wsf[32+crow(r,hi)]);
  bf16*Ow=Oc+(rowbase+q0+wid*QBLK)*PO;
  { bf16*stg=(bf16*)(shm+LDS_OST)+wid*2048;
    #pragma unroll
    for(int r=0;r<16;++r){const int orow=crow(r,hi);
      #pragma unroll
      for(int d0=0;d0<2;++d0)stg[orow*64+d0*32+r32]=__float2bfloat16(o[d0][r]*rli[r]);}
    asm volatile("s_waitcnt lgkmcnt(0)":::"memory");
    #pragma unroll
    for(int i=0;i<4;++i){const int row=i*8+(lane>>3),ch=lane&7; const u32x4 v=*(const u32x4*)(stg+row*64+ch*8); ATTN_STORE16(Ow+(long)row*PO+ch*8,v);} }
  asm volatile("s_waitcnt lgkmcnt(0)\n\ts_barrier":::"memory");
  #undef CINIT
  #undef DMA_K
  #undef DMA_V
  #undef CMASK
  #undef START
  #undef RESC
  #undef ROT
}
constexpr int LDS_WS128=LDS_V+NSLOT*2*SLOTB, LDS_OST128=LDS_WS128+NW*64*4, LDS_BYTES128=LDS_OST128+NW*4096;
template<int THRL,bool NODEC> __device__ __forceinline__ void attn_unit128(int b,int qb,const bf16*Qc,const bf16*__restrict__ Kc,const bf16*__restrict__ Vc,bf16*Oc,char*shm,const int wv){ constexpr bool HASB=false; constexpr int t0=0; const float* kbg=nullptr;
  int tid_=wv*64+mk_lane();
  const int tid=tid_,lane=tid&63,r32=lane&31,hi=lane>>5; const int wid=__builtin_amdgcn_readfirstlane(tid>>6);
  const long rowbase=(long)b*SEQ; const int q0=qb*QB;
  const bf16*Qw=Qc+(rowbase+q0+wid*QBLK)*PQ;
  const bf16*Kh=Kc+(rowbase+(long)t0*KVBLK)*PQ,*Vh=Vc+(rowbase+(long)t0*KVBLK)*PQ;
  const unsigned lds0=(unsigned)(uintptr_t)shm;
  float*wsf=(float*)(shm+LDS_WS128)+wid*64;
  const bf16*ksrc=Kh+(long)lane*PQ+wid*8;
  const bf16*vsrc=Vh+(long)(16*(wid&3)+(lane>>2))*PQ+(wid>>2)*32+(lane&3)*8;
  const unsigned kdst=lds0+LDS_K+wid*1024, vdst=lds0+LDS_V+(wid>>2)*4096+(wid&3)*1024;
  #define DMA_K(t,slot) glds16(ksrc+(long)(t)*KVBLK*PQ,(unsigned)__builtin_amdgcn_readfirstlane(kdst+(slot)))
  #define DMA_V(t,slot) do{ glds16(vsrc+(long)(t)*KVBLK*PQ,(unsigned)__builtin_amdgcn_readfirstlane(vdst+2*(slot))); glds16(vsrc+64+(long)(t)*KVBLK*PQ,(unsigned)__builtin_amdgcn_readfirstlane(vdst+8192+2*(slot))); }while(0)
  const int vb0=(int)(lds0+LDS_V)+((lane>>4)&1)*32+(lane&3)*8+(4*hi+((lane&15)>>2))*64;
  const char*Kbase=shm+LDS_K; bf16x8 kf[8];
  const lds_cptr shm3=(lds_cptr)shm; const lds_cptr kp0=shm3+LDS_K+hi*1024+r32*16; const lds_cptr vp0=shm3+LDS_V+((lane>>4)&1)*32+(lane&3)*8+(4*hi+((lane&15)>>2))*64;
  const int NT=(q0+QB)/KVBLK-t0;
  typedef __attribute__((address_space(3))) const f32x4 lds_cf4; typedef __attribute__((address_space(3))) f32x4 lds_f4;
  const __attribute__((address_space(3))) char* kbl=(const __attribute__((address_space(3))) char*)shm+LDS_KBIAS+hi*16;
  if(HASB){ const int n4=(q0+QB-t0*KVBLK)/4; for(int i=tid;i<n4;i+=NW*64){ const f32x4 v=*(const f32x4*)(kbg+t0*KVBLK+4*i); *((lds_f4*)((__attribute__((address_space(3))) char*)shm+LDS_KBIAS)+i)=v; } }
  DMA_K(0,0);DMA_V(0,0);DMA_K(1,SLOTB);
  bf16x8 qr[4];
  #pragma unroll
  for(int d0=0;d0<4;++d0)qr[d0]=*reinterpret_cast<const bf16x8*>(&Qw[(long)r32*PQ+d0*16+hi*8]);
  float mhat=0.f,l_reg=0.f;f32x16 o[4];o[0]=f32x16{};o[1]=f32x16{};o[2]=f32x16{};o[3]=f32x16{};
  const int qrel=wid*QBLK+r32;
  float mref=0.f;
  #define CINIT(C0,C1,t) do{ if(HASB){ const __attribute__((address_space(3))) char* kp_=kbl+(t)*256; \
      _Pragma("unroll") for(int g_=0;g_<4;++g_){ const f32x4 a_=*(lds_cf4*)(kp_+g_*32), b_=*(lds_cf4*)(kp_+128+g_*32); \
        _Pragma("unroll") for(int e_=0;e_<4;++e_){ C0[4*g_+e_]=a_[e_]-mhat; C1[4*g_+e_]=b_[e_]-mhat; } } } \
    }while(0)
  #define CMASK(P0,P1,t) do{int jb_=(t)-(NT-4); if(jb_>=0)cmask(P0,P1,jb_,qrel,hi);}while(0)
  bool resc=false;
  #define START(P0,P1) do{ resc=false; \
    if(!NODEC){ const float rm=rowmax(P0,P1); const float dl=__any(rm>(float)THRL)?__builtin_fmaxf(rm,0.f):0.f; mhat=fadd_s(mhat,dl); \
      _Pragma("unroll") for(int r=0;r<16;++r){P0[r]=fsub_s(P0[r],dl);P1[r]=fsub_s(P1[r],dl);} \
      } \
    _Pragma("unroll") for(int r=0;r<16;++r)P0[r]=__builtin_amdgcn_exp2f(P0[r]); }while(0)
  #define RESC() do{ if(resc){ asm volatile("s_waitcnt lgkmcnt(0)":::"memory"); \
      _Pragma("unroll") for(int d_=0;d_<4;++d_) _Pragma("unroll") for(int r=0;r<16;++r)o[d_][r]*=wsf[crow(r,hi)]; } }while(0)
  f32x16 pA0,pA1,pB0,pB1;
  int sl_prev=0,sl_cur=0,sl_next=SLOTB;
  #define ROT() do{sl_prev=sl_cur;sl_cur=sl_next;sl_next=(sl_next==(NSLOT-1)*SLOTB)?0:sl_next+SLOTB;}while(0)
  DMA_K(2,2*SLOTB);
  WAIT_BAR(4);
  { f32x16 ci0=f32x16{}; asm volatile("":"+v"(ci0)); qkt(pA0,pA1,Kbase,qr,ci0,ci0,r32,hi); } asm volatile("s_nop 15\n\ts_nop 7":"+v"(pA0),"+v"(pA1));CMASK(pA0,pA1,0);
  START(pA0,pA1);
  _Pragma("unroll") for(int r=0;r<16;++r)pA1[r]=__builtin_amdgcn_exp2f(pA1[r]);
  WAIT_BAR(0);
  DMA_K(3,0);DMA_V(1,SLOTB);
  ROT();
  kload8(kf,kp0+sl_cur);
  WAIT_BAR(3);
  s16x4 vlo[4],vhi[4]; u32x4 pw0,pw1,pw2,pw3;
  #define PKW(P,B) cvtpk_s(P[B],P[B+1])
  #define PAF(k) __builtin_bit_cast(bf16x8,pw##k)
  #define VFR(i) (bf16x8){vlo[(i)&3][0],vlo[(i)&3][1],vlo[(i)&3][2],vlo[(i)&3][3],vhi[(i)&3][0],vhi[(i)&3][1],vhi[(i)&3][2],vhi[(i)&3][3]}
  #define PIN(x) asm volatile("":"+v"(x))
  #define MX3(a,b,c) __builtin_fmaxf(__builtin_fmaxf((a),(b)),(c))
  #define GAPA(MF,A0,A1,A2,A3,W0,W1,PW) do{ MF; sacc+=A0; sacc+=A1; sacc+=A2; sacc+=A3; PIN(sacc); W0; W1; PIN(PW); SBAR(); }while(0)
  #define EX(v) __builtin_amdgcn_exp2f(v)
  #define GAPB(MF,X,B,Y) do{ MF; X[B]=EX(X[B]); X[B+1]=EX(X[B+1]); X[B+2]=EX(X[B+2]); X[B+3]=EX(X[B+3]); PIN(X); if(HASB){ Y[B]-=mhat; Y[B+1]-=mhat; Y[B+2]-=mhat; Y[B+3]-=mhat; PIN(Y); } SBAR(); }while(0)
  #define LOADB(Y0,Y1,t) do{ if(HASB){ const __attribute__((address_space(3))) char* kp_=kbl+(t)*256; \
      _Pragma("unroll") for(int g_=0;g_<4;++g_){ const f32x4 a_=*(lds_cf4*)(kp_+g_*32), b_=*(lds_cf4*)(kp_+128+g_*32); \
        _Pragma("unroll") for(int e_=0;e_<4;++e_){ Y0[4*g_+e_]=a_[e_]; Y1[4*g_+e_]=b_[e_]; } } } }while(0)
  #define VOFF(j) ((((j)>>3)*8192)+((((j)&7)&1)*4096)+((((j)&7)>>1)*1024))
  #define VRDJ(j) do{ vlo[(j)&3]=vtr(vp_+VOFF(j)); vhi[(j)&3]=vtr(vp_+VOFF(j)+512); SBAR(); }while(0)
  #define GAPC(MF,Y,B) do{ MF; SBAR(); }while(0)
  #define KRD(G,j) do{ if(G){ kload2(kf,kp0+sl_next,j); SBAR(); } }while(0)
  #define STEP(C0,C1,P0,P1,t,GK,GV,GL) do{ SBAR(); \
    const lds_cptr vp_=vp0+2*sl_prev; \
    VRDJ(0); float sacc=(P0[0]+P0[1]); \
    GAPA(C0=__builtin_amdgcn_mfma_f32_32x32x16_bf16(kf[0],qr[0],zero16,0,0,0), P0[2],P0[3],P0[4],P0[5],     pw0[0]=PKW(P0,0), pw0[1]=PKW(P0,2), pw0); \
    VRDJ(1); GAPA(C1=__builtin_amdgcn_mfma_f32_32x32x16_bf16(kf[1],qr[0],zero16,0,0,0), P0[6],P0[7],P0[8],P0[9],     pw0[2]=PKW(P0,4), pw0[3]=PKW(P0,6), pw0); \
    VRDJ(2); GAPA(C0=__builtin_amdgcn_mfma_f32_32x32x16_bf16(kf[2],qr[1],C0,0,0,0),   P0[10],P0[11],P0[12],P0[13], pw1[0]=PKW(P0,8), pw1[1]=PKW(P0,10), pw1); \
    VRDJ(3); GAPA(C1=__builtin_amdgcn_mfma_f32_32x32x16_bf16(kf[3],qr[1],C1,0,0,0),   P0[14],P0[15],P1[0],P1[1],   pw1[2]=PKW(P0,12),pw1[3]=PKW(P0,14), pw1); \
    GAPA(C0=__builtin_amdgcn_mfma_f32_32x32x16_bf16(kf[4],qr[2],C0,0,0,0),   P1[2],P1[3],P1[4],P1[5],     pw2[0]=PKW(P1,0), pw2[1]=PKW(P1,2), pw2); \
    GAPA(C1=__builtin_amdgcn_mfma_f32_32x32x16_bf16(kf[5],qr[2],C1,0,0,0),   P1[6],P1[7],P1[8],P1[9],     pw2[2]=PKW(P1,4), pw2[3]=PKW(P1,6), pw2); \
    GAPA(C0=__builtin_amdgcn_mfma_f32_32x32x16_bf16(kf[6],qr[3],C0,0,0,0),   P1[10],P1[11],P1[12],P1[13], pw3[0]=PKW(P1,8), pw3[1]=PKW(P1,10), pw3); \
    GAPA(C1=__builtin_amdgcn_mfma_f32_32x32x16_bf16(kf[7],qr[3],C1,0,0,0),   P1[14],P1[15],0.f,0.f,       pw3[2]=PKW(P1,12),pw3[3]=PKW(P1,14), pw3); \
    l_reg+=sacc; \
    if(!NODEC){ if(__builtin_expect(__any(mhat!=0.f),0)){ _Pragma("unroll") for(int r=0;r<16;++r){C0[r]-=mhat;C1[r]-=mhat;} } } \
    if(GK){DMA_K((t)+3,sl_cur);} if(GV){DMA_V((t)+1,sl_next);} \
    CMASK(C0,C1,t); \
    resc=false; if(!NODEC){ float a=MX3(C0[0],C0[1],C1[0]),b=MX3(C0[2],C0[3],C1[1]); a=MX3(a,C1[2],C1[3]); \
      _Pragma("unroll") for(int r=4;r<16;r+=4){a=MX3(a,C0[r],C0[r+1]);b=MX3(b,C0[r+2],C0[r+3]);a=MX3(a,C1[r],C1[r+1]);b=MX3(b,C1[r+2],C1[r+3]);} \
      float rm=__builtin_fmaxf(a,b); { auto rr=__builtin_amdgcn_permlane32_swap(__float_as_uint(rm),__float_as_uint(rm),false,false); rm=__builtin_fmaxf(__uint_as_float(rr[0]),__uint_as_float(rr[1])); } \
      resc=false; \
      if(__builtin_expect(__any(rm>(float)THRL),0)){ const float dl=__builtin_fmaxf(rm,0.f); mhat+=dl; \
        _Pragma("unroll") for(int r=0;r<16;++r){C0[r]-=dl;C1[r]-=dl;} \
        const float f=__builtin_amdgcn_exp2f(-dl); l_reg*=f; if(hi==0)wsf[r32]=f; resc=true; } } \
    SBAR(); \
    GAPB(o[0]=__builtin_amdgcn_mfma_f32_32x32x16_bf16(PAF(0),VFR(0),o[0],0,0,0), C0,0,P0); VRDJ(4); \
    GAPB(o[1]=__builtin_amdgcn_mfma_f32_32x32x16_bf16(PAF(0),VFR(1),o[1],0,0,0), C0,4,P0); VRDJ(5); \
    GAPB(o[0]=__builtin_amdgcn_mfma_f32_32x32x16_bf16(PAF(1),VFR(2),o[0],0,0,0), C0,8,P0); VRDJ(6); \
    GAPB(o[1]=__builtin_amdgcn_mfma_f32_32x32x16_bf16(PAF(1),VFR(3),o[1],0,0,0), C0,12,P0); VRDJ(7); \
    GAPB(o[0]=__builtin_amdgcn_mfma_f32_32x32x16_bf16(PAF(2),VFR(4),o[0],0,0,0), C1,0,P1); VRDJ(8); \
    GAPB(o[1]=__builtin_amdgcn_mfma_f32_32x32x16_bf16(PAF(2),VFR(5),o[1],0,0,0), C1,4,P1); VRDJ(9); \
    GAPB(o[0]=__builtin_amdgcn_mfma_f32_32x32x16_bf16(PAF(3),VFR(6),o[0],0,0,0), C1,8,P1); VRDJ(10); \
    GAPB(o[1]=__builtin_amdgcn_mfma_f32_32x32x16_bf16(PAF(3),VFR(7),o[1],0,0,0), C1,12,P1); VRDJ(11); \
    GAPC(o[2]=__builtin_amdgcn_mfma_f32_32x32x16_bf16(PAF(0),VFR(8),o[2],0,0,0), P0,0); VRDJ(12); \
    GAPC(o[3]=__builtin_amdgcn_mfma_f32_32x32x16_bf16(PAF(0),VFR(9),o[3],0,0,0), P0,4); VRDJ(13); \
    KRD(GL,0); GAPC(o[2]=__builtin_amdgcn_mfma_f32_32x32x16_bf16(PAF(1),VFR(10),o[2],0,0,0), P0,8); VRDJ(14); \
    KRD(GL,1); GAPC(o[3]=__builtin_amdgcn_mfma_f32_32x32x16_bf16(PAF(1),VFR(11),o[3],0,0,0), P0,12); VRDJ(15); \
    KRD(GL,2); GAPC(o[2]=__builtin_amdgcn_mfma_f32_32x32x16_bf16(PAF(2),VFR(12),o[2],0,0,0), P1,0); \
    KRD(GL,3); GAPC(o[3]=__builtin_amdgcn_mfma_f32_32x32x16_bf16(PAF(2),VFR(13),o[3],0,0,0), P1,4); \
    GAPC(o[2]=__builtin_amdgcn_mfma_f32_32x32x16_bf16(PAF(3),VFR(14),o[2],0,0,0), P1,8); \
    GAPC(o[3]=__builtin_amdgcn_mfma_f32_32x32x16_bf16(PAF(3),VFR(15),o[3],0,0,0), P1,12); \
    }while(0)
  const f32x16 zero16=f32x16{};
  int t=1;
  #undef CMASK
  #define CMASK(P0,P1,t) do{}while(0)
  for(;t+5<NT;t+=2){
    STEP(pB0,pB1,pA0,pA1,t,true,true,true);     WAIT_BAR(3); RESC(); ROT();
    STEP(pA0,pA1,pB0,pB1,t+1,true,true,true);   WAIT_BAR(3); RESC(); ROT();
  }
  #undef CMASK
  #define CMASK(P0,P1,t) do{int jb_=(t)-(NT-4); if(jb_>=0)cmask(P0,P1,jb_,qrel,hi);}while(0)
  #define ENDW(tt) do{ if((tt)+3<NT){WAIT_BAR(3);} else if((tt)+2<NT){WAIT_BAR(2);} else {WAIT_BAR(0);} }while(0)
  for(;t+1<NT;t+=2){
    STEP(pB0,pB1,pA0,pA1,t,(t+3<NT),(t+1<NT),(t+1<NT));       ENDW(t);   RESC(); ROT();
    STEP(pA0,pA1,pB0,pB1,t+1,(t+4<NT),(t+2<NT),(t+2<NT));     ENDW(t+1); RESC(); ROT();
  }
  STEP(pB0,pB1,pA0,pA1,NT-1,false,false,false); RESC();
  { float sacc=pB0[0]+pB0[1]; _Pragma("unroll") for(int r=2;r<16;++r)sacc+=pB0[r]; _Pragma("unroll") for(int r=0;r<16;++r)sacc+=pB1[r]; l_reg+=sacc;
    pw0=(u32x4){PKW(pB0,0),PKW(pB0,2),PKW(pB0,4),PKW(pB0,6)};pw1=(u32x4){PKW(pB0,8),PKW(pB0,10),PKW(pB0,12),PKW(pB0,14)};pw2=(u32x4){PKW(pB1,0),PKW(pB1,2),PKW(pB1,4),PKW(pB1,6)};pw3=(u32x4){PKW(pB1,8),PKW(pB1,10),PKW(pB1,12),PKW(pB1,14)};
    SBAR(); pv(o,vb0+2*sl_cur,PAF(0),PAF(1),PAF(2),PAF(3)); pv(o+2,vb0+2*sl_cur+8192,PAF(0),PAF(1),PAF(2),PAF(3)); }
  #undef PKW
  #undef PAF
  #undef VFR
  #undef PIN
  #undef MX3
  #undef GAPA
  #undef GAPB
  #undef LOADB
  #undef EX
  #undef VRDJ
  #undef VOFF
  #undef GAPC
  #undef KRD
  #undef STEP
  #undef ENDW
  {auto rr=__builtin_amdgcn_permlane32_swap(__float_as_uint(l_reg),__float_as_uint(l_reg),false,false);l_reg=__uint_as_float(rr[0])+__uint_as_float(rr[1]);}
  if(hi==0)wsf[32+r32]=l_reg;asm volatile("s_waitcnt lgkmcnt(0)":::"memory");
  float rli[16];
  #pragma unroll
  for(int r=0;r<16;++r)rli[r]=__builtin_amdgcn_rcpf(wsf[32+crow(r,hi)]);
  bf16*Ow=Oc+(rowbase+q0+wid*QBLK)*PO;
  { bf16*stg=(bf16*)(shm+LDS_OST128)+wid*2048;
    #pragma unroll
    for(int hf=0;hf<2;++hf){
      #pragma unroll
      for(int r=0;r<16;++r){const int orow=crow(r,hi);
        #pragma unroll
        for(int d0=0;d0<2;++d0)stg[orow*64+d0*32+r32]=__float2bfloat16(o[2*hf+d0][r]*rli[r]);}
      asm volatile("s_waitcnt lgkmcnt(0)":::"memory");
      #pragma unroll
      for(int i=0;i<4;++i){const int row=i*8+(lane>>3),ch=lane&7; const u32x4 v=*(const u32x4*)(stg+row*64+ch*8); ATTN_STORE16(Ow+(long)row*PO+hf*64+ch*8,v);}
      asm volatile("s_waitcnt lgkmcnt(0)":::"memory"); } }
  asm volatile("s_waitcnt lgkmcnt(0)\n\ts_barrier":::"memory");
  #undef CINIT
  #undef DMA_K
  #undef DMA_V
  #undef CMASK
  #undef START
  #undef RESC
  #undef ROT
}
constexpr int ATTN_LDS_BYTES=(LDS_BYTES>LDS_BYTES128)?LDS_BYTES:LDS_BYTES128;
#undef SBAR
#undef WAIT_BAR
}

namespace xattn {
using pg8::bf16_t; using pg8::bf16x8; using pg8::u32x4; using pg8::f32x4;
using f32x16 = __attribute__((ext_vector_type(16))) float;
#define XLAS __attribute__((address_space(3)))
constexpr int XB0 = 0, XB1 = 32768, X_WSF = 65536, X_OST = X_WSF + 2048, X_LDS_BYTES = X_OST + 8 * 4096;
__device__ __forceinline__ int crow(int r, int hi) { return (r & 3) + 8 * (r >> 2) + 4 * hi; }
__device__ __forceinline__ unsigned pk(float lo, float hi) { return pg8::cvt_pk_bf16(lo, hi); }
__device__ __forceinline__ void unit(int b, int h, int qblk, const bf16_t* __restrict__ CQ, const bf16_t* __restrict__ CK, const bf16_t* __restrict__ CVT, bf16_t* __restrict__ CO, XLAS unsigned char* lds, const int wv) {
    const int tid = wv * 64 + mk_lane(), lane = tid & 63, r32 = lane & 31, hi = lane >> 5; const int wid = __builtin_amdgcn_readfirstlane(tid >> 6);
    const size_t qrow0 = (size_t)b * 4096 + (size_t)qblk * 256 + wid * 32;
    const bf16_t* Qw = CQ + (qrow0 + r32) * 1024 + h * 256 + hi * 8;
    const bf16_t* Kg = CK + ((size_t)b * 256 + lane) * 1024 + h * 256 + wid * 8;
    const bf16_t* Vg = CVT + ((size_t)h * 256 + lane) * 2048 + (size_t)b * 256 + wid * 8;
    u32x4 st[4];
#define X_LOADK(dc) do { _Pragma("unroll") for (int i_ = 0; i_ < 4; ++i_) st[i_] = *(const u32x4*)(Kg + (dc) * 64 + (size_t)i_ * 64 * 1024); } while (0)
#define X_LOADV(c)  do { _Pragma("unroll") for (int i_ = 0; i_ < 4; ++i_) st[i_] = *(const u32x4*)(Vg + (size_t)(c) * 64 * 2048 + i_ * 64); } while (0)
#define X_STOREK(buf) do { _Pragma("unroll") for (int i_ = 0; i_ < 4; ++i_) *(XLAS u32x4*)(lds + (buf) + wid * 4096 + (64 * i_ + lane) * 16) = st[i_]; } while (0)
#define X_STOREV(buf) do { _Pragma("unroll") for (int i_ = 0; i_ < 4; ++i_) *(XLAS u32x4*)(lds + (buf) + (wid + 8 * i_) * 1024 + lane * 16) = st[i_]; } while (0)
    const int kswz = (r32 & ~12) | ((r32 & 4) << 1) | ((r32 & 8) >> 1);
    const int koff = hi * 4096 + kswz * 16;
    const int voff = hi * 1024 + r32 * 16;
    f32x16 s[8];
#pragma unroll
    for (int kt = 0; kt < 8; ++kt) s[kt] = f32x16{};
    X_LOADK(0);
    bf16x8 qfa[4][4];
#pragma unroll
    for (int dc = 0; dc < 4; ++dc)
#pragma unroll
        for (int ks = 0; ks < 4; ++ks) qfa[dc][ks] = *(const bf16x8*)(Qw + dc * 64 + ks * 16);
    X_STOREK(XB0);
    __syncthreads();
#pragma unroll
    for (int dc = 0; dc < 4; ++dc) {
        const int buf = (dc & 1) ? XB1 : XB0, nbuf = (dc & 1) ? XB0 : XB1;
        if (dc < 3) X_LOADK(dc + 1); else X_LOADV(0);
#pragma unroll
        for (int kt = 0; kt < 8; ++kt)
#pragma unroll
            for (int ks = 0; ks < 4; ++ks) {
                const bf16x8 kf = *(const XLAS bf16x8*)(lds + buf + koff + kt * 512 + ks * 8192);
                s[kt] = __builtin_amdgcn_mfma_f32_32x32x16_bf16(kf, qfa[dc][ks], s[kt], 0, 0, 0);
            }
        if (dc < 3) X_STOREK(nbuf); else X_STOREV(nbuf);
        __syncthreads();
    }
    float mx = s[0][0];
#pragma unroll
    for (int kt = 0; kt < 8; ++kt)
#pragma unroll
        for (int r = 0; r < 16; ++r) mx = fmaxf(mx, s[kt][r]);
    mx = fmaxf(mx, __shfl_xor(mx, 32));
    float l = 0.f;
#pragma unroll
    for (int kt = 0; kt < 8; ++kt)
#pragma unroll
        for (int r = 0; r < 16; ++r) { const float p = __builtin_amdgcn_exp2f(s[kt][r] - mx); s[kt][r] = p; l += p; }
    l += __shfl_xor(l, 32);
    u32x4 pw[16];
#pragma unroll
    for (int kt = 0; kt < 8; ++kt)
#pragma unroll
        for (int j2 = 0; j2 < 2; ++j2)
            pw[2 * kt + j2] = (u32x4){pk(s[kt][8 * j2 + 0], s[kt][8 * j2 + 1]), pk(s[kt][8 * j2 + 2], s[kt][8 * j2 + 3]), pk(s[kt][8 * j2 + 4], s[kt][8 * j2 + 5]), pk(s[kt][8 * j2 + 6], s[kt][8 * j2 + 7])};
    XLAS float* wsf = (XLAS float*)(lds + X_WSF) + wid * 64;
    if (hi == 0) wsf[r32] = l;
    asm volatile("s_waitcnt lgkmcnt(0)" ::: "memory");
    float rli[16];
#pragma unroll
    for (int r = 0; r < 16; ++r) rli[r] = __builtin_amdgcn_rcpf(wsf[crow(r, hi)]);
    XLAS bf16_t* stg = (XLAS bf16_t*)(lds + X_OST) + wid * 2048;
    bf16_t* Ow = CO + qrow0 * 1024 + h * 256;
#pragma unroll
    for (int c = 0; c < 4; ++c) {
        const int buf = (c & 1) ? XB1 : XB0, nbuf = (c & 1) ? XB0 : XB1;
        if (c < 3) X_LOADV(c + 1);
        f32x16 o[2]; o[0] = f32x16{}; o[1] = f32x16{};
#pragma unroll
        for (int j = 0; j < 16; ++j)
#pragma unroll
            for (int dt = 0; dt < 2; ++dt) {
                const bf16x8 vf = *(const XLAS bf16x8*)(lds + buf + voff + dt * 512 + j * 2048);
                o[dt] = __builtin_amdgcn_mfma_f32_32x32x16_bf16(__builtin_bit_cast(bf16x8, pw[j]), vf, o[dt], 0, 0, 0);
            }
#pragma unroll
        for (int r = 0; r < 16; ++r) { const int orow = crow(r, hi);
#pragma unroll
            for (int dt = 0; dt < 2; ++dt) { const unsigned w = pk(o[dt][r] * rli[r], 0.f); stg[orow * 64 + dt * 32 + r32] = (bf16_t)(w & 0xffffu); } }
        asm volatile("s_waitcnt lgkmcnt(0)" ::: "memory");
#pragma unroll
        for (int i = 0; i < 4; ++i) { const int row = i * 8 + (lane >> 3), ch = lane & 7; const u32x4 v = *(const XLAS u32x4*)(stg + row * 64 + ch * 8); *(u32x4*)(Ow + (size_t)row * 1024 + c * 64 + ch * 8) = v; }
        asm volatile("s_waitcnt lgkmcnt(0)" ::: "memory");
        if (c < 3) X_STOREV(nbuf);
        __syncthreads();
    }
#undef X_LOADK
#undef X_LOADV
#undef X_STOREK
#undef X_STOREV
}
}

#ifndef MK_PER_PHASE
#define MK_PER_PHASE 0
#endif
constexpr int NWAVES = 8;
constexpr int BATCH = 8, SEQ = 4096, D = 1024, M = BATCH * SEQ, FF = 4096, NMEM = 256, MM = BATCH * NMEM, INW = 3080, NPROJ = 3072, NATT = 1536;
constexpr float EPS = 1e-6f, SUBLN_EPS = 1e-5f;
constexpr int N_PHASES = 11;

constexpr size_t MiB = 1u << 20;
constexpr size_t WS_ROPE = 0;
constexpr size_t WS_LOGF = 446 * MiB;
constexpr size_t WS_KB   = 447 * MiB;
constexpr size_t WS_NRM  = 3 * MiB;
constexpr size_t WS_BAR  = 3 * MiB + 65536;
constexpr size_t WS_SS1  = 4 * MiB, WS_SS2 = 6 * MiB, WS_SS3 = 444 * MiB;
constexpr size_t WS_WIN = 408 * MiB, WS_WOUT = 414 * MiB, WS_WCQ = 416 * MiB, WS_WCKV = 418 * MiB, WS_WCO = 422 * MiB, WS_WUP = 424 * MiB, WS_WDN = 432 * MiB;
constexpr size_t WS_MEMN = 440 * MiB, WS_CK = 46 * MiB, WS_CVT = 50 * MiB;
constexpr size_t WS_SA = 56 * MiB;
constexpr size_t WS_SB = 448 * MiB;
constexpr size_t WS_PROJ = 216 * MiB;
constexpr size_t WS_ATT = 120 * MiB;
constexpr size_t WS_ZH = 120 * MiB;
constexpr size_t WS_END = 512 * MiB;
static_assert(WS_WIN >= WS_PROJ + (size_t)M * NPROJ * 2 && WS_WDN + 8 * MiB <= WS_MEMN && WS_MEMN + 4 * MiB <= WS_SS3 && WS_SS3 + 2 * MiB <= WS_LOGF && WS_LOGF + MiB <= WS_KB && WS_KB + MiB <= WS_SB, "weight copies and the small prologue outputs sit in the gap");
static_assert(WS_SA + 64 * MiB <= WS_ATT && WS_ATT + (size_t)M * NATT * 2 <= WS_PROJ && WS_PROJ + (size_t)M * NPROJ * 2 <= WS_SB && WS_ZH + (size_t)M * FF * 2 <= WS_SB && WS_ZH >= WS_SA + 64 * MiB && WS_SB + 64 * MiB <= WS_END, "d_ws map: slot A | ATT | PROJ | (gap) | slot B; ZH overlays ATT + PROJ only");

constexpr int RING_BYTES = 131072, LDS_BYTES = 147456;
static_assert(attn_body::ATTN_LDS_BYTES <= RING_BYTES && xattn::X_LDS_BYTES <= RING_BYTES && pg8::STAGE_BYTES <= RING_BYTES, "LDS map");

#define LAS __attribute__((address_space(3)))
typedef unsigned short bf16;
typedef unsigned v4u __attribute__((ext_vector_type(4)));
typedef float f32x4 __attribute__((ext_vector_type(4)));
#define LDS_WAIT() asm volatile("s_waitcnt lgkmcnt(0)" ::: "memory")
__device__ __forceinline__ unsigned f2bf(float f) { unsigned u = __builtin_bit_cast(unsigned, f); return (u + 0x7fffu + ((u >> 16) & 1u)) >> 16; }
__device__ __forceinline__ unsigned pk2(float lo, float hi) { return f2bf(lo) | (f2bf(hi) << 16); }
__device__ __forceinline__ float bflo(unsigned w) { return __builtin_bit_cast(float, w << 16); }
__device__ __forceinline__ float bfhi(unsigned w) { return __builtin_bit_cast(float, w & 0xffff0000u); }
__device__ __forceinline__ float wave_sum(float v) {
#pragma unroll
    for (int o = 1; o < 64; o <<= 1) v += __shfl_xor(v, o);
    return v;
}

#define XB_TMO      128
#define XB_XCNT(j)  (256  + 64 * (j))
#define XB_XSUB(j)  (1280 + 64 * (j))
#define XB_XGEN(j)  (2304 + 64 * (j))
#define XB_TOP      3328
#define XB_TOPGEN   3392
#define XCD_BAR_WORDS 3456
#define XB_SPIN_CAP (1u << 18)

__device__ __forceinline__ unsigned xb_ld(unsigned* p)              { return __hip_atomic_load(p, __ATOMIC_RELAXED, __HIP_MEMORY_SCOPE_AGENT); }
__device__ __forceinline__ unsigned xb_add(unsigned* p, unsigned v) { return __hip_atomic_fetch_add(p, v, __ATOMIC_RELAXED, __HIP_MEMORY_SCOPE_AGENT); }
__device__ __forceinline__ unsigned xb_xcc_id() { return (unsigned)__builtin_amdgcn_s_getreg((3 << 11) | 20) & 0xFu; }
#define XB_SPIN(cond, bar) do { unsigned _sp = 0; while (cond) { __builtin_amdgcn_s_sleep(1); \
    if ((++_sp & 255u) == 0u) { if (xb_ld(&(bar)[XB_TMO])) break; if (_sp > XB_SPIN_CAP) { atomicAdd(&(bar)[XB_TMO], 1u); break; } } } } while (0)

struct XcdBarrier {
    unsigned* bar; unsigned x;
    volatile LAS unsigned* st;
};

__device__ __forceinline__ XcdBarrier xcd_barrier_post(unsigned* bar, volatile LAS unsigned* st, bool leader) {
    XcdBarrier b; b.bar = bar; b.x = xb_xcc_id(); b.st = st;
    if (leader) (void)xb_add(&bar[XB_XCNT(b.x)], 1u);
    return b;
}
__device__ __forceinline__ void xcd_barrier_complete(unsigned* bar, unsigned x, unsigned& nloc, unsigned& nx) {
    const unsigned G = gridDim.x * gridDim.y * gridDim.z;
    unsigned sum, cnt, mine, sp = 0u;
    for (;;) {
        sum = 0u; cnt = 0u; mine = 0u;
#pragma unroll
        for (unsigned j = 0; j < 16; ++j) { const unsigned c = xb_ld(&bar[XB_XCNT(j)]); sum += c; cnt += (c > 0u) ? 1u : 0u; mine = (j == x) ? c : mine; }
        if (sum == G) break;
        __builtin_amdgcn_s_sleep(1);
        if ((++sp & 255u) == 0u) { if (xb_ld(&bar[XB_TMO])) break; if (sp > XB_SPIN_CAP) { atomicAdd(&bar[XB_TMO], 1u); break; } }
    }
    nloc = mine > 0u ? mine : 1u; nx = cnt > 0u ? cnt : 1u;
}

__device__ __forceinline__ void xcd_barrier(const XcdBarrier& b, bool leader) {
    asm volatile("s_waitcnt vmcnt(0)" ::: "memory");
    __syncthreads();
    if (leader) {
        unsigned* bar = b.bar;
        __builtin_amdgcn_s_waitcnt(0);
        unsigned nloc = b.st[0], nx = b.st[1];
        if (nloc == 0u) { xcd_barrier_complete(bar, b.x, nloc, nx); b.st[0] = nloc; b.st[1] = nx; }
        const unsigned old = xb_add(&bar[XB_XSUB(b.x)], 1u);
        const unsigned gen = old / nloc;
        if (old + 1u == (gen + 1u) * nloc) {
            __builtin_amdgcn_fence(__ATOMIC_RELEASE, "agent");
            asm volatile("s_waitcnt vmcnt(0)" ::: "memory");
            const unsigned og = xb_add(&bar[XB_TOP], 1u);
            const unsigned tg = og / nx;
            if (og + 1u == (tg + 1u) * nx) xb_add(&bar[XB_TOPGEN], 1u);
            else XB_SPIN(xb_ld(&bar[XB_TOPGEN]) == tg, bar);
            __builtin_amdgcn_fence(__ATOMIC_ACQUIRE, "agent");
            xb_add(&bar[XB_XGEN(b.x)], 1u);
            asm volatile("s_waitcnt vmcnt(0)" ::: "memory");
        } else {
            XB_SPIN(xb_ld(&bar[XB_XGEN(b.x)]) == gen, bar);
            __builtin_amdgcn_fence(__ATOMIC_ACQUIRE, "agent");
            asm volatile("s_waitcnt vmcnt(0)" ::: "memory");
        }
    }
    __syncthreads();
}

struct Params { const float* in[21]; float* out; unsigned char* ws; int ph_lo, ph_hi; };
enum { I_X = 0, I_MEM, I_GMIX, I_WIN, I_BF, I_LQ1, I_LK1, I_LQ2, I_LK2, I_GSUB, I_GFOX, I_WOUT, I_GCROSS, I_GMEM, I_WCQ, I_WCKV, I_WCO, I_GMLP, I_WUP, I_WDN, I_GFIN };

__device__ __forceinline__ void p0_transpose_item(const float* W, int K, int ldw, int nblk, bf16* WT, LAS float* scr, int item, int lane, const float* gk = nullptr  ) {
    const int kb = item / nblk, nb = item % nblk, k0 = 64 * kb, n0 = 32 * nb;
    { f32x4 v[8]; float gg[8];
#pragma unroll
        for (int it = 0; it < 8; ++it) { const int kk = 8 * it + (lane >> 3); v[it] = __builtin_nontemporal_load((const f32x4*)(W + (size_t)(k0 + kk) * ldw + n0 + 4 * (lane & 7)));     gg[it] = gk ? gk[k0 + kk] : 1.f; }
#pragma unroll
        for (int it = 0; it < 8; ++it) { const int kk = 8 * it + (lane >> 3); LAS float* d = scr + kk * 33 + 4 * (lane & 7); d[0] = v[it].x * gg[it]; d[1] = v[it].y * gg[it]; d[2] = v[it].z * gg[it]; d[3] = v[it].w * gg[it]; } }
    LDS_WAIT(); asm volatile("" ::: "memory");
    const int c = lane & 7;
#pragma unroll
    for (int j = 0; j < 4; ++j) { const int n = (lane >> 3) + 8 * j; const LAS float* s = scr + (8 * c) * 33 + n;
        v4u o; o.x = pk2(s[0 * 33], s[1 * 33]); o.y = pk2(s[2 * 33], s[3 * 33]); o.z = pk2(s[4 * 33], s[5 * 33]); o.w = pk2(s[6 * 33], s[7 * 33]);
        *(v4u*)(WT + (size_t)(n0 + n) * K + k0 + 8 * c) = o; }
    LDS_WAIT(); asm volatile("" ::: "memory");
}

__device__ __forceinline__ void rms_row(const float* xrow, const f32x4 (&gq)[4], bf16* orow, int lane, f32x4 (&v)[4]) {
    const f32x4* xr = (const f32x4*)xrow + lane; float s = 0.f;
#pragma unroll
    for (int j = 0; j < 4; ++j) { v[j] = xr[64 * j]; s += (v[j].x * v[j].x + v[j].y * v[j].y) + (v[j].z * v[j].z + v[j].w * v[j].w); }
    const float rstd = 1.0f / sqrtf(wave_sum(s) * (1.f / 1024.f) + EPS);
    unsigned long long* o8 = (unsigned long long*)orow + lane;
#pragma unroll
    for (int j = 0; j < 4; ++j) { v[j] = v[j] * rstd * gq[j]; o8[64 * j] = (unsigned long long)pk2(v[j].x, v[j].y) | ((unsigned long long)pk2(v[j].z, v[j].w) << 32); }
}

template <class Sched> __device__ __forceinline__ void build_rstd_tables(LAS unsigned char* lds, const Sched& S, const float* sspart, float eps, int wave) {
    const int lane = mk_lane(), tid = wave * 64 + lane;
    LAS int* pml = (LAS int*)(lds + RING_BYTES + 1536); LAS float* tab = (LAS float*)(lds + RING_BYTES + 2048);
    if (tid == 0) { int n = 0; pg8::Unit u; for (int i = 0; S.next(i, u); ++i) { bool f = false; for (int j = 0; j < n; ++j) f |= (pml[j] == u.pm); if (!f && n < 8) pml[n++] = u.pm; } pml[8] = n; }
    __syncthreads();
    const int n = pml[8];
    for (int idx = tid; idx < n * 256; idx += NWAVES * 64) tab[idx] = pg8::row_rstd(sspart, pml[idx >> 8] * 256 + (idx & 255), eps);
    __syncthreads();
}
__global__ void __launch_bounds__(NWAVES * 64, 2) mk_fwd(Params P) {
    extern __shared__ __attribute__((aligned(16))) unsigned char lds_raw[];
    LAS unsigned char* lds = (LAS unsigned char*)lds_raw;
    const int wave = __builtin_amdgcn_readfirstlane((int)threadIdx.x >> 6);
#define LANE_TID const int lane = mk_lane(), tid = wave * 64 + lane
    const int G = gridDim.x; const int bx = blockIdx.x; const int vcu = (G % 8 == 0) ? (bx % 8) * (G / 8) + bx / 8 : bx;
    const int gw = vcu * NWAVES + wave, NGW = G * NWAVES;
    unsigned char* const ws = P.ws;
#define ROPE ((float*)(P.ws + WS_ROPE))
#define LOGF ((float*)(P.ws + WS_LOGF))
#define KBIAS ((float*)(P.ws + WS_KB))
#define NRM ((float*)(P.ws + WS_NRM))
#define SS1 ((float*)(P.ws + WS_SS1))
#define SS2 ((float*)(P.ws + WS_SS2))
#define SS3 ((float*)(P.ws + WS_SS3))
#define Win_t ((bf16*)(P.ws + WS_WIN))
#define Wout_t ((bf16*)(P.ws + WS_WOUT))
#define Wcq_t ((bf16*)(P.ws + WS_WCQ))
#define Wckv_t ((bf16*)(P.ws + WS_WCKV))
#define Wco_t ((bf16*)(P.ws + WS_WCO))
#define Wup_t ((bf16*)(P.ws + WS_WUP))
#define Wdn_t ((bf16*)(P.ws + WS_WDN))
#define MEMN ((bf16*)(P.ws + WS_MEMN))
#define CKb ((bf16*)(P.ws + WS_CK))
#define CVT ((bf16*)(P.ws + WS_CVT))
#define XN ((bf16*)(P.ws + WS_SB))
#define MIXA ((bf16*)(P.ws + WS_SA))
#define CQ ((bf16*)(P.ws + WS_SA))
#define H2B ((bf16*)(P.ws + WS_SA))
#define H1B ((bf16*)(P.ws + WS_SB))
#define CO ((bf16*)(P.ws + WS_PROJ))
#define PROJ ((bf16*)(P.ws + WS_PROJ))
#define ATT ((bf16*)(P.ws + WS_ATT))
#define ZH ((bf16*)(P.ws + WS_ZH))
    const int lo = P.ph_lo, hi_ph = P.ph_hi;
    volatile LAS unsigned* xst = (volatile LAS unsigned*)(lds + RING_BYTES + 1024);
    { const int l0 = mk_lane(); if (wave == 0 && l0 < 2) xst[l0] = 0u; }
    __syncthreads();
    XcdBarrier bar; bar.bar = (unsigned*)(ws + WS_BAR); bar.x = 0; bar.st = xst;
    if (hi_ph - lo > 1) bar = xcd_barrier_post((unsigned*)(ws + WS_BAR), xst, wave == 0 && mk_lane() == 0);
    if (lo < 0) cg::this_grid().sync();
#define IN(k) (lo <= (k) && (k) < hi_ph)
#ifndef MK_MASK
#define MK_MASK 0x7ff
#endif
#ifndef MK_ATT_MASK
#define MK_ATT_MASK 3
#endif
#ifndef MK_REP_MASK
#define MK_REP_MASK 0
#endif
#define PH(k) (IN(k) && ((MK_MASK >> (k)) & 1))
#define REPS(k) for (int rep_ = 0; rep_ < (((MK_REP_MASK) >> (k)) & 1) + 1; ++rep_)
#define SEAM(k) do { if (IN(k) && IN((k) + 1)) { xcd_barrier(bar, wave == 0 && mk_lane() == 0); } } while (0)

    if (PH(0)) REPS(0) {
        LANE_TID;
        {
            const float* win = P.in[I_WIN];
            for (int k = tid; k < 1024; k += NWAVES * 64) { const f32x4 a = *(const f32x4*)(win + (size_t)k * INW + 3072), b = *(const f32x4*)(win + (size_t)k * INW + 3076);
                const int slot = (((k >> 8) * 4 + (k & 3)) * 64 + ((k & 255) >> 2)); *(LAS f32x4*)(lds + slot * 32) = a; *(LAS f32x4*)(lds + slot * 32 + 16) = b; }
        }
        if (bx == 0 && tid < BATCH * 64) NRM[tid] = 0.f;
        __syncthreads();
        LAS float* scr = (LAS float*)(lds + 32768 + wave * 8704);
        {
            constexpr int I_IN = 16 * 96, I_SQ = 16 * 32, I_CKV = 16 * 64, I_UP = 16 * 128, I_DN = 64 * 32;
            constexpr int NITEMS = I_IN + 3 * I_SQ + I_CKV + I_UP + I_DN;
            for (int it = gw; it < NITEMS; it += NGW) {
                int r = it;
                if (r < I_IN) { p0_transpose_item(P.in[I_WIN], D, INW, 96, Win_t, scr, r, lane, P.in[I_GMIX]); continue; } r -= I_IN;
                if (r < I_SQ) { p0_transpose_item(P.in[I_WOUT], D, D, 32, Wout_t, scr, r, lane); continue; } r -= I_SQ;
                if (r < I_SQ) { p0_transpose_item(P.in[I_WCQ], D, D, 32, Wcq_t, scr, r, lane, P.in[I_GCROSS]); continue; } r -= I_SQ;
                if (r < I_SQ) { p0_transpose_item(P.in[I_WCO], D, D, 32, Wco_t, scr, r, lane); continue; } r -= I_SQ;
                if (r < I_CKV) { p0_transpose_item(P.in[I_WCKV], D, 2 * D, 64, Wckv_t, scr, r, lane); continue; } r -= I_CKV;
                if (r < I_UP) { p0_transpose_item(P.in[I_WUP], D, FF, 128, Wup_t, scr, r, lane, P.in[I_GMLP]); continue; } r -= I_UP;
                p0_transpose_item(P.in[I_WDN], FF, D, 32, Wdn_t, scr, r, lane);
            }
        }
        {
            for (int idx = gw * 64 + lane; idx < SEQ * 8; idx += NGW * 64) {
                const int pos = idx >> 3, j = idx & 7;
                const float f = j == 0 ? 1.0f : j == 1 ? 0.1939227432012558f : j == 2 ? 0.03760603070259094f : j == 3 ? 0.007292664609849453f : j == 4 ? 0.0014142135623842478f : j == 5 ? 0.00027424818836152554f : j == 6 ? 5.318296098266728e-05f : 1.0313386155758053e-05f;
                const float ang = (float)pos * f;
                double rev = (double)ang * 0.15915494309189535; rev -= __builtin_rint(rev);
                const float x = (float)(rev * 6.283185307179586);
                ROPE[pos * 16 + j] = cosf(x); ROPE[pos * 16 + 8 + j] = sinf(x);
            }
        }
        {
            f32x4 gq[4];
#pragma unroll
            for (int j = 0; j < 4; ++j) gq[j] = ((const f32x4*)P.in[I_GMIX])[64 * j + lane];
            const float bfv = P.in[I_BF][lane & 7];
            const bool b0 = lane & 1, b1 = lane & 2, b2 = lane & 4;
            const bool xal = (G == 256); const int mstart = xal ? (bx & 7) * SEQ + ((bx >> 3) * NWAVES + wave) * 4 : gw * 4, mstep = xal ? 1024 : NGW * 4, mend = xal ? (bx & 7) * SEQ + SEQ : M;
            for (int m0 = mstart; m0 < mend; m0 += mstep) {
                f32x4 v[4][4]; float s[4];
#pragma unroll
                for (int r = 0; r < 4; ++r)
#pragma unroll
                    for (int jj = 0; jj < 4; ++jj) v[r][jj] = __builtin_nontemporal_load((const f32x4*)(P.in[I_X] + (size_t)(m0 + r) * D) + 64 * jj + lane);
#pragma unroll
                for (int r = 0; r < 4; ++r) { s[r] = 0.f;
#pragma unroll
                    for (int jj = 0; jj < 4; ++jj) s[r] += (v[r][jj].x * v[r][jj].x + v[r][jj].y * v[r][jj].y) + (v[r][jj].z * v[r][jj].z + v[r][jj].w * v[r][jj].w); }
#pragma unroll
                for (int r = 0; r < 4; ++r) { const float ssum = wave_sum(s[r]); const float rstd = 1.0f / sqrtf(ssum * (1.f / 1024.f) + EPS);
                    unsigned long long* o8 = (unsigned long long*)(XN + (size_t)(m0 + r) * D) + lane;
                    if (lane < 4) ((f32x4*)(SS3 + (size_t)(m0 + r) * 16))[lane] = (f32x4){lane == 0 ? ssum : 0.f, 0.f, 0.f, 0.f};
#pragma unroll
                    for (int jj = 0; jj < 4; ++jj) { o8[64 * jj] = (unsigned long long)pk2(v[r][jj].x, v[r][jj].y) | ((unsigned long long)pk2(v[r][jj].z, v[r][jj].w) << 32);
                        v[r][jj] = v[r][jj] * rstd * gq[jj]; } }
                f32x4 a0[4], a1[4];
#pragma unroll
                for (int r = 0; r < 4; ++r) { a0[r] = (f32x4){0.f, 0.f, 0.f, 0.f}; a1[r] = a0[r]; }
#pragma unroll
                for (int jj = 0; jj < 4; ++jj)
#pragma unroll
                    for (int i = 0; i < 4; ++i) { const LAS f32x4* wp = (const LAS f32x4*)(lds + ((jj * 4 + i) * 64 + lane) * 32); const f32x4 w0 = wp[0], w1 = wp[1];
#pragma unroll
                        for (int r = 0; r < 4; ++r) { a0[r] += w0 * v[r][jj][i]; a1[r] += w1 * v[r][jj][i]; } }
#pragma unroll
                for (int r = 0; r < 4; ++r) {
                    float c0, c1, c2, c3, d0, d1, z;
                    { const float k0 = b0 ? a0[r][1] : a0[r][0], g0 = b0 ? a0[r][0] : a0[r][1]; c0 = k0 + __shfl_xor(g0, 1); }
                    { const float k0 = b0 ? a0[r][3] : a0[r][2], g0 = b0 ? a0[r][2] : a0[r][3]; c1 = k0 + __shfl_xor(g0, 1); }
                    { const float k0 = b0 ? a1[r][1] : a1[r][0], g0 = b0 ? a1[r][0] : a1[r][1]; c2 = k0 + __shfl_xor(g0, 1); }
                    { const float k0 = b0 ? a1[r][3] : a1[r][2], g0 = b0 ? a1[r][2] : a1[r][3]; c3 = k0 + __shfl_xor(g0, 1); }
                    { const float k0 = b1 ? c1 : c0, g0 = b1 ? c0 : c1; d0 = k0 + __shfl_xor(g0, 2); }
                    { const float k0 = b1 ? c3 : c2, g0 = b1 ? c2 : c3; d1 = k0 + __shfl_xor(g0, 2); }
                    { const float k0 = b2 ? d1 : d0, g0 = b2 ? d0 : d1; z = k0 + __shfl_xor(g0, 4); }
                    z += __shfl_xor(z, 8); z += __shfl_xor(z, 16); z += __shfl_xor(z, 32);
                    z += bfv;
                    const float ls = fminf(z, 0.f) - __logf(1.0f + __expf(-fabsf(z)));
                    const int m = m0 + r;
                    if (lane < 8) LOGF[((size_t)(m >> 12) * 8 + lane) * SEQ + (m & 4095)] = ls;
                }
            }
        }
        {
            f32x4 gq[4];
#pragma unroll
            for (int j = 0; j < 4; ++j) gq[j] = ((const f32x4*)P.in[I_GMEM])[64 * j + lane];
            for (int m = gw; m < MM; m += NGW) { f32x4 v[4]; rms_row(P.in[I_MEM] + (size_t)m * D, gq, MEMN + (size_t)m * D, lane, v); }
        }
        __syncthreads();
    }
    SEAM(0);

    if (PH(1)) REPS(1) {
        LANE_TID;
        if (bx < BATCH * 8) {
            const float* src = LOGF + (size_t)bx * SEQ + tid * 8; float* dst = KBIAS + (size_t)bx * SEQ + tid * 8;
            const f32x4 a = *(const f32x4*)src, b = *(const f32x4*)(src + 4);
            float p[8]; p[0] = a[0]; p[1] = p[0] + a[1]; p[2] = p[1] + a[2]; p[3] = p[2] + a[3]; p[4] = p[3] + b[0]; p[5] = p[4] + b[1]; p[6] = p[5] + b[2]; p[7] = p[6] + b[3];
            float inc = p[7];
#pragma unroll
            for (int o = 1; o < 64; o <<= 1) { const float t = __shfl_up(inc, o); if (lane >= o) inc += t; }
            LAS float* wt = (LAS float*)lds;
            if (lane == 63) wt[wave] = inc;
            __syncthreads();
            float pre = inc - p[7];
            for (int w = 0; w < wave; ++w) pre += wt[w];
            const float c = -1.4426950408889634f;
            *(f32x4*)dst = (f32x4){(pre + p[0]) * c, (pre + p[1]) * c, (pre + p[2]) * c, (pre + p[3]) * c};
            *(f32x4*)(dst + 4) = (f32x4){(pre + p[4]) * c, (pre + p[5]) * c, (pre + p[6]) * c, (pre + p[7]) * c};
            __syncthreads();
        }
        { pg8::Gemm g{XN, Win_t, M, NPROJ, D}; pg8::StaticOrder S; S.init(M, NPROJ, G, bx);
          build_rstd_tables(lds, S, SS3, EPS, wave);
          pg8::EpiProj E{PROJ, ROPE, NRM, SS3, (const LAS int*)(lds + RING_BYTES + 1536), (const LAS float*)(lds + RING_BYTES + 2048)};
          pg8::gemm_phase<pg8::EpiProj, pg8::StaticOrder, true, true>(lds, g, S, E, wave); }
    }
    SEAM(1);

    if (PH(2)) REPS(2) {
        for (int p = vcu; p < 1024; p += G) {
            const int pp = p & 511, bh = pp >> 3, s = pp & 7, b = bh >> 3, hm = bh & 7;
#ifdef MK_REP_ATT
            if (rep_ == 1 && !((MK_REP_ATT) & (p < 512 ? 1 : 2))) continue;
#endif
            for (int hh = 0; hh < 2; ++hh) {
                const int qb = hh ? s : 15 - s;
                if (p < 512) { if (!(MK_ATT_MASK & 1)) continue;
                    const float* nq = NRM + 256 + ((b * 2 + 0) * 8 + hm) * 2; const float* nk = NRM + 256 + ((b * 2 + 1) * 8 + hm) * 2;
                    const float bqd = sqrtf((nq[0] + nq[1]) * (nk[0] + nk[1])) * 1.02f;
                    if (bqd < 64.f)
                        attn_body::attn_unit128<16, true>(b, qb, (const attn_body::bf16*)PROJ + hm * 64, (const attn_body::bf16*)PROJ + 512 + hm * 64, (const attn_body::bf16*)PROJ + 1024 + (hm >> 1) * 128,
                                                          (attn_body::bf16*)ATT + (hm & 1) * 512 + (hm >> 1) * 128, (char*)lds_raw, wave);
                    else
                        attn_body::attn_unit128<16, false>(b, qb, (const attn_body::bf16*)PROJ + hm * 64, (const attn_body::bf16*)PROJ + 512 + hm * 64, (const attn_body::bf16*)PROJ + 1024 + (hm >> 1) * 128,
                                                           (attn_body::bf16*)ATT + (hm & 1) * 512 + (hm >> 1) * 128, (char*)lds_raw, wave);
                } else { if (!(MK_ATT_MASK & 2)) continue; const int h = hm;
                    const float* nq = NRM + ((b * 2 + 0) * 8 + h) * 2; const float* nk = NRM + ((b * 2 + 1) * 8 + h) * 2; const float* kbr = KBIAS + (size_t)(b * 8 + h) * SEQ;
                    const float bqk = sqrtf((nq[0] + nq[1]) * (nk[0] + nk[1])) * 1.02f;
                    const int NTf = 4 * qb + 4, tc = 2 * (mk_lane() & 31);
                    const bool skip_ok = (tc >= 2) && (tc <= NTf - 4) && (2.f * bqk + kbr[64 * tc - 1 + (tc ? 0 : 1)] - kbr[256 * qb] < -40.f);
                    const unsigned long long bm = __ballot(skip_ok);
                    const int t0 = bm ? 2 * ((63 - __builtin_clzll(bm)) & 31) : 0;
                    attn_body::attn_unit<8, true>(b, qb, (const attn_body::bf16*)PROJ + 1536 + h * 64, (const attn_body::bf16*)PROJ + 2048 + h * 64, (const attn_body::bf16*)PROJ + 2560 + h * 64,
                                                  (attn_body::bf16*)ATT + 1024 + h * 64, kbr, t0, (char*)lds_raw, wave);
                }
            }
        }
    }
    SEAM(2);

    if (PH(3)) REPS(3) {
        LANE_TID;
        if (bx < 64) {
        { pg8::Gemm g{MEMN, Wckv_t, MM, D, D}; pg8::StaticOrder S; S.init(MM, D, G, bx);
          pg8::EpiBf16<0> E{CKb, D, nullptr, 0, 0, 1.f};
          pg8::gemm_phase<pg8::EpiBf16<0>, pg8::StaticOrder, true, true>(lds, g, S, E, wave); }
        { pg8::Gemm g{Wckv_t + (size_t)D * D, MEMN, D, MM, D}; pg8::StaticOrder S; S.init(D, MM, G, (bx + G - 32) % G);
          pg8::EpiBf16<0> E{CVT, MM, nullptr, 0, 0, 1.f};
          pg8::gemm_phase<pg8::EpiBf16<0>, pg8::StaticOrder, true, true>(lds, g, S, E, wave); }
        }
        const float sa = wave_sum(P.in[I_LQ1][lane] * P.in[I_LK1][lane]), sb = wave_sum(P.in[I_LQ2][lane] * P.in[I_LK2][lane]);
        const float lam = __expf(sa) - __expf(sb) + 0.2f;
        const f32x4 gs0 = *(const f32x4*)(P.in[I_GSUB] + (8 * lane) % 128), gs1 = *(const f32x4*)(P.in[I_GSUB] + (8 * lane) % 128 + 4);
        const f32x4 gf0 = *(const f32x4*)(P.in[I_GFOX] + (8 * lane) % 64), gf1 = *(const f32x4*)(P.in[I_GFOX] + (8 * lane) % 64 + 4);
        const int gw3 = (G > 64) ? (bx - 64) * NWAVES + wave : gw, NGW3 = (G > 64) ? (G - 64) * NWAVES : NGW;
        const bool xal3 = (G == 256); const int m3start = xal3 ? (bx & 7) * SEQ + ((bx - 64) >> 3) * NWAVES + wave : gw3, m3step = xal3 ? 24 * NWAVES : NGW3, m3end = xal3 ? (bx & 7) * SEQ + SEQ : M;
        if (G <= 64 || bx >= 64)
        for (int m = m3start; m < m3end; m += m3step) {
            const bf16* a = ATT + (size_t)m * NATT + 8 * lane;
            const v4u o1 = *(const v4u*)a, o2 = *(const v4u*)(a + 512), of = *(const v4u*)(a + 1024);
            float d[8], f[8];
#pragma unroll
            for (int e = 0; e < 4; ++e) { d[2 * e] = bflo(o1[e]) - lam * bflo(o2[e]); d[2 * e + 1] = bfhi(o1[e]) - lam * bfhi(o2[e]); f[2 * e] = bflo(of[e]); f[2 * e + 1] = bfhi(of[e]); }
            float sd = 0.f, sf = 0.f;
#pragma unroll
            for (int e = 0; e < 8; ++e) { sd += d[e] * d[e]; sf += f[e] * f[e]; }
            sd += __shfl_xor(sd, 1); sd += __shfl_xor(sd, 2); sd += __shfl_xor(sd, 4); sd += __shfl_xor(sd, 8);
            sf += __shfl_xor(sf, 1); sf += __shfl_xor(sf, 2); sf += __shfl_xor(sf, 4);
            const float rd = 0.8f / sqrtf(sd * (1.f / 128.f) + SUBLN_EPS), rf = 1.0f / sqrtf(sf * (1.f / 64.f) + EPS);
            v4u wd, wf;
            wd.x = pk2(d[0] * rd * gs0[0], d[1] * rd * gs0[1]); wd.y = pk2(d[2] * rd * gs0[2], d[3] * rd * gs0[3]); wd.z = pk2(d[4] * rd * gs1[0], d[5] * rd * gs1[1]); wd.w = pk2(d[6] * rd * gs1[2], d[7] * rd * gs1[3]);
            wf.x = pk2(f[0] * rf * gf0[0], f[1] * rf * gf0[1]); wf.y = pk2(f[2] * rf * gf0[2], f[3] * rf * gf0[3]); wf.z = pk2(f[4] * rf * gf1[0], f[5] * rf * gf1[1]); wf.w = pk2(f[6] * rf * gf1[2], f[7] * rf * gf1[3]);
            bf16* o = MIXA + (size_t)m * D + 8 * lane;
            *(v4u*)o = wd; *(v4u*)(o + 512) = wf;
        }
    }
    SEAM(3);

    if (PH(4)) REPS(4) { pg8::Gemm g{MIXA, Wout_t, M, D, D}; pg8::StaticOrder S; S.init(M, D, G, bx);
        pg8::EpiRes2<true, true> E{XN, H1B, SS1};
        pg8::gemm_phase<pg8::EpiRes2<true, true>, pg8::StaticOrder, true, true>(lds, g, S, E, wave); }
    SEAM(4);

    if (PH(5)) REPS(5) { pg8::Gemm g{H1B, Wcq_t, M, D, D}; pg8::StaticOrder S; S.init(M, D, G, bx);
        build_rstd_tables(lds, S, SS1, EPS, wave);
        pg8::EpiRowScale<0> E{CQ, D, SS1, EPS, pg8::CROSS_C2, (const LAS int*)(lds + RING_BYTES + 1536), (const LAS float*)(lds + RING_BYTES + 2048)};
        pg8::gemm_phase<pg8::EpiRowScale<0>, pg8::StaticOrder, true, true>(lds, g, S, E, wave); }
    SEAM(5);

    if (PH(6)) REPS(6) {
        const int upc = (512 + G - 1) / G;
        for (int u = vcu * upc; u < (vcu + 1) * upc && u < 512; ++u) { const int bh = u >> 4, qblk = u & 15; xattn::unit(bh >> 2, bh & 3, qblk, CQ, CKb, CVT, CO, lds, wave); }
    }
    SEAM(6);

    if (PH(7)) REPS(7) { pg8::Gemm g{CO, Wco_t, M, D, D}; pg8::StaticOrder S; S.init(M, D, G, bx);
        pg8::EpiRes2<true, true> E{H1B, H2B, SS2};
        pg8::gemm_phase<pg8::EpiRes2<true, true>, pg8::StaticOrder, true, true>(lds, g, S, E, wave); }
    SEAM(7);

    if (PH(8)) REPS(8) { pg8::Gemm g{H2B, Wup_t, M, FF, D}; pg8::StaticOrder S; S.init(M, FF, G, bx);
        build_rstd_tables(lds, S, SS2, EPS, wave);
        pg8::EpiRowScale<1> E{ZH, FF, SS2, EPS, 1.f, (const LAS int*)(lds + RING_BYTES + 1536), (const LAS float*)(lds + RING_BYTES + 2048)};
        pg8::gemm_phase<pg8::EpiRowScale<1>, pg8::StaticOrder, true, true>(lds, g, S, E, wave); }
    SEAM(8);

    if (PH(9)) REPS(9) { pg8::Gemm g{ZH, Wdn_t, M, D, FF}; pg8::StaticOrder S; S.init(M, D, G, bx); S.rev = true;
        pg8::EpiRes2<true, true> E{H2B, H1B  , SS3};
        pg8::gemm_phase<pg8::EpiRes2<true, true>, pg8::StaticOrder, true, true>(lds, g, S, E, wave); }
    SEAM(9);

    if (PH(10)) REPS(10) {
        LANE_TID;
        f32x4 gq[4];
#pragma unroll
        for (int j = 0; j < 4; ++j) gq[j] = ((const f32x4*)P.in[I_GFIN])[64 * j + lane];
        const bool xal = (G == 256); const int mstart = xal ? (bx & 7) * SEQ + ((bx >> 3) * NWAVES + wave) * 4 : gw * 4, mstep = xal ? 1024 : NGW * 4, mend = xal ? (bx & 7) * SEQ + SEQ : M;
        for (int m0 = mstart; m0 < mend; m0 += mstep) {
            unsigned long long w[4][4]; float rr[4];
#pragma unroll
            for (int q = 0; q < 4; ++q) { const unsigned long long* hb = (const unsigned long long*)(H1B + (size_t)(m0 + q) * D) + lane;
#pragma unroll
                for (int j = 0; j < 4; ++j) w[q][j] = hb[64 * j];
                rr[q] = pg8::row_rstd(SS3, m0 + q, EPS); }
#pragma unroll
            for (int q = 0; q < 4; ++q) { f32x4* o = (f32x4*)(P.out + (size_t)(m0 + q) * D) + lane;
#pragma unroll
                for (int j = 0; j < 4; ++j) { const unsigned lo = (unsigned)w[q][j], hi2 = (unsigned)(w[q][j] >> 32);
                    const f32x4 v = {bflo(lo), bfhi(lo), bflo(hi2), bfhi(hi2)}; o[64 * j] = v * rr[q] * gq[j]; } }
        }
    }
#undef IN
#undef SEAM
#undef LANE_TID
#undef ROPE
#undef LOGF
#undef KBIAS
#undef NRM
#undef SS1
#undef SS2
#undef SS3
#undef Win_t
#undef Wout_t
#undef Wcq_t
#undef Wckv_t
#undef Wco_t
#undef Wup_t
#undef Wdn_t
#undef MEMN
#undef CKb
#undef CVT
#undef XN
#undef MIXA
#undef CQ
#undef H2B
#undef H1B
#undef CO
#undef PROJ
#undef ATT
#undef ZH
}

extern "C" void kernel_launch(void* const* d_in, const int* in_sizes, int n_in, void* d_out, int out_size, void* d_ws, size_t ws_size, hipStream_t stream) {
    static int grid = 0;
    if (grid == 0) {
        if (n_in != 21 || in_sizes[0] != M * D || out_size != M * D || ws_size < WS_END) { fprintf(stderr, "kernel_launch: unexpected shapes (n_in %d, in0 %d, out %d, ws %zu); nothing launched\n", n_in, n_in > 0 ? in_sizes[0] : -1, out_size, ws_size); grid = -1; return; }
        int dev = 0, cus = 0, per_cu = 0;
        if (hipGetDevice(&dev) != hipSuccess || hipDeviceGetAttribute(&cus, hipDeviceAttributeMultiprocessorCount, dev) != hipSuccess) { grid = -1; return; }
        if (hipFuncSetAttribute((const void*)mk_fwd, hipFuncAttributeMaxDynamicSharedMemorySize, LDS_BYTES) != hipSuccess) { fprintf(stderr, "kernel_launch: hipFuncSetAttribute failed\n"); grid = -1; return; }
        if (hipOccupancyMaxActiveBlocksPerMultiprocessor(&per_cu, (const void*)mk_fwd, NWAVES * 64, LDS_BYTES) != hipSuccess || per_cu < 1) { fprintf(stderr, "kernel_launch: occupancy query says %d blocks per CU\n", per_cu); per_cu = 1; }
        (void)hipGetLastError();
        grid = cus * per_cu;
    }
    if (grid < 0) return;
    if (hipMemsetAsync((char*)d_ws + WS_BAR, 0, XCD_BAR_WORDS * 4, stream) != hipSuccess) { fprintf(stderr, "kernel_launch: memset of the barrier words failed\n"); return; }
    Params p{};
    for (int i = 0; i < 21; ++i) p.in[i] = (const float*)d_in[i];
    p.out = (float*)d_out; p.ws = (unsigned char*)d_ws;
#if MK_PER_PHASE
    for (int ph = 0; ph < N_PHASES; ++ph) { p.ph_lo = ph; p.ph_hi = ph + 1; hipLaunchKernelGGL(mk_fwd, dim3(grid), dim3(NWAVES * 64), LDS_BYTES, stream, p); }
#else
    p.ph_lo = 0; p.ph_hi = N_PHASES;
    void* args[] = {&p};
    const hipError_t e = hipLaunchCooperativeKernel((const void*)mk_fwd, dim3(grid), dim3(NWAVES * 64), args, LDS_BYTES, stream);
    if (e != hipSuccess) fprintf(stderr, "kernel_launch: cooperative launch failed: %s (grid %d)\n", hipGetErrorString(e), grid);
#endif
}
```
